# Optimizing an MI355X kernel written in HIP

```python
import jax, jax.numpy as jnp
from jax import lax
import numpy as np

D_MODEL = 2048
BATCH = 2
SEQ = 8192
DEPTH = 4

MLA_HEADS = 8
MLA_NOPE_DIM = 128
MLA_ROPE_DIM = 64
MLA_V_DIM = 128
Q_LORA_RANK = 512
KV_LORA_RANK = 256
MLA_WIDTH = MLA_HEADS * MLA_V_DIM
RET_HEADS = 8
RET_QK_DIM = 128
RET_V_DIM = 128
RET_WIDTH = RET_HEADS * RET_V_DIM
RET_CHUNK = 128
MIX_WIDTH = MLA_WIDTH + RET_WIDTH
D_FF = 4 * D_MODEL
Q_BLOCK = 128
ROPE_BASE = 10000.0
NORM_EPS = 1e-6
GROUPNORM_EPS = 1e-6
IN_WIDTHS = (Q_LORA_RANK, KV_LORA_RANK, MLA_ROPE_DIM,
             RET_HEADS * RET_QK_DIM, RET_HEADS * RET_QK_DIM, RET_WIDTH, RET_WIDTH)
IN_WIDTH = Q_LORA_RANK + KV_LORA_RANK + MLA_ROPE_DIM + 2 * RET_HEADS * RET_QK_DIM + 2 * RET_WIDTH

kernel_name = "hybrid_mla_retention_parallel_heads"


def _split_points():
    pts, acc = [], 0
    for w in IN_WIDTHS[:-1]:
        acc += w
        pts.append(acc)
    return pts


def rmsnorm(x, g):
    xf = x.astype(jnp.float32)
    y = xf * lax.rsqrt(jnp.mean(xf * xf, axis=-1, keepdims=True) + NORM_EPS)
    return (y * g.astype(jnp.float32)).astype(x.dtype)


def rope_tables(positions, dim):
    inv_freq = ROPE_BASE ** (-jnp.arange(0, dim, 2, dtype=jnp.float32) / dim)
    ang = positions.astype(jnp.float32)[..., None] * inv_freq
    return jnp.cos(ang), jnp.sin(ang)


def apply_rope(x, cos, sin):
    half = x.shape[-1] // 2
    x1, x2 = x[..., :half], x[..., half:]
    out = jnp.concatenate([x1 * cos - x2 * sin, x2 * cos + x1 * sin], axis=-1)
    return out.astype(x.dtype)


def mla_attention(c_q, c_kv, k_rope, q_norm_g, kv_norm_g, w_uq, w_ukv, cos, sin):
    B, S, _ = c_q.shape
    H, DN, DR, DV = MLA_HEADS, MLA_NOPE_DIM, MLA_ROPE_DIM, MLA_V_DIM
    q = (rmsnorm(c_q, q_norm_g) @ w_uq).reshape(B, S, H, DN + DR)
    q_nope = q[..., :DN]
    q_rope = apply_rope(q[..., DN:], cos[:, :, None, :], sin[:, :, None, :])
    kv = (rmsnorm(c_kv, kv_norm_g) @ w_ukv).reshape(B, S, H, DN + DV)
    k_nope, v = kv[..., :DN], kv[..., DN:]
    k_r = apply_rope(k_rope, cos, sin)
    scale = (DN + DR) ** -0.5
    nb = S // Q_BLOCK
    qn_blocks = q_nope.reshape(B, nb, Q_BLOCK, H, DN).transpose(1, 0, 2, 3, 4)
    qr_blocks = q_rope.reshape(B, nb, Q_BLOCK, H, DR).transpose(1, 0, 2, 3, 4)
    key_pos = jnp.arange(S)

    def one_block(args):
        qn, qr, blk = args
        s = (jnp.einsum('bqhd,bkhd->bhqk', qn, k_nope)
             + jnp.einsum('bqhr,bkr->bhqk', qr, k_r)).astype(jnp.float32) * scale
        q_pos = blk * Q_BLOCK + jnp.arange(Q_BLOCK)
        mask = key_pos[None, :] <= q_pos[:, None]
        s = jnp.where(mask[None, None], s, -jnp.inf)
        p = jax.nn.softmax(s, axis=-1).astype(v.dtype)
        return jnp.einsum('bhqk,bkhd->bqhd', p, v)

    out = lax.map(one_block, (qn_blocks, qr_blocks, jnp.arange(nb)))
    return out.transpose(1, 0, 2, 3, 4).reshape(B, S, H * DV)


def retention(rq, rk, rv, rg, cos, sin):
    B, S, _ = rq.shape
    H, DK, DV, C = RET_HEADS, RET_QK_DIM, RET_V_DIM, RET_CHUNK
    nc = S // C
    q = apply_rope(rq.reshape(B, S, H, DK), cos[:, :, None, :], sin[:, :, None, :]).astype(jnp.float32) * DK ** -0.5
    k = apply_rope(rk.reshape(B, S, H, DK), cos[:, :, None, :], sin[:, :, None, :]).astype(jnp.float32)
    v = rv.reshape(B, S, H, DV).astype(jnp.float32)
    log_gamma = jnp.log1p(-jnp.exp2(-5.0 - jnp.arange(H, dtype=jnp.float32)))
    idx = jnp.arange(C, dtype=jnp.float32)
    rel = idx[:, None] - idx[None, :]
    decay_intra = jnp.where(rel >= 0, jnp.exp(log_gamma[:, None, None] * jnp.maximum(rel, 0.0)), 0.0)
    xi = jnp.exp(log_gamma[:, None] * (idx + 1.0))
    zeta = jnp.exp(log_gamma[:, None] * (C - 1.0 - idx))
    chunk_decay = jnp.exp(log_gamma * C)

    def to_chunks(t, d):
        return t.reshape(B, nc, C, H, d).transpose(1, 0, 3, 2, 4)

    def step(state, qkv):
        qc, kc, vc = qkv
        scores = jnp.einsum('bhqd,bhkd->bhqk', qc, kc) * decay_intra[None]
        o = (jnp.einsum('bhqk,bhkv->bhqv', scores, vc)
             + jnp.einsum('bhqd,bhdv->bhqv', qc * xi[None, :, :, None], state))
        state = (chunk_decay[None, :, None, None] * state
                 + jnp.einsum('bhkd,bhkv->bhdv', kc * zeta[None, :, :, None], vc))
        return state, o

    state0 = jnp.zeros((B, H, DK, DV), jnp.float32)
    _, o = lax.scan(step, state0, (to_chunks(q, DK), to_chunks(k, DK), to_chunks(v, DV)))
    o = o.transpose(1, 0, 3, 2, 4).reshape(B, S, H, DV)
    mu = jnp.mean(o, axis=-1, keepdims=True)
    var = jnp.mean(jnp.square(o - mu), axis=-1, keepdims=True)
    o = ((o - mu) * lax.rsqrt(var + GROUPNORM_EPS)).reshape(B, S, H * DV)
    return (o * jax.nn.silu(rg.astype(jnp.float32))).astype(rq.dtype)


def setup_inputs(seed: int = 0) -> dict:
    key = jax.random.key(seed)
    ks = jax.random.split(key, 16)
    f32 = jnp.float32

    def w(k, shape, fan_in):
        return jax.random.normal(k, shape, f32) * fan_in ** -0.5

    def gain(k, shape):
        return 1.0 + 0.02 * jax.random.normal(k, shape, f32)

    x = jax.random.normal(ks[0], (BATCH, SEQ, D_MODEL), f32)
    positions = jnp.broadcast_to(jnp.arange(SEQ, dtype=jnp.int32), (BATCH, SEQ))
    return {
        "x": x,
        "positions": positions,
        "attn_norm": gain(ks[1], (DEPTH, D_MODEL)),
        "w_in": w(ks[2], (DEPTH, D_MODEL, IN_WIDTH), D_MODEL),
        "q_norm": gain(ks[3], (DEPTH, Q_LORA_RANK)),
        "kv_norm": gain(ks[4], (DEPTH, KV_LORA_RANK)),
        "w_uq": w(ks[5], (DEPTH, Q_LORA_RANK, MLA_HEADS * (MLA_NOPE_DIM + MLA_ROPE_DIM)), Q_LORA_RANK),
        "w_ukv": w(ks[6], (DEPTH, KV_LORA_RANK, MLA_HEADS * (MLA_NOPE_DIM + MLA_V_DIM)), KV_LORA_RANK),
        "beta_attn": gain(ks[7], (DEPTH, MLA_WIDTH)),
        "beta_ret": gain(ks[8], (DEPTH, RET_WIDTH)),
        "w_o": w(ks[9], (DEPTH, MIX_WIDTH, D_MODEL), MIX_WIDTH),
        "mlp_norm": gain(ks[10], (DEPTH, D_MODEL)),
        "w_up": w(ks[11], (DEPTH, D_MODEL, D_FF), D_MODEL),
        "w_down": w(ks[12], (DEPTH, D_FF, D_MODEL), D_FF),
        "final_norm": gain(ks[13], (D_MODEL,)),
    }


def reference(x, positions, attn_norm, w_in, q_norm, kv_norm, w_uq, w_ukv, beta_attn, beta_ret,
              w_o, mlp_norm, w_up, w_down, final_norm):
    cos64, sin64 = rope_tables(positions, MLA_ROPE_DIM)
    cos128, sin128 = rope_tables(positions, RET_QK_DIM)
    split_pts = _split_points()
    for l in range(DEPTH):
        h = rmsnorm(x, attn_norm[l])
        proj = h @ w_in[l]
        c_q, c_kv, k_rope, rq, rk, rv, rg = jnp.split(proj, split_pts, axis=-1)
        a = mla_attention(c_q, c_kv, k_rope, q_norm[l], kv_norm[l], w_uq[l], w_ukv[l], cos64, sin64)
        r = retention(rq, rk, rv, rg, cos128, sin128)
        mixed = jnp.concatenate([rmsnorm(a, beta_attn[l]), r * beta_ret[l]], axis=-1)
        x = x + mixed @ w_o[l]
        h = rmsnorm(x, mlp_norm[l])
        x = x + jnp.square(jax.nn.relu(h @ w_up[l])) @ w_down[l]
    return rmsnorm(x, final_norm)
```

```cpp
#include <hip/hip_runtime.h>
#include <cstdio>
#include <cstdint>
#include <cmath>
namespace pg8 {
#define PG8_LAS __attribute__((address_space(3)))
typedef unsigned short bf16_t;
typedef short bf16x8 __attribute__((ext_vector_type(8)));
typedef float f32x4 __attribute__((ext_vector_type(4)));
typedef unsigned u32x4 __attribute__((ext_vector_type(4)));
constexpr int BM = 256, BK = 64, HALF = 128, HTB = HALF * BK * 2  , STAGE_BYTES = 8 * HTB, NXCD = 8, WGM = 8;

__host__ __device__ __forceinline__ int lds_byte(int r, int c) { const int st = (r >> 4) * 2 + (c >> 5), rr = r & 15, cc = c & 31, ob = rr * 64 + cc * 2; return st * 1024 + (ob ^ (((ob >> 9) & 1) << 5)); }
__host__ __device__ __forceinline__ void stage_rc(int b, int& R, int& C) { const int st = b / 1024, sb = b % 1024, swz = sb ^ (((sb >> 9) & 1) << 5); R = (st >> 1) * 16 + swz / 64; C = (st & 1) * 32 + (swz % 64) / 2; }
__host__ __device__ __forceinline__ int perm32(int rho) { const int n = rho >> 4, i = rho & 15; return 8 * (i >> 2) + 4 * n + (i & 3); }

struct Unit { int pm, pn; };
struct Gemm { const bf16_t* A; const bf16_t* Bt; int M, N, K; };

struct StaticOrder {
    int nM, nN, nwg, G, c;
    __host__ __device__ void init(int M, int N, int G_, int c_) { nM = M / BM; nN = N / BM; nwg = nM * nN; G = G_; c = c_; }
    __host__ __device__ bool next(int i, Unit& u) const {
        const long L = (long)i * G + c; if (L >= nwg) return false;
        int wgid = (int)L; { const int q = nwg / NXCD, r = nwg % NXCD, xcd = wgid % NXCD, off = wgid / NXCD; wgid = (xcd < r ? xcd * (q + 1) : r * (q + 1) + (xcd - r) * q) + off; }
        const int nig = WGM * nN, gid = wgid / nig, fm = gid * WGM, gsz = (nM - fm) < WGM ? (nM - fm) : WGM;
        u.pm = fm + ((wgid % nig) % gsz); u.pn = (wgid % nig) / gsz; return true;
    }
    __device__ __forceinline__ void a_ready(const Unit&) const {}
    __device__ __forceinline__ void done(const Unit&) const {}
};

__device__ __forceinline__ unsigned cvt_pk_bf16(float lo, float hi) { unsigned r; asm volatile("v_cvt_pk_bf16_f32 %0, %1, %2" : "=v"(r) : "v"(lo), "v"(hi)); return r; }
typedef float f32x2 __attribute__((ext_vector_type(2)));
__device__ __forceinline__ f32x2 gelu_pk(f32x2 v) {
    const f32x2 av = __builtin_elementwise_abs(v), d = av * 0.2316418882f + 1.0f;
    f32x2 t; t.x = __builtin_amdgcn_rcpf(d.x); t.y = __builtin_amdgcn_rcpf(d.y);
    f32x2 q = t * 0.5307027145f + (-0.7265760135f); q = q * t + 0.7107068705f; q = q * t + (-0.142248368f); q = q * t + 0.127414796f; q = q * t;
    const f32x2 s = (v * v) * (-0.72134752044f);
    f32x2 e; e.x = __builtin_amdgcn_exp2f(s.x); e.y = __builtin_amdgcn_exp2f(s.y);
    const f32x2 m = v * (q * e), r = v - m;
    f32x2 o; o.x = v.x < 0.f ? m.x : r.x; o.y = v.y < 0.f ? m.y : r.y; return o;
}

template <int ACT  > struct EpiBf16 {
    static constexpr bool PERM = true, AFTER_DRAIN = false; static_assert(ACT == 0 || ACT == 1, "EpiBf16: ACT is 0 (none) or 1 (gelu_pk)");
    bf16_t* O; int ldc; const float* bias; int split_cols; size_t split_stride; float scale0;
    __device__ __forceinline__ void operator()(const f32x4 (&acc)[2][2][4][2], const Unit& u, int wr, int wc, int fr, int fq) const {
        const int row0 = u.pm * BM + wr * 64 + fr; int colt = u.pn * BM; bf16_t* base = O;
        float sc = 1.f; if (split_cols) { const int t = colt / split_cols; base += (size_t)t * split_stride; colt -= t * split_cols; if (t == 0) sc = scale0; }
        const int col0 = colt + wc * 32 + 8 * fq, bcol0 = u.pn * BM + wc * 32 + 8 * fq;
        f32x4 bv[2][2];
#pragma unroll
        for (int bj = 0; bj < 2; ++bj)
#pragma unroll
            for (int n = 0; n < 2; ++n) bv[bj][n] = bias ? *(const f32x4*)(bias + bcol0 + bj * HALF + 4 * n) : (f32x4){0.f, 0.f, 0.f, 0.f};
#pragma unroll
        for (int ai = 0; ai < 2; ++ai)
#pragma unroll
            for (int m = 0; m < 4; ++m) { bf16_t* rowp = base + (size_t)(row0 + ai * HALF + m * 16) * ldc + col0;
#pragma unroll
                for (int bj = 0; bj < 2; ++bj) { f32x4 v0 = acc[ai][bj][m][0] + bv[bj][0], v1 = acc[ai][bj][m][1] + bv[bj][1];
                    if (ACT == 1) { f32x2 a = gelu_pk((f32x2){v0[0], v0[1]}), b = gelu_pk((f32x2){v0[2], v0[3]}), c = gelu_pk((f32x2){v1[0], v1[1]}), d = gelu_pk((f32x2){v1[2], v1[3]});
                        v0 = (f32x4){a.x, a.y, b.x, b.y}; v1 = (f32x4){c.x, c.y, d.x, d.y}; }
                    v0 = v0 * sc; v1 = v1 * sc; u32x4 w; w.x = cvt_pk_bf16(v0[0], v0[1]); w.y = cvt_pk_bf16(v0[2], v0[3]); w.z = cvt_pk_bf16(v1[0], v1[1]); w.w = cvt_pk_bf16(v1[2], v1[3]);
                    *(u32x4*)(rowp + bj * HALF) = w; } }
    }
};

struct PanelStats {
    unsigned* xbuf;
    unsigned* cnt;
    unsigned* tmo;
    int ntn; float eps;
    unsigned code;
    __device__ __forceinline__ bool run(const f32x4 (&v)[2][2][4][2], const Unit& u, int wr, int wc, int fr, int fq, PG8_LAS unsigned char* lds, int wid, int lane) const {
        typedef float f32x2v __attribute__((ext_vector_type(2)));
        PG8_LAS f32x2v* P = (PG8_LAS f32x2v*)lds;
        PG8_LAS f32x2v* S = (PG8_LAS f32x2v*)(lds + 8192);
        PG8_LAS unsigned* flag = (PG8_LAS unsigned*)(lds + 8192 + 2048);
#pragma unroll
        for (int ai = 0; ai < 2; ++ai)
#pragma unroll
            for (int m = 0; m < 4; ++m) {
                float s = 0.f;
#pragma unroll
                for (int bj = 0; bj < 2; ++bj)
#pragma unroll
                    for (int n = 0; n < 2; ++n) { const f32x4 x = v[ai][bj][m][n]; s += (x[0] + x[1]) + (x[2] + x[3]); }
                s += __shfl_xor(s, 16); s += __shfl_xor(s, 32);
                const float mw = s * (1.0f / 64.0f); float q = 0.f;
#pragma unroll
                for (int bj = 0; bj < 2; ++bj)
#pragma unroll
                    for (int n = 0; n < 2; ++n) { const f32x4 d = v[ai][bj][m][n] - mw; q += (d[0] * d[0] + d[1] * d[1]) + (d[2] * d[2] + d[3] * d[3]); }
                q += __shfl_xor(q, 16); q += __shfl_xor(q, 32);
                if (fq == 0) P[(ai * HALF + wr * 64 + m * 16 + fr) * 4 + wc] = (f32x2v){mw, q};
            }
        asm volatile("s_waitcnt lgkmcnt(0)" ::: "memory"); __builtin_amdgcn_s_barrier(); asm volatile("" ::: "memory");
#if defined(BROKEN_EXCHANGE_NO_WAIT)
#warning BROKEN CONTROL BUILD: the row-statistics exchange does not wait; results are wrong by design
        if (blockIdx.x >= 64) { const long long t0_ = clock64(); while (clock64() - t0_ < 60000) __builtin_amdgcn_s_sleep(8); }
#endif
        const int row = wid * 32 + (lane & 31);
        if (lane < 32) {
            const f32x2v a = P[row * 4 + 0], b = P[row * 4 + 1], c = P[row * 4 + 2], d = P[row * 4 + 3];
            const float mt = (a.x + b.x + c.x + d.x) * 0.25f;
            const float da = a.x - mt, db = b.x - mt, dc = c.x - mt, dd = d.x - mt;
            const float m2 = (a.y + b.y) + (c.y + d.y) + 64.0f * ((da * da + db * db) + (dc * dc + dd * dd));
            unsigned long long* slot = (unsigned long long*)xbuf + ((size_t)(u.pm * BM + row) * 4 + u.pn);
            __hip_atomic_store(slot, ((unsigned long long)__float_as_uint(m2) << 32) | __float_as_uint(mt), __ATOMIC_RELAXED, __HIP_MEMORY_SCOPE_AGENT);
        }
        asm volatile("s_waitcnt vmcnt(0)" ::: "memory");
        if (lane == 0) __hip_atomic_fetch_add(cnt + 64 * u.pm, 1u, __ATOMIC_RELAXED, __HIP_MEMORY_SCOPE_AGENT);
        if (wid == 0) {
            bool dead = false; const unsigned long long t0 = __builtin_amdgcn_s_memrealtime(); const unsigned want = 8u * (unsigned)ntn;
            for (;;) {
#if defined(BROKEN_EXCHANGE_NO_WAIT)
                break;
#endif
                if ((unsigned)__builtin_amdgcn_readfirstlane(__hip_atomic_load(cnt + 64 * u.pm, __ATOMIC_RELAXED, __HIP_MEMORY_SCOPE_AGENT)) >= want) break;
                if (__builtin_amdgcn_s_memrealtime() - t0 > 2000000ull) {
                    if (lane == 0) { unsigned expect = 0u; __hip_atomic_compare_exchange_strong(tmo + 1, &expect, code | (unsigned)(u.pm & 0xff), __ATOMIC_RELAXED, __ATOMIC_RELAXED, __HIP_MEMORY_SCOPE_AGENT);
                                     __hip_atomic_store(tmo, 1u, __ATOMIC_RELAXED, __HIP_MEMORY_SCOPE_AGENT); }
                    dead = true; break; }
                __builtin_amdgcn_s_sleep(2);
            }
            __builtin_amdgcn_fence(__ATOMIC_ACQUIRE, "agent");
            if (lane == 0) flag[0] = dead ? 1u : 0u;
        }
        asm volatile("s_waitcnt vmcnt(0) lgkmcnt(0)" ::: "memory"); __builtin_amdgcn_s_barrier(); asm volatile("" ::: "memory");
        const bool bad = flag[0] != 0u;
        if (lane < 32) {
            const unsigned long long* slot = (const unsigned long long*)xbuf + (size_t)(u.pm * BM + row) * 4; float mt[4], m2[4]; float ms = 0.f;
#pragma unroll
            for (int t = 0; t < 4; ++t) { if (t < ntn) { const unsigned long long w = __hip_atomic_load(slot + t, __ATOMIC_RELAXED, __HIP_MEMORY_SCOPE_AGENT); mt[t] = __uint_as_float((unsigned)w); m2[t] = __uint_as_float((unsigned)(w >> 32)); } else { mt[t] = 0.f; m2[t] = 0.f; } ms += mt[t]; }
            const float mean = ms / (float)ntn; float q = 0.f;
#pragma unroll
            for (int t = 0; t < 4; ++t) if (t < ntn) { const float dm = mt[t] - mean; q += m2[t] + 256.0f * dm * dm; }
            S[row] = (f32x2v){mean, 1.0f / sqrtf(q / (256.0f * (float)ntn) + eps)};
        }
        asm volatile("s_waitcnt lgkmcnt(0)" ::: "memory"); __builtin_amdgcn_s_barrier(); asm volatile("" ::: "memory");
        return bad;
    }
};
struct EpiLnRes {
    static constexpr bool PERM = false, AFTER_DRAIN = true;
    const float* base; float* out; int ldc; const float* bias; PanelStats st; unsigned poison;
    __device__ __forceinline__ void fused(f32x4 (&acc)[2][2][4][2], const Unit& u, int wr, int wc, int fr, int fq, PG8_LAS unsigned char* lds, int wid, int lane) const {
        typedef float f32x2v __attribute__((ext_vector_type(2)));
        const PG8_LAS f32x2v* S = (const PG8_LAS f32x2v*)(lds + 8192);
        const int col0 = u.pn * BM + wc * 32 + 4 * fq;
#pragma unroll
        for (int bj = 0; bj < 2; ++bj)
#pragma unroll
            for (int n = 0; n < 2; ++n) { const f32x4 bv = bias ? *(const f32x4*)(bias + col0 + bj * HALF + n * 16) : (f32x4){0.f, 0.f, 0.f, 0.f};
#pragma unroll
                for (int ai = 0; ai < 2; ++ai)
#pragma unroll
                    for (int m = 0; m < 4; ++m) acc[ai][bj][m][n] += bv; }
        f32x4 pre[4][2][2];
#pragma unroll
        for (int m = 0; m < 4; ++m) { const size_t off = (size_t)(u.pm * BM + wr * 64 + m * 16 + fr) * ldc + col0;
#pragma unroll
            for (int bj = 0; bj < 2; ++bj)
#pragma unroll
                for (int n = 0; n < 2; ++n) pre[m][bj][n] = *(const f32x4*)(base + off + bj * HALF + n * 16); }
        const bool bad = st.run(acc, u, wr, wc, fr, fq, lds, wid, lane) || poison != 0u;
        const float qnan = __builtin_nanf("");
#pragma unroll
        for (int ai = 0; ai < 2; ++ai)
#pragma unroll
            for (int m = 0; m < 4; ++m) { const int r = ai * HALF + wr * 64 + m * 16 + fr; const f32x2v sr = S[r]; const size_t off = (size_t)(u.pm * BM + r) * ldc + col0;
#pragma unroll
                for (int bj = 0; bj < 2; ++bj)
#pragma unroll
                    for (int n = 0; n < 2; ++n) { const f32x4 bs = ai == 0 ? pre[m][bj][n] : *(const f32x4*)(base + off + bj * HALF + n * 16); f32x4 o = bs + (acc[ai][bj][m][n] - sr.x) * sr.y;
                        if (bad) o = (f32x4){qnan, qnan, qnan, qnan}; *(f32x4*)(out + off + bj * HALF + n * 16) = o; }
                if (m & 1) asm volatile("" ::: "memory"); }
    }
};
struct EpiLnResLn {
    static constexpr bool PERM = false, AFTER_DRAIN = true;
    const float* base; float* out; bf16_t* xn; int ldc; const float* bias; PanelStats st1, st2; unsigned poison;
    __device__ __forceinline__ void fused(f32x4 (&acc)[2][2][4][2], const Unit& u, int wr, int wc, int fr, int fq, PG8_LAS unsigned char* lds, int wid, int lane) const {
        typedef float f32x2v __attribute__((ext_vector_type(2))); typedef unsigned u32x2v __attribute__((ext_vector_type(2)));
        const PG8_LAS f32x2v* S = (const PG8_LAS f32x2v*)(lds + 8192);
        const int col0 = u.pn * BM + wc * 32 + 4 * fq;
#pragma unroll
        for (int bj = 0; bj < 2; ++bj)
#pragma unroll
            for (int n = 0; n < 2; ++n) { const f32x4 bv = bias ? *(const f32x4*)(bias + col0 + bj * HALF + n * 16) : (f32x4){0.f, 0.f, 0.f, 0.f};
#pragma unroll
                for (int ai = 0; ai < 2; ++ai)
#pragma unroll
                    for (int m = 0; m < 4; ++m) acc[ai][bj][m][n] += bv; }
        bool bad = st1.run(acc, u, wr, wc, fr, fq, lds, wid, lane) || poison != 0u;
        const float qnan = __builtin_nanf("");
#pragma unroll
        for (int ai = 0; ai < 2; ++ai)
#pragma unroll
            for (int m = 0; m < 4; ++m) { const int r = ai * HALF + wr * 64 + m * 16 + fr; const f32x2v sr = S[r]; const size_t off = (size_t)(u.pm * BM + r) * ldc + col0;
#pragma unroll
                for (int bj = 0; bj < 2; ++bj)
#pragma unroll
                    for (int n = 0; n < 2; ++n) { const f32x4 bs = *(const f32x4*)(base + off + bj * HALF + n * 16); acc[ai][bj][m][n] = bs + (acc[ai][bj][m][n] - sr.x) * sr.y; }
                asm volatile("" : "+v"(acc[ai][0][m][0]), "+v"(acc[ai][0][m][1]), "+v"(acc[ai][1][m][0]), "+v"(acc[ai][1][m][1]));
                if (m & 1) asm volatile("" ::: "memory"); }
        const bool bad1 = bad;
        bad = st2.run(acc, u, wr, wc, fr, fq, lds, wid, lane) || bad;
#pragma unroll
        for (int ai = 0; ai < 2; ++ai)
#pragma unroll
            for (int m = 0; m < 4; ++m) { const int r = ai * HALF + wr * 64 + m * 16 + fr; const f32x2v sr = S[r]; const size_t off = (size_t)(u.pm * BM + r) * ldc + col0;
#pragma unroll
                for (int bj = 0; bj < 2; ++bj)
#pragma unroll
                    for (int n = 0; n < 2; ++n) { const f32x4 x1 = acc[ai][bj][m][n]; *(f32x4*)(out + off + bj * HALF + n * 16) = bad1 ? (f32x4){qnan, qnan, qnan, qnan} : x1;
                        const f32x4 o = (x1 - sr.x) * sr.y; u32x2v w; w.x = cvt_pk_bf16(o[0], o[1]); w.y = cvt_pk_bf16(o[2], o[3]);
                        if (bad) { w.x = 0x7fc07fc0u; w.y = 0x7fc07fc0u; } *(u32x2v*)(xn + off + bj * HALF + n * 16) = w; }
                asm volatile("" ::: "memory"); }
    }
};

template <class Epi, class Sched, bool ALIGN_EPI = false, bool SP2 = false>
__device__ __forceinline__ void gemm_phase(PG8_LAS unsigned char* lds, const Gemm g, const Sched& S, const Epi& E) {
    int tid_l = threadIdx.x; asm volatile("" : "+v"(tid_l));
    const int tid = tid_l, wid = __builtin_amdgcn_readfirstlane(tid >> 6), lane = tid & 63, wr = wid >> 2, wc = wid & 3, fr = lane & 15, fq = lane >> 4;
    const int K = g.K, nt = K / BK;
    unsigned voffA[2], voffB[2];
#pragma unroll
    for (int i = 0; i < 2; ++i) { int R, C; stage_rc(tid * 16 + i * 8192, R, C); const int Rb = Epi::PERM ? ((R & ~31) + perm32(R & 31)) : R;
        voffA[i] = (unsigned)(R * K + C) * 2u; voffB[i] = (unsigned)(Rb * K + C) * 2u; }
    const size_t kstep = (size_t)(BK * 2);
    const size_t hstep = (size_t)HALF * K * 2;
    const size_t tstep = 2 * hstep;
    const unsigned ldsw = (unsigned)wid * 1024u;
    const int aoff = lds_byte(wr * 64 + fr, fq * 8), boff = lds_byte(wc * 32 + fr, fq * 8);
#define PG8_SA(b, h) (((b) * 2 + (h)) * HTB)
#define PG8_SB(b, h) ((4 + (b) * 2 + (h)) * HTB)
#define PG8_STAGE(bufoff, gbase, voff) do { _Pragma("unroll") for (int _i = 0; _i < 2; ++_i) \
        __builtin_amdgcn_global_load_lds((const unsigned*)((const char*)(gbase) + (voff)[_i]), (PG8_LAS unsigned*)(lds + (bufoff) + ldsw + _i * 8192), 16, 0, 0); } while (0)
#define PG8_LDA(dst, b, h) do { _Pragma("unroll") for (int m = 0; m < 4; ++m) _Pragma("unroll") for (int k = 0; k < 2; ++k) dst[m][k] = *(const PG8_LAS bf16x8*)(lds + PG8_SA(b, h) + aoff + m * 2048 + k * 1024); } while (0)
#define PG8_LDB(dst, b, h) do { _Pragma("unroll") for (int n = 0; n < 2; ++n) _Pragma("unroll") for (int k = 0; k < 2; ++k) dst[n][k] = *(const PG8_LAS bf16x8*)(lds + PG8_SB(b, h) + boff + n * 2048 + k * 1024); } while (0)
#define PG8_MMA(ai, bj, At, Bt) do { __builtin_amdgcn_s_setprio(1); _Pragma("unroll") for (int m = 0; m < 4; ++m) _Pragma("unroll") for (int n = 0; n < 2; ++n) _Pragma("unroll") for (int k = 0; k < 2; ++k) \
        acc[ai][bj][m][n] = __builtin_amdgcn_mfma_f32_16x16x32_bf16(Bt[n][k], At[m][k], acc[ai][bj][m][n], 0, 0, 0); __builtin_amdgcn_s_setprio(0); } while (0)
#define PG8_WAIT_V(n) asm volatile("s_waitcnt vmcnt(" #n ")" ::: "memory")
#define PG8_WAIT_L(n) asm volatile("s_waitcnt lgkmcnt(" #n ")" ::: "memory")
#define PG8_BAR __builtin_amdgcn_s_barrier()
#define PG8_SCHED __builtin_amdgcn_sched_barrier(0)
    Unit cur, nxt; int ui = 0;
    if (!S.next(0, cur)) return;
    f32x4 acc[2][2][4][2];
#pragma unroll
    for (int a = 0; a < 2; ++a)
#pragma unroll
        for (int b = 0; b < 2; ++b)
#pragma unroll
            for (int m = 0; m < 4; ++m)
#pragma unroll
                for (int n = 0; n < 2; ++n) acc[a][b][m][n] = (f32x4){0.f, 0.f, 0.f, 0.f};
    bf16x8 At[4][2], B0[2][2], B1[2][2];
    const char* cA = (const char*)g.A + (size_t)cur.pm * tstep; const char* cB = (const char*)g.Bt + (size_t)cur.pn * tstep;
    S.a_ready(cur);
    if constexpr (SP2) {
        PG8_STAGE(PG8_SB(0, 0), cB, voffB); PG8_STAGE(PG8_SB(0, 1), cB + hstep, voffB); PG8_STAGE(PG8_SA(0, 0), cA, voffA); PG8_STAGE(PG8_SA(0, 1), cA + hstep, voffA);
        if (wr == 1) PG8_BAR;
        PG8_WAIT_V(2); PG8_BAR;
        PG8_STAGE(PG8_SB(1, 0), cB + kstep, voffB); PG8_STAGE(PG8_SA(1, 0), cA + kstep, voffA); PG8_STAGE(PG8_SB(1, 1), cB + hstep + kstep, voffB);
        PG8_WAIT_V(6); PG8_BAR;
    } else {
        PG8_STAGE(PG8_SB(0, 0), cB, voffB); PG8_STAGE(PG8_SA(0, 0), cA, voffA); PG8_STAGE(PG8_SB(0, 1), cB + hstep, voffB); PG8_STAGE(PG8_SA(0, 1), cA + hstep, voffA);
        if (wr == 1) PG8_BAR;
        PG8_WAIT_V(4); PG8_BAR;
        PG8_STAGE(PG8_SB(1, 0), cB + kstep, voffB); PG8_STAGE(PG8_SA(1, 0), cA + kstep, voffA); PG8_STAGE(PG8_SB(1, 1), cB + hstep + kstep, voffB);
        PG8_WAIT_V(6); PG8_BAR;
    }
    for (;;) {
        const bool has_next = S.next(ui + 1, nxt);
        const char* nA = has_next ? (const char*)g.A + (size_t)nxt.pm * tstep : cA; const char* nB = has_next ? (const char*)g.Bt + (size_t)nxt.pn * tstep : cB;
        for (int t = 0; t < nt; t += 2) {
            const bool last = (t == nt - 2);
            const char* a1 = cA + (size_t)(t + 1) * kstep;
            const char* a2 = last ? nA : cA + (size_t)(t + 2) * kstep; const char* b2 = last ? nB : cB + (size_t)(t + 2) * kstep;
            const char* a3 = a2 + kstep; const char* b3 = b2 + kstep;
            if (last && has_next) S.a_ready(nxt);
            if constexpr (SP2) {
            PG8_LDB(B0, 0, 0); PG8_LDB(B1, 0, 1); PG8_SCHED; PG8_LDA(At, 0, 0); PG8_STAGE(PG8_SA(1, 1), a1 + hstep, voffA);
            PG8_WAIT_V(8); PG8_WAIT_L(0); PG8_BAR; PG8_MMA(0, 0, At, B0); PG8_MMA(0, 1, At, B1); PG8_BAR; PG8_SCHED;
            PG8_LDA(At, 0, 1); PG8_STAGE(PG8_SB(0, 0), b2, voffB); PG8_STAGE(PG8_SB(0, 1), b2 + hstep, voffB); PG8_STAGE(PG8_SA(0, 0), a2, voffA);
            PG8_WAIT_V(8); PG8_WAIT_L(0); PG8_BAR; PG8_MMA(1, 0, At, B0); PG8_MMA(1, 1, At, B1); PG8_BAR; PG8_SCHED;
            PG8_LDB(B0, 1, 0); PG8_LDB(B1, 1, 1); PG8_SCHED; PG8_LDA(At, 1, 0); PG8_STAGE(PG8_SA(0, 1), a2 + hstep, voffA);
            PG8_WAIT_V(8); PG8_WAIT_L(0); PG8_BAR; PG8_MMA(0, 0, At, B0); PG8_MMA(0, 1, At, B1); PG8_BAR; PG8_SCHED;
            PG8_LDA(At, 1, 1); PG8_STAGE(PG8_SB(1, 0), b3, voffB); PG8_STAGE(PG8_SB(1, 1), b3 + hstep, voffB); PG8_STAGE(PG8_SA(1, 0), a3, voffA);
            PG8_WAIT_V(8); PG8_WAIT_L(0); PG8_BAR; PG8_MMA(1, 0, At, B0); PG8_MMA(1, 1, At, B1); PG8_BAR; PG8_SCHED;
            } else {
            PG8_LDB(B0, 0, 0); PG8_SCHED; PG8_LDA(At, 0, 0); PG8_STAGE(PG8_SA(1, 1), a1 + hstep, voffA);
            PG8_WAIT_L(8); PG8_BAR; PG8_WAIT_L(0); PG8_MMA(0, 0, At, B0); PG8_BAR; PG8_SCHED;
            PG8_LDB(B1, 0, 1); PG8_STAGE(PG8_SB(0, 0), b2, voffB);
            PG8_BAR; PG8_WAIT_L(0); PG8_MMA(0, 1, At, B1); PG8_BAR;
            PG8_LDA(At, 0, 1); PG8_STAGE(PG8_SA(0, 0), a2, voffA);
            PG8_BAR; PG8_WAIT_L(0); PG8_MMA(1, 0, At, B0); PG8_BAR; PG8_SCHED;
            PG8_STAGE(PG8_SB(0, 1), b2 + hstep, voffB);
            PG8_WAIT_V(6); PG8_BAR; PG8_MMA(1, 1, At, B1); PG8_BAR;
            PG8_LDB(B0, 1, 0); PG8_SCHED; PG8_LDA(At, 1, 0); PG8_STAGE(PG8_SA(0, 1), a2 + hstep, voffA);
            PG8_WAIT_L(8); PG8_BAR; PG8_WAIT_L(0); PG8_MMA(0, 0, At, B0); PG8_BAR; PG8_SCHED;
            PG8_LDB(B1, 1, 1); PG8_STAGE(PG8_SB(1, 0), b3, voffB);
            PG8_BAR; PG8_WAIT_L(0); PG8_MMA(0, 1, At, B1); PG8_BAR;
            PG8_LDA(At, 1, 1); PG8_STAGE(PG8_SA(1, 0), a3, voffA);
            PG8_BAR; PG8_WAIT_L(0); PG8_MMA(1, 0, At, B0); PG8_BAR; PG8_SCHED;
            PG8_STAGE(PG8_SB(1, 1), b3 + hstep, voffB);
            PG8_WAIT_V(6); PG8_BAR; PG8_MMA(1, 1, At, B1); PG8_BAR;
            }
        }
        if constexpr (ALIGN_EPI) { if (wr == 0) PG8_BAR; }
        if constexpr (!Epi::AFTER_DRAIN) { E(acc, cur, wr, wc, fr, fq); S.done(cur); }
        if (!has_next) break;
#pragma unroll
        for (int a = 0; a < 2; ++a)
#pragma unroll
            for (int b = 0; b < 2; ++b)
#pragma unroll
                for (int m = 0; m < 4; ++m)
#pragma unroll
                    for (int n = 0; n < 2; ++n) acc[a][b][m][n] = (f32x4){0.f, 0.f, 0.f, 0.f};
        cur = nxt; cA = nA; cB = nB; ++ui;
        if constexpr (ALIGN_EPI) { if (wr == 1) PG8_BAR; }
    }
    PG8_WAIT_V(0);
    if constexpr (!ALIGN_EPI) { if (wr == 0) PG8_BAR; }
    PG8_BAR;
    if constexpr (Epi::AFTER_DRAIN) { E.fused(acc, cur, wr, wc, fr, fq, lds, wid, lane); S.done(cur); }
#undef PG8_SA
#undef PG8_SB
#undef PG8_STAGE
#undef PG8_LDA
#undef PG8_LDB
#undef PG8_MMA
#undef PG8_WAIT_V
#undef PG8_WAIT_L
#undef PG8_BAR
#undef PG8_SCHED
}
}
namespace pg8 {
__device__ __forceinline__ u32x4 pack8bf(const f32x4 a, const f32x4 b) { u32x4 w; w.x = cvt_pk_bf16(a[0], a[1]); w.y = cvt_pk_bf16(a[2], a[3]); w.z = cvt_pk_bf16(b[0], b[1]); w.w = cvt_pk_bf16(b[2], b[3]); return w; }
__device__ __forceinline__ void rope8(f32x4& v0, f32x4& v1, const f32x4 cs, const f32x4 sn) {
    float a, b;
    a = v0[0]; b = v0[1]; v0[0] = a * cs[0] - b * sn[0]; v0[1] = b * cs[0] + a * sn[0];
    a = v0[2]; b = v0[3]; v0[2] = a * cs[1] - b * sn[1]; v0[3] = b * cs[1] + a * sn[1];
    a = v1[0]; b = v1[1]; v1[0] = a * cs[2] - b * sn[2]; v1[1] = b * cs[2] + a * sn[2];
    a = v1[2]; b = v1[3]; v1[2] = a * cs[3] - b * sn[3]; v1[3] = b * cs[3] + a * sn[3];
}
__device__ __forceinline__ float silu_f(float x) { return x * __builtin_amdgcn_rcpf(1.0f + __builtin_amdgcn_exp2f(-1.4426950408889634f * x)); }

struct EpiIn {
    static constexpr bool PERM = true, AFTER_DRAIN = false;
    float* P1; bf16_t* RQ; bf16_t* RK; bf16_t* RV; bf16_t* RG; const float* c128; const float* s128;
    __device__ __forceinline__ void operator()(const f32x4 (&acc)[2][2][4][2], const Unit& u, int wr, int wc, int fr, int fq) const {
        const int pn = u.pn, row0 = u.pm * BM + wr * 64 + fr, cw = wc * 32 + 8 * fq;
        if (pn < 4) {
#pragma unroll
            for (int ai = 0; ai < 2; ++ai)
#pragma unroll
                for (int m = 0; m < 4; ++m) { float* rp = P1 + (size_t)(row0 + ai * HALF + m * 16) * 1024 + pn * 256 + cw;
#pragma unroll
                    for (int bj = 0; bj < 2; ++bj) { *(f32x4*)(rp + bj * HALF) = acc[ai][bj][m][0]; *(f32x4*)(rp + bj * HALF + 4) = acc[ai][bj][m][1]; } }
        } else if (pn < 12) {
            bf16_t* T = pn < 8 ? RQ : RK; const float sc = pn < 8 ? 0.08838834764831845f : 1.0f; const int ct = ((pn - 4) & 3) * 256 + cw, j0 = cw >> 1;
#pragma unroll
            for (int ai = 0; ai < 2; ++ai)
#pragma unroll
                for (int m = 0; m < 4; ++m) { const size_t row = (size_t)(row0 + ai * HALF + m * 16);
                    const f32x4 cs = *(const f32x4*)(c128 + row * 64 + j0), sn = *(const f32x4*)(s128 + row * 64 + j0);
#pragma unroll
                    for (int bj = 0; bj < 2; ++bj) { f32x4 v0 = acc[ai][bj][m][0], v1 = acc[ai][bj][m][1]; rope8(v0, v1, cs, sn); v0 = v0 * sc; v1 = v1 * sc;
                        *(u32x4*)(T + row * 1024 + ct + bj * HALF) = pack8bf(v0, v1); } }
        } else if (pn < 16) {
            const int ct = (pn - 12) * 256 + cw;
#pragma unroll
            for (int ai = 0; ai < 2; ++ai)
#pragma unroll
                for (int m = 0; m < 4; ++m) { bf16_t* rp = RV + (size_t)(row0 + ai * HALF + m * 16) * 1024 + ct;
#pragma unroll
                    for (int bj = 0; bj < 2; ++bj) *(u32x4*)(rp + bj * HALF) = pack8bf(acc[ai][bj][m][0], acc[ai][bj][m][1]); }
        } else {
            const int ct = (pn - 16) * 256 + cw;
#pragma unroll
            for (int ai = 0; ai < 2; ++ai)
#pragma unroll
                for (int m = 0; m < 4; ++m) { bf16_t* rp = RG + (size_t)(row0 + ai * HALF + m * 16) * 1024 + ct;
#pragma unroll
                    for (int bj = 0; bj < 2; ++bj) { f32x4 v0 = acc[ai][bj][m][0], v1 = acc[ai][bj][m][1];
#pragma unroll
                        for (int e = 0; e < 4; ++e) { v0[e] = silu_f(v0[e]); v1[e] = silu_f(v1[e]); }
                        *(u32x4*)(rp + bj * HALF) = pack8bf(v0, v1); } }
        }
    }
};
struct EpiQ {
    static constexpr bool PERM = true, AFTER_DRAIN = false;
    bf16_t* Q; const float* c64; const float* s64; float sc;
    __device__ __forceinline__ void operator()(const f32x4 (&acc)[2][2][4][2], const Unit& u, int wr, int wc, int fr, int fq) const {
        const int row0 = u.pm * BM + wr * 64 + fr, cw = wc * 32 + 8 * fq;
#pragma unroll
        for (int bj = 0; bj < 2; ++bj) { const int c0 = u.pn * 256 + bj * HALF + cw, dd = c0 % 192; const bool rp = dd >= 128; const int j0 = rp ? ((dd - 128) >> 1) : 0;
#pragma unroll
            for (int ai = 0; ai < 2; ++ai)
#pragma unroll
                for (int m = 0; m < 4; ++m) { const size_t row = (size_t)(row0 + ai * HALF + m * 16); f32x4 v0 = acc[ai][bj][m][0], v1 = acc[ai][bj][m][1];
                    if (rp) { const f32x4 cs = *(const f32x4*)(c64 + row * 32 + j0), sn = *(const f32x4*)(s64 + row * 32 + j0); rope8(v0, v1, cs, sn); }
                    v0 = v0 * sc; v1 = v1 * sc; *(u32x4*)(Q + row * 1536 + c0) = pack8bf(v0, v1); } }
    }
};
struct EpiKV {
    static constexpr bool PERM = true, AFTER_DRAIN = false;
    bf16_t* K; bf16_t* V;
    __device__ __forceinline__ void operator()(const f32x4 (&acc)[2][2][4][2], const Unit& u, int wr, int wc, int fr, int fq) const {
        const int row0 = u.pm * BM + wr * 64 + fr, cw = wc * 32 + 8 * fq;
#pragma unroll
        for (int ai = 0; ai < 2; ++ai)
#pragma unroll
            for (int m = 0; m < 4; ++m) { const size_t row = (size_t)(row0 + ai * HALF + m * 16);
                *(u32x4*)(K + row * 1536 + u.pn * 192 + cw) = pack8bf(acc[ai][0][m][0], acc[ai][0][m][1]);
                *(u32x4*)(V + row * 1024 + u.pn * 128 + cw) = pack8bf(acc[ai][1][m][0], acc[ai][1][m][1]); }
    }
};
struct EpiRes {
    static constexpr bool PERM = true, AFTER_DRAIN = false;
    const float* base; float* out; int ldc;
    __device__ __forceinline__ void operator()(const f32x4 (&acc)[2][2][4][2], const Unit& u, int wr, int wc, int fr, int fq) const {
        const int row0 = u.pm * BM + wr * 64 + fr, c0 = u.pn * BM + wc * 32 + 8 * fq;
#pragma unroll
        for (int ai = 0; ai < 2; ++ai)
#pragma unroll
            for (int m = 0; m < 4; ++m) { const size_t off = (size_t)(row0 + ai * HALF + m * 16) * ldc + c0;
#pragma unroll
                for (int bj = 0; bj < 2; ++bj) { const f32x4 b0 = *(const f32x4*)(base + off + bj * HALF), b1 = *(const f32x4*)(base + off + bj * HALF + 4);
                    *(f32x4*)(out + off + bj * HALF) = b0 + acc[ai][bj][m][0]; *(f32x4*)(out + off + bj * HALF + 4) = b1 + acc[ai][bj][m][1]; } }
    }
};
struct EpiRelu2 {
    static constexpr bool PERM = true, AFTER_DRAIN = false;
    bf16_t* O; int ldc;
    __device__ __forceinline__ void operator()(const f32x4 (&acc)[2][2][4][2], const Unit& u, int wr, int wc, int fr, int fq) const {
        const int row0 = u.pm * BM + wr * 64 + fr, c0 = u.pn * BM + wc * 32 + 8 * fq;
#pragma unroll
        for (int ai = 0; ai < 2; ++ai)
#pragma unroll
            for (int m = 0; m < 4; ++m) { bf16_t* rp = O + (size_t)(row0 + ai * HALF + m * 16) * ldc + c0;
#pragma unroll
                for (int bj = 0; bj < 2; ++bj) { f32x4 v0 = acc[ai][bj][m][0], v1 = acc[ai][bj][m][1];
#pragma unroll
                    for (int e = 0; e < 4; ++e) { const float a = fmaxf(v0[e], 0.f), b = fmaxf(v1[e], 0.f); v0[e] = a * a; v1[e] = b * b; }
                    *(u32x4*)(rp + bj * HALF) = pack8bf(v0, v1); } }
    }
};
}
constexpr int NWAVES = 8;
constexpr int BATCH = 2, SEQ = 8192, DM = 2048, DEPTH = 4, M = BATCH * SEQ;
constexpr int NH = 8, QLORA = 512, KVLORA = 256, DQK = 192, DNOPE = 128, DROPE = 64, DV = 128, FF = 8192;
constexpr int IN_SRC = 4928, IN_PAD = 5120;
constexpr int RCH = 128, NCH = SEQ / RCH;
constexpr float NORM_EPS = 1e-6f, GN_EPS = 1e-6f;
constexpr float QSCALE = 0.07216878364870323f * 1.4426950408889634f;

constexpr size_t MiB = 1u << 20;
constexpr size_t WS_CTL = 0, CTL_ZERO_BYTES = 1 * MiB;
constexpr size_t WS_C64 = 2 * MiB, WS_S64 = 4 * MiB, WS_C128 = 6 * MiB, WS_S128 = 10 * MiB;
constexpr size_t WS_WIN = 16 * MiB, WS_WUQ = 36 * MiB, WS_WUKV = 38 * MiB, WS_WO = 40 * MiB, WS_WUP = 48 * MiB, WS_WDN = 80 * MiB;
constexpr size_t WS_H = 112 * MiB;
constexpr size_t WS_MIX = 176 * MiB;
constexpr size_t WS_P1 = 240 * MiB;
constexpr size_t WS_RQ = 304 * MiB, WS_RK = 336 * MiB, WS_RV = 368 * MiB, WS_RG = 400 * MiB;
constexpr size_t WS_CQN = 432 * MiB, WS_CKVN = 448 * MiB;
constexpr size_t WS_Q = 456 * MiB, WS_K = 504 * MiB, WS_V = 552 * MiB;
constexpr size_t WS_U = 584 * MiB, WS_S = 648 * MiB;
constexpr size_t WS_UF = 240 * MiB;
constexpr size_t WS_END = 680 * MiB;
static_assert(WS_UF + (size_t)M * FF * 2 <= WS_END && WS_S + (size_t)16 * 64 * 16384 * 2 <= WS_END && WS_U + (size_t)16 * 64 * 16384 * 4 <= WS_S, "d_ws map");
static_assert(WS_WIN + (size_t)IN_PAD * DM * 2 <= WS_WUQ && WS_WUQ + (size_t)1536 * 512 * 2 <= WS_WUKV && WS_WUKV + (size_t)2048 * 256 * 2 <= WS_WO && WS_WO + (size_t)DM * DM * 2 <= WS_WUP && WS_WUP + (size_t)FF * DM * 2 <= WS_WDN && WS_WDN + (size_t)FF * DM * 2 <= WS_H, "weights map");
constexpr int CW_TMO = 0, CW_CODE = 1, CW_BAR = 4096;

constexpr int RING_OFF = 0, RING_BYTES = 131072;
constexpr int LDSCTL_OFF = RING_BYTES, MISC_OFF = LDSCTL_OFF + 320;
constexpr int LDS_BYTES = 147456;
static_assert(MISC_OFF + 128 <= LDS_BYTES, "LDS map");

#define GAS __attribute__((address_space(1)))
#define LAS __attribute__((address_space(3)))
typedef unsigned short bf16;
typedef unsigned v4u __attribute__((ext_vector_type(4)));
typedef float f32x4 __attribute__((ext_vector_type(4)));
typedef short bf16x8 __attribute__((ext_vector_type(8)));
typedef GAS unsigned gu32;
typedef GAS unsigned long long gu64;
#define RLX_AGENT __ATOMIC_RELAXED, __HIP_MEMORY_SCOPE_AGENT
#define LDS_WAIT() asm volatile("s_waitcnt lgkmcnt(0)" ::: "memory")
#define VM_WAIT() asm volatile("s_waitcnt vmcnt(0)" ::: "memory")
__device__ __forceinline__ unsigned long long rt() { return __builtin_amdgcn_s_memrealtime(); }
__device__ __forceinline__ unsigned f2bf(float f) { unsigned u = __builtin_bit_cast(unsigned, f); return (u + 0x7fffu + ((u >> 16) & 1u)) >> 16; }
__device__ __forceinline__ unsigned pk2(float lo, float hi) { return f2bf(lo) | (f2bf(hi) << 16); }

#define XB_TMO      128
#define XB_XCNT(j)  (256  + 64 * (j))
#define XB_XSUB(j)  (1280 + 64 * (j))
#define XB_XGEN(j)  (2304 + 64 * (j))
#define XB_TOP      3328
#define XB_TOPGEN   3392
#define XCD_BAR_WORDS 3456
#define XB_SPIN_CAP (1u << 18)

__device__ __forceinline__ unsigned xb_ld(unsigned* p)              { return __hip_atomic_load(p, __ATOMIC_RELAXED, __HIP_MEMORY_SCOPE_AGENT); }
__device__ __forceinline__ unsigned xb_add(unsigned* p, unsigned v) { return __hip_atomic_fetch_add(p, v, __ATOMIC_RELAXED, __HIP_MEMORY_SCOPE_AGENT); }
__device__ __forceinline__ unsigned xb_xcc_id() { return (unsigned)__builtin_amdgcn_s_getreg((3 << 11) | 20) & 0xFu; }
#define XB_SPIN(cond, bar) do { unsigned _sp = 0; while (cond) { __builtin_amdgcn_s_sleep(1); \
    if ((++_sp & 255u) == 0u) { if (xb_ld(&(bar)[XB_TMO])) break; if (_sp > XB_SPIN_CAP) { atomicAdd(&(bar)[XB_TMO], 1u); break; } } } } while (0)

struct XcdBarrier {
    unsigned* bar; unsigned x;
    volatile LAS unsigned* st;
};

__device__ __forceinline__ XcdBarrier xcd_barrier_post(unsigned* bar, volatile LAS unsigned* st) {
    XcdBarrier b; b.bar = bar; b.x = xb_xcc_id(); b.st = st;
    if (threadIdx.x == 0) (void)xb_add(&bar[XB_XCNT(b.x)], 1u);
    return b;
}
__device__ __forceinline__ void xcd_barrier_complete(unsigned* bar, unsigned x, unsigned& nloc, unsigned& nx) {
    const unsigned G = gridDim.x * gridDim.y * gridDim.z;
    unsigned sum, cnt, mine, sp = 0u;
    for (;;) {
        sum = 0u; cnt = 0u; mine = 0u;
#pragma unroll
        for (unsigned j = 0; j < 16; ++j) { const unsigned c = xb_ld(&bar[XB_XCNT(j)]); sum += c; cnt += (c > 0u) ? 1u : 0u; mine = (j == x) ? c : mine; }
        if (sum == G) break;
        __builtin_amdgcn_s_sleep(1);
        if ((++sp & 255u) == 0u) { if (xb_ld(&bar[XB_TMO])) break; if (sp > XB_SPIN_CAP) { atomicAdd(&bar[XB_TMO], 1u); break; } }
    }
    nloc = mine > 0u ? mine : 1u; nx = cnt > 0u ? cnt : 1u;
}

__device__ __forceinline__ void xcd_barrier(const XcdBarrier& b) {
    asm volatile("s_waitcnt vmcnt(0)" ::: "memory");
    __syncthreads();
    if (threadIdx.x == 0) {
        unsigned* bar = b.bar;
        __builtin_amdgcn_s_waitcnt(0);
        unsigned nloc = b.st[0], nx = b.st[1];
        if (nloc == 0u) { xcd_barrier_complete(bar, b.x, nloc, nx); b.st[0] = nloc; b.st[1] = nx; }
        const unsigned old = xb_add(&bar[XB_XSUB(b.x)], 1u);
        const unsigned gen = old / nloc;
        if (old + 1u == (gen + 1u) * nloc) {
            __builtin_amdgcn_fence(__ATOMIC_RELEASE, "agent");
            asm volatile("s_waitcnt vmcnt(0)" ::: "memory");
            const unsigned og = xb_add(&bar[XB_TOP], 1u);
            const unsigned tg = og / nx;
            if (og + 1u == (tg + 1u) * nx) xb_add(&bar[XB_TOPGEN], 1u);
            else XB_SPIN(xb_ld(&bar[XB_TOPGEN]) == tg, bar);
            __builtin_amdgcn_fence(__ATOMIC_ACQUIRE, "agent");
            xb_add(&bar[XB_XGEN(b.x)], 1u);
            asm volatile("s_waitcnt vmcnt(0)" ::: "memory");
        } else {
            XB_SPIN(xb_ld(&bar[XB_XGEN(b.x)]) == gen, bar);
            __builtin_amdgcn_fence(__ATOMIC_ACQUIRE, "agent");
            asm volatile("s_waitcnt vmcnt(0)" ::: "memory");
        }
    }
    __syncthreads();
}

typedef short s16x4 __attribute__((ext_vector_type(4)));
typedef float f32x16 __attribute__((ext_vector_type(16)));
typedef float f32x2 __attribute__((ext_vector_type(2)));
typedef LAS unsigned char* ldsp;
typedef const LAS unsigned char* cldsp;
#define SBARRIER() do { __builtin_amdgcn_s_barrier(); asm volatile("" ::: "memory"); } while (0)
__device__ __forceinline__ float wave_sum(float v) {
#pragma unroll
    for (int o = 1; o < 64; o <<= 1) v += __shfl_xor(v, o);
    return v;
}
__device__ __forceinline__ unsigned cvtpk(float lo, float hi) { unsigned r; asm volatile("v_cvt_pk_bf16_f32 %0, %1, %2" : "=v"(r) : "v"(lo), "v"(hi)); return r; }
__device__ __forceinline__ float bf_lo(unsigned w) { return __builtin_bit_cast(float, w << 16); }
__device__ __forceinline__ float bf_hi(unsigned w) { return __builtin_bit_cast(float, w & 0xffff0000u); }
__device__ __forceinline__ int crow(int r, int hi) { return (r & 3) + 8 * (r >> 2) + 4 * hi; }
__device__ __forceinline__ void glds16(const void* g, ldsp l) { __builtin_amdgcn_global_load_lds((const unsigned*)g, (LAS unsigned*)l, 16, 0, 0); }
typedef short v4i16_t __attribute__((ext_vector_type(4)));
__device__ __forceinline__ s16x4 trrd(cldsp p) { return __builtin_bit_cast(s16x4, __builtin_amdgcn_ds_read_tr16_b64_v4i16((LAS v4i16_t*)p)); }
#define MK8(lo, hi) ((bf16x8){(lo)[0], (lo)[1], (lo)[2], (lo)[3], (hi)[0], (hi)[1], (hi)[2], (hi)[3]})
__device__ __forceinline__ bf16x8 pack8f(const f32x16& p, int b) {
    v4u w; w.x = cvtpk(p[b], p[b + 1]); w.y = cvtpk(p[b + 2], p[b + 3]); w.z = cvtpk(p[b + 4], p[b + 5]); w.w = cvtpk(p[b + 6], p[b + 7]); return __builtin_bit_cast(bf16x8, w);
}
#define MFMA32(a, b, c) __builtin_amdgcn_mfma_f32_32x32x16_bf16((a), (b), (c), 0, 0, 0)
__device__ __forceinline__ int tr_att_base(int lane) { return (4 * (lane >> 5) + ((lane & 15) >> 2)) * 64 + ((lane >> 4) & 1) * 32 + (lane & 3) * 8; }
__device__ __forceinline__ int tr_nat_base(int lane) { return (8 * (lane >> 5) + ((lane & 15) >> 2)) * 64 + ((lane >> 4) & 1) * 32 + (lane & 3) * 8; }

struct Args {
    const float* x; const int* pos; const float* attn_norm; const float* w_in; const float* q_norm; const float* kv_norm; const float* w_uq; const float* w_ukv;
    const float* beta_attn; const float* beta_ret; const float* w_o; const float* mlp_norm; const float* w_up; const float* w_down; const float* final_norm;
    float* out; unsigned char* ws;
    double invf64[32]; double invf128[64];
    float lg2g[8];
};
static_assert(sizeof(Args) == 17 * 8 + 96 * 8 + 32, "Args has no padding");
typedef const __attribute__((address_space(4))) Args* cargs_t;
__device__ __forceinline__ cargs_t get_args() { cargs_t p = (cargs_t)__builtin_amdgcn_kernarg_segment_ptr(); asm volatile("" : "+s"(p)); return p; }

__device__ __forceinline__ void sincos_d(double ang, float& s, float& c) {
    const double k = __builtin_rint(ang * 0.63661977236758134308);
    double y = __builtin_fma(-k, 1.57079632679489655800e+00, ang); y = __builtin_fma(-k, 6.12323399573676603587e-17, y);
    const double z = y * y;
    double sp = 1.0 / 6227020800.0; sp = sp * z - 1.0 / 39916800.0; sp = sp * z + 1.0 / 362880.0; sp = sp * z - 1.0 / 5040.0; sp = sp * z + 1.0 / 120.0; sp = sp * z - 1.0 / 6.0; sp = sp * z + 1.0; sp = sp * y;
    double cp = -1.0 / 87178291200.0; cp = cp * z + 1.0 / 479001600.0; cp = cp * z - 1.0 / 3628800.0; cp = cp * z + 1.0 / 40320.0; cp = cp * z - 1.0 / 720.0; cp = cp * z + 1.0 / 24.0; cp = cp * z - 0.5; cp = cp * z + 1.0;
    const int q = (int)((long long)k & 3);
    const double ss = (q == 0) ? sp : (q == 1) ? cp : (q == 2) ? -sp : -cp;
    const double cc = (q == 0) ? cp : (q == 1) ? -sp : (q == 2) ? -cp : sp;
    s = (float)ss; c = (float)cc;
}
__device__ __forceinline__ void rope_tables(cargs_t a, int gtid, int nthr) {
    unsigned char* ws = a->ws; const int* pos = a->pos;
    float* c64 = (float*)(ws + WS_C64); float* s64 = (float*)(ws + WS_S64); float* c128 = (float*)(ws + WS_C128); float* s128 = (float*)(ws + WS_S128);
    for (int i = gtid; i < M * 96; i += nthr) { const int m = i / 96, j = i - m * 96; const double p = (double)pos[m]; float s, c;
        if (j < 32) { sincos_d(p * a->invf64[j], s, c); c64[m * 32 + j] = c; s64[m * 32 + j] = s; }
        else { sincos_d(p * a->invf128[j - 32], s, c); c128[m * 64 + j - 32] = c; s128[m * 64 + j - 32] = s; } }
}
template <class Map>
__device__ __forceinline__ void transpose_item(const float* W, int K, int N, bf16* WT, const Map& map, LAS float* scr, int item, int lane) {
    const int nblk = N / 32, kb = item / nblk, nb = item % nblk, k0 = 64 * kb, n0 = 32 * nb;
#pragma unroll 8
    for (int i = 0; i < 32; ++i) { const int kk = 2 * i + (lane >> 5); scr[kk * 33 + (lane & 31)] = W[(size_t)(k0 + kk) * N + n0 + (lane & 31)]; }
    LDS_WAIT(); asm volatile("" ::: "memory");
    const int c = lane & 7;
#pragma unroll
    for (int j = 0; j < 4; ++j) { const int n = (lane >> 3) + 8 * j; const LAS float* s = scr + (8 * c) * 33 + n;
        v4u o; o.x = pk2(s[0 * 33], s[1 * 33]); o.y = pk2(s[2 * 33], s[3 * 33]); o.z = pk2(s[4 * 33], s[5 * 33]); o.w = pk2(s[6 * 33], s[7 * 33]);
        *(GAS v4u*)(WT + (size_t)map(n0 + n) * K + k0 + 8 * c) = o; }
    LDS_WAIT(); asm volatile("" ::: "memory");
}
struct MapId { __device__ __forceinline__ int operator()(int n) const { return n; } };
struct MapWin {
    __device__ __forceinline__ int operator()(int n) const {
        if (n < 832) return n;
        if (n < 2880) { const int e = n - 832, g = e >> 7, d = e & 127; return 1024 + g * 128 + (d < 64 ? 2 * d : 2 * (d - 64) + 1); }
        return n + 192;
    }
};
struct MapWuq {
    __device__ __forceinline__ int operator()(int n) const { const int h = n / 192, d = n - h * 192; if (d < 128) return n; const int e = d - 128; return h * 192 + 128 + (e < 32 ? 2 * e : 2 * (e - 32) + 1); }
};
__device__ __forceinline__ void convert_weights(cargs_t a, int l, ldsp lds, int gw, int ngw, int wave, int lane, int gtid, int nthr) {
    unsigned char* ws = a->ws;
    LAS float* scr = (LAS float*)(lds + RING_OFF + wave * 16384);
    bf16* Win = (bf16*)(ws + WS_WIN); bf16* Wuq = (bf16*)(ws + WS_WUQ); bf16* Wukv = (bf16*)(ws + WS_WUKV); bf16* Wo = (bf16*)(ws + WS_WO); bf16* Wup = (bf16*)(ws + WS_WUP); bf16* Wdn = (bf16*)(ws + WS_WDN);
    const float* w_in = a->w_in + (size_t)l * DM * IN_SRC; const float* w_uq = a->w_uq + (size_t)l * QLORA * 1536; const float* w_ukv = a->w_ukv + (size_t)l * KVLORA * 2048;
    const float* w_o = a->w_o + (size_t)l * DM * DM; const float* w_up = a->w_up + (size_t)l * DM * FF; const float* w_dn = a->w_down + (size_t)l * FF * DM;
    constexpr int I_IN = (DM / 64) * (IN_SRC / 32), I_UQ = (QLORA / 64) * (1536 / 32), I_UKV = (KVLORA / 64) * (2048 / 32), I_O = (DM / 64) * (DM / 32), I_UP = (DM / 64) * (FF / 32), I_DN = (FF / 64) * (DM / 32);
    constexpr int NITEMS = I_IN + I_UQ + I_UKV + I_O + I_UP + I_DN;
    for (int it = gw; it < NITEMS; it += ngw) {
        int r = it;
        if (r < I_IN) { transpose_item(w_in, DM, IN_SRC, Win, MapWin(), scr, r, lane); continue; } r -= I_IN;
        if (r < I_UQ) { transpose_item(w_uq, QLORA, 1536, Wuq, MapWuq(), scr, r, lane); continue; } r -= I_UQ;
        if (r < I_UKV) { transpose_item(w_ukv, KVLORA, 2048, Wukv, MapId(), scr, r, lane); continue; } r -= I_UKV;
        if (r < I_O) { transpose_item(w_o, DM, DM, Wo, MapId(), scr, r, lane); continue; } r -= I_O;
        if (r < I_UP) { transpose_item(w_up, DM, FF, Wup, MapId(), scr, r, lane); continue; } r -= I_UP;
        transpose_item(w_dn, FF, DM, Wdn, MapId(), scr, r, lane);
    }
    GAS v4u* pz = (GAS v4u*)(Win + (size_t)832 * DM);
    for (int i = gtid; i < 192 * DM / 8; i += nthr) pz[i] = (v4u){0u, 0u, 0u, 0u};
}
__device__ __forceinline__ void rms_row_2048(const float* xrow, const float* g, bf16* orow, int lane) {
    const GAS f32x4* xr = (const GAS f32x4*)xrow + lane; const GAS f32x4* gr = (const GAS f32x4*)g + lane;
    f32x4 v[8]; float s = 0.f;
#pragma unroll
    for (int j = 0; j < 8; ++j) { v[j] = xr[64 * j]; s += (v[j].x * v[j].x + v[j].y * v[j].y) + (v[j].z * v[j].z + v[j].w * v[j].w); }
    const float r = 1.0f / sqrtf(wave_sum(s) * (1.0f / DM) + NORM_EPS);
    GAS unsigned long long* o8 = (GAS unsigned long long*)orow + lane;
#pragma unroll
    for (int j = 0; j < 8; ++j) { const f32x4 gg = gr[64 * j]; o8[64 * j] = (unsigned long long)cvtpk(v[j].x * r * gg.x, v[j].y * r * gg.y) | ((unsigned long long)cvtpk(v[j].z * r * gg.z, v[j].w * r * gg.w) << 32); }
}
__device__ __forceinline__ void rms_row_final(float* xrow, const float* g, int lane) {
    GAS f32x4* xr = (GAS f32x4*)xrow + lane; const GAS f32x4* gr = (const GAS f32x4*)g + lane;
    f32x4 v[8]; float s = 0.f;
#pragma unroll
    for (int j = 0; j < 8; ++j) { v[j] = xr[64 * j]; s += (v[j].x * v[j].x + v[j].y * v[j].y) + (v[j].z * v[j].z + v[j].w * v[j].w); }
    const float r = 1.0f / sqrtf(wave_sum(s) * (1.0f / DM) + NORM_EPS);
#pragma unroll
    for (int j = 0; j < 8; ++j) { const f32x4 gg = gr[64 * j]; xr[64 * j] = (f32x4){v[j].x * r * gg.x, v[j].y * r * gg.y, v[j].z * r * gg.z, v[j].w * r * gg.w}; }
}
__device__ __forceinline__ void lowrank_row(unsigned char* ws, const float* gq, const float* gkv, int row, int lane) {
    const float* p = (const float*)(ws + WS_P1) + (size_t)row * 1024;
    const f32x4 q0 = *(const GAS f32x4*)(p + lane * 4), q1 = *(const GAS f32x4*)(p + 256 + lane * 4), kv = *(const GAS f32x4*)(p + 512 + lane * 4);
    const float sq = wave_sum((q0.x * q0.x + q0.y * q0.y) + (q0.z * q0.z + q0.w * q0.w) + (q1.x * q1.x + q1.y * q1.y) + (q1.z * q1.z + q1.w * q1.w));
    const float skv = wave_sum((kv.x * kv.x + kv.y * kv.y) + (kv.z * kv.z + kv.w * kv.w));
    const float rq = 1.0f / sqrtf(sq * (1.0f / QLORA) + NORM_EPS), rkv = 1.0f / sqrtf(skv * (1.0f / KVLORA) + NORM_EPS);
    const f32x4 g0 = *(const GAS f32x4*)(gq + lane * 4), g1 = *(const GAS f32x4*)(gq + 256 + lane * 4), g2 = *(const GAS f32x4*)(gkv + lane * 4);
    bf16* cq = (bf16*)(ws + WS_CQN) + (size_t)row * QLORA; bf16* ckv = (bf16*)(ws + WS_CKVN) + (size_t)row * KVLORA;
    *(GAS unsigned long long*)(cq + lane * 4) = (unsigned long long)cvtpk(q0.x * rq * g0.x, q0.y * rq * g0.y) | ((unsigned long long)cvtpk(q0.z * rq * g0.z, q0.w * rq * g0.w) << 32);
    *(GAS unsigned long long*)(cq + 256 + lane * 4) = (unsigned long long)cvtpk(q1.x * rq * g1.x, q1.y * rq * g1.y) | ((unsigned long long)cvtpk(q1.z * rq * g1.z, q1.w * rq * g1.w) << 32);
    *(GAS unsigned long long*)(ckv + lane * 4) = (unsigned long long)cvtpk(kv.x * rkv * g2.x, kv.y * rkv * g2.y) | ((unsigned long long)cvtpk(kv.z * rkv * g2.z, kv.w * rkv * g2.w) << 32);
    if (lane < 32) {
        const float x1 = p[768 + lane], x2 = p[800 + lane];
        const float c = ((const float*)(ws + WS_C64))[(size_t)row * 32 + lane], s = ((const float*)(ws + WS_S64))[(size_t)row * 32 + lane];
        const unsigned w = cvtpk(x1 * c - x2 * s, x2 * c + x1 * s);
        bf16* kr = (bf16*)(ws + WS_K) + (size_t)row * 1536 + 128 + 2 * lane;
#pragma unroll
        for (int h = 0; h < NH; ++h) *(GAS unsigned*)(kr + h * 192) = w;
    }
}
__device__ __forceinline__ void attn_norm_row(bf16* mix, const float* g, int row, int lane) {
    bf16* p = mix + (size_t)row * DM;
    v4u w[2]; float f[16]; float s = 0.f;
#pragma unroll
    for (int j = 0; j < 2; ++j) { w[j] = *(const GAS v4u*)(p + j * 512 + lane * 8);
        f[j * 8 + 0] = bf_lo(w[j].x); f[j * 8 + 1] = bf_hi(w[j].x); f[j * 8 + 2] = bf_lo(w[j].y); f[j * 8 + 3] = bf_hi(w[j].y);
        f[j * 8 + 4] = bf_lo(w[j].z); f[j * 8 + 5] = bf_hi(w[j].z); f[j * 8 + 6] = bf_lo(w[j].w); f[j * 8 + 7] = bf_hi(w[j].w); }
#pragma unroll
    for (int e = 0; e < 16; ++e) s += f[e] * f[e];
    const float r = 1.0f / sqrtf(wave_sum(s) * (1.0f / 1024.0f) + NORM_EPS);
#pragma unroll
    for (int j = 0; j < 2; ++j) { const f32x4 ga = *(const GAS f32x4*)(g + j * 512 + lane * 8), gb = *(const GAS f32x4*)(g + j * 512 + lane * 8 + 4);
        v4u o; o.x = cvtpk(f[j * 8 + 0] * r * ga.x, f[j * 8 + 1] * r * ga.y); o.y = cvtpk(f[j * 8 + 2] * r * ga.z, f[j * 8 + 3] * r * ga.w);
        o.z = cvtpk(f[j * 8 + 4] * r * gb.x, f[j * 8 + 5] * r * gb.y); o.w = cvtpk(f[j * 8 + 6] * r * gb.z, f[j * 8 + 7] * r * gb.w);
        *(GAS v4u*)(p + j * 512 + lane * 8) = o; }
}

constexpr int AT_KSLOT = 64 * DQK * 2, AT_VSLOT = 64 * DV * 2, AT_K = 0, AT_V = 2 * AT_KSLOT, AT_WS = AT_V + 2 * AT_VSLOT, AT_BYTES = AT_WS + NWAVES * 256;
static_assert(AT_BYTES <= RING_BYTES, "attention LDS");
__device__ __forceinline__ void attn_unit(const bf16* Qg, const bf16* Kg, const bf16* Vg, bf16* Og, int b, int h, int qb, ldsp lds, int tid) {
    const int lane = tid & 63, r32 = lane & 31, hi = lane >> 5; const int wid = __builtin_amdgcn_readfirstlane(tid >> 6);
    const size_t rowbase = (size_t)b * SEQ; const int q0 = qb * 256, NT = (q0 + 256) / 64, qw0 = q0 + wid * 32;
    const bf16* Kh = Kg + rowbase * 1536 + h * DQK; const bf16* Vh = Vg + rowbase * 1024 + h * DV;
    LAS float* wsf = (LAS float*)(lds + AT_WS) + wid * 64;
#define AT_DMA(t, s) do { const bf16* kr_ = Kh + (size_t)((t) * 64 + lane) * 1536; \
        _Pragma("unroll") for (int i_ = 0; i_ < 3; ++i_) { const int c_ = wid + 8 * i_; glds16(kr_ + c_ * 8, lds + AT_K + (s) * AT_KSLOT + c_ * 1024); } \
        _Pragma("unroll") for (int i_ = 0; i_ < 2; ++i_) { const int c_ = wid + 8 * i_; \
            glds16(Vh + (size_t)((t) * 64 + 16 * (c_ & 3) + (lane >> 2)) * 1024 + (c_ >> 2) * 32 + (lane & 3) * 8, lds + AT_V + (s) * AT_VSLOT + c_ * 1024); } } while (0)
    AT_DMA(0, 0);
    bf16x8 qr[12];
    { const bf16* qp = Qg + (rowbase + qw0 + r32) * 1536 + h * DQK + hi * 8;
#pragma unroll
      for (int d0 = 0; d0 < 12; ++d0) qr[d0] = *(const GAS bf16x8*)(qp + d0 * 16); }
    float m_run = -1e30f, l_run = 0.f; f32x16 o[4];
#pragma unroll
    for (int d = 0; d < 4; ++d)
#pragma unroll
        for (int r = 0; r < 16; ++r) o[d][r] = 0.f;
    const int vlane = tr_att_base(lane);
    for (int t = 0; t < NT; ++t) {
        const int s = t & 1;
        asm volatile("s_waitcnt vmcnt(0)" ::: "memory"); SBARRIER();
        if (t + 1 < NT) AT_DMA(t + 1, s ^ 1);
        const int kbase = t * 64;
        if (kbase <= qw0 + 31) {
            f32x16 p0, p1;
#pragma unroll
            for (int r = 0; r < 16; ++r) { p0[r] = 0.f; p1[r] = 0.f; }
            cldsp kb = lds + AT_K + s * AT_KSLOT + hi * 1024 + r32 * 16;
#pragma unroll
            for (int d0 = 0; d0 < 12; ++d0) { const bf16x8 a0 = *(const LAS bf16x8*)(kb + d0 * 2048), a1 = *(const LAS bf16x8*)(kb + d0 * 2048 + 512);
                p0 = MFMA32(a0, qr[d0], p0); p1 = MFMA32(a1, qr[d0], p1); }
            if (kbase + 63 > qw0) {
                const int qi = qw0 + r32; const float NEG = -__builtin_inff();
#pragma unroll
                for (int r = 0; r < 16; ++r) { const int kv = kbase + crow(r, hi); if (kv > qi) p0[r] = NEG; if (kv + 32 > qi) p1[r] = NEG; }
            }
            float mx = fmaxf(p0[0], p1[0]);
#pragma unroll
            for (int r = 1; r < 16; ++r) mx = fmaxf(mx, fmaxf(p0[r], p1[r]));
            mx = fmaxf(mx, __shfl_xor(mx, 32));
            const float mn = fmaxf(m_run, mx), alpha = __builtin_amdgcn_exp2f(m_run - mn); m_run = mn;
            float rs = 0.f;
#pragma unroll
            for (int r = 0; r < 16; ++r) { p0[r] = __builtin_amdgcn_exp2f(p0[r] - mn); p1[r] = __builtin_amdgcn_exp2f(p1[r] - mn); rs += p0[r] + p1[r]; }
            rs += __shfl_xor(rs, 32);
            l_run = l_run * alpha + rs;
            if (__any(alpha != 1.0f)) {
                if (hi == 0) wsf[r32] = alpha;
                asm volatile("s_waitcnt lgkmcnt(0)" ::: "memory");
#pragma unroll
                for (int r = 0; r < 16; ++r) { const float al = wsf[crow(r, hi)];
#pragma unroll
                    for (int d = 0; d < 4; ++d) o[d][r] *= al; }
            }
            bf16x8 pa[4]; pa[0] = pack8f(p0, 0); pa[1] = pack8f(p0, 8); pa[2] = pack8f(p1, 0); pa[3] = pack8f(p1, 8);
            cldsp vb = lds + AT_V + s * AT_VSLOT + vlane;
#pragma unroll
            for (int d0 = 0; d0 < 4; ++d0)
#pragma unroll
                for (int ks = 0; ks < 4; ++ks) { const s16x4 lo = trrd(vb + (d0 * 4 + ks) * 1024), hh = trrd(vb + (d0 * 4 + ks) * 1024 + 512);
                    o[d0] = MFMA32(pa[ks], MK8(lo, hh), o[d0]); }
        }
    }
    if (hi == 0) wsf[32 + r32] = l_run;
    asm volatile("s_waitcnt lgkmcnt(0)" ::: "memory");
    bf16* Ow = Og + (rowbase + qw0) * DM + h * DV;
#pragma unroll
    for (int r = 0; r < 16; ++r) { const int orow = crow(r, hi); const float rl = 1.0f / wsf[32 + orow];
#pragma unroll
        for (int d0 = 0; d0 < 4; ++d0) { const float v = o[d0][r] * rl; const float vn = __shfl_xor(v, 1);
            if ((r32 & 1) == 0) *(GAS unsigned*)(Ow + (size_t)orow * DM + d0 * 32 + r32) = cvtpk(v, vn); } }
    asm volatile("s_waitcnt lgkmcnt(0)" ::: "memory"); SBARRIER();
#undef AT_DMA
}

constexpr int RT_K = 0, RT_V = 32768, RT_S = 65536, RT_O = 0, RT_OSTRIDE = 132;
static_assert(RT_S + 32768 <= RING_BYTES && RT_O + 128 * RT_OSTRIDE * 4 <= RING_BYTES, "retention LDS");
__device__ __forceinline__ void ret_state_unit(const bf16* RK, const bf16* RV, float* U, int bh, int c, float lg2g, ldsp lds, int tid) {
    const int lane = tid & 63, r32 = lane & 31, hi = lane >> 5; const int wid = __builtin_amdgcn_readfirstlane(tid >> 6);
    const int b = bh >> 3, h = bh & 7; const size_t row0 = (size_t)b * SEQ + (size_t)c * RCH;
#pragma unroll
    for (int i = 0; i < 4; ++i) { const int ch = wid * 4 + i, cb = ch >> 3, ks = ch & 7; const size_t tok = row0 + 16 * ks + (lane >> 2); const int col = h * 128 + cb * 32 + (lane & 3) * 8;
        glds16(RK + tok * 1024 + col, lds + RT_K + ch * 1024);
        const v4u w = *(const GAS v4u*)(RV + tok * 1024 + col); const float z = __builtin_amdgcn_exp2f(lg2g * (float)(127 - (16 * ks + (lane >> 2))));
        v4u o; o.x = cvtpk(bf_lo(w.x) * z, bf_hi(w.x) * z); o.y = cvtpk(bf_lo(w.y) * z, bf_hi(w.y) * z); o.z = cvtpk(bf_lo(w.z) * z, bf_hi(w.z) * z); o.w = cvtpk(bf_lo(w.w) * z, bf_hi(w.w) * z);
        *(LAS v4u*)(lds + RT_V + ch * 1024 + lane * 16) = o; }
    asm volatile("s_waitcnt vmcnt(0) lgkmcnt(0)" ::: "memory"); SBARRIER();
    const int dkb = wid >> 1, dvb0 = (wid & 1) * 2; const int nb = tr_nat_base(lane);
    f32x16 acc[2];
#pragma unroll
    for (int r = 0; r < 16; ++r) { acc[0][r] = 0.f; acc[1][r] = 0.f; }
#pragma unroll
    for (int ks = 0; ks < 8; ++ks) { cldsp ka = lds + RT_K + (dkb * 8 + ks) * 1024 + nb; const s16x4 al = trrd(ka), ah = trrd(ka + 256); const bf16x8 A = MK8(al, ah);
#pragma unroll
        for (int j = 0; j < 2; ++j) { cldsp vb = lds + RT_V + ((dvb0 + j) * 8 + ks) * 1024 + nb; const s16x4 bl = trrd(vb), bh2 = trrd(vb + 256); acc[j] = MFMA32(A, MK8(bl, bh2), acc[j]); } }
    float* Uu = U + ((size_t)bh * NCH + c) * 16384;
#pragma unroll
    for (int j = 0; j < 2; ++j)
#pragma unroll
        for (int r = 0; r < 16; ++r) Uu[(dkb * 32 + crow(r, hi)) * 128 + (dvb0 + j) * 32 + r32] = acc[j][r];
    asm volatile("s_waitcnt lgkmcnt(0)" ::: "memory"); SBARRIER();
}
__device__ __forceinline__ void ret_scan(const float* U, bf16* S, cargs_t a, int gtid, int nthr) {
    for (int it = gtid; it < 16 * 8192; it += nthr) { const int bh = it >> 13, e2 = it & 8191; const float g = __builtin_amdgcn_exp2f(128.0f * a->lg2g[bh & 7]);
        const float* up = U + (size_t)bh * NCH * 16384 + e2 * 2; bf16* sp = S + (size_t)bh * NCH * 16384 + e2 * 2; float s0 = 0.f, s1 = 0.f;
#pragma unroll 8
        for (int c = 0; c < NCH; ++c) { *(GAS unsigned*)(sp + (size_t)c * 16384) = cvtpk(s0, s1); const f32x2 u = *(const GAS f32x2*)(up + (size_t)c * 16384); s0 = s0 * g + u.x; s1 = s1 * g + u.y; } }
}
__device__ __forceinline__ void ret_out_unit(const bf16* RQ, const bf16* RK, const bf16* RV, const bf16* RG, const bf16* S, const float* beta, bf16* MIX, int bh, int c, float lg2g, ldsp lds, int tid) {
    const int lane = tid & 63, r32 = lane & 31, hi = lane >> 5; const int wid = __builtin_amdgcn_readfirstlane(tid >> 6);
    const int b = bh >> 3, h = bh & 7; const size_t row0 = (size_t)b * SEQ + (size_t)c * RCH;
    const int rb = wid & 3, dh = wid >> 2;
    const bf16* Ss = S + ((size_t)bh * NCH + c) * 16384;
#pragma unroll
    for (int i = 0; i < 4; ++i) { const int id = wid * 4 + i;
        glds16(RK + (row0 + (id & 1) * 64 + lane) * 1024 + h * 128 + (id >> 1) * 8, lds + RT_K + id * 1024);
        const int cb = id >> 3, ks = id & 7;
        glds16(RV + (row0 + 16 * ks + (lane >> 2)) * 1024 + h * 128 + cb * 32 + (lane & 3) * 8, lds + RT_V + id * 1024);
        glds16(Ss + (16 * ks + (lane >> 2)) * 128 + cb * 32 + (lane & 3) * 8, lds + RT_S + id * 1024); }
    bf16x8 qr[8];
    { const bf16* qp = RQ + (row0 + rb * 32 + r32) * 1024 + h * 128 + hi * 8;
#pragma unroll
      for (int d0 = 0; d0 < 8; ++d0) qr[d0] = *(const GAS bf16x8*)(qp + d0 * 16); }
    asm volatile("s_waitcnt vmcnt(0)" ::: "memory"); SBARRIER();
    f32x16 o[2];
#pragma unroll
    for (int r = 0; r < 16; ++r) { o[0][r] = 0.f; o[1][r] = 0.f; }
    { const int nb = tr_nat_base(lane);
#pragma unroll
      for (int ks = 0; ks < 8; ++ks)
#pragma unroll
          for (int j = 0; j < 2; ++j) { cldsp sb = lds + RT_S + ((dh * 2 + j) * 8 + ks) * 1024 + nb; const s16x4 bl = trrd(sb), bh2 = trrd(sb + 256); o[j] = MFMA32(qr[ks], MK8(bl, bh2), o[j]); }
#pragma unroll
      for (int r = 0; r < 16; ++r) { const float xi = __builtin_amdgcn_exp2f(lg2g * (float)(rb * 32 + crow(r, hi) + 1)); o[0][r] *= xi; o[1][r] *= xi; } }
    const int ab = tr_att_base(lane);
    for (int kb = 0; kb <= rb; ++kb) {
        f32x16 p;
#pragma unroll
        for (int r = 0; r < 16; ++r) p[r] = 0.f;
        cldsp kp = lds + RT_K + hi * 2048 + (kb * 32 + r32) * 16;
#pragma unroll
        for (int d0 = 0; d0 < 8; ++d0) { const bf16x8 ka = *(const LAS bf16x8*)(kp + d0 * 4096); p = MFMA32(ka, qr[d0], p); }
        const int qi = rb * 32 + r32;
#pragma unroll
        for (int r = 0; r < 16; ++r) { const int kj = kb * 32 + crow(r, hi); const float dcy = __builtin_amdgcn_exp2f(lg2g * (float)(qi - kj)); p[r] = (qi >= kj) ? p[r] * dcy : 0.f; }
        const bf16x8 pa0 = pack8f(p, 0), pa1 = pack8f(p, 8);
#pragma unroll
        for (int j = 0; j < 2; ++j) { cldsp vb = lds + RT_V + ((dh * 2 + j) * 8 + kb * 2) * 1024 + ab;
            { const s16x4 lo = trrd(vb), hh = trrd(vb + 512); o[j] = MFMA32(pa0, MK8(lo, hh), o[j]); }
            { const s16x4 lo = trrd(vb + 1024), hh = trrd(vb + 1024 + 512); o[j] = MFMA32(pa1, MK8(lo, hh), o[j]); } }
    }
    asm volatile("s_waitcnt lgkmcnt(0)" ::: "memory"); SBARRIER();
    LAS float* ob = (LAS float*)(lds + RT_O);
#pragma unroll
    for (int j = 0; j < 2; ++j)
#pragma unroll
        for (int r = 0; r < 16; ++r) ob[(rb * 32 + crow(r, hi)) * RT_OSTRIDE + (dh * 2 + j) * 32 + r32] = o[j][r];
    asm volatile("s_waitcnt lgkmcnt(0)" ::: "memory"); SBARRIER();
    const float be0 = beta[h * 128 + lane], be1 = beta[h * 128 + 64 + lane];
#pragma unroll 4
    for (int i = 0; i < 16; ++i) { const int rr = wid * 16 + i; const float v0 = ob[rr * RT_OSTRIDE + lane], v1 = ob[rr * RT_OSTRIDE + 64 + lane];
        const float mu = wave_sum(v0 + v1) * (1.0f / 128.0f); const float d0 = v0 - mu, d1 = v1 - mu; const float var = wave_sum(d0 * d0 + d1 * d1) * (1.0f / 128.0f);
        const float rs = 1.0f / sqrtf(var + GN_EPS);
        const bf16* gp = RG + (row0 + rr) * 1024 + h * 128; const float g0 = __builtin_bit_cast(float, (unsigned)gp[lane] << 16), g1 = __builtin_bit_cast(float, (unsigned)gp[64 + lane] << 16);
        bf16* mp = MIX + (row0 + rr) * DM + 1024 + h * 128;
        mp[lane] = (bf16)f2bf(d0 * rs * g0 * be0); mp[64 + lane] = (bf16)f2bf(d1 * rs * g1 * be1); }
    asm volatile("s_waitcnt lgkmcnt(0)" ::: "memory"); SBARRIER();
}

#define PHASE_IDS() int tid = tid0; asm volatile("" : "+v"(tid)); int G = G0, bx = bx0; asm volatile("" : "+s"(G), "+s"(bx)); \
    const int lane = tid & 63; const int wave = __builtin_amdgcn_readfirstlane(tid >> 6); const int vcu = (G % 8 == 0) ? (bx % 8) * (G / 8) + bx / 8 : bx; (void)lane; (void)wave; (void)vcu
#define GW (vcu * NWAVES + wave)
#define NGW (G * NWAVES)
#define GTID (vcu * (NWAVES * 64) + tid)
#define NTHR (G * NWAVES * 64)
template <int l> __device__ __forceinline__ void layer_body(const int tid0, const int G0, const int bx0, const ldsp lds, const XcdBarrier& bar) {
#ifndef NO_T1
        { PHASE_IDS(); cargs_t a = get_args();
          if (l == 0) rope_tables(a, GTID, NTHR);
          convert_weights(a, l, lds, GW, NGW, wave, lane, GTID, NTHR);
          const float* xin = (l == 0) ? a->x : a->out; const float* g = a->attn_norm + l * DM; bf16* Hb = (bf16*)(a->ws + WS_H);
          for (int m = GW; m < M; m += NGW) rms_row_2048(xin + (size_t)m * DM, g, Hb + (size_t)m * DM, lane); }
#endif
        xcd_barrier(bar);
#ifndef NO_G1
        { PHASE_IDS(); cargs_t a = get_args(); unsigned char* ws = a->ws;
          pg8::Gemm g{(bf16*)(ws + WS_H), (bf16*)(ws + WS_WIN), M, IN_PAD, DM}; pg8::StaticOrder S; S.init(M, IN_PAD, G, bx);
          pg8::EpiIn E{(float*)(ws + WS_P1), (bf16*)(ws + WS_RQ), (bf16*)(ws + WS_RK), (bf16*)(ws + WS_RV), (bf16*)(ws + WS_RG), (const float*)(ws + WS_C128), (const float*)(ws + WS_S128)};
          pg8::gemm_phase<pg8::EpiIn, pg8::StaticOrder, true, true>(lds + RING_OFF, g, S, E); }
#endif
        xcd_barrier(bar);
#ifndef NO_T2
        { PHASE_IDS(); cargs_t a = get_args(); unsigned char* ws = a->ws; const float* gq = a->q_norm + l * QLORA; const float* gkv = a->kv_norm + l * KVLORA;
          for (int m = GW; m < M; m += NGW) lowrank_row(ws, gq, gkv, m, lane); }
#endif
        xcd_barrier(bar);
#ifndef NO_G2A
        { PHASE_IDS(); cargs_t a = get_args(); unsigned char* ws = a->ws;
          pg8::Gemm g{(bf16*)(ws + WS_CQN), (bf16*)(ws + WS_WUQ), M, 1536, QLORA}; pg8::StaticOrder S; S.init(M, 1536, G, bx);
          pg8::EpiQ E{(bf16*)(ws + WS_Q), (const float*)(ws + WS_C64), (const float*)(ws + WS_S64), QSCALE};
          pg8::gemm_phase<pg8::EpiQ, pg8::StaticOrder, true, true>(lds + RING_OFF, g, S, E); }
#endif
        __syncthreads();
#ifndef NO_G2B
        { PHASE_IDS(); cargs_t a = get_args(); unsigned char* ws = a->ws;
          pg8::Gemm g{(bf16*)(ws + WS_CKVN), (bf16*)(ws + WS_WUKV), M, 2048, KVLORA}; pg8::StaticOrder S; S.init(M, 2048, G, bx);
          pg8::EpiKV E{(bf16*)(ws + WS_K), (bf16*)(ws + WS_V)};
          pg8::gemm_phase<pg8::EpiKV, pg8::StaticOrder, true, true>(lds + RING_OFF, g, S, E); }
#endif
        __syncthreads();
#ifndef NO_R1
        { PHASE_IDS(); cargs_t a = get_args(); unsigned char* ws = a->ws;
          for (int u = vcu; u < 16 * NCH; u += G) ret_state_unit((const bf16*)(ws + WS_RK), (const bf16*)(ws + WS_RV), (float*)(ws + WS_U), u >> 6, u & 63, a->lg2g[(u >> 6) & 7], lds + RING_OFF, tid); }
#endif
        xcd_barrier(bar);
#ifndef NO_ATT
        { PHASE_IDS(); cargs_t a = get_args(); unsigned char* ws = a->ws;
          for (int u = vcu; u < 256; u += G) { const int bh = u >> 4, x = u & 15;
            attn_unit((const bf16*)(ws + WS_Q), (const bf16*)(ws + WS_K), (const bf16*)(ws + WS_V), (bf16*)(ws + WS_MIX), bh >> 3, bh & 7, x, lds + RING_OFF, tid);
            attn_unit((const bf16*)(ws + WS_Q), (const bf16*)(ws + WS_K), (const bf16*)(ws + WS_V), (bf16*)(ws + WS_MIX), bh >> 3, bh & 7, 31 - x, lds + RING_OFF, tid); } }
#endif
#ifndef NO_R2
        { PHASE_IDS(); cargs_t a = get_args(); unsigned char* ws = a->ws; ret_scan((const float*)(ws + WS_U), (bf16*)(ws + WS_S), a, GTID, NTHR); }
#endif
        xcd_barrier(bar);
#ifndef NO_R3
        { PHASE_IDS(); cargs_t a = get_args(); unsigned char* ws = a->ws; const float* beta = a->beta_ret + l * 1024;
          for (int u = vcu; u < 16 * NCH; u += G) ret_out_unit((const bf16*)(ws + WS_RQ), (const bf16*)(ws + WS_RK), (const bf16*)(ws + WS_RV), (const bf16*)(ws + WS_RG), (const bf16*)(ws + WS_S), beta, (bf16*)(ws + WS_MIX),
                                                              u >> 6, u & 63, a->lg2g[(u >> 6) & 7], lds + RING_OFF, tid); }
#endif
#ifndef NO_T3
        { PHASE_IDS(); cargs_t a = get_args(); bf16* mix = (bf16*)(a->ws + WS_MIX); const float* g = a->beta_attn + l * 1024;
          for (int m = GW; m < M; m += NGW) attn_norm_row(mix, g, m, lane); }
#endif
        xcd_barrier(bar);
#ifndef NO_G3
        { PHASE_IDS(); cargs_t a = get_args(); unsigned char* ws = a->ws;
          pg8::Gemm g{(bf16*)(ws + WS_MIX), (bf16*)(ws + WS_WO), M, DM, DM}; pg8::StaticOrder S; S.init(M, DM, G, bx);
          pg8::EpiRes E{(l == 0) ? a->x : (const float*)a->out, a->out, DM};
          pg8::gemm_phase<pg8::EpiRes, pg8::StaticOrder, true, true>(lds + RING_OFF, g, S, E); }
#endif
        xcd_barrier(bar);
#ifndef NO_T4
        { PHASE_IDS(); cargs_t a = get_args(); const float* xr = a->out; const float* g = a->mlp_norm + l * DM; bf16* Hb = (bf16*)(a->ws + WS_H);
          for (int m = GW; m < M; m += NGW) rms_row_2048(xr + (size_t)m * DM, g, Hb + (size_t)m * DM, lane); }
#endif
        xcd_barrier(bar);
#ifndef NO_G4
        { PHASE_IDS(); cargs_t a = get_args(); unsigned char* ws = a->ws;
          pg8::Gemm g{(bf16*)(ws + WS_H), (bf16*)(ws + WS_WUP), M, FF, DM}; pg8::StaticOrder S; S.init(M, FF, G, bx);
          pg8::EpiRelu2 E{(bf16*)(ws + WS_UF), FF};
          pg8::gemm_phase<pg8::EpiRelu2, pg8::StaticOrder, true, true>(lds + RING_OFF, g, S, E); }
#endif
        xcd_barrier(bar);
#ifndef NO_G5
        { PHASE_IDS(); cargs_t a = get_args(); unsigned char* ws = a->ws;
          pg8::Gemm g{(bf16*)(ws + WS_UF), (bf16*)(ws + WS_WDN), M, DM, FF}; pg8::StaticOrder S; S.init(M, DM, G, bx);
          pg8::EpiRes E{a->out, a->out, DM};
          pg8::gemm_phase<pg8::EpiRes, pg8::StaticOrder, true, true>(lds + RING_OFF, g, S, E); }
#endif
        xcd_barrier(bar);
    }

__global__ void __launch_bounds__(NWAVES * 64, 2) fwd_kernel(Args args_in_kernarg) {
    extern __shared__ __attribute__((aligned(16))) unsigned char lds_raw[];
    const ldsp lds = (ldsp)lds_raw;
    volatile LAS unsigned* MISC = (volatile LAS unsigned*)(lds + MISC_OFF);
    const int tid0 = threadIdx.x; const int G0 = gridDim.x, bx0 = blockIdx.x;
    for (int u = tid0; u < (LDS_BYTES - LDSCTL_OFF) / 4; u += NWAVES * 64) ((LAS unsigned*)(lds + LDSCTL_OFF))[u] = 0u;
    __syncthreads();
    XcdBarrier bar;
    { PHASE_IDS(); cargs_t a = get_args(); bar = xcd_barrier_post((unsigned*)((gu32*)(a->ws + WS_CTL) + CW_BAR), MISC + 8); }

    layer_body<0>(tid0, G0, bx0, lds, bar);
    layer_body<1>(tid0, G0, bx0, lds, bar);
    layer_body<2>(tid0, G0, bx0, lds, bar);
    layer_body<3>(tid0, G0, bx0, lds, bar);
    { PHASE_IDS(); cargs_t a = get_args(); float* xo = a->out; const float* g = a->final_norm;
      for (int m = GW; m < M; m += NGW) rms_row_final(xo + (size_t)m * DM, g, lane); }
}

extern "C" void kernel_launch(void* const* d_in, const int* in_sizes, int n_in, void* d_out, int out_size, void* d_ws, size_t ws_size, hipStream_t stream) {
    static int grid = 0;
    if (grid == 0) {
        if (n_in != 15 || in_sizes[0] != M * DM || out_size != M * DM || ws_size < WS_END) { fprintf(stderr, "kernel_launch: unexpected shapes (n_in %d, in0 %d, out %d, ws %zu, need %zu); nothing launched\n", n_in, n_in > 0 ? in_sizes[0] : -1, out_size, ws_size, (size_t)WS_END); grid = -1; return; }
        int dev = 0, cus = 0, per_cu = 0;
        if (hipGetDevice(&dev) != hipSuccess || hipDeviceGetAttribute(&cus, hipDeviceAttributeMultiprocessorCount, dev) != hipSuccess) { fprintf(stderr, "kernel_launch: device query failed\n"); grid = -1; return; }
        if (hipFuncSetAttribute((const void*)fwd_kernel, hipFuncAttributeMaxDynamicSharedMemorySize, LDS_BYTES) != hipSuccess) { fprintf(stderr, "kernel_launch: hipFuncSetAttribute failed\n"); grid = -1; return; }
        if (hipOccupancyMaxActiveBlocksPerMultiprocessor(&per_cu, (const void*)fwd_kernel, NWAVES * 64, LDS_BYTES) != hipSuccess || per_cu < 1)
            fprintf(stderr, "kernel_launch: note: occupancy query reports %d workgroups per CU\n", per_cu);
        (void)hipGetLastError();
        grid = cus;
    }
    if (grid < 0) return;
    if (hipMemsetAsync((char*)d_ws + WS_CTL, 0, CTL_ZERO_BYTES, stream) != hipSuccess) { fprintf(stderr, "kernel_launch: hipMemsetAsync failed\n"); return; }
    Args a{};
    a.x = (const float*)d_in[0]; a.pos = (const int*)d_in[1]; a.attn_norm = (const float*)d_in[2]; a.w_in = (const float*)d_in[3]; a.q_norm = (const float*)d_in[4]; a.kv_norm = (const float*)d_in[5];
    a.w_uq = (const float*)d_in[6]; a.w_ukv = (const float*)d_in[7]; a.beta_attn = (const float*)d_in[8]; a.beta_ret = (const float*)d_in[9]; a.w_o = (const float*)d_in[10]; a.mlp_norm = (const float*)d_in[11];
    a.w_up = (const float*)d_in[12]; a.w_down = (const float*)d_in[13]; a.final_norm = (const float*)d_in[14];
    a.out = (float*)d_out; a.ws = (unsigned char*)d_ws;
    for (int j = 0; j < 32; ++j) a.invf64[j] = pow(10000.0, -(double)(2 * j) / 64.0);
    for (int j = 0; j < 64; ++j) a.invf128[j] = pow(10000.0, -(double)(2 * j) / 128.0);
    for (int h = 0; h < 8; ++h) a.lg2g[h] = (float)(log1p(-exp2(-5.0 - (double)h)) / log(2.0));
    hipLaunchKernelGGL(fwd_kernel, dim3(grid), dim3(NWAVES * 64), LDS_BYTES, stream, a);
    const hipError_t le = hipPeekAtLastError();
    if (le != hipSuccess) fprintf(stderr, "kernel_launch: launch failed: %s\n", hipGetErrorName(le));
}
```

```cpp
#include <hip/hip_runtime.h>
#include <cstdio>
#include <cstdint>
#include <cmath>
namespace pg8 {
#define PG8_LAS __attribute__((address_space(3)))
typedef unsigned short bf16_t;
typedef short bf16x8 __attribute__((ext_vector_type(8)));
typedef float f32x4 __attribute__((ext_vector_type(4)));
typedef unsigned u32x4 __attribute__((ext_vector_type(4)));
constexpr int BM = 256, BK = 64, HALF = 128, HTB = HALF * BK * 2  , STAGE_BYTES = 8 * HTB, NXCD = 8, WGM = 8;

__host__ __device__ __forceinline__ int lds_byte(int r, int c) { const int st = (r >> 4) * 2 + (c >> 5), rr = r & 15, cc = c & 31, ob = rr * 64 + cc * 2; return st * 1024 + (ob ^ (((ob >> 9) & 1) << 5)); }
__host__ __device__ __forceinline__ void stage_rc(int b, int& R, int& C) { const int st = b / 1024, sb = b % 1024, swz = sb ^ (((sb >> 9) & 1) << 5); R = (st >> 1) * 16 + swz / 64; C = (st & 1) * 32 + (swz % 64) / 2; }
__host__ __device__ __forceinline__ int perm32(int rho) { const int n = rho >> 4, i = rho & 15; return 8 * (i >> 2) + 4 * n + (i & 3); }

struct Unit { int pm, pn; };
struct Gemm { const bf16_t* A; const bf16_t* Bt; int M, N, K; };

struct StaticOrder {
    int nM, nN, nwg, G, c;
    __host__ __device__ void init(int M, int N, int G_, int c_) { nM = M / BM; nN = N / BM; nwg = nM * nN; G = G_; c = c_; }
    __host__ __device__ bool next(int i, Unit& u) const {
        const long L = (long)i * G + c; if (L >= nwg) return false;
        int wgid = (int)L; { const int q = nwg / NXCD, r = nwg % NXCD, xcd = wgid % NXCD, off = wgid / NXCD; wgid = (xcd < r ? xcd * (q + 1) : r * (q + 1) + (xcd - r) * q) + off; }
        const int nig = WGM * nN, gid = wgid / nig, fm = gid * WGM, gsz = (nM - fm) < WGM ? (nM - fm) : WGM;
        u.pm = fm + ((wgid % nig) % gsz); u.pn = (wgid % nig) / gsz; return true;
    }
    __device__ __forceinline__ void a_ready(const Unit&) const {}
    __device__ __forceinline__ void done(const Unit&) const {}
};

__device__ __forceinline__ unsigned cvt_pk_bf16(float lo, float hi) { unsigned r; asm volatile("v_cvt_pk_bf16_f32 %0, %1, %2" : "=v"(r) : "v"(lo), "v"(hi)); return r; }
typedef float f32x2 __attribute__((ext_vector_type(2)));
__device__ __forceinline__ f32x2 gelu_pk(f32x2 v) {
    const f32x2 av = __builtin_elementwise_abs(v), d = av * 0.2316418882f + 1.0f;
    f32x2 t; t.x = __builtin_amdgcn_rcpf(d.x); t.y = __builtin_amdgcn_rcpf(d.y);
    f32x2 q = t * 0.5307027145f + (-0.7265760135f); q = q * t + 0.7107068705f; q = q * t + (-0.142248368f); q = q * t + 0.127414796f; q = q * t;
    const f32x2 s = (v * v) * (-0.72134752044f);
    f32x2 e; e.x = __builtin_amdgcn_exp2f(s.x); e.y = __builtin_amdgcn_exp2f(s.y);
    const f32x2 m = v * (q * e), r = v - m;
    f32x2 o; o.x = v.x < 0.f ? m.x : r.x; o.y = v.y < 0.f ? m.y : r.y; return o;
}

template <int ACT  > struct EpiBf16 {
    static constexpr bool PERM = true, AFTER_DRAIN = false; static_assert(ACT == 0 || ACT == 1, "EpiBf16: ACT is 0 (none) or 1 (gelu_pk)");
    bf16_t* O; int ldc; const float* bias; int split_cols; size_t split_stride; float scale0;
    __device__ __forceinline__ void operator()(const f32x4 (&acc)[2][2][4][2], const Unit& u, int wr, int wc, int fr, int fq) const {
        const int row0 = u.pm * BM + wr * 64 + fr; int colt = u.pn * BM; bf16_t* base = O;
        float sc = 1.f; if (split_cols) { const int t = colt / split_cols; base += (size_t)t * split_stride; colt -= t * split_cols; if (t == 0) sc = scale0; }
        const int col0 = colt + wc * 32 + 8 * fq, bcol0 = u.pn * BM + wc * 32 + 8 * fq;
        f32x4 bv[2][2];
#pragma unroll
        for (int bj = 0; bj < 2; ++bj)
#pragma unroll
            for (int n = 0; n < 2; ++n) bv[bj][n] = bias ? *(const f32x4*)(bias + bcol0 + bj * HALF + 4 * n) : (f32x4){0.f, 0.f, 0.f, 0.f};
#pragma unroll
        for (int ai = 0; ai < 2; ++ai)
#pragma unroll
            for (int m = 0; m < 4; ++m) { bf16_t* rowp = base + (size_t)(row0 + ai * HALF + m * 16) * ldc + col0;
#pragma unroll
                for (int bj = 0; bj < 2; ++bj) { f32x4 v0 = acc[ai][bj][m][0] + bv[bj][0], v1 = acc[ai][bj][m][1] + bv[bj][1];
                    if (ACT == 1) { f32x2 a = gelu_pk((f32x2){v0[0], v0[1]}), b = gelu_pk((f32x2){v0[2], v0[3]}), c = gelu_pk((f32x2){v1[0], v1[1]}), d = gelu_pk((f32x2){v1[2], v1[3]});
                        v0 = (f32x4){a.x, a.y, b.x, b.y}; v1 = (f32x4){c.x, c.y, d.x, d.y}; }
                    v0 = v0 * sc; v1 = v1 * sc; u32x4 w; w.x = cvt_pk_bf16(v0[0], v0[1]); w.y = cvt_pk_bf16(v0[2], v0[3]); w.z = cvt_pk_bf16(v1[0], v1[1]); w.w = cvt_pk_bf16(v1[2], v1[3]);
                    *(u32x4*)(rowp + bj * HALF) = w; } }
    }
};

struct PanelStats {
    unsigned* xbuf;
    unsigned* cnt;
    unsigned* tmo;
    int ntn; float eps;
    unsigned code;
    __device__ __forceinline__ bool run(const f32x4 (&v)[2][2][4][2], const Unit& u, int wr, int wc, int fr, int fq, PG8_LAS unsigned char* lds, int wid, int lane) const {
        typedef float f32x2v __attribute__((ext_vector_type(2)));
        PG8_LAS f32x2v* P = (PG8_LAS f32x2v*)lds;
        PG8_LAS f32x2v* S = (PG8_LAS f32x2v*)(lds + 8192);
        PG8_LAS unsigned* flag = (PG8_LAS unsigned*)(lds + 8192 + 2048);
#pragma unroll
        for (int ai = 0; ai < 2; ++ai)
#pragma unroll
            for (int m = 0; m < 4; ++m) {
                float s = 0.f;
#pragma unroll
                for (int bj = 0; bj < 2; ++bj)
#pragma unroll
                    for (int n = 0; n < 2; ++n) { const f32x4 x = v[ai][bj][m][n]; s += (x[0] + x[1]) + (x[2] + x[3]); }
                s += __shfl_xor(s, 16); s += __shfl_xor(s, 32);
                const float mw = s * (1.0f / 64.0f); float q = 0.f;
#pragma unroll
                for (int bj = 0; bj < 2; ++bj)
#pragma unroll
                    for (int n = 0; n < 2; ++n) { const f32x4 d = v[ai][bj][m][n] - mw; q += (d[0] * d[0] + d[1] * d[1]) + (d[2] * d[2] + d[3] * d[3]); }
                q += __shfl_xor(q, 16); q += __shfl_xor(q, 32);
                if (fq == 0) P[(ai * HALF + wr * 64 + m * 16 + fr) * 4 + wc] = (f32x2v){mw, q};
            }
        asm volatile("s_waitcnt lgkmcnt(0)" ::: "memory"); __builtin_amdgcn_s_barrier(); asm volatile("" ::: "memory");
#if defined(BROKEN_EXCHANGE_NO_WAIT)
#warning BROKEN CONTROL BUILD: the row-statistics exchange does not wait; results are wrong by design
        if (blockIdx.x >= 64) { const long long t0_ = clock64(); while (clock64() - t0_ < 60000) __builtin_amdgcn_s_sleep(8); }
#endif
        const int row = wid * 32 + (lane & 31);
        if (lane < 32) {
            const f32x2v a = P[row * 4 + 0], b = P[row * 4 + 1], c = P[row * 4 + 2], d = P[row * 4 + 3];
            const float mt = (a.x + b.x + c.x + d.x) * 0.25f;
            const float da = a.x - mt, db = b.x - mt, dc = c.x - mt, dd = d.x - mt;
            const float m2 = (a.y + b.y) + (c.y + d.y) + 64.0f * ((da * da + db * db) + (dc * dc + dd * dd));
            unsigned long long* slot = (unsigned long long*)xbuf + ((size_t)(u.pm * BM + row) * 4 + u.pn);
            __hip_atomic_store(slot, ((unsigned long long)__float_as_uint(m2) << 32) | __float_as_uint(mt), __ATOMIC_RELAXED, __HIP_MEMORY_SCOPE_AGENT);
        }
        asm volatile("s_waitcnt vmcnt(0)" ::: "memory");
        if (lane == 0) __hip_atomic_fetch_add(cnt + 64 * u.pm, 1u, __ATOMIC_RELAXED, __HIP_MEMORY_SCOPE_AGENT);
        if (wid == 0) {
            bool dead = false; const unsigned long long t0 = __builtin_amdgcn_s_memrealtime(); const unsigned want = 8u * (unsigned)ntn;
            for (;;) {
#if defined(BROKEN_EXCHANGE_NO_WAIT)
                break;
#endif
                if ((unsigned)__builtin_amdgcn_readfirstlane(__hip_atomic_load(cnt + 64 * u.pm, __ATOMIC_RELAXED, __HIP_MEMORY_SCOPE_AGENT)) >= want) break;
                if (__builtin_amdgcn_s_memrealtime() - t0 > 2000000ull) {
                    if (lane == 0) { unsigned expect = 0u; __hip_atomic_compare_exchange_strong(tmo + 1, &expect, code | (unsigned)(u.pm & 0xff), __ATOMIC_RELAXED, __ATOMIC_RELAXED, __HIP_MEMORY_SCOPE_AGENT);
                                     __hip_atomic_store(tmo, 1u, __ATOMIC_RELAXED, __HIP_MEMORY_SCOPE_AGENT); }
                    dead = true; break; }
                __builtin_amdgcn_s_sleep(2);
            }
            __builtin_amdgcn_fence(__ATOMIC_ACQUIRE, "agent");
            if (lane == 0) flag[0] = dead ? 1u : 0u;
        }
        asm volatile("s_waitcnt vmcnt(0) lgkmcnt(0)" ::: "memory"); __builtin_amdgcn_s_barrier(); asm volatile("" ::: "memory");
        const bool bad = flag[0] != 0u;
        if (lane < 32) {
            const unsigned long long* slot = (const unsigned long long*)xbuf + (size_t)(u.pm * BM + row) * 4; float mt[4], m2[4]; float ms = 0.f;
#pragma unroll
            for (int t = 0; t < 4; ++t) { if (t < ntn) { const unsigned long long w = __hip_atomic_load(slot + t, __ATOMIC_RELAXED, __HIP_MEMORY_SCOPE_AGENT); mt[t] = __uint_as_float((unsigned)w); m2[t] = __uint_as_float((unsigned)(w >> 32)); } else { mt[t] = 0.f; m2[t] = 0.f; } ms += mt[t]; }
            const float mean = ms / (float)ntn; float q = 0.f;
#pragma unroll
            for (int t = 0; t < 4; ++t) if (t < ntn) { const float dm = mt[t] - mean; q += m2[t] + 256.0f * dm * dm; }
            S[row] = (f32x2v){mean, 1.0f / sqrtf(q / (256.0f * (float)ntn) + eps)};
        }
        asm volatile("s_waitcnt lgkmcnt(0)" ::: "memory"); __builtin_amdgcn_s_barrier(); asm volatile("" ::: "memory");
        return bad;
    }
};
struct EpiLnRes {
    static constexpr bool PERM = false, AFTER_DRAIN = true;
    const float* base; float* out; int ldc; const float* bias; PanelStats st; unsigned poison;
    __device__ __forceinline__ void fused(f32x4 (&acc)[2][2][4][2], const Unit& u, int wr, int wc, int fr, int fq, PG8_LAS unsigned char* lds, int wid, int lane) const {
        typedef float f32x2v __attribute__((ext_vector_type(2)));
        const PG8_LAS f32x2v* S = (const PG8_LAS f32x2v*)(lds + 8192);
        const int col0 = u.pn * BM + wc * 32 + 4 * fq;
#pragma unroll
        for (int bj = 0; bj < 2; ++bj)
#pragma unroll
            for (int n = 0; n < 2; ++n) { const f32x4 bv = bias ? *(const f32x4*)(bias + col0 + bj * HALF + n * 16) : (f32x4){0.f, 0.f, 0.f, 0.f};
#pragma unroll
                for (int ai = 0; ai < 2; ++ai)
#pragma unroll
                    for (int m = 0; m < 4; ++m) acc[ai][bj][m][n] += bv; }
        f32x4 pre[4][2][2];
#pragma unroll
        for (int m = 0; m < 4; ++m) { const size_t off = (size_t)(u.pm * BM + wr * 64 + m * 16 + fr) * ldc + col0;
#pragma unroll
            for (int bj = 0; bj < 2; ++bj)
#pragma unroll
                for (int n = 0; n < 2; ++n) pre[m][bj][n] = *(const f32x4*)(base + off + bj * HALF + n * 16); }
        const bool bad = st.run(acc, u, wr, wc, fr, fq, lds, wid, lane) || poison != 0u;
        const float qnan = __builtin_nanf("");
#pragma unroll
        for (int ai = 0; ai < 2; ++ai)
#pragma unroll
            for (int m = 0; m < 4; ++m) { const int r = ai * HALF + wr * 64 + m * 16 + fr; const f32x2v sr = S[r]; const size_t off = (size_t)(u.pm * BM + r) * ldc + col0;
#pragma unroll
                for (int bj = 0; bj < 2; ++bj)
#pragma unroll
                    for (int n = 0; n < 2; ++n) { const f32x4 bs = ai == 0 ? pre[m][bj][n] : *(const f32x4*)(base + off + bj * HALF + n * 16); f32x4 o = bs + (acc[ai][bj][m][n] - sr.x) * sr.y;
                        if (bad) o = (f32x4){qnan, qnan, qnan, qnan}; *(f32x4*)(out + off + bj * HALF + n * 16) = o; }
                if (m & 1) asm volatile("" ::: "memory"); }
    }
};
struct EpiLnResLn {
    static constexpr bool PERM = false, AFTER_DRAIN = true;
    const float* base; float* out; bf16_t* xn; int ldc; const float* bias; PanelStats st1, st2; unsigned poison;
    __device__ __forceinline__ void fused(f32x4 (&acc)[2][2][4][2], const Unit& u, int wr, int wc, int fr, int fq, PG8_LAS unsigned char* lds, int wid, int lane) const {
        typedef float f32x2v __attribute__((ext_vector_type(2))); typedef unsigned u32x2v __attribute__((ext_vector_type(2)));
        const PG8_LAS f32x2v* S = (const PG8_LAS f32x2v*)(lds + 8192);
        const int col0 = u.pn * BM + wc * 32 + 4 * fq;
#pragma unroll
        for (int bj = 0; bj < 2; ++bj)
#pragma unroll
            for (int n = 0; n < 2; ++n) { const f32x4 bv = bias ? *(const f32x4*)(bias + col0 + bj * HALF + n * 16) : (f32x4){0.f, 0.f, 0.f, 0.f};
#pragma unroll
                for (int ai = 0; ai < 2; ++ai)
#pragma unroll
                    for (int m = 0; m < 4; ++m) acc[ai][bj][m][n] += bv; }
        bool bad = st1.run(acc, u, wr, wc, fr, fq, lds, wid, lane) || poison != 0u;
        const float qnan = __builtin_nanf("");
#pragma unroll
        for (int ai = 0; ai < 2; ++ai)
#pragma unroll
            for (int m = 0; m < 4; ++m) { const int r = ai * HALF + wr * 64 + m * 16 + fr; const f32x2v sr = S[r]; const size_t off = (size_t)(u.pm * BM + r) * ldc + col0;
#pragma unroll
                for (int bj = 0; bj < 2; ++bj)
#pragma unroll
                    for (int n = 0; n < 2; ++n) { const f32x4 bs = *(const f32x4*)(base + off + bj * HALF + n * 16); acc[ai][bj][m][n] = bs + (acc[ai][bj][m][n] - sr.x) * sr.y; }
                asm volatile("" : "+v"(acc[ai][0][m][0]), "+v"(acc[ai][0][m][1]), "+v"(acc[ai][1][m][0]), "+v"(acc[ai][1][m][1]));
                if (m & 1) asm volatile("" ::: "memory"); }
        const bool bad1 = bad;
        bad = st2.run(acc, u, wr, wc, fr, fq, lds, wid, lane) || bad;
#pragma unroll
        for (int ai = 0; ai < 2; ++ai)
#pragma unroll
            for (int m = 0; m < 4; ++m) { const int r = ai * HALF + wr * 64 + m * 16 + fr; const f32x2v sr = S[r]; const size_t off = (size_t)(u.pm * BM + r) * ldc + col0;
#pragma unroll
                for (int bj = 0; bj < 2; ++bj)
#pragma unroll
                    for (int n = 0; n < 2; ++n) { const f32x4 x1 = acc[ai][bj][m][n]; *(f32x4*)(out + off + bj * HALF + n * 16) = bad1 ? (f32x4){qnan, qnan, qnan, qnan} : x1;
                        const f32x4 o = (x1 - sr.x) * sr.y; u32x2v w; w.x = cvt_pk_bf16(o[0], o[1]); w.y = cvt_pk_bf16(o[2], o[3]);
                        if (bad) { w.x = 0x7fc07fc0u; w.y = 0x7fc07fc0u; } *(u32x2v*)(xn + off + bj * HALF + n * 16) = w; }
                asm volatile("" ::: "memory"); }
    }
};

template <class Epi, class Sched, bool ALIGN_EPI = false, bool SP2 = false>
__device__ __forceinline__ void gemm_phase(PG8_LAS unsigned char* lds, const Gemm g, const Sched& S, const Epi& E) {
    int tid_l = threadIdx.x; asm volatile("" : "+v"(tid_l));
    const int tid = tid_l, wid = __builtin_amdgcn_readfirstlane(tid >> 6), lane = tid & 63, wr = wid >> 2, wc = wid & 3, fr = lane & 15, fq = lane >> 4;
    const int K = g.K, nt = K / BK;
    unsigned voffA[2], voffB[2];
#pragma unroll
    for (int i = 0; i < 2; ++i) { int R, C; stage_rc(tid * 16 + i * 8192, R, C); const int Rb = Epi::PERM ? ((R & ~31) + perm32(R & 31)) : R;
        voffA[i] = (unsigned)(R * K + C) * 2u; voffB[i] = (unsigned)(Rb * K + C) * 2u; }
    const size_t kstep = (size_t)(BK * 2);
    const size_t hstep = (size_t)HALF * K * 2;
    const size_t tstep = 2 * hstep;
    const unsigned ldsw = (unsigned)wid * 1024u;
    const int aoff = lds_byte(wr * 64 + fr, fq * 8), boff = lds_byte(wc * 32 + fr, fq * 8);
#define PG8_SA(b, h) (((b) * 2 + (h)) * HTB)
#define PG8_SB(b, h) ((4 + (b) * 2 + (h)) * HTB)
#define PG8_STAGE(bufoff, gbase, voff) do { _Pragma("unroll") for (int _i = 0; _i < 2; ++_i) \
        __builtin_amdgcn_global_load_lds((const unsigned*)((const char*)(gbase) + (voff)[_i]), (PG8_LAS unsigned*)(lds + (bufoff) + ldsw + _i * 8192), 16, 0, 0); } while (0)
#define PG8_LDA(dst, b, h) do { _Pragma("unroll") for (int m = 0; m < 4; ++m) _Pragma("unroll") for (int k = 0; k < 2; ++k) dst[m][k] = *(const PG8_LAS bf16x8*)(lds + PG8_SA(b, h) + aoff + m * 2048 + k * 1024); } while (0)
#define PG8_LDB(dst, b, h) do { _Pragma("unroll") for (int n = 0; n < 2; ++n) _Pragma("unroll") for (int k = 0; k < 2; ++k) dst[n][k] = *(const PG8_LAS bf16x8*)(lds + PG8_SB(b, h) + boff + n * 2048 + k * 1024); } while (0)
#define PG8_MMA(ai, bj, At, Bt) do { __builtin_amdgcn_s_setprio(1); _Pragma("unroll") for (int m = 0; m < 4; ++m) _Pragma("unroll") for (int n = 0; n < 2; ++n) _Pragma("unroll") for (int k = 0; k < 2; ++k) \
        acc[ai][bj][m][n] = __builtin_amdgcn_mfma_f32_16x16x32_bf16(Bt[n][k], At[m][k], acc[ai][bj][m][n], 0, 0, 0); __builtin_amdgcn_s_setprio(0); } while (0)
#define PG8_WAIT_V(n) asm volatile("s_waitcnt vmcnt(" #n ")" ::: "memory")
#define PG8_WAIT_L(n) asm volatile("s_waitcnt lgkmcnt(" #n ")" ::: "memory")
#define PG8_BAR __builtin_amdgcn_s_barrier()
#define PG8_SCHED __builtin_amdgcn_sched_barrier(0)
    Unit cur, nxt; int ui = 0;
    if (!S.next(0, cur)) return;
    f32x4 acc[2][2][4][2];
#pragma unroll
    for (int a = 0; a < 2; ++a)
#pragma unroll
        for (int b = 0; b < 2; ++b)
#pragma unroll
            for (int m = 0; m < 4; ++m)
#pragma unroll
                for (int n = 0; n < 2; ++n) acc[a][b][m][n] = (f32x4){0.f, 0.f, 0.f, 0.f};
    bf16x8 At[4][2], B0[2][2], B1[2][2];
    const char* cA = (const char*)g.A + (size_t)cur.pm * tstep; const char* cB = (const char*)g.Bt + (size_t)cur.pn * tstep;
    S.a_ready(cur);
    if constexpr (SP2) {
        PG8_STAGE(PG8_SB(0, 0), cB, voffB); PG8_STAGE(PG8_SB(0, 1), cB + hstep, voffB); PG8_STAGE(PG8_SA(0, 0), cA, voffA); PG8_STAGE(PG8_SA(0, 1), cA + hstep, voffA);
        if (wr == 1) PG8_BAR;
        PG8_WAIT_V(2); PG8_BAR;
        PG8_STAGE(PG8_SB(1, 0), cB + kstep, voffB); PG8_STAGE(PG8_SA(1, 0), cA + kstep, voffA); PG8_STAGE(PG8_SB(1, 1), cB + hstep + kstep, voffB);
        PG8_WAIT_V(6); PG8_BAR;
    } else {
        PG8_STAGE(PG8_SB(0, 0), cB, voffB); PG8_STAGE(PG8_SA(0, 0), cA, voffA); PG8_STAGE(PG8_SB(0, 1), cB + hstep, voffB); PG8_STAGE(PG8_SA(0, 1), cA + hstep, voffA);
        if (wr == 1) PG8_BAR;
        PG8_WAIT_V(4); PG8_BAR;
        PG8_STAGE(PG8_SB(1, 0), cB + kstep, voffB); PG8_STAGE(PG8_SA(1, 0), cA + kstep, voffA); PG8_STAGE(PG8_SB(1, 1), cB + hstep + kstep, voffB);
        PG8_WAIT_V(6); PG8_BAR;
    }
    for (;;) {
        const bool has_next = S.next(ui + 1, nxt);
        const char* nA = has_next ? (const char*)g.A + (size_t)nxt.pm * tstep : cA; const char* nB = has_next ? (const char*)g.Bt + (size_t)nxt.pn * tstep : cB;
        for (int t = 0; t < nt; t += 2) {
            const bool last = (t == nt - 2);
            const char* a1 = cA + (size_t)(t + 1) * kstep;
            const char* a2 = last ? nA : cA + (size_t)(t + 2) * kstep; const char* b2 = last ? nB : cB + (size_t)(t + 2) * kstep;
            const char* a3 = a2 + kstep; const char* b3 = b2 + kstep;
            if (last && has_next) S.a_ready(nxt);
            if constexpr (SP2) {
            PG8_LDB(B0, 0, 0); PG8_LDB(B1, 0, 1); PG8_SCHED; PG8_LDA(At, 0, 0); PG8_STAGE(PG8_SA(1, 1), a1 + hstep, voffA);
            PG8_WAIT_V(8); PG8_WAIT_L(0); PG8_BAR; PG8_MMA(0, 0, At, B0); PG8_MMA(0, 1, At, B1); PG8_BAR; PG8_SCHED;
            PG8_LDA(At, 0, 1); PG8_STAGE(PG8_SB(0, 0), b2, voffB); PG8_STAGE(PG8_SB(0, 1), b2 + hstep, voffB); PG8_STAGE(PG8_SA(0, 0), a2, voffA);
            PG8_WAIT_V(8); PG8_WAIT_L(0); PG8_BAR; PG8_MMA(1, 0, At, B0); PG8_MMA(1, 1, At, B1); PG8_BAR; PG8_SCHED;
            PG8_LDB(B0, 1, 0); PG8_LDB(B1, 1, 1); PG8_SCHED; PG8_LDA(At, 1, 0); PG8_STAGE(PG8_SA(0, 1), a2 + hstep, voffA);
            PG8_WAIT_V(8); PG8_WAIT_L(0); PG8_BAR; PG8_MMA(0, 0, At, B0); PG8_MMA(0, 1, At, B1); PG8_BAR; PG8_SCHED;
            PG8_LDA(At, 1, 1); PG8_STAGE(PG8_SB(1, 0), b3, voffB); PG8_STAGE(PG8_SB(1, 1), b3 + hstep, voffB); PG8_STAGE(PG8_SA(1, 0), a3, voffA);
            PG8_WAIT_V(8); PG8_WAIT_L(0); PG8_BAR; PG8_MMA(1, 0, At, B0); PG8_MMA(1, 1, At, B1); PG8_BAR; PG8_SCHED;
            } else {
            PG8_LDB(B0, 0, 0); PG8_SCHED; PG8_LDA(At, 0, 0); PG8_STAGE(PG8_SA(1, 1), a1 + hstep, voffA);
            PG8_WAIT_L(8); PG8_BAR; PG8_WAIT_L(0); PG8_MMA(0, 0, At, B0); PG8_BAR; PG8_SCHED;
            PG8_LDB(B1, 0, 1); PG8_STAGE(PG8_SB(0, 0), b2, voffB);
            PG8_BAR; PG8_WAIT_L(0); PG8_MMA(0, 1, At, B1); PG8_BAR;
            PG8_LDA(At, 0, 1); PG8_STAGE(PG8_SA(0, 0), a2, voffA);
            PG8_BAR; PG8_WAIT_L(0); PG8_MMA(1, 0, At, B0); PG8_BAR; PG8_SCHED;
            PG8_STAGE(PG8_SB(0, 1), b2 + hstep, voffB);
            PG8_WAIT_V(6); PG8_BAR; PG8_MMA(1, 1, At, B1); PG8_BAR;
            PG8_LDB(B0, 1, 0); PG8_SCHED; PG8_LDA(At, 1, 0); PG8_STAGE(PG8_SA(0, 1), a2 + hstep, voffA);
            PG8_WAIT_L(8); PG8_BAR; PG8_WAIT_L(0); PG8_MMA(0, 0, At, B0); PG8_BAR; PG8_SCHED;
            PG8_LDB(B1, 1, 1); PG8_STAGE(PG8_SB(1, 0), b3, voffB);
            PG8_BAR; PG8_WAIT_L(0); PG8_MMA(0, 1, At, B1); PG8_BAR;
            PG8_LDA(At, 1, 1); PG8_STAGE(PG8_SA(1, 0), a3, voffA);
            PG8_BAR; PG8_WAIT_L(0); PG8_MMA(1, 0, At, B0); PG8_BAR; PG8_SCHED;
            PG8_STAGE(PG8_SB(1, 1), b3 + hstep, voffB);
            PG8_WAIT_V(6); PG8_BAR; PG8_MMA(1, 1, At, B1); PG8_BAR;
            }
        }
        if constexpr (ALIGN_EPI) { if (wr == 0) PG8_BAR; }
        if constexpr (!Epi::AFTER_DRAIN) { E(acc, cur, wr, wc, fr, fq); S.done(cur); }
        if (!has_next) break;
#pragma unroll
        for (int a = 0; a < 2; ++a)
#pragma unroll
            for (int b = 0; b < 2; ++b)
#pragma unroll
                for (int m = 0; m < 4; ++m)
#pragma unroll
                    for (int n = 0; n < 2; ++n) acc[a][b][m][n] = (f32x4){0.f, 0.f, 0.f, 0.f};
        cur = nxt; cA = nA; cB = nB; ++ui;
        if constexpr (ALIGN_EPI) { if (wr == 1) PG8_BAR; }
    }
    PG8_WAIT_V(0);
    if constexpr (!ALIGN_EPI) { if (wr == 0) PG8_BAR; }
    PG8_BAR;
    if constexpr (Epi::AFTER_DRAIN) { E.fused(acc, cur, wr, wc, fr, fq, lds, wid, lane); S.done(cur); }
#undef PG8_SA
#undef PG8_SB
#undef PG8_STAGE
#undef PG8_LDA
#undef PG8_LDB
#undef PG8_MMA
#undef PG8_WAIT_V
#undef PG8_WAIT_L
#undef PG8_BAR
#undef PG8_SCHED
}
}
namespace pg8 {
__device__ __forceinline__ u32x4 pack8bf(const f32x4 a, const f32x4 b) { u32x4 w; w.x = cvt_pk_bf16(a[0], a[1]); w.y = cvt_pk_bf16(a[2], a[3]); w.z = cvt_pk_bf16(b[0], b[1]); w.w = cvt_pk_bf16(b[2], b[3]); return w; }
__device__ __forceinline__ void rope8(f32x4& v0, f32x4& v1, const f32x4 cs, const f32x4 sn) {
    float a, b;
    a = v0[0]; b = v0[1]; v0[0] = a * cs[0] - b * sn[0]; v0[1] = b * cs[0] + a * sn[0];
    a = v0[2]; b = v0[3]; v0[2] = a * cs[1] - b * sn[1]; v0[3] = b * cs[1] + a * sn[1];
    a = v1[0]; b = v1[1]; v1[0] = a * cs[2] - b * sn[2]; v1[1] = b * cs[2] + a * sn[2];
    a = v1[2]; b = v1[3]; v1[2] = a * cs[3] - b * sn[3]; v1[3] = b * cs[3] + a * sn[3];
}
__device__ __forceinline__ float silu_f(float x) { return x * __builtin_amdgcn_rcpf(1.0f + __builtin_amdgcn_exp2f(-1.4426950408889634f * x)); }
__device__ __forceinline__ float sq4(const f32x4 v) { return (v[0] * v[0] + v[1] * v[1]) + (v[2] * v[2] + v[3] * v[3]); }
template <int NP> __device__ __forceinline__ float row_scale(const float* SS, size_t row, float inv_n, float eps, int fq) {
    const float* p = SS + row * NP; float s;
    if constexpr (NP == 32) { const f32x4 a = *(const f32x4*)(p + fq * 8), b = *(const f32x4*)(p + fq * 8 + 4); s = ((a[0] + a[1]) + (a[2] + a[3])) + ((b[0] + b[1]) + (b[2] + b[3])); s += __shfl_xor(s, 16); s += __shfl_xor(s, 32); }
    else if constexpr (NP == 8) { const f32x4 a = *(const f32x4*)p, b = *(const f32x4*)(p + 4); s = ((a[0] + a[1]) + (a[2] + a[3])) + ((b[0] + b[1]) + (b[2] + b[3])); }
    else { const f32x4 a = *(const f32x4*)p; s = (a[0] + a[1]) + (a[2] + a[3]); }
    return 1.0f / sqrtf(s * inv_n + eps);
}

struct EpiIn {
    static constexpr bool PERM = true, AFTER_DRAIN = false;
    const float* XSS; bf16_t* CQ; bf16_t* CKV; float* CQSS; float* CKVSS; bf16_t* Kb; const float* c64; const float* s64;
    bf16_t* RQ; bf16_t* RK; bf16_t* RV; bf16_t* RG; const float* c128; const float* s128;
    const PG8_LAS float* rtab; int rpm;
    __device__ __forceinline__ void operator()(const f32x4 (&acc)[2][2][4][2], const Unit& u, int wr, int wc, int fr, int fq) const {
        const int pn = u.pn, row0 = u.pm * BM + wr * 64 + fr, cw = wc * 32 + 8 * fq;
#pragma unroll
        for (int ai = 0; ai < 2; ++ai) {
            float r4[4];
#pragma unroll
            for (int m = 0; m < 4; ++m) r4[m] = (u.pm == rpm) ? rtab[wr * 64 + fr + ai * HALF + m * 16] : row_scale<32>(XSS, (size_t)(row0 + ai * HALF + m * 16), 1.0f / 2048.0f, 1e-6f, fq);
            asm volatile("" : "+v"(r4[0]), "+v"(r4[1]), "+v"(r4[2]), "+v"(r4[3]));
            if (pn < 3) {
#pragma unroll
                for (int m = 0; m < 4; ++m) { const size_t row = (size_t)(row0 + ai * HALF + m * 16); const float r = r4[m];
                    const f32x4 a0 = acc[ai][0][m][0] * r, a1 = acc[ai][0][m][1] * r, b0 = acc[ai][1][m][0] * r, b1 = acc[ai][1][m][1] * r;
                    float s = (sq4(a0) + sq4(a1)) + (sq4(b0) + sq4(b1)); s += __shfl_xor(s, 16); s += __shfl_xor(s, 32);
                    if (pn < 2) { bf16_t* rp = CQ + row * 512 + pn * 256 + cw; *(u32x4*)rp = pack8bf(a0, a1); *(u32x4*)(rp + HALF) = pack8bf(b0, b1); if (fq == 0) CQSS[row * 8 + pn * 4 + wc] = s; }
                    else { bf16_t* rp = CKV + row * 256 + cw; *(u32x4*)rp = pack8bf(a0, a1); *(u32x4*)(rp + HALF) = pack8bf(b0, b1); if (fq == 0) CKVSS[row * 4 + wc] = s; } }
            } else if (pn == 3) {
                if (wc < 2) { const int j0 = cw >> 1;
#pragma unroll
                    for (int m = 0; m < 4; ++m) { const size_t row = (size_t)(row0 + ai * HALF + m * 16); const float r = r4[m];
                        const f32x4 cs = *(const f32x4*)(c64 + row * 32 + j0), sn = *(const f32x4*)(s64 + row * 32 + j0);
                        f32x4 v0 = acc[ai][0][m][0] * r, v1 = acc[ai][0][m][1] * r; rope8(v0, v1, cs, sn); const u32x4 w = pack8bf(v0, v1);
                        bf16_t* kp = Kb + row * 1536 + 128 + cw;
#pragma unroll
                        for (int h = 0; h < 8; ++h) *(u32x4*)(kp + h * 192) = w; } }
            } else if (pn < 12) {
                bf16_t* T = pn < 8 ? RQ : RK; const float sc = pn < 8 ? 0.08838834764831845f : 1.0f; const int ct = ((pn - 4) & 3) * 256 + cw, j0 = cw >> 1;
#pragma unroll
                for (int m = 0; m < 4; ++m) { const size_t row = (size_t)(row0 + ai * HALF + m * 16); const float r = r4[m] * sc;
                    const f32x4 cs = *(const f32x4*)(c128 + row * 64 + j0), sn = *(const f32x4*)(s128 + row * 64 + j0);
#pragma unroll
                    for (int bj = 0; bj < 2; ++bj) { f32x4 v0 = acc[ai][bj][m][0] * r, v1 = acc[ai][bj][m][1] * r; rope8(v0, v1, cs, sn);
                        *(u32x4*)(T + row * 1024 + ct + bj * HALF) = pack8bf(v0, v1); } }
            } else if (pn < 16) {
                const int ct = (pn - 12) * 256 + cw;
#pragma unroll
                for (int m = 0; m < 4; ++m) { const size_t row = (size_t)(row0 + ai * HALF + m * 16); bf16_t* rp = RV + row * 1024 + ct; const float r = r4[m];
#pragma unroll
                    for (int bj = 0; bj < 2; ++bj) *(u32x4*)(rp + bj * HALF) = pack8bf(acc[ai][bj][m][0] * r, acc[ai][bj][m][1] * r); }
            } else {
                const int ct = (pn - 16) * 256 + cw;
#pragma unroll
                for (int m = 0; m < 4; ++m) { const size_t row = (size_t)(row0 + ai * HALF + m * 16); bf16_t* rp = RG + row * 1024 + ct; const float r = r4[m];
#pragma unroll
                    for (int bj = 0; bj < 2; ++bj) { f32x4 v0 = acc[ai][bj][m][0] * r, v1 = acc[ai][bj][m][1] * r;
#pragma unroll
                        for (int e = 0; e < 4; ++e) { v0[e] = silu_f(v0[e]); v1[e] = silu_f(v1[e]); }
                        *(u32x4*)(rp + bj * HALF) = pack8bf(v0, v1); } }
            }
        }
    }
};
struct EpiQ {
    static constexpr bool PERM = true, AFTER_DRAIN = false;
    const float* CQSS; bf16_t* Q; const float* c64; const float* s64; float sc;
    __device__ __forceinline__ void operator()(const f32x4 (&acc)[2][2][4][2], const Unit& u, int wr, int wc, int fr, int fq) const {
        const int row0 = u.pm * BM + wr * 64 + fr, cw = wc * 32 + 8 * fq;
#pragma unroll
        for (int ai = 0; ai < 2; ++ai)
#pragma unroll
            for (int m = 0; m < 4; ++m) { const size_t row = (size_t)(row0 + ai * HALF + m * 16); const float r = row_scale<8>(CQSS, row, 1.0f / 512.0f, 1e-6f, fq) * sc;
#pragma unroll
                for (int bj = 0; bj < 2; ++bj) { const int c0 = u.pn * 256 + bj * HALF + cw, dd = c0 % 192; const bool rp = dd >= 128; const int j0 = rp ? ((dd - 128) >> 1) : 0;
                    f32x4 v0 = acc[ai][bj][m][0] * r, v1 = acc[ai][bj][m][1] * r;
                    if (rp) { const f32x4 cs = *(const f32x4*)(c64 + row * 32 + j0), sn = *(const f32x4*)(s64 + row * 32 + j0); rope8(v0, v1, cs, sn); }
                    *(u32x4*)(Q + row * 1536 + c0) = pack8bf(v0, v1); } }
    }
};
struct EpiKV {
    static constexpr bool PERM = true, AFTER_DRAIN = false;
    const float* CKVSS; bf16_t* K; bf16_t* V;
    __device__ __forceinline__ void operator()(const f32x4 (&acc)[2][2][4][2], const Unit& u, int wr, int wc, int fr, int fq) const {
        const int row0 = u.pm * BM + wr * 64 + fr, cw = wc * 32 + 8 * fq;
#pragma unroll
        for (int ai = 0; ai < 2; ++ai)
#pragma unroll
            for (int m = 0; m < 4; ++m) { const size_t row = (size_t)(row0 + ai * HALF + m * 16); const float r = row_scale<4>(CKVSS, row, 1.0f / 256.0f, 1e-6f, fq);
                *(u32x4*)(K + row * 1536 + u.pn * 192 + cw) = pack8bf(acc[ai][0][m][0] * r, acc[ai][0][m][1] * r);
                *(u32x4*)(V + row * 1024 + u.pn * 128 + cw) = pack8bf(acc[ai][1][m][0] * r, acc[ai][1][m][1] * r); }
    }
};
template <bool SCALE2  , bool WRITE_XB>
struct EpiResT {
    static constexpr bool PERM = true, AFTER_DRAIN = false;
    const float* base; float* out; bf16_t* XB; float* XSS; const float* RS; const PG8_LAS float* rtab; int rpm;
    __device__ __forceinline__ void operator()(const f32x4 (&acc)[2][2][4][2], const Unit& u, int wr, int wc, int fr, int fq) const {
        const int row0 = u.pm * BM + wr * 64 + fr, c0 = u.pn * BM + wc * 32 + 8 * fq;
#pragma unroll
        for (int ai = 0; ai < 2; ++ai) {
            float r2[4];
#pragma unroll
            for (int m = 0; m < 4; ++m) { if constexpr (SCALE2) { const float r = (u.pm == rpm) ? rtab[wr * 64 + fr + ai * HALF + m * 16] : row_scale<32>(RS, (size_t)(row0 + ai * HALF + m * 16), 1.0f / 2048.0f, 1e-6f, fq); r2[m] = r * r; } else r2[m] = 1.0f; }
            if constexpr (SCALE2) asm volatile("" : "+v"(r2[0]), "+v"(r2[1]), "+v"(r2[2]), "+v"(r2[3]));
            f32x4 pre[4][4];
#pragma unroll
            for (int m = 0; m < 4; ++m) { const size_t off = (size_t)(row0 + ai * HALF + m * 16) * 2048 + c0;
                pre[m][0] = *(const f32x4*)(base + off); pre[m][1] = *(const f32x4*)(base + off + 4); pre[m][2] = *(const f32x4*)(base + off + HALF); pre[m][3] = *(const f32x4*)(base + off + HALF + 4); }
#pragma unroll
            for (int m = 0; m < 4; ++m) asm volatile("" : "+v"(pre[m][0]), "+v"(pre[m][1]), "+v"(pre[m][2]), "+v"(pre[m][3]));
#pragma unroll
            for (int m = 0; m < 4; ++m) { const size_t row = (size_t)(row0 + ai * HALF + m * 16); const size_t off = row * 2048 + c0;
                f32x4 a0, a1, b0, b1;
                if constexpr (SCALE2) { a0 = pre[m][0] + acc[ai][0][m][0] * r2[m]; a1 = pre[m][1] + acc[ai][0][m][1] * r2[m]; b0 = pre[m][2] + acc[ai][1][m][0] * r2[m]; b1 = pre[m][3] + acc[ai][1][m][1] * r2[m]; }
                else { a0 = pre[m][0] + acc[ai][0][m][0]; a1 = pre[m][1] + acc[ai][0][m][1]; b0 = pre[m][2] + acc[ai][1][m][0]; b1 = pre[m][3] + acc[ai][1][m][1]; }
                *(f32x4*)(out + off) = a0; *(f32x4*)(out + off + 4) = a1; *(f32x4*)(out + off + HALF) = b0; *(f32x4*)(out + off + HALF + 4) = b1;
                if constexpr (WRITE_XB) { *(u32x4*)(XB + off) = pack8bf(a0, a1); *(u32x4*)(XB + off + HALF) = pack8bf(b0, b1); }
                float s = (sq4(a0) + sq4(a1)) + (sq4(b0) + sq4(b1)); s += __shfl_xor(s, 16); s += __shfl_xor(s, 32);
                if (fq == 0) XSS[row * 32 + u.pn * 4 + wc] = s; }
        }
    }
};
struct EpiRelu2 {
    static constexpr bool PERM = true, AFTER_DRAIN = false;
    bf16_t* O; int ldc;
    __device__ __forceinline__ void operator()(const f32x4 (&acc)[2][2][4][2], const Unit& u, int wr, int wc, int fr, int fq) const {
        const int row0 = u.pm * BM + wr * 64 + fr, c0 = u.pn * BM + wc * 32 + 8 * fq;
#pragma unroll
        for (int ai = 0; ai < 2; ++ai)
#pragma unroll
            for (int m = 0; m < 4; ++m) { bf16_t* rp = O + (size_t)(row0 + ai * HALF + m * 16) * ldc + c0;
#pragma unroll
                for (int bj = 0; bj < 2; ++bj) { f32x4 v0 = acc[ai][bj][m][0], v1 = acc[ai][bj][m][1];
#pragma unroll
                    for (int e = 0; e < 4; ++e) { v0[e] = __int_as_float(max(__float_as_int(v0[e]), 0)); v1[e] = __int_as_float(max(__float_as_int(v1[e]), 0)); }
                    v0 = v0 * v0; v1 = v1 * v1;
                    *(u32x4*)(rp + bj * HALF) = pack8bf(v0, v1); } }
    }
};
}
constexpr int NWAVES = 8;
constexpr int BATCH = 2, SEQ = 8192, DM = 2048, DEPTH = 4, M = BATCH * SEQ;
constexpr int NH = 8, QLORA = 512, KVLORA = 256, DQK = 192, DNOPE = 128, DROPE = 64, DV = 128, FF = 8192;
constexpr int IN_SRC = 4928, IN_PAD = 5120;
constexpr int RCH = 128, NCH = SEQ / RCH;
constexpr float NORM_EPS = 1e-6f, GN_EPS = 1e-6f;
constexpr float QSCALE = 0.07216878364870323f * 1.4426950408889634f;

constexpr size_t MiB = 1u << 20;
constexpr size_t WS_CTL = 0, CTL_ZERO_BYTES = 128 * 1024;
constexpr size_t WS_C64 = 2 * MiB, WS_S64 = 4 * MiB, WS_C128 = 6 * MiB, WS_S128 = 10 * MiB;
constexpr size_t WS_XSS = 14 * MiB;
constexpr size_t WS_W = 16 * MiB, W_STRIDE = 96 * MiB;
constexpr size_t WO_WIN = 0, WO_WUQ = 20 * MiB, WO_WUKV = 22 * MiB, WO_WO = 24 * MiB, WO_WUP = 32 * MiB, WO_WDN = 64 * MiB;
constexpr size_t WS_XB = 208 * MiB;
constexpr size_t WS_MIX = 272 * MiB;
constexpr size_t WS_CQSS = 336 * MiB, WS_CKVSS = 337 * MiB;
constexpr size_t WS_RQ = 338 * MiB, WS_RK = 370 * MiB, WS_RV = 402 * MiB, WS_RG = 434 * MiB;
constexpr size_t WS_CQ = 466 * MiB, WS_CKV = 482 * MiB;
constexpr size_t WS_Q = 490 * MiB, WS_K = 538 * MiB, WS_V = 586 * MiB;
constexpr size_t WS_U = 618 * MiB, WS_S = 682 * MiB;
constexpr size_t WS_UF = 338 * MiB;
constexpr size_t WS_XSS2 = 714 * MiB;
constexpr size_t WS_END = 716 * MiB;
static_assert(WS_UF + (size_t)M * FF * 2 <= WS_U && WS_S + (size_t)16 * 64 * 16384 * 2 <= WS_END && WS_U + (size_t)16 * 64 * 16384 * 4 <= WS_S, "d_ws map");
static_assert(WO_WIN + (size_t)IN_PAD * DM * 2 <= WO_WUQ && WO_WUQ + (size_t)1536 * 512 * 2 <= WO_WUKV && WO_WUKV + (size_t)2048 * 256 * 2 <= WO_WO && WO_WO + (size_t)DM * DM * 2 <= WO_WUP && WO_WUP + (size_t)FF * DM * 2 <= WO_WDN && WO_WDN + (size_t)FF * DM * 2 <= W_STRIDE && WS_W + 2 * W_STRIDE <= WS_XB, "weights map");
constexpr int CW_TMO = 0, CW_CODE = 1, CW_BAR = 4096;
constexpr int CW_AQ = 12288;
constexpr int CW_SRDY = 12544, CW_RQ = 12800;
constexpr int CW_PB = 13312;
static_assert((CW_PB + DEPTH * 2 * 64 * 16) * 4 <= (int)CTL_ZERO_BYTES && CW_PB >= CW_RQ + 64 * DEPTH, "panel counters inside the per-call memset");
constexpr int CW_WQ = 8192;
static_assert(CW_BAR + 3456 <= CW_WQ && (CW_WQ + 64 * DEPTH) <= CW_AQ && (CW_AQ + 64 * DEPTH) <= CW_SRDY && (CW_SRDY + 64 * DEPTH) <= CW_RQ && (CW_RQ + 64 * DEPTH) * 4 <= (int)CTL_ZERO_BYTES, "control words inside the per-call memset");

constexpr int RING_OFF = 0, RING_BYTES = 131072;
constexpr int LDSCTL_OFF = RING_BYTES, MISC_OFF = LDSCTL_OFF + 320;
constexpr int LDS_BYTES = 147456;
static_assert(MISC_OFF + 128 <= LDS_BYTES, "LDS map");

#define GAS __attribute__((address_space(1)))
#define LAS __attribute__((address_space(3)))
typedef unsigned short bf16;
typedef unsigned v4u __attribute__((ext_vector_type(4)));
typedef float f32x4 __attribute__((ext_vector_type(4)));
typedef short bf16x8 __attribute__((ext_vector_type(8)));
typedef GAS unsigned gu32;
typedef GAS unsigned long long gu64;
#define RLX_AGENT __ATOMIC_RELAXED, __HIP_MEMORY_SCOPE_AGENT
#define LDS_WAIT() asm volatile("s_waitcnt lgkmcnt(0)" ::: "memory")
#define VM_WAIT() asm volatile("s_waitcnt vmcnt(0)" ::: "memory")
__device__ __forceinline__ unsigned long long rt() { return __builtin_amdgcn_s_memrealtime(); }
__device__ __forceinline__ unsigned f2bf(float f) { unsigned u = __builtin_bit_cast(unsigned, f); return (u + 0x7fffu + ((u >> 16) & 1u)) >> 16; }
__device__ __forceinline__ unsigned pk2(float lo, float hi) { return f2bf(lo) | (f2bf(hi) << 16); }

#define XB_TMO      128
#define XB_XCNT(j)  (256  + 64 * (j))
#define XB_XSUB(j)  (1280 + 64 * (j))
#define XB_XGEN(j)  (2304 + 64 * (j))
#define XB_TOP      3328
#define XB_TOPGEN   3392
#define XCD_BAR_WORDS 3456
#define XB_SPIN_CAP (1u << 18)

__device__ __forceinline__ unsigned xb_ld(unsigned* p)              { return __hip_atomic_load(p, __ATOMIC_RELAXED, __HIP_MEMORY_SCOPE_AGENT); }
__device__ __forceinline__ unsigned xb_add(unsigned* p, unsigned v) { return __hip_atomic_fetch_add(p, v, __ATOMIC_RELAXED, __HIP_MEMORY_SCOPE_AGENT); }
__device__ __forceinline__ unsigned xb_xcc_id() { return (unsigned)__builtin_amdgcn_s_getreg((3 << 11) | 20) & 0xFu; }
#define XB_SPIN(cond, bar) do { unsigned _sp = 0; while (cond) { __builtin_amdgcn_s_sleep(1); \
    if ((++_sp & 255u) == 0u) { if (xb_ld(&(bar)[XB_TMO])) break; if (_sp > XB_SPIN_CAP) { atomicAdd(&(bar)[XB_TMO], 1u); break; } } } } while (0)

struct XcdBarrier {
    unsigned* bar; unsigned x;
    volatile LAS unsigned* st;
};

__device__ __forceinline__ XcdBarrier xcd_barrier_post(unsigned* bar, volatile LAS unsigned* st) {
    XcdBarrier b; b.bar = bar; b.x = xb_xcc_id(); b.st = st;
    if (threadIdx.x == 0) (void)xb_add(&bar[XB_XCNT(b.x)], 1u);
    return b;
}
__device__ __forceinline__ void xcd_barrier_complete(unsigned* bar, unsigned x, unsigned& nloc, unsigned& nx) {
    const unsigned G = gridDim.x * gridDim.y * gridDim.z;
    unsigned sum, cnt, mine, sp = 0u;
    for (;;) {
        sum = 0u; cnt = 0u; mine = 0u;
#pragma unroll
        for (unsigned j = 0; j < 16; ++j) { const unsigned c = xb_ld(&bar[XB_XCNT(j)]); sum += c; cnt += (c > 0u) ? 1u : 0u; mine = (j == x) ? c : mine; }
        if (sum == G) break;
        __builtin_amdgcn_s_sleep(1);
        if ((++sp & 255u) == 0u) { if (xb_ld(&bar[XB_TMO])) break; if (sp > XB_SPIN_CAP) { atomicAdd(&bar[XB_TMO], 1u); break; } }
    }
    nloc = mine > 0u ? mine : 1u; nx = cnt > 0u ? cnt : 1u;
}

__device__ __forceinline__ void xcd_barrier(const XcdBarrier& b) {
    asm volatile("s_waitcnt vmcnt(0)" ::: "memory");
    __syncthreads();
    if (threadIdx.x == 0) {
        unsigned* bar = b.bar;
        __builtin_amdgcn_s_waitcnt(0);
        unsigned nloc = b.st[0], nx = b.st[1];
        if (nloc == 0u) { xcd_barrier_complete(bar, b.x, nloc, nx); b.st[0] = nloc; b.st[1] = nx; }
        const unsigned old = xb_add(&bar[XB_XSUB(b.x)], 1u);
        const unsigned gen = old / nloc;
        if (old + 1u == (gen + 1u) * nloc) {
            __builtin_amdgcn_fence(__ATOMIC_RELEASE, "agent");
            asm volatile("s_waitcnt vmcnt(0)" ::: "memory");
            const unsigned og = xb_add(&bar[XB_TOP], 1u);
            const unsigned tg = og / nx;
            if (og + 1u == (tg + 1u) * nx) xb_add(&bar[XB_TOPGEN], 1u);
            else XB_SPIN(xb_ld(&bar[XB_TOPGEN]) == tg, bar);
            __builtin_amdgcn_fence(__ATOMIC_ACQUIRE, "agent");
            xb_add(&bar[XB_XGEN(b.x)], 1u);
            asm volatile("s_waitcnt vmcnt(0)" ::: "memory");
        } else {
            XB_SPIN(xb_ld(&bar[XB_XGEN(b.x)]) == gen, bar);
            __builtin_amdgcn_fence(__ATOMIC_ACQUIRE, "agent");
            asm volatile("s_waitcnt vmcnt(0)" ::: "memory");
        }
    }
    __syncthreads();
}

__device__ __forceinline__ void panel_post(unsigned* cnt, const pg8::StaticOrder& S) {
    asm volatile("s_waitcnt vmcnt(0)" ::: "memory");
    __syncthreads();
    if (threadIdx.x == 0) {
        __builtin_amdgcn_fence(__ATOMIC_RELEASE, "agent"); asm volatile("s_waitcnt vmcnt(0)" ::: "memory");
        pg8::Unit u; for (int i = 0; S.next(i, u); ++i) (void)xb_add(&cnt[u.pm * 16], 1u);
    }
}
__device__ __forceinline__ void panel_wait(unsigned* cnt, const pg8::StaticOrder& S, unsigned need, unsigned* bar) {
    if (threadIdx.x == 0) {
        pg8::Unit u; for (int i = 0; S.next(i, u); ++i) XB_SPIN(xb_ld(&cnt[u.pm * 16]) < need, bar);
        __builtin_amdgcn_fence(__ATOMIC_ACQUIRE, "agent"); asm volatile("s_waitcnt vmcnt(0)" ::: "memory");
    }
    __syncthreads();
}

typedef short s16x4 __attribute__((ext_vector_type(4)));
typedef float f32x16 __attribute__((ext_vector_type(16)));
typedef float f32x2 __attribute__((ext_vector_type(2)));
typedef LAS unsigned char* ldsp;
typedef const LAS unsigned char* cldsp;
#define SBARRIER() do { __builtin_amdgcn_s_barrier(); asm volatile("" ::: "memory"); } while (0)
__device__ __forceinline__ float wave_sum(float v) {
#pragma unroll
    for (int o = 1; o < 64; o <<= 1) v += __shfl_xor(v, o);
    return v;
}
__device__ __forceinline__ unsigned cvtpk(float lo, float hi) { unsigned r; asm volatile("v_cvt_pk_bf16_f32 %0, %1, %2" : "=v"(r) : "v"(lo), "v"(hi)); return r; }
__device__ __forceinline__ float bf_lo(unsigned w) { return __builtin_bit_cast(float, w << 16); }
__device__ __forceinline__ float bf_hi(unsigned w) { return __builtin_bit_cast(float, w & 0xffff0000u); }
__device__ __forceinline__ int crow(int r, int hi) { return (r & 3) + 8 * (r >> 2) + 4 * hi; }
__device__ __forceinline__ void glds16(const void* g, ldsp l) { __builtin_amdgcn_global_load_lds((const unsigned*)g, (LAS unsigned*)l, 16, 0, 0); }
typedef short v4i16_t __attribute__((ext_vector_type(4)));
__device__ __forceinline__ s16x4 trrd(cldsp p) { return __builtin_bit_cast(s16x4, __builtin_amdgcn_ds_read_tr16_b64_v4i16((LAS v4i16_t*)p)); }
#define MK8(lo, hi) ((bf16x8){(lo)[0], (lo)[1], (lo)[2], (lo)[3], (hi)[0], (hi)[1], (hi)[2], (hi)[3]})
__device__ __forceinline__ bf16x8 pack8f(const f32x16& p, int b) {
    v4u w; w.x = cvtpk(p[b], p[b + 1]); w.y = cvtpk(p[b + 2], p[b + 3]); w.z = cvtpk(p[b + 4], p[b + 5]); w.w = cvtpk(p[b + 6], p[b + 7]); return __builtin_bit_cast(bf16x8, w);
}
#define MFMA32(a, b, c) __builtin_amdgcn_mfma_f32_32x32x16_bf16((a), (b), (c), 0, 0, 0)
__device__ __forceinline__ int tr_att_base(int lane) { return (4 * (lane >> 5) + ((lane & 15) >> 2)) * 64 + ((lane >> 4) & 1) * 32 + (lane & 3) * 8; }
__device__ __forceinline__ int tr_nat_base(int lane) { return (8 * (lane >> 5) + ((lane & 15) >> 2)) * 64 + ((lane >> 4) & 1) * 32 + (lane & 3) * 8; }

struct Args {
    const float* x; const int* pos; const float* attn_norm; const float* w_in; const float* q_norm; const float* kv_norm; const float* w_uq; const float* w_ukv;
    const float* beta_attn; const float* beta_ret; const float* w_o; const float* mlp_norm; const float* w_up; const float* w_down; const float* final_norm;
    float* out; unsigned char* ws;
    double invf64[32]; double invf128[64];
    float lg2g[8];
};
static_assert(sizeof(Args) == 17 * 8 + 96 * 8 + 32, "Args has no padding");
typedef const __attribute__((address_space(4))) Args* cargs_t;
__device__ __forceinline__ cargs_t get_args() { cargs_t p = (cargs_t)__builtin_amdgcn_kernarg_segment_ptr(); asm volatile("" : "+s"(p)); return p; }

__device__ __forceinline__ void sincos_d(double ang, float& s, float& c) {
    const double k = __builtin_rint(ang * 0.63661977236758134308);
    double y = __builtin_fma(-k, 1.57079632679489655800e+00, ang); y = __builtin_fma(-k, 6.12323399573676603587e-17, y);
    const double z = y * y;
    double sp = 1.0 / 6227020800.0; sp = sp * z - 1.0 / 39916800.0; sp = sp * z + 1.0 / 362880.0; sp = sp * z - 1.0 / 5040.0; sp = sp * z + 1.0 / 120.0; sp = sp * z - 1.0 / 6.0; sp = sp * z + 1.0; sp = sp * y;
    double cp = -1.0 / 87178291200.0; cp = cp * z + 1.0 / 479001600.0; cp = cp * z - 1.0 / 3628800.0; cp = cp * z + 1.0 / 40320.0; cp = cp * z - 1.0 / 720.0; cp = cp * z + 1.0 / 24.0; cp = cp * z - 0.5; cp = cp * z + 1.0;
    const int q = (int)((long long)k & 3);
    const double ss = (q == 0) ? sp : (q == 1) ? cp : (q == 2) ? -sp : -cp;
    const double cc = (q == 0) ? cp : (q == 1) ? -sp : (q == 2) ? -cp : sp;
    s = (float)ss; c = (float)cc;
}
__device__ __forceinline__ void rope_tables(cargs_t a, int gtid, int nthr) {
    unsigned char* ws = a->ws; const int* pos = a->pos;
    float* c64 = (float*)(ws + WS_C64); float* s64 = (float*)(ws + WS_S64); float* c128 = (float*)(ws + WS_C128); float* s128 = (float*)(ws + WS_S128);
    for (int i = gtid; i < M * 96; i += nthr) { const int m = i / 96, j = i - m * 96; const double p = (double)pos[m]; float s, c;
        if (j < 32) { sincos_d(p * a->invf64[j], s, c); c64[m * 32 + j] = c; s64[m * 32 + j] = s; }
        else { sincos_d(p * a->invf128[j - 32], s, c); c128[m * 64 + j - 32] = c; s128[m * 64 + j - 32] = s; } }
}
template <class Map, class Gain>
__device__ __forceinline__ void transpose_item(const float* W, int K, int N, bf16* WT, const Map& map, const Gain& gain, LAS float* scr, int item, int lane) {
    const int nblk = N / 32, kb = item / nblk, nb = item % nblk, k0 = 64 * kb, n0 = 32 * nb;
#pragma unroll 8
    for (int i = 0; i < 32; ++i) { const int kk = 2 * i + (lane >> 5); scr[kk * 33 + (lane & 31)] = W[(size_t)(k0 + kk) * N + n0 + (lane & 31)] * gain(k0 + kk); }
    LDS_WAIT(); asm volatile("" ::: "memory");
    const int c = lane & 7;
#pragma unroll
    for (int j = 0; j < 4; ++j) { const int n = (lane >> 3) + 8 * j; const LAS float* s = scr + (8 * c) * 33 + n;
        v4u o; o.x = pk2(s[0 * 33], s[1 * 33]); o.y = pk2(s[2 * 33], s[3 * 33]); o.z = pk2(s[4 * 33], s[5 * 33]); o.w = pk2(s[6 * 33], s[7 * 33]);
        *(GAS v4u*)(WT + (size_t)map(n0 + n) * K + k0 + 8 * c) = o; }
    LDS_WAIT(); asm volatile("" ::: "memory");
}
struct GainNone { __device__ __forceinline__ float operator()(int) const { return 1.0f; } };
struct GainVec { const float* g; __device__ __forceinline__ float operator()(int k) const { return g[k]; } };
struct GainVec2 { const float* g0; const float* g1; int split; __device__ __forceinline__ float operator()(int k) const { return k < split ? g0[k] : g1[k - split]; } };
struct MapId { __device__ __forceinline__ int operator()(int n) const { return n; } };
struct MapWin {
    __device__ __forceinline__ int operator()(int n) const {
        if (n < 768) return n;
        if (n < 832) { const int d = n - 768; return 768 + (d < 32 ? 2 * d : 2 * (d - 32) + 1); }
        if (n < 2880) { const int e = n - 832, g = e >> 7, d = e & 127; return 1024 + g * 128 + (d < 64 ? 2 * d : 2 * (d - 64) + 1); }
        return n + 192;
    }
};
struct MapWuq {
    __device__ __forceinline__ int operator()(int n) const { const int h = n / 192, d = n - h * 192; if (d < 128) return n; const int e = d - 128; return h * 192 + 128 + (e < 32 ? 2 * e : 2 * (e - 32) + 1); }
};
template <bool DYN>
__device__ __forceinline__ void convert_weights(cargs_t a, int l, ldsp lds, int gw, int ngw, int wave, int lane, int gtid, int nthr, unsigned* qctr) {
    unsigned char* wb = a->ws + WS_W + (size_t)(l & 1) * W_STRIDE;
    LAS float* scr = (LAS float*)(lds + RING_OFF + wave * 16384);
    bf16* Win = (bf16*)(wb + WO_WIN); bf16* Wuq = (bf16*)(wb + WO_WUQ); bf16* Wukv = (bf16*)(wb + WO_WUKV); bf16* Wo = (bf16*)(wb + WO_WO); bf16* Wup = (bf16*)(wb + WO_WUP); bf16* Wdn = (bf16*)(wb + WO_WDN);
    const float* w_in = a->w_in + (size_t)l * DM * IN_SRC; const float* w_uq = a->w_uq + (size_t)l * QLORA * 1536; const float* w_ukv = a->w_ukv + (size_t)l * KVLORA * 2048;
    const float* w_o = a->w_o + (size_t)l * DM * DM; const float* w_up = a->w_up + (size_t)l * DM * FF; const float* w_dn = a->w_down + (size_t)l * FF * DM;
    const GainVec g_in{a->attn_norm + l * DM}, g_uq{a->q_norm + l * QLORA}, g_ukv{a->kv_norm + l * KVLORA}, g_up{a->mlp_norm + l * DM}; const GainVec2 g_o{a->beta_attn + l * 1024, a->beta_ret + l * 1024, 1024};
    constexpr int I_IN = (DM / 64) * (IN_SRC / 32), I_UQ = (QLORA / 64) * (1536 / 32), I_UKV = (KVLORA / 64) * (2048 / 32), I_O = (DM / 64) * (DM / 32), I_UP = (DM / 64) * (FF / 32), I_DN = (FF / 64) * (DM / 32);
    constexpr int NITEMS = I_IN + I_UQ + I_UKV + I_O + I_UP + I_DN, CH = 16;
    GAS v4u* pz = (GAS v4u*)(Win + (size_t)832 * DM);
    for (int i = gtid; i < 192 * DM / 8; i += nthr) pz[i] = (v4u){0u, 0u, 0u, 0u};
    int it = DYN ? 0 : gw, it_end = 0;
    for (;;) {
        if constexpr (DYN) { if (it >= it_end) { unsigned c = 0u; if (lane == 0) c = __hip_atomic_fetch_add(qctr, 1u, __ATOMIC_RELAXED, __HIP_MEMORY_SCOPE_AGENT);
                it = (int)__builtin_amdgcn_readfirstlane(c) * CH; it_end = it + CH; if (it >= NITEMS) break; }
            if (it >= NITEMS) break; }
        else { if (it >= NITEMS) break; }
        int r = it;
        if (r < I_IN) transpose_item(w_in, DM, IN_SRC, Win, MapWin(), g_in, scr, r, lane);
        else if ((r -= I_IN) < I_UQ) transpose_item(w_uq, QLORA, 1536, Wuq, MapWuq(), g_uq, scr, r, lane);
        else if ((r -= I_UQ) < I_UKV) transpose_item(w_ukv, KVLORA, 2048, Wukv, MapId(), g_ukv, scr, r, lane);
        else if ((r -= I_UKV) < I_O) transpose_item(w_o, DM, DM, Wo, MapId(), g_o, scr, r, lane);
        else if ((r -= I_O) < I_UP) transpose_item(w_up, DM, FF, Wup, MapId(), g_up, scr, r, lane);
        else { r -= I_UP; transpose_item(w_dn, FF, DM, Wdn, MapId(), GainNone(), scr, r, lane); }
        it += DYN ? 1 : ngw;
    }
}
constexpr int RTAB_OFF = LDSCTL_OFF + 1024;
static_assert(RTAB_OFF + 1024 <= LDS_BYTES, "row-scale table inside the LDS allocation");
__device__ __forceinline__ void fill_rtab(const float* SS, int pm, ldsp lds, int tid) {
    if (tid < 256) { const GAS f32x4* p = (const GAS f32x4*)(SS + (size_t)(pm * 256 + tid) * 32); float s = 0.f;
#pragma unroll
        for (int j = 0; j < 8; ++j) { const f32x4 v = p[j]; s += (v.x + v.y) + (v.z + v.w); }
        ((LAS float*)(lds + RTAB_OFF))[tid] = 1.0f / sqrtf(s * (1.0f / DM) + NORM_EPS); }
    __syncthreads();
}
template <int NR> __device__ __forceinline__ void prep_rows(const float* x, bf16* XB, float* XSS, int row, int stride, int lane) {
    f32x4 v[NR][8]; float s[NR];
#pragma unroll
    for (int q = 0; q < NR; ++q) { const GAS f32x4* xr = (const GAS f32x4*)(x + (size_t)(row + q * stride) * DM) + lane;
#pragma unroll
        for (int j = 0; j < 8; ++j) v[q][j] = xr[64 * j]; }
#pragma unroll
    for (int q = 0; q < NR; ++q) { float t = 0.f;
#pragma unroll
        for (int j = 0; j < 8; ++j) t += (v[q][j].x * v[q][j].x + v[q][j].y * v[q][j].y) + (v[q][j].z * v[q][j].z + v[q][j].w * v[q][j].w);
        s[q] = wave_sum(t); }
#pragma unroll
    for (int q = 0; q < NR; ++q) { GAS unsigned long long* o8 = (GAS unsigned long long*)(XB + (size_t)(row + q * stride) * DM) + lane;
#pragma unroll
        for (int j = 0; j < 8; ++j) o8[64 * j] = (unsigned long long)cvtpk(v[q][j].x, v[q][j].y) | ((unsigned long long)cvtpk(v[q][j].z, v[q][j].w) << 32);
        if (lane < 32) XSS[(size_t)(row + q * stride) * 32 + lane] = (lane == 0) ? s[q] : 0.f; }
}
template <int NR> __device__ __forceinline__ void rms_rows_final(float* xo, const float* XSS, const float* g, int row, int stride, int lane) {
    f32x4 v[NR][8]; float r[NR]; const GAS f32x4* gr = (const GAS f32x4*)g + lane;
#pragma unroll
    for (int q = 0; q < NR; ++q) { const GAS f32x4* xr = (const GAS f32x4*)(xo + (size_t)(row + q * stride) * DM) + lane;
#pragma unroll
        for (int j = 0; j < 8; ++j) v[q][j] = xr[64 * j];
        r[q] = (lane < 32) ? XSS[(size_t)(row + q * stride) * 32 + lane] : 0.f; }
#pragma unroll
    for (int q = 0; q < NR; ++q) r[q] = 1.0f / sqrtf(wave_sum(r[q]) * (1.0f / DM) + NORM_EPS);
#pragma unroll
    for (int q = 0; q < NR; ++q) { GAS f32x4* xr = (GAS f32x4*)(xo + (size_t)(row + q * stride) * DM) + lane;
#pragma unroll
        for (int j = 0; j < 8; ++j) { const f32x4 gg = gr[64 * j]; const float rr = r[q]; xr[64 * j] = (f32x4){v[q][j].x * rr * gg.x, v[q][j].y * rr * gg.y, v[q][j].z * rr * gg.z, v[q][j].w * rr * gg.w}; } }
}
template <int NR> __device__ __forceinline__ void attn_norm_rows(bf16* mix, int row, int stride, int lane) {
    v4u w[NR][2]; float r[NR];
#pragma unroll
    for (int q = 0; q < NR; ++q) { const bf16* p = mix + (size_t)(row + q * stride) * DM; w[q][0] = *(const GAS v4u*)(p + lane * 8); w[q][1] = *(const GAS v4u*)(p + 512 + lane * 8); }
#pragma unroll
    for (int q = 0; q < NR; ++q) { float s = 0.f;
#pragma unroll
        for (int j = 0; j < 2; ++j) { const v4u u = w[q][j]; const float f0 = bf_lo(u.x), f1 = bf_hi(u.x), f2 = bf_lo(u.y), f3 = bf_hi(u.y), f4 = bf_lo(u.z), f5 = bf_hi(u.z), f6 = bf_lo(u.w), f7 = bf_hi(u.w);
            s += ((f0 * f0 + f1 * f1) + (f2 * f2 + f3 * f3)) + ((f4 * f4 + f5 * f5) + (f6 * f6 + f7 * f7)); }
        r[q] = 1.0f / sqrtf(wave_sum(s) * (1.0f / 1024.0f) + NORM_EPS); }
#pragma unroll
    for (int q = 0; q < NR; ++q) { bf16* p = mix + (size_t)(row + q * stride) * DM; const float rr = r[q];
#pragma unroll
        for (int j = 0; j < 2; ++j) { const v4u u = w[q][j]; v4u o; o.x = cvtpk(bf_lo(u.x) * rr, bf_hi(u.x) * rr); o.y = cvtpk(bf_lo(u.y) * rr, bf_hi(u.y) * rr); o.z = cvtpk(bf_lo(u.z) * rr, bf_hi(u.z) * rr); o.w = cvtpk(bf_lo(u.w) * rr, bf_hi(u.w) * rr);
            *(GAS v4u*)(p + j * 512 + lane * 8) = o; } }
}

#ifdef PROBE_ATT
#ifndef PROBE_ATT_WAVE
#define PROBE_ATT_WAVE 0
#endif
#define ATP_DECL() unsigned long long atp_t_ = __builtin_readcyclecounter(), atp_acc_ = 0ull; const bool atp_on_ = (blockIdx.x == 0) && (wid == PROBE_ATT_WAVE)
#define ATP(k) do { if (atp_on_) { const unsigned long long n_ = __builtin_readcyclecounter(); if ((k) == ((PROBE_ATT) + 1) % 4) atp_acc_ += n_ - atp_t_; atp_t_ = n_; } } while (0)
#define ATP_END() do { if (atp_on_ && lane == 0) { volatile LAS unsigned long long* q_ = (volatile LAS unsigned long long*)(lds + LDSCTL_OFF + 80); q_[0] += atp_acc_; } } while (0)
#else
#define ATP_DECL() do { } while (0)
#define ATP(k) do { } while (0)
#define ATP_END() do { } while (0)
#endif
__device__ __forceinline__ float max3f(float a, float b, float c) { float r; asm("v_max3_f32 %0, %1, %2, %3" : "=v"(r) : "v"(a), "v"(b), "v"(c)); return r; }
__device__ __forceinline__ float max2f(float a, float b) { float r; asm("v_max_f32_e32 %0, %1, %2" : "=v"(r) : "v"(a), "v"(b)); return r; }
constexpr int AT_KSLOT = 64 * DQK * 2, AT_VSLOT = 64 * DV * 2, AT_K = 0, AT_V = 2 * AT_KSLOT, AT_WS = AT_V + 2 * AT_VSLOT, AT_BYTES = AT_WS + NWAVES * 256;
static_assert(AT_BYTES <= RING_BYTES, "attention LDS");
__device__ __forceinline__ void attn_unit(const bf16* Qg, const bf16* Kg, const bf16* Vg, bf16* Og, int b, int h, int qb, ldsp lds, int tid) {
    const int lane = tid & 63, r32 = lane & 31, hi = lane >> 5; const int wid = __builtin_amdgcn_readfirstlane(tid >> 6);
    const size_t rowbase = (size_t)b * SEQ; const int q0 = qb * 256, NT = (q0 + 256) / 64, qw0 = q0 + wid * 32;
    const bf16* Kh = Kg + rowbase * 1536 + h * DQK; const bf16* Vh = Vg + rowbase * 1024 + h * DV;
    LAS float* wsf = (LAS float*)(lds + AT_WS) + wid * 64;
    const int krow_ = lane >> 2, kpiece_ = (lane & 3) ^ (((krow_ >> 2) ^ krow_) & 3);
#define AT_DMA(t, s) do { \
        _Pragma("unroll") for (int i_ = 0; i_ < 3; ++i_) { const int c_ = wid + 8 * i_; \
            glds16(Kh + (size_t)((t) * 64 + 16 * (c_ & 3) + krow_) * 1536 + (c_ >> 2) * 32 + kpiece_ * 8, lds + AT_K + (s) * AT_KSLOT + c_ * 1024); } \
        _Pragma("unroll") for (int i_ = 0; i_ < 2; ++i_) { const int c_ = wid + 8 * i_; \
            glds16(Vh + (size_t)((t) * 64 + 16 * (c_ & 3) + (lane >> 2)) * 1024 + (c_ >> 2) * 32 + (lane & 3) * 8, lds + AT_V + (s) * AT_VSLOT + c_ * 1024); } } while (0)
    AT_DMA(0, 0);
    bf16x8 qr[12];
    { const bf16* qp = Qg + (rowbase + qw0 + r32) * 1536 + h * DQK + hi * 8;
#pragma unroll
      for (int d0 = 0; d0 < 12; ++d0) qr[d0] = *(const GAS bf16x8*)(qp + d0 * 16); }
    float m_run = 0.f, l_run = 0.f; f32x16 o[4];
#pragma unroll
    for (int d = 0; d < 4; ++d)
#pragma unroll
        for (int r = 0; r < 16; ++r) o[d][r] = 0.f;
    const int vlane = tr_att_base(lane);
    const int kfr_ = r32 & 15, kfrag_ = (r32 >> 4) * 1024 + kfr_ * 64 + ((hi ^ (((kfr_ >> 2) ^ kfr_) & 3)) << 4), kfx_ = ((kfrag_ ^ 32) - kfrag_);
    ATP_DECL();
    for (int t = 0; t < NT; ++t) {
        const int s = t & 1;
        ATP(0);
        asm volatile("s_waitcnt vmcnt(0)" ::: "memory"); SBARRIER();
        if (t + 1 < NT) AT_DMA(t + 1, s ^ 1);
        ATP(1);
        const int kbase = t * 64;
        if (kbase <= qw0 + 31) {
            f32x16 p0, p1;
            cldsp kb = lds + AT_K + s * AT_KSLOT + kfrag_;
#pragma unroll
            for (int r = 0; r < 16; ++r) { p0[r] = 0.f; p1[r] = 0.f; }
#define KFA(d) (kb + ((d) >> 1) * 4096 + (((d) & 1) ? kfx_ : 0))
            bf16x8 ka0 = *(const LAS bf16x8*)(KFA(0)), ka1 = *(const LAS bf16x8*)(KFA(0) + 2048), kb0 = *(const LAS bf16x8*)(KFA(1)), kb1 = *(const LAS bf16x8*)(KFA(1) + 2048);
#pragma unroll
            for (int d0 = 0; d0 < 12; ++d0) {
                bf16x8 kc0 = ka0, kc1 = ka1;
                if (d0 + 2 < 12) { kc0 = *(const LAS bf16x8*)(KFA(d0 + 2)); kc1 = *(const LAS bf16x8*)(KFA(d0 + 2) + 2048); }
                __builtin_amdgcn_sched_barrier(0);
                p0 = MFMA32(ka0, qr[d0], p0); p1 = MFMA32(ka1, qr[d0], p1);
                __builtin_amdgcn_sched_barrier(0);
                ka0 = kb0; ka1 = kb1; kb0 = kc0; kb1 = kc1;
            }
#undef KFA
            if (kbase + 63 > qw0) {
                const int qi = qw0 + r32; const float NEG = -__builtin_inff();
#pragma unroll
                for (int r = 0; r < 16; ++r) { const int kv = kbase + crow(r, hi); if (kv > qi) p0[r] = NEG; if (kv + 32 > qi) p1[r] = NEG; }
            }
            asm volatile("s_nop 15\n\ts_nop 7" : "+v"(p0), "+v"(p1));
            float mx;
            { float xa = max3f(p0[0], p0[1], p1[0]), xb = max3f(p0[2], p0[3], p1[1]); xa = max3f(xa, p1[2], p1[3]);
#pragma unroll
              for (int r = 4; r < 16; r += 4) { xa = max3f(xa, p0[r], p0[r + 1]); xb = max3f(xb, p0[r + 2], p0[r + 3]); xa = max3f(xa, p1[r], p1[r + 1]); xb = max3f(xb, p1[r + 2], p1[r + 3]); }
              mx = max2f(xa, xb); }
            { const auto sw_ = __builtin_amdgcn_permlane32_swap(__float_as_uint(mx), __float_as_uint(mx), false, false); mx = max2f(__uint_as_float(sw_[0]), __uint_as_float(sw_[1])); }
            asm volatile("" : "+v"(mx)); ATP(2);
            cldsp vb = lds + AT_V + s * AT_VSLOT + vlane;
            s16x4 vpre[4]; vpre[0] = trrd(vb); vpre[1] = trrd(vb + 512); vpre[2] = trrd(vb + 1024); vpre[3] = trrd(vb + 1024 + 512);
            const bool first = (t == 0);
            if (first || !__all(mx - m_run <= 8.0f)) {
                const float mn = first ? mx : fmaxf(m_run, mx);
                if (!first) { const float alpha = __builtin_amdgcn_exp2f(m_run - mn); l_run *= alpha;
                    if (hi == 0) wsf[r32] = alpha;
                    asm volatile("s_waitcnt lgkmcnt(0)" ::: "memory");
#pragma unroll
                    for (int r = 0; r < 16; ++r) { const float al = wsf[crow(r, hi)];
#pragma unroll
                        for (int d = 0; d < 4; ++d) o[d][r] *= al; } }
                m_run = mn;
            }
            float rs = 0.f;
#pragma unroll
            for (int r = 0; r < 16; ++r) { p0[r] = __builtin_amdgcn_exp2f(p0[r] - m_run); p1[r] = __builtin_amdgcn_exp2f(p1[r] - m_run); rs += p0[r] + p1[r]; }
            l_run += rs;
            bf16x8 pa[4]; pa[0] = pack8f(p0, 0); pa[1] = pack8f(p0, 8); pa[2] = pack8f(p1, 0); pa[3] = pack8f(p1, 8);
            ATP(3);
            { s16x4 c0 = vpre[0], c1 = vpre[1], c2 = vpre[2], c3 = vpre[3];
#pragma unroll
              for (int st = 0; st < 8; ++st) { const int d0 = st >> 1, k2 = (st & 1) * 2;
                s16x4 n0 = c0, n1 = c1, n2 = c2, n3 = c3;
                if (st + 1 < 8) { const int dn = (st + 1) >> 1, kn = ((st + 1) & 1) * 2; cldsp q = vb + (dn * 4 + kn) * 1024; n0 = trrd(q); n1 = trrd(q + 512); n2 = trrd(q + 1024); n3 = trrd(q + 1024 + 512); }
                __builtin_amdgcn_sched_barrier(0);
                o[d0] = MFMA32(pa[k2], MK8(c0, c1), o[d0]); o[d0] = MFMA32(pa[k2 + 1], MK8(c2, c3), o[d0]);
                __builtin_amdgcn_sched_barrier(0);
                c0 = n0; c1 = n1; c2 = n2; c3 = n3; } }
        }
    }
    ATP(0); ATP_END();
    l_run += __shfl_xor(l_run, 32);
    if (hi == 0) wsf[32 + r32] = l_run;
    asm volatile("s_waitcnt lgkmcnt(0)" ::: "memory");
    bf16* Ow = Og + (rowbase + qw0) * DM + h * DV;
#pragma unroll
    for (int r = 0; r < 16; ++r) { const int orow = crow(r, hi); const float rl = 1.0f / wsf[32 + orow];
#pragma unroll
        for (int d0 = 0; d0 < 4; ++d0) { const float v = o[d0][r] * rl; const float vn = __shfl_xor(v, 1);
            if ((r32 & 1) == 0) *(GAS unsigned*)(Ow + (size_t)orow * DM + d0 * 32 + r32) = cvtpk(v, vn); } }
    asm volatile("s_waitcnt lgkmcnt(0)" ::: "memory"); SBARRIER();
#undef AT_DMA
}

constexpr int RT_K = 0, RT_V = 32768, RT_S = 65536, RT_O = 0, RT_OSTRIDE = 132;
static_assert(RT_S + 32768 <= RING_BYTES && RT_O + 128 * RT_OSTRIDE * 4 + 1024 <= RING_BYTES, "retention LDS");
__device__ __forceinline__ void ret_state_unit(const bf16* RK, const bf16* RV, float* U, int bh, int c, float lg2g, ldsp lds, int tid) {
    const int lane = tid & 63, r32 = lane & 31, hi = lane >> 5; const int wid = __builtin_amdgcn_readfirstlane(tid >> 6);
    const int b = bh >> 3, h = bh & 7; const size_t row0 = (size_t)b * SEQ + (size_t)c * RCH;
#pragma unroll
    for (int i = 0; i < 4; ++i) { const int ch = wid * 4 + i, cb = ch >> 3, ks = ch & 7; const size_t tok = row0 + 16 * ks + (lane >> 2); const int col = h * 128 + cb * 32 + (lane & 3) * 8;
        glds16(RK + tok * 1024 + col, lds + RT_K + ch * 1024);
        const v4u w = *(const GAS v4u*)(RV + tok * 1024 + col); const float z = __builtin_amdgcn_exp2f(lg2g * (float)(127 - (16 * ks + (lane >> 2))));
        v4u o; o.x = cvtpk(bf_lo(w.x) * z, bf_hi(w.x) * z); o.y = cvtpk(bf_lo(w.y) * z, bf_hi(w.y) * z); o.z = cvtpk(bf_lo(w.z) * z, bf_hi(w.z) * z); o.w = cvtpk(bf_lo(w.w) * z, bf_hi(w.w) * z);
        *(LAS v4u*)(lds + RT_V + ch * 1024 + lane * 16) = o; }
    asm volatile("s_waitcnt vmcnt(0) lgkmcnt(0)" ::: "memory"); SBARRIER();
    const int dkb = wid >> 1, dvb0 = (wid & 1) * 2; const int nb = tr_nat_base(lane);
    f32x16 acc[2];
#pragma unroll
    for (int r = 0; r < 16; ++r) { acc[0][r] = 0.f; acc[1][r] = 0.f; }
#pragma unroll
    for (int ks = 0; ks < 8; ++ks) { cldsp ka = lds + RT_K + (dkb * 8 + ks) * 1024 + nb; const s16x4 al = trrd(ka), ah = trrd(ka + 256); const bf16x8 A = MK8(al, ah);
#pragma unroll
        for (int j = 0; j < 2; ++j) { cldsp vb = lds + RT_V + ((dvb0 + j) * 8 + ks) * 1024 + nb; const s16x4 bl = trrd(vb), bh2 = trrd(vb + 256); acc[j] = MFMA32(A, MK8(bl, bh2), acc[j]); } }
    float* Uu = U + ((size_t)bh * NCH + c) * 16384;
#pragma unroll
    for (int j = 0; j < 2; ++j)
#pragma unroll
        for (int r = 0; r < 16; ++r) Uu[(dkb * 32 + crow(r, hi)) * 128 + (dvb0 + j) * 32 + r32] = acc[j][r];
    asm volatile("s_waitcnt lgkmcnt(0)" ::: "memory"); SBARRIER();
}
__device__ __forceinline__ void ret_scan(const float* U, bf16* S, cargs_t a, int gtid, int nthr) {
    for (int it = gtid; it < 16 * 8192; it += nthr) { const int bh = it >> 13, e2 = it & 8191; const float g = __builtin_amdgcn_exp2f(128.0f * a->lg2g[bh & 7]);
        const float* up = U + (size_t)bh * NCH * 16384 + e2 * 2; bf16* sp = S + (size_t)bh * NCH * 16384 + e2 * 2; float s0 = 0.f, s1 = 0.f;
#pragma unroll 8
        for (int c = 0; c < NCH; ++c) { *(GAS unsigned*)(sp + (size_t)c * 16384) = cvtpk(s0, s1); const f32x2 u = *(const GAS f32x2*)(up + (size_t)c * 16384); s0 = s0 * g + u.x; s1 = s1 * g + u.y; } }
}
__device__ __forceinline__ void ret_out_unit(const bf16* RQ, const bf16* RK, const bf16* RV, const bf16* RG, const bf16* S, bf16* MIX, int bh, int c, float lg2g, ldsp lds, int tid) {
    const int lane = tid & 63, r32 = lane & 31, hi = lane >> 5; const int wid = __builtin_amdgcn_readfirstlane(tid >> 6);
    const int b = bh >> 3, h = bh & 7; const size_t row0 = (size_t)b * SEQ + (size_t)c * RCH;
    const int rb = wid & 3, dh = wid >> 2;
    const bf16* Ss = S + ((size_t)bh * NCH + c) * 16384;
#pragma unroll
    for (int i = 0; i < 4; ++i) { const int id = wid * 4 + i;
        glds16(RK + (row0 + (id & 1) * 64 + lane) * 1024 + h * 128 + (id >> 1) * 8, lds + RT_K + id * 1024);
        const int cb = id >> 3, ks = id & 7;
        glds16(RV + (row0 + 16 * ks + (lane >> 2)) * 1024 + h * 128 + cb * 32 + (lane & 3) * 8, lds + RT_V + id * 1024);
        glds16(Ss + (16 * ks + (lane >> 2)) * 128 + cb * 32 + (lane & 3) * 8, lds + RT_S + id * 1024); }
    unsigned gate[16];
#pragma unroll
    for (int i = 0; i < 16; ++i) gate[i] = *(const GAS unsigned*)(RG + (row0 + wid * 16 + i) * 1024 + h * 128 + 2 * lane);
    bf16x8 qr[8];
    { const bf16* qp = RQ + (row0 + rb * 32 + r32) * 1024 + h * 128 + hi * 8;
#pragma unroll
      for (int d0 = 0; d0 < 8; ++d0) qr[d0] = *(const GAS bf16x8*)(qp + d0 * 16); }
    asm volatile("s_waitcnt vmcnt(0)" ::: "memory"); SBARRIER();
    f32x16 o[2];
#pragma unroll
    for (int r = 0; r < 16; ++r) { o[0][r] = 0.f; o[1][r] = 0.f; }
    { const int nb = tr_nat_base(lane);
#pragma unroll
      for (int ks = 0; ks < 8; ++ks)
#pragma unroll
          for (int j = 0; j < 2; ++j) { cldsp sb = lds + RT_S + ((dh * 2 + j) * 8 + ks) * 1024 + nb; const s16x4 bl = trrd(sb), bh2 = trrd(sb + 256); o[j] = MFMA32(qr[ks], MK8(bl, bh2), o[j]); }
#pragma unroll
      for (int r = 0; r < 16; ++r) { const float xi = __builtin_amdgcn_exp2f(lg2g * (float)(rb * 32 + crow(r, hi) + 1)); o[0][r] *= xi; o[1][r] *= xi; } }
    const int ab = tr_att_base(lane);
    for (int kb = 0; kb <= rb; ++kb) {
        f32x16 p;
#pragma unroll
        for (int r = 0; r < 16; ++r) p[r] = 0.f;
        cldsp kp = lds + RT_K + hi * 2048 + (kb * 32 + r32) * 16;
#pragma unroll
        for (int d0 = 0; d0 < 8; ++d0) { const bf16x8 ka = *(const LAS bf16x8*)(kp + d0 * 4096); p = MFMA32(ka, qr[d0], p); }
        const int qi = rb * 32 + r32;
#pragma unroll
        for (int r = 0; r < 16; ++r) { const int kj = kb * 32 + crow(r, hi); const float dcy = __builtin_amdgcn_exp2f(lg2g * (float)(qi - kj)); p[r] = (qi >= kj) ? p[r] * dcy : 0.f; }
        const bf16x8 pa0 = pack8f(p, 0), pa1 = pack8f(p, 8);
#pragma unroll
        for (int j = 0; j < 2; ++j) { cldsp vb = lds + RT_V + ((dh * 2 + j) * 8 + kb * 2) * 1024 + ab;
            { const s16x4 lo = trrd(vb), hh = trrd(vb + 512); o[j] = MFMA32(pa0, MK8(lo, hh), o[j]); }
            { const s16x4 lo = trrd(vb + 1024), hh = trrd(vb + 1024 + 512); o[j] = MFMA32(pa1, MK8(lo, hh), o[j]); } }
    }
    asm volatile("s_waitcnt lgkmcnt(0)" ::: "memory"); SBARRIER();
    LAS float* ob = (LAS float*)(lds + RT_O);
#pragma unroll
    for (int j = 0; j < 2; ++j)
#pragma unroll
        for (int r = 0; r < 16; ++r) ob[(rb * 32 + crow(r, hi)) * RT_OSTRIDE + (dh * 2 + j) * 32 + r32] = o[j][r];
    asm volatile("s_waitcnt lgkmcnt(0)" ::: "memory"); SBARRIER();
    { const int srow = tid >> 2, sq = tid & 3; const LAS float* rp = ob + srow * RT_OSTRIDE + 16 * sq; float s1 = 0.f, s2 = 0.f;
#pragma unroll
      for (int j = 0; j < 2; ++j)
#pragma unroll
          for (int i = 0; i < 4; ++i) { const f32x4 v = *(const LAS f32x4*)(rp + 64 * j + 4 * i); s1 += (v.x + v.y) + (v.z + v.w); s2 += (v.x * v.x + v.y * v.y) + (v.z * v.z + v.w * v.w); }
      s1 += __builtin_bit_cast(float, __builtin_amdgcn_mov_dpp(__builtin_bit_cast(int, s1), 0xB1, 0xf, 0xf, true)); s2 += __builtin_bit_cast(float, __builtin_amdgcn_mov_dpp(__builtin_bit_cast(int, s2), 0xB1, 0xf, 0xf, true));
      s1 += __builtin_bit_cast(float, __builtin_amdgcn_mov_dpp(__builtin_bit_cast(int, s1), 0x4E, 0xf, 0xf, true)); s2 += __builtin_bit_cast(float, __builtin_amdgcn_mov_dpp(__builtin_bit_cast(int, s2), 0x4E, 0xf, 0xf, true));
      const float mu = s1 * (1.0f / 128.0f), var = fmaxf(s2 * (1.0f / 128.0f) - mu * mu, 0.f);
      if (sq == 0) *(LAS f32x2*)(ob + 128 * RT_OSTRIDE + 2 * srow) = (f32x2){mu, 1.0f / sqrtf(var + GN_EPS)}; }
    asm volatile("s_waitcnt lgkmcnt(0)" ::: "memory"); SBARRIER();
#pragma unroll
    for (int i = 0; i < 16; ++i) { const int rr = wid * 16 + i; const f32x2 v = *(const LAS f32x2*)(ob + rr * RT_OSTRIDE + 2 * lane); const f32x2 st = *(const LAS f32x2*)(ob + 128 * RT_OSTRIDE + 2 * rr);
        *(GAS unsigned*)(MIX + (row0 + rr) * DM + 1024 + h * 128 + 2 * lane) = cvtpk((v.x - st.x) * st.y * bf_lo(gate[i]), (v.y - st.x) * st.y * bf_hi(gate[i])); }
    asm volatile("s_waitcnt lgkmcnt(0)" ::: "memory"); SBARRIER();
}


#define PHASE_IDS() int tid = tid0; asm volatile("" : "+v"(tid)); int G = G0, bx = bx0; asm volatile("" : "+s"(G), "+s"(bx)); \
    const int lane = tid & 63; const int wave = __builtin_amdgcn_readfirstlane(tid >> 6); const int vcu = (G % 8 == 0) ? (bx % 8) * (G / 8) + bx / 8 : bx; (void)lane; (void)wave; (void)vcu
#define GW (vcu * NWAVES + wave)
#define NGW (G * NWAVES)
#define GTID (vcu * (NWAVES * 64) + tid)
#define NTHR (G * NWAVES * 64)
#ifndef PG_ALIGN
#define PG_ALIGN true
#endif
#define XBAR() xcd_barrier(bar)
#ifdef PROBE_SPAN
#ifndef PROBE_BLOCK
#define PROBE_BLOCK 0
#endif
#ifdef PROBE_CLK
#define PTIME() __builtin_readcyclecounter()
#else
#define PTIME() __builtin_amdgcn_s_memrealtime()
#endif
#ifdef PROBE_PRE
#define STAMP(k) do { if (tid0 == 0 && bx0 == PROBE_BLOCK) { volatile LAS unsigned long long* ts_ = (volatile LAS unsigned long long*)(lds + LDSCTL_OFF + 64); if ((k) == PROBE_SPAN) ts_[0] = PTIME(); } } while (0)
#define STAMP_PRE(k) do { if (tid0 == 0 && bx0 == PROBE_BLOCK) { volatile LAS unsigned long long* ts_ = (volatile LAS unsigned long long*)(lds + LDSCTL_OFF + 64); if ((k) == PROBE_SPAN + 1) ts_[1] += PTIME() - ts_[0]; } } while (0)
#else
#define STAMP(k) do { if (tid0 == 0 && bx0 == PROBE_BLOCK) { volatile LAS unsigned long long* ts_ = (volatile LAS unsigned long long*)(lds + LDSCTL_OFF + 64); const unsigned long long t_ = PTIME(); \
    if ((k) == PROBE_SPAN) ts_[0] = t_; if ((k) == PROBE_SPAN + 1) ts_[1] += t_ - ts_[0]; } } while (0)
#define STAMP_PRE(k) do { } while (0)
#endif
#else
#define STAMP(k) do { } while (0)
#define STAMP_PRE(k) do { } while (0)
#endif
template <int l> __device__ __forceinline__ void layer_body(const int tid0, const int G0, const int bx0, const ldsp lds, const XcdBarrier& bar) {
    STAMP(0);
#ifdef PROBE_IDLE
    { const unsigned long long t0_ = __builtin_amdgcn_s_memrealtime(); while (__builtin_amdgcn_s_memrealtime() - t0_ < (unsigned long long)(PROBE_IDLE) * 100ull) __builtin_amdgcn_s_sleep(32); }
#endif
    { PHASE_IDS(); cargs_t a = get_args(); unsigned char* ws = a->ws; unsigned char* wb = ws + WS_W + (size_t)(l & 1) * W_STRIDE;
      pg8::Gemm g{(bf16*)(ws + WS_XB), (bf16*)(wb + WO_WIN), M, IN_PAD, DM}; pg8::StaticOrder S; S.init(M, IN_PAD, G, bx);
      pg8::Unit u0_; const int pm0_ = S.next(0, u0_) ? u0_.pm : 0; fill_rtab((const float*)(ws + WS_XSS2), pm0_, lds, tid);
      pg8::EpiIn E{(const float*)(ws + WS_XSS2), (bf16*)(ws + WS_CQ), (bf16*)(ws + WS_CKV), (float*)(ws + WS_CQSS), (float*)(ws + WS_CKVSS), (bf16*)(ws + WS_K), (const float*)(ws + WS_C64), (const float*)(ws + WS_S64),
                   (bf16*)(ws + WS_RQ), (bf16*)(ws + WS_RK), (bf16*)(ws + WS_RV), (bf16*)(ws + WS_RG), (const float*)(ws + WS_C128), (const float*)(ws + WS_S128), (const LAS float*)(lds + RTAB_OFF), pm0_};
      pg8::gemm_phase<pg8::EpiIn, pg8::StaticOrder, PG_ALIGN, true>(lds + RING_OFF, g, S, E); }
    STAMP_PRE(1); XBAR(); STAMP(1);
    { PHASE_IDS(); cargs_t a = get_args(); unsigned char* ws = a->ws; unsigned char* wb = ws + WS_W + (size_t)(l & 1) * W_STRIDE;
      pg8::Gemm g{(bf16*)(ws + WS_CQ), (bf16*)(wb + WO_WUQ), M, 1536, QLORA}; pg8::StaticOrder S; S.init(M, 1536, G, bx);
      pg8::EpiQ E{(const float*)(ws + WS_CQSS), (bf16*)(ws + WS_Q), (const float*)(ws + WS_C64), (const float*)(ws + WS_S64), QSCALE};
      pg8::gemm_phase<pg8::EpiQ, pg8::StaticOrder, PG_ALIGN, true>(lds + RING_OFF, g, S, E); }
    __syncthreads();
    { PHASE_IDS(); cargs_t a = get_args(); unsigned char* ws = a->ws; unsigned char* wb = ws + WS_W + (size_t)(l & 1) * W_STRIDE;
      pg8::Gemm g{(bf16*)(ws + WS_CKV), (bf16*)(wb + WO_WUKV), M, 2048, KVLORA}; pg8::StaticOrder S; S.init(M, 2048, G, bx);
      pg8::EpiKV E{(const float*)(ws + WS_CKVSS), (bf16*)(ws + WS_K), (bf16*)(ws + WS_V)};
      pg8::gemm_phase<pg8::EpiKV, pg8::StaticOrder, PG_ALIGN, true>(lds + RING_OFF, g, S, E); }
    __syncthreads();
    { PHASE_IDS(); cargs_t a = get_args(); unsigned char* ws = a->ws;
      for (int u = vcu; u < 16 * NCH; u += G) ret_state_unit((const bf16*)(ws + WS_RK), (const bf16*)(ws + WS_RV), (float*)(ws + WS_U), u >> 6, u & 63, a->lg2g[(u >> 6) & 7], lds + RING_OFF, tid); }
    STAMP_PRE(2); XBAR(); STAMP(2);
    { PHASE_IDS(); cargs_t a = get_args(); unsigned char* ws = a->ws;
      for (int u = vcu; u < 256; u += G) { const int bh = u >> 4, x = u & 15;
        attn_unit((const bf16*)(ws + WS_Q), (const bf16*)(ws + WS_K), (const bf16*)(ws + WS_V), (bf16*)(ws + WS_MIX), bh >> 3, bh & 7, 31 - x, lds + RING_OFF, tid);
        attn_unit((const bf16*)(ws + WS_Q), (const bf16*)(ws + WS_K), (const bf16*)(ws + WS_V), (bf16*)(ws + WS_MIX), bh >> 3, bh & 7, x, lds + RING_OFF, tid); } }
    { PHASE_IDS(); cargs_t a = get_args(); unsigned char* ws = a->ws; ret_scan((const float*)(ws + WS_U), (bf16*)(ws + WS_S), a, GTID, NTHR); }
    if (l + 1 < DEPTH) { PHASE_IDS(); cargs_t a = get_args(); __syncthreads(); convert_weights<true>(a, l + 1, lds, GW, NGW, wave, lane, GTID, NTHR, (unsigned*)((gu32*)(a->ws + WS_CTL) + CW_WQ + l * 64)); }
    STAMP_PRE(3); XBAR(); STAMP(3);
    { PHASE_IDS(); cargs_t a = get_args(); unsigned char* ws = a->ws;
      for (int u = vcu; u < 16 * NCH; u += G) ret_out_unit((const bf16*)(ws + WS_RQ), (const bf16*)(ws + WS_RK), (const bf16*)(ws + WS_RV), (const bf16*)(ws + WS_RG), (const bf16*)(ws + WS_S), (bf16*)(ws + WS_MIX),
                                                          u >> 6, u & 63, a->lg2g[(u >> 6) & 7], lds + RING_OFF, tid); }
    { PHASE_IDS(); cargs_t a = get_args(); bf16* mix = (bf16*)(a->ws + WS_MIX);
      { int m = GW; for (; m + 3 * NGW < M; m += 4 * NGW) attn_norm_rows<4>(mix, m, NGW, lane); for (; m < M; m += NGW) attn_norm_rows<1>(mix, m, NGW, lane); } }
    STAMP_PRE(4); XBAR(); STAMP(4);
    { PHASE_IDS(); cargs_t a = get_args(); unsigned char* ws = a->ws; unsigned char* wb = ws + WS_W + (size_t)(l & 1) * W_STRIDE;
      pg8::Gemm g{(bf16*)(ws + WS_MIX), (bf16*)(wb + WO_WO), M, DM, DM}; pg8::StaticOrder S; S.init(M, DM, G, bx);
      typedef pg8::EpiResT<false, true> EpiR; EpiR E{(l == 0) ? a->x : (const float*)a->out, a->out, (bf16*)(ws + WS_XB), (float*)(ws + WS_XSS), nullptr, nullptr, -1};
      pg8::gemm_phase<EpiR, pg8::StaticOrder, PG_ALIGN, true>(lds + RING_OFF, g, S, E); }
    { PHASE_IDS(); cargs_t a = get_args(); pg8::StaticOrder S; S.init(M, DM, G, bx); panel_post((unsigned*)((gu32*)(a->ws + WS_CTL) + CW_PB + (l * 2 + 0) * 1024), S); }
    STAMP_PRE(5); STAMP(5);
    { PHASE_IDS(); cargs_t a = get_args(); pg8::StaticOrder S; S.init(M, FF, G, bx);
      panel_wait((unsigned*)((gu32*)(a->ws + WS_CTL) + CW_PB + (l * 2 + 0) * 1024), S, DM / 256, (unsigned*)((gu32*)(a->ws + WS_CTL) + CW_BAR)); }
    { PHASE_IDS(); cargs_t a = get_args(); unsigned char* ws = a->ws; unsigned char* wb = ws + WS_W + (size_t)(l & 1) * W_STRIDE;
      pg8::Gemm g{(bf16*)(ws + WS_XB), (bf16*)(wb + WO_WUP), M, FF, DM}; pg8::StaticOrder S; S.init(M, FF, G, bx);
      pg8::EpiRelu2 E{(bf16*)(ws + WS_UF), FF};
      pg8::gemm_phase<pg8::EpiRelu2, pg8::StaticOrder, PG_ALIGN, true>(lds + RING_OFF, g, S, E); }
    { PHASE_IDS(); cargs_t a = get_args(); pg8::StaticOrder S; S.init(M, FF, G, bx); panel_post((unsigned*)((gu32*)(a->ws + WS_CTL) + CW_PB + (l * 2 + 1) * 1024), S); }
    STAMP_PRE(6); STAMP(6);
    { PHASE_IDS(); cargs_t a = get_args(); pg8::StaticOrder S; S.init(M, DM, G, bx);
      panel_wait((unsigned*)((gu32*)(a->ws + WS_CTL) + CW_PB + (l * 2 + 1) * 1024), S, FF / 256, (unsigned*)((gu32*)(a->ws + WS_CTL) + CW_BAR)); }
    { PHASE_IDS(); cargs_t a = get_args(); unsigned char* ws = a->ws; unsigned char* wb = ws + WS_W + (size_t)(l & 1) * W_STRIDE;
      pg8::Gemm g{(bf16*)(ws + WS_UF), (bf16*)(wb + WO_WDN), M, DM, FF}; pg8::StaticOrder S; S.init(M, DM, G, bx);
      pg8::Unit u0_; const int pm0_ = S.next(0, u0_) ? u0_.pm : 0; fill_rtab((const float*)(ws + WS_XSS), pm0_, lds, tid);
      typedef pg8::EpiResT<true, (l + 1 < DEPTH)> EpiR; EpiR E{a->out, a->out, (bf16*)(ws + WS_XB), (float*)(ws + WS_XSS2), (const float*)(ws + WS_XSS), (const LAS float*)(lds + RTAB_OFF), pm0_};
      pg8::gemm_phase<EpiR, pg8::StaticOrder, PG_ALIGN, true>(lds + RING_OFF, g, S, E); }
    STAMP_PRE(7); XBAR(); STAMP(7);
}

__global__ void __launch_bounds__(NWAVES * 64, 2) fwd_kernel(Args args_in_kernarg) {
    extern __shared__ __attribute__((aligned(16))) unsigned char lds_raw[];
    const ldsp lds = (ldsp)lds_raw;
    volatile LAS unsigned* MISC = (volatile LAS unsigned*)(lds + MISC_OFF);
    const int tid0 = threadIdx.x; const int G0 = gridDim.x, bx0 = blockIdx.x;
    for (int u = tid0; u < (LDS_BYTES - LDSCTL_OFF) / 4; u += NWAVES * 64) ((LAS unsigned*)(lds + LDSCTL_OFF))[u] = 0u;
    __syncthreads();
    XcdBarrier bar;
    { PHASE_IDS(); cargs_t a = get_args(); bar = xcd_barrier_post((unsigned*)((gu32*)(a->ws + WS_CTL) + CW_BAR), MISC + 8); }
    { PHASE_IDS(); cargs_t a = get_args();
      rope_tables(a, GTID, NTHR);
      convert_weights<false>(a, 0, lds, GW, NGW, wave, lane, GTID, NTHR, nullptr);
      const float* x = a->x; bf16* XB = (bf16*)(a->ws + WS_XB); float* XSS = (float*)(a->ws + WS_XSS2);
      { int m = GW; for (; m + NGW < M; m += 2 * NGW) prep_rows<2>(x, XB, XSS, m, NGW, lane); for (; m < M; m += NGW) prep_rows<1>(x, XB, XSS, m, NGW, lane); } }
    XBAR();

    layer_body<0>(tid0, G0, bx0, lds, bar);
    layer_body<1>(tid0, G0, bx0, lds, bar);
    layer_body<2>(tid0, G0, bx0, lds, bar);
    layer_body<3>(tid0, G0, bx0, lds, bar);
    { PHASE_IDS(); cargs_t a = get_args(); float* xo = a->out; const float* g = a->final_norm; const float* XSS = (const float*)(a->ws + WS_XSS2);
      { int m = GW; for (; m + NGW < M; m += 2 * NGW) rms_rows_final<2>(xo, XSS, g, m, NGW, lane); for (; m < M; m += NGW) rms_rows_final<1>(xo, XSS, g, m, NGW, lane); } }
#if defined(PROBE_ATT) || defined(PROBE_R3)
    if (tid0 == 0 && bx0 == 0) { volatile LAS unsigned long long* q_ = (volatile LAS unsigned long long*)(lds + LDSCTL_OFF + 80); const unsigned long long T_ = q_[0] / 3ull, t0_ = __builtin_amdgcn_s_memrealtime();
        while (__builtin_amdgcn_s_memrealtime() - t0_ < T_) __builtin_amdgcn_s_sleep(8); }
#endif
#ifdef PROBE_SPAN
    if (tid0 == 0 && bx0 == PROBE_BLOCK) { volatile LAS unsigned long long* ts_ = (volatile LAS unsigned long long*)(lds + LDSCTL_OFF + 64);
#ifdef PROBE_CLK
        const unsigned long long T_ = ts_[1] / 3ull,
#else
        const unsigned long long T_ = ts_[1] * 8ull,
#endif
        t0_ = __builtin_amdgcn_s_memrealtime();
        while (__builtin_amdgcn_s_memrealtime() - t0_ < T_) __builtin_amdgcn_s_sleep(8); }
#endif
}

extern "C" void kernel_launch(void* const* d_in, const int* in_sizes, int n_in, void* d_out, int out_size, void* d_ws, size_t ws_size, hipStream_t stream) {
    static int grid = 0;
    if (grid == 0) {
        if (n_in != 15 || in_sizes[0] != M * DM || out_size != M * DM || ws_size < WS_END) { fprintf(stderr, "kernel_launch: unexpected shapes (n_in %d, in0 %d, out %d, ws %zu, need %zu); nothing launched\n", n_in, n_in > 0 ? in_sizes[0] : -1, out_size, ws_size, (size_t)WS_END); grid = -1; return; }
        int dev = 0, cus = 0, per_cu = 0;
        if (hipGetDevice(&dev) != hipSuccess || hipDeviceGetAttribute(&cus, hipDeviceAttributeMultiprocessorCount, dev) != hipSuccess) { fprintf(stderr, "kernel_launch: device query failed\n"); grid = -1; return; }
        if (hipFuncSetAttribute((const void*)fwd_kernel, hipFuncAttributeMaxDynamicSharedMemorySize, LDS_BYTES) != hipSuccess) { fprintf(stderr, "kernel_launch: hipFuncSetAttribute failed\n"); grid = -1; return; }
        if (hipOccupancyMaxActiveBlocksPerMultiprocessor(&per_cu, (const void*)fwd_kernel, NWAVES * 64, LDS_BYTES) != hipSuccess || per_cu < 1)
            fprintf(stderr, "kernel_launch: note: occupancy query reports %d workgroups per CU\n", per_cu);
        (void)hipGetLastError();
        grid = cus;
    }
    if (grid < 0) return;
    if (hipMemsetAsync((char*)d_ws + WS_CTL, 0, CTL_ZERO_BYTES, stream) != hipSuccess) { fprintf(stderr, "kernel_launch: hipMemsetAsync failed\n"); return; }
    Args a{};
    a.x = (const float*)d_in[0]; a.pos = (const int*)d_in[1]; a.attn_norm = (const float*)d_in[2]; a.w_in = (const float*)d_in[3]; a.q_norm = (const float*)d_in[4]; a.kv_norm = (const float*)d_in[5];
    a.w_uq = (const float*)d_in[6]; a.w_ukv = (const float*)d_in[7]; a.beta_attn = (const float*)d_in[8]; a.beta_ret = (const float*)d_in[9]; a.w_o = (const float*)d_in[10]; a.mlp_norm = (const float*)d_in[11];
    a.w_up = (const float*)d_in[12]; a.w_down = (const float*)d_in[13]; a.final_norm = (const float*)d_in[14];
    a.out = (float*)d_out; a.ws = (unsigned char*)d_ws;
    for (int j = 0; j < 32; ++j) a.invf64[j] = pow(10000.0, -(double)(2 * j) / 64.0);
    for (int j = 0; j < 64; ++j) a.invf128[j] = pow(10000.0, -(double)(2 * j) / 128.0);
    for (int h = 0; h < 8; ++h) a.lg2g[h] = (float)(log1p(-exp2(-5.0 - (double)h)) / log(2.0));
    hipLaunchKernelGGL(fwd_kernel, dim3(grid), dim3(NWAVES * 64), LDS_BYTES, stream, a);
    const hipError_t le = hipPeekAtLastError();
    if (le != hipSuccess) fprintf(stderr, "kernel_launch: launch failed: %s\n", hipGetErrorName(le));
}
```

```cpp
#include <hip/hip_runtime.h>
#include <cstdio>
#include <cstdint>
#include <cmath>
namespace pg8 {
#define PG8_LAS __attribute__((address_space(3)))
typedef unsigned short bf16_t;
typedef short bf16x8 __attribute__((ext_vector_type(8)));
typedef float f32x4 __attribute__((ext_vector_type(4)));
typedef unsigned u32x4 __attribute__((ext_vector_type(4)));
constexpr int BM = 256, BK = 64, HALF = 128, HTB = HALF * BK * 2  , STAGE_BYTES = 8 * HTB, NXCD = 8, WGM = 8;

__host__ __device__ __forceinline__ int lds_byte(int r, int c) { const int st = (r >> 4) * 2 + (c >> 5), rr = r & 15, cc = c & 31, ob = rr * 64 + cc * 2; return st * 1024 + (ob ^ (((ob >> 9) & 1) << 5)); }
__host__ __device__ __forceinline__ void stage_rc(int b, int& R, int& C) { const int st = b / 1024, sb = b % 1024, swz = sb ^ (((sb >> 9) & 1) << 5); R = (st >> 1) * 16 + swz / 64; C = (st & 1) * 32 + (swz % 64) / 2; }
__host__ __device__ __forceinline__ int perm32(int rho) { const int n = rho >> 4, i = rho & 15; return 8 * (i >> 2) + 4 * n + (i & 3); }

struct Unit { int pm, pn; };
struct Gemm { const bf16_t* A; const bf16_t* Bt; int M, N, K; };

struct StaticOrder {
    int nM, nN, nwg, G, c;
    __host__ __device__ void init(int M, int N, int G_, int c_) { nM = M / BM; nN = N / BM; nwg = nM * nN; G = G_; c = c_; }
    __host__ __device__ bool next(int i, Unit& u) const {
        const long L = (long)i * G + c; if (L >= nwg) return false;
        int wgid = (int)L; { const int q = nwg / NXCD, r = nwg % NXCD, xcd = wgid % NXCD, off = wgid / NXCD; wgid = (xcd < r ? xcd * (q + 1) : r * (q + 1) + (xcd - r) * q) + off; }
        const int nig = WGM * nN, gid = wgid / nig, fm = gid * WGM, gsz = (nM - fm) < WGM ? (nM - fm) : WGM;
        u.pm = fm + ((wgid % nig) % gsz); u.pn = (wgid % nig) / gsz; return true;
    }
    __device__ __forceinline__ void a_ready(const Unit&) const {}
    __device__ __forceinline__ void done(const Unit&) const {}
};

__device__ __forceinline__ unsigned cvt_pk_bf16(float lo, float hi) { unsigned r; asm volatile("v_cvt_pk_bf16_f32 %0, %1, %2" : "=v"(r) : "v"(lo), "v"(hi)); return r; }
typedef float f32x2 __attribute__((ext_vector_type(2)));
__device__ __forceinline__ f32x2 gelu_pk(f32x2 v) {
    const f32x2 av = __builtin_elementwise_abs(v), d = av * 0.2316418882f + 1.0f;
    f32x2 t; t.x = __builtin_amdgcn_rcpf(d.x); t.y = __builtin_amdgcn_rcpf(d.y);
    f32x2 q = t * 0.5307027145f + (-0.7265760135f); q = q * t + 0.7107068705f; q = q * t + (-0.142248368f); q = q * t + 0.127414796f; q = q * t;
    const f32x2 s = (v * v) * (-0.72134752044f);
    f32x2 e; e.x = __builtin_amdgcn_exp2f(s.x); e.y = __builtin_amdgcn_exp2f(s.y);
    const f32x2 m = v * (q * e), r = v - m;
    f32x2 o; o.x = v.x < 0.f ? m.x : r.x; o.y = v.y < 0.f ? m.y : r.y; return o;
}

template <int ACT  > struct EpiBf16 {
    static constexpr bool PERM = true, AFTER_DRAIN = false; static_assert(ACT == 0 || ACT == 1, "EpiBf16: ACT is 0 (none) or 1 (gelu_pk)");
    bf16_t* O; int ldc; const float* bias; int split_cols; size_t split_stride; float scale0;
    __device__ __forceinline__ void operator()(const f32x4 (&acc)[2][2][4][2], const Unit& u, int wr, int wc, int fr, int fq) const {
        const int row0 = u.pm * BM + wr * 64 + fr; int colt = u.pn * BM; bf16_t* base = O;
        float sc = 1.f; if (split_cols) { const int t = colt / split_cols; base += (size_t)t * split_stride; colt -= t * split_cols; if (t == 0) sc = scale0; }
        const int col0 = colt + wc * 32 + 8 * fq, bcol0 = u.pn * BM + wc * 32 + 8 * fq;
        f32x4 bv[2][2];
#pragma unroll
        for (int bj = 0; bj < 2; ++bj)
#pragma unroll
            for (int n = 0; n < 2; ++n) bv[bj][n] = bias ? *(const f32x4*)(bias + bcol0 + bj * HALF + 4 * n) : (f32x4){0.f, 0.f, 0.f, 0.f};
#pragma unroll
        for (int ai = 0; ai < 2; ++ai)
#pragma unroll
            for (int m = 0; m < 4; ++m) { bf16_t* rowp = base + (size_t)(row0 + ai * HALF + m * 16) * ldc + col0;
#pragma unroll
                for (int bj = 0; bj < 2; ++bj) { f32x4 v0 = acc[ai][bj][m][0] + bv[bj][0], v1 = acc[ai][bj][m][1] + bv[bj][1];
                    if (ACT == 1) { f32x2 a = gelu_pk((f32x2){v0[0], v0[1]}), b = gelu_pk((f32x2){v0[2], v0[3]}), c = gelu_pk((f32x2){v1[0], v1[1]}), d = gelu_pk((f32x2){v1[2], v1[3]});
                        v0 = (f32x4){a.x, a.y, b.x, b.y}; v1 = (f32x4){c.x, c.y, d.x, d.y}; }
                    v0 = v0 * sc; v1 = v1 * sc; u32x4 w; w.x = cvt_pk_bf16(v0[0], v0[1]); w.y = cvt_pk_bf16(v0[2], v0[3]); w.z = cvt_pk_bf16(v1[0], v1[1]); w.w = cvt_pk_bf16(v1[2], v1[3]);
                    *(u32x4*)(rowp + bj * HALF) = w; } }
    }
};

struct PanelStats {
    unsigned* xbuf;
    unsigned* cnt;
    unsigned* tmo;
    int ntn; float eps;
    unsigned code;
    __device__ __forceinline__ bool run(const f32x4 (&v)[2][2][4][2], const Unit& u, int wr, int wc, int fr, int fq, PG8_LAS unsigned char* lds, int wid, int lane) const {
        typedef float f32x2v __attribute__((ext_vector_type(2)));
        PG8_LAS f32x2v* P = (PG8_LAS f32x2v*)lds;
        PG8_LAS f32x2v* S = (PG8_LAS f32x2v*)(lds + 8192);
        PG8_LAS unsigned* flag = (PG8_LAS unsigned*)(lds + 8192 + 2048);
#pragma unroll
        for (int ai = 0; ai < 2; ++ai)
#pragma unroll
            for (int m = 0; m < 4; ++m) {
                float s = 0.f;
#pragma unroll
                for (int bj = 0; bj < 2; ++bj)
#pragma unroll
                    for (int n = 0; n < 2; ++n) { const f32x4 x = v[ai][bj][m][n]; s += (x[0] + x[1]) + (x[2] + x[3]); }
                s += __shfl_xor(s, 16); s += __shfl_xor(s, 32);
                const float mw = s * (1.0f / 64.0f); float q = 0.f;
#pragma unroll
                for (int bj = 0; bj < 2; ++bj)
#pragma unroll
                    for (int n = 0; n < 2; ++n) { const f32x4 d = v[ai][bj][m][n] - mw; q += (d[0] * d[0] + d[1] * d[1]) + (d[2] * d[2] + d[3] * d[3]); }
                q += __shfl_xor(q, 16); q += __shfl_xor(q, 32);
                if (fq == 0) P[(ai * HALF + wr * 64 + m * 16 + fr) * 4 + wc] = (f32x2v){mw, q};
            }
        asm volatile("s_waitcnt lgkmcnt(0)" ::: "memory"); __builtin_amdgcn_s_barrier(); asm volatile("" ::: "memory");
#if defined(BROKEN_EXCHANGE_NO_WAIT)
#warning BROKEN CONTROL BUILD: the row-statistics exchange does not wait; results are wrong by design
        if (blockIdx.x >= 64) { const long long t0_ = clock64(); while (clock64() - t0_ < 60000) __builtin_amdgcn_s_sleep(8); }
#endif
        const int row = wid * 32 + (lane & 31);
        if (lane < 32) {
            const f32x2v a = P[row * 4 + 0], b = P[row * 4 + 1], c = P[row * 4 + 2], d = P[row * 4 + 3];
            const float mt = (a.x + b.x + c.x + d.x) * 0.25f;
            const float da = a.x - mt, db = b.x - mt, dc = c.x - mt, dd = d.x - mt;
            const float m2 = (a.y + b.y) + (c.y + d.y) + 64.0f * ((da * da + db * db) + (dc * dc + dd * dd));
            unsigned long long* slot = (unsigned long long*)xbuf + ((size_t)(u.pm * BM + row) * 4 + u.pn);
            __hip_atomic_store(slot, ((unsigned long long)__float_as_uint(m2) << 32) | __float_as_uint(mt), __ATOMIC_RELAXED, __HIP_MEMORY_SCOPE_AGENT);
        }
        asm volatile("s_waitcnt vmcnt(0)" ::: "memory");
        if (lane == 0) __hip_atomic_fetch_add(cnt + 64 * u.pm, 1u, __ATOMIC_RELAXED, __HIP_MEMORY_SCOPE_AGENT);
        if (wid == 0) {
            bool dead = false; const unsigned long long t0 = __builtin_amdgcn_s_memrealtime(); const unsigned want = 8u * (unsigned)ntn;
            for (;;) {
#if defined(BROKEN_EXCHANGE_NO_WAIT)
                break;
#endif
                if ((unsigned)__builtin_amdgcn_readfirstlane(__hip_atomic_load(cnt + 64 * u.pm, __ATOMIC_RELAXED, __HIP_MEMORY_SCOPE_AGENT)) >= want) break;
                if (__builtin_amdgcn_s_memrealtime() - t0 > 2000000ull) {
                    if (lane == 0) { unsigned expect = 0u; __hip_atomic_compare_exchange_strong(tmo + 1, &expect, code | (unsigned)(u.pm & 0xff), __ATOMIC_RELAXED, __ATOMIC_RELAXED, __HIP_MEMORY_SCOPE_AGENT);
                                     __hip_atomic_store(tmo, 1u, __ATOMIC_RELAXED, __HIP_MEMORY_SCOPE_AGENT); }
                    dead = true; break; }
                __builtin_amdgcn_s_sleep(2);
            }
            __builtin_amdgcn_fence(__ATOMIC_ACQUIRE, "agent");
            if (lane == 0) flag[0] = dead ? 1u : 0u;
        }
        asm volatile("s_waitcnt vmcnt(0) lgkmcnt(0)" ::: "memory"); __builtin_amdgcn_s_barrier(); asm volatile("" ::: "memory");
        const bool bad = flag[0] != 0u;
        if (lane < 32) {
            const unsigned long long* slot = (const unsigned long long*)xbuf + (size_t)(u.pm * BM + row) * 4; float mt[4], m2[4]; float ms = 0.f;
#pragma unroll
            for (int t = 0; t < 4; ++t) { if (t < ntn) { const unsigned long long w = __hip_atomic_load(slot + t, __ATOMIC_RELAXED, __HIP_MEMORY_SCOPE_AGENT); mt[t] = __uint_as_float((unsigned)w); m2[t] = __uint_as_float((unsigned)(w >> 32)); } else { mt[t] = 0.f; m2[t] = 0.f; } ms += mt[t]; }
            const float mean = ms / (float)ntn; float q = 0.f;
#pragma unroll
            for (int t = 0; t < 4; ++t) if (t < ntn) { const float dm = mt[t] - mean; q += m2[t] + 256.0f * dm * dm; }
            S[row] = (f32x2v){mean, 1.0f / sqrtf(q / (256.0f * (float)ntn) + eps)};
        }
        asm volatile("s_waitcnt lgkmcnt(0)" ::: "memory"); __builtin_amdgcn_s_barrier(); asm volatile("" ::: "memory");
        return bad;
    }
};
struct EpiLnRes {
    static constexpr bool PERM = false, AFTER_DRAIN = true;
    const float* base; float* out; int ldc; const float* bias; PanelStats st; unsigned poison;
    __device__ __forceinline__ void fused(f32x4 (&acc)[2][2][4][2], const Unit& u, int wr, int wc, int fr, int fq, PG8_LAS unsigned char* lds, int wid, int lane) const {
        typedef float f32x2v __attribute__((ext_vector_type(2)));
        const PG8_LAS f32x2v* S = (const PG8_LAS f32x2v*)(lds + 8192);
        const int col0 = u.pn * BM + wc * 32 + 4 * fq;
#pragma unroll
        for (int bj = 0; bj < 2; ++bj)
#pragma unroll
            for (int n = 0; n < 2; ++n) { const f32x4 bv = bias ? *(const f32x4*)(bias + col0 + bj * HALF + n * 16) : (f32x4){0.f, 0.f, 0.f, 0.f};
#pragma unroll
                for (int ai = 0; ai < 2; ++ai)
#pragma unroll
                    for (int m = 0; m < 4; ++m) acc[ai][bj][m][n] += bv; }
        f32x4 pre[4][2][2];
#pragma unroll
        for (int m = 0; m < 4; ++m) { const size_t off = (size_t)(u.pm * BM + wr * 64 + m * 16 + fr) * ldc + col0;
#pragma unroll
            for (int bj = 0; bj < 2; ++bj)
#pragma unroll
                for (int n = 0; n < 2; ++n) pre[m][bj][n] = *(const f32x4*)(base + off + bj * HALF + n * 16); }
        const bool bad = st.run(acc, u, wr, wc, fr, fq, lds, wid, lane) || poison != 0u;
        const float qnan = __builtin_nanf("");
#pragma unroll
        for (int ai = 0; ai < 2; ++ai)
#pragma unroll
            for (int m = 0; m < 4; ++m) { const int r = ai * HALF + wr * 64 + m * 16 + fr; const f32x2v sr = S[r]; const size_t off = (size_t)(u.pm * BM + r) * ldc + col0;
#pragma unroll
                for (int bj = 0; bj < 2; ++bj)
#pragma unroll
                    for (int n = 0; n < 2; ++n) { const f32x4 bs = ai == 0 ? pre[m][bj][n] : *(const f32x4*)(base + off + bj * HALF + n * 16); f32x4 o = bs + (acc[ai][bj][m][n] - sr.x) * sr.y;
                        if (bad) o = (f32x4){qnan, qnan, qnan, qnan}; *(f32x4*)(out + off + bj * HALF + n * 16) = o; }
                if (m & 1) asm volatile("" ::: "memory"); }
    }
};
struct EpiLnResLn {
    static constexpr bool PERM = false, AFTER_DRAIN = true;
    const float* base; float* out; bf16_t* xn; int ldc; const float* bias; PanelStats st1, st2; unsigned poison;
    __device__ __forceinline__ void fused(f32x4 (&acc)[2][2][4][2], const Unit& u, int wr, int wc, int fr, int fq, PG8_LAS unsigned char* lds, int wid, int lane) const {
        typedef float f32x2v __attribute__((ext_vector_type(2))); typedef unsigned u32x2v __attribute__((ext_vector_type(2)));
        const PG8_LAS f32x2v* S = (const PG8_LAS f32x2v*)(lds + 8192);
        const int col0 = u.pn * BM + wc * 32 + 4 * fq;
#pragma unroll
        for (int bj = 0; bj < 2; ++bj)
#pragma unroll
            for (int n = 0; n < 2; ++n) { const f32x4 bv = bias ? *(const f32x4*)(bias + col0 + bj * HALF + n * 16) : (f32x4){0.f, 0.f, 0.f, 0.f};
#pragma unroll
                for (int ai = 0; ai < 2; ++ai)
#pragma unroll
                    for (int m = 0; m < 4; ++m) acc[ai][bj][m][n] += bv; }
        bool bad = st1.run(acc, u, wr, wc, fr, fq, lds, wid, lane) || poison != 0u;
        const float qnan = __builtin_nanf("");
#pragma unroll
        for (int ai = 0; ai < 2; ++ai)
#pragma unroll
            for (int m = 0; m < 4; ++m) { const int r = ai * HALF + wr * 64 + m * 16 + fr; const f32x2v sr = S[r]; const size_t off = (size_t)(u.pm * BM + r) * ldc + col0;
#pragma unroll
                for (int bj = 0; bj < 2; ++bj)
#pragma unroll
                    for (int n = 0; n < 2; ++n) { const f32x4 bs = *(const f32x4*)(base + off + bj * HALF + n * 16); acc[ai][bj][m][n] = bs + (acc[ai][bj][m][n] - sr.x) * sr.y; }
                asm volatile("" : "+v"(acc[ai][0][m][0]), "+v"(acc[ai][0][m][1]), "+v"(acc[ai][1][m][0]), "+v"(acc[ai][1][m][1]));
                if (m & 1) asm volatile("" ::: "memory"); }
        const bool bad1 = bad;
        bad = st2.run(acc, u, wr, wc, fr, fq, lds, wid, lane) || bad;
#pragma unroll
        for (int ai = 0; ai < 2; ++ai)
#pragma unroll
            for (int m = 0; m < 4; ++m) { const int r = ai * HALF + wr * 64 + m * 16 + fr; const f32x2v sr = S[r]; const size_t off = (size_t)(u.pm * BM + r) * ldc + col0;
#pragma unroll
                for (int bj = 0; bj < 2; ++bj)
#pragma unroll
                    for (int n = 0; n < 2; ++n) { const f32x4 x1 = acc[ai][bj][m][n]; *(f32x4*)(out + off + bj * HALF + n * 16) = bad1 ? (f32x4){qnan, qnan, qnan, qnan} : x1;
                        const f32x4 o = (x1 - sr.x) * sr.y; u32x2v w; w.x = cvt_pk_bf16(o[0], o[1]); w.y = cvt_pk_bf16(o[2], o[3]);
                        if (bad) { w.x = 0x7fc07fc0u; w.y = 0x7fc07fc0u; } *(u32x2v*)(xn + off + bj * HALF + n * 16) = w; }
                asm volatile("" ::: "memory"); }
    }
};

template <class Epi, class Sched, bool ALIGN_EPI = false, bool SP2 = false>
__device__ __forceinline__ void gemm_phase(PG8_LAS unsigned char* lds, const Gemm g, const Sched& S, const Epi& E) {
    int tid_l = threadIdx.x; asm volatile("" : "+v"(tid_l));
    const int tid = tid_l, wid = __builtin_amdgcn_readfirstlane(tid >> 6), lane = tid & 63, wr = wid >> 2, wc = wid & 3, fr = lane & 15, fq = lane >> 4;
    const int K = g.K, nt = K / BK;
    unsigned voffA[2], voffB[2];
#pragma unroll
    for (int i = 0; i < 2; ++i) { int R, C; stage_rc(tid * 16 + i * 8192, R, C); const int Rb = Epi::PERM ? ((R & ~31) + perm32(R & 31)) : R;
        voffA[i] = (unsigned)(R * K + C) * 2u; voffB[i] = (unsigned)(Rb * K + C) * 2u; }
    const size_t kstep = (size_t)(BK * 2);
    const size_t hstep = (size_t)HALF * K * 2;
    const size_t tstep = 2 * hstep;
    const unsigned ldsw = (unsigned)wid * 1024u;
    const int aoff = lds_byte(wr * 64 + fr, fq * 8), boff = lds_byte(wc * 32 + fr, fq * 8);
#define PG8_SA(b, h) (((b) * 2 + (h)) * HTB)
#define PG8_SB(b, h) ((4 + (b) * 2 + (h)) * HTB)
#define PG8_STAGE(bufoff, gbase, voff) do { _Pragma("unroll") for (int _i = 0; _i < 2; ++_i) \
        __builtin_amdgcn_global_load_lds((const unsigned*)((const char*)(gbase) + (voff)[_i]), (PG8_LAS unsigned*)(lds + (bufoff) + ldsw + _i * 8192), 16, 0, 0); } while (0)
#define PG8_LDA(dst, b, h) do { _Pragma("unroll") for (int m = 0; m < 4; ++m) _Pragma("unroll") for (int k = 0; k < 2; ++k) dst[m][k] = *(const PG8_LAS bf16x8*)(lds + PG8_SA(b, h) + aoff + m * 2048 + k * 1024); } while (0)
#define PG8_LDB(dst, b, h) do { _Pragma("unroll") for (int n = 0; n < 2; ++n) _Pragma("unroll") for (int k = 0; k < 2; ++k) dst[n][k] = *(const PG8_LAS bf16x8*)(lds + PG8_SB(b, h) + boff + n * 2048 + k * 1024); } while (0)
#define PG8_MMA(ai, bj, At, Bt) do { __builtin_amdgcn_s_setprio(1); _Pragma("unroll") for (int m = 0; m < 4; ++m) _Pragma("unroll") for (int n = 0; n < 2; ++n) _Pragma("unroll") for (int k = 0; k < 2; ++k) \
        acc[ai][bj][m][n] = __builtin_amdgcn_mfma_f32_16x16x32_bf16(Bt[n][k], At[m][k], acc[ai][bj][m][n], 0, 0, 0); __builtin_amdgcn_s_setprio(0); } while (0)
#define PG8_WAIT_V(n) asm volatile("s_waitcnt vmcnt(" #n ")" ::: "memory")
#define PG8_WAIT_L(n) asm volatile("s_waitcnt lgkmcnt(" #n ")" ::: "memory")
#define PG8_BAR __builtin_amdgcn_s_barrier()
#define PG8_SCHED __builtin_amdgcn_sched_barrier(0)
    Unit cur, nxt; int ui = 0;
    if (!S.next(0, cur)) return;
    f32x4 acc[2][2][4][2];
#pragma unroll
    for (int a = 0; a < 2; ++a)
#pragma unroll
        for (int b = 0; b < 2; ++b)
#pragma unroll
            for (int m = 0; m < 4; ++m)
#pragma unroll
                for (int n = 0; n < 2; ++n) acc[a][b][m][n] = (f32x4){0.f, 0.f, 0.f, 0.f};
    bf16x8 At[4][2], B0[2][2], B1[2][2];
    const char* cA = (const char*)g.A + (size_t)cur.pm * tstep; const char* cB = (const char*)g.Bt + (size_t)cur.pn * tstep;
    S.a_ready(cur);
    if constexpr (SP2) {
        PG8_STAGE(PG8_SB(0, 0), cB, voffB); PG8_STAGE(PG8_SB(0, 1), cB + hstep, voffB); PG8_STAGE(PG8_SA(0, 0), cA, voffA); PG8_STAGE(PG8_SA(0, 1), cA + hstep, voffA);
        if (wr == 1) PG8_BAR;
        PG8_WAIT_V(2); PG8_BAR;
        PG8_STAGE(PG8_SB(1, 0), cB + kstep, voffB); PG8_STAGE(PG8_SA(1, 0), cA + kstep, voffA); PG8_STAGE(PG8_SB(1, 1), cB + hstep + kstep, voffB);
        PG8_WAIT_V(6); PG8_BAR;
    } else {
        PG8_STAGE(PG8_SB(0, 0), cB, voffB); PG8_STAGE(PG8_SA(0, 0), cA, voffA); PG8_STAGE(PG8_SB(0, 1), cB + hstep, voffB); PG8_STAGE(PG8_SA(0, 1), cA + hstep, voffA);
        if (wr == 1) PG8_BAR;
        PG8_WAIT_V(4); PG8_BAR;
        PG8_STAGE(PG8_SB(1, 0), cB + kstep, voffB); PG8_STAGE(PG8_SA(1, 0), cA + kstep, voffA); PG8_STAGE(PG8_SB(1, 1), cB + hstep + kstep, voffB);
        PG8_WAIT_V(6); PG8_BAR;
    }
    for (;;) {
        const bool has_next = S.next(ui + 1, nxt);
        const char* nA = has_next ? (const char*)g.A + (size_t)nxt.pm * tstep : cA; const char* nB = has_next ? (const char*)g.Bt + (size_t)nxt.pn * tstep : cB;
        for (int t = 0; t < nt; t += 2) {
            const bool last = (t == nt - 2);
            const char* a1 = cA + (size_t)(t + 1) * kstep;
            const char* a2 = last ? nA : cA + (size_t)(t + 2) * kstep; const char* b2 = last ? nB : cB + (size_t)(t + 2) * kstep;
            const char* a3 = a2 + kstep; const char* b3 = b2 + kstep;
            if (last && has_next) S.a_ready(nxt);
            if constexpr (SP2) {
            PG8_LDB(B0, 0, 0); PG8_LDB(B1, 0, 1); PG8_SCHED; PG8_LDA(At, 0, 0); PG8_STAGE(PG8_SA(1, 1), a1 + hstep, voffA);
            PG8_WAIT_V(8); PG8_WAIT_L(0); PG8_BAR; PG8_MMA(0, 0, At, B0); PG8_MMA(0, 1, At, B1); PG8_BAR; PG8_SCHED;
            PG8_LDA(At, 0, 1); PG8_STAGE(PG8_SB(0, 0), b2, voffB); PG8_STAGE(PG8_SB(0, 1), b2 + hstep, voffB); PG8_STAGE(PG8_SA(0, 0), a2, voffA);
            PG8_WAIT_V(8); PG8_WAIT_L(0); PG8_BAR; PG8_MMA(1, 0, At, B0); PG8_MMA(1, 1, At, B1); PG8_BAR; PG8_SCHED;
            PG8_LDB(B0, 1, 0); PG8_LDB(B1, 1, 1); PG8_SCHED; PG8_LDA(At, 1, 0); PG8_STAGE(PG8_SA(0, 1), a2 + hstep, voffA);
            PG8_WAIT_V(8); PG8_WAIT_L(0); PG8_BAR; PG8_MMA(0, 0, At, B0); PG8_MMA(0, 1, At, B1); PG8_BAR; PG8_SCHED;
            PG8_LDA(At, 1, 1); PG8_STAGE(PG8_SB(1, 0), b3, voffB); PG8_STAGE(PG8_SB(1, 1), b3 + hstep, voffB); PG8_STAGE(PG8_SA(1, 0), a3, voffA);
            PG8_WAIT_V(8); PG8_WAIT_L(0); PG8_BAR; PG8_MMA(1, 0, At, B0); PG8_MMA(1, 1, At, B1); PG8_BAR; PG8_SCHED;
            } else {
            PG8_LDB(B0, 0, 0); PG8_SCHED; PG8_LDA(At, 0, 0); PG8_STAGE(PG8_SA(1, 1), a1 + hstep, voffA);
            PG8_WAIT_L(8); PG8_BAR; PG8_WAIT_L(0); PG8_MMA(0, 0, At, B0); PG8_BAR; PG8_SCHED;
            PG8_LDB(B1, 0, 1); PG8_STAGE(PG8_SB(0, 0), b2, voffB);
            PG8_BAR; PG8_WAIT_L(0); PG8_MMA(0, 1, At, B1); PG8_BAR;
            PG8_LDA(At, 0, 1); PG8_STAGE(PG8_SA(0, 0), a2, voffA);
            PG8_BAR; PG8_WAIT_L(0); PG8_MMA(1, 0, At, B0); PG8_BAR; PG8_SCHED;
            PG8_STAGE(PG8_SB(0, 1), b2 + hstep, voffB);
            PG8_WAIT_V(6); PG8_BAR; PG8_MMA(1, 1, At, B1); PG8_BAR;
            PG8_LDB(B0, 1, 0); PG8_SCHED; PG8_LDA(At, 1, 0); PG8_STAGE(PG8_SA(0, 1), a2 + hstep, voffA);
            PG8_WAIT_L(8); PG8_BAR; PG8_WAIT_L(0); PG8_MMA(0, 0, At, B0); PG8_BAR; PG8_SCHED;
            PG8_LDB(B1, 1, 1); PG8_STAGE(PG8_SB(1, 0), b3, voffB);
            PG8_BAR; PG8_WAIT_L(0); PG8_MMA(0, 1, At, B1); PG8_BAR;
            PG8_LDA(At, 1, 1); PG8_STAGE(PG8_SA(1, 0), a3, voffA);
            PG8_BAR; PG8_WAIT_L(0); PG8_MMA(1, 0, At, B0); PG8_BAR; PG8_SCHED;
            PG8_STAGE(PG8_SB(1, 1), b3 + hstep, voffB);
            PG8_WAIT_V(6); PG8_BAR; PG8_MMA(1, 1, At, B1); PG8_BAR;
            }
        }
        if constexpr (ALIGN_EPI) { if (wr == 0) PG8_BAR; }
        if constexpr (!Epi::AFTER_DRAIN) { E(acc, cur, wr, wc, fr, fq); S.done(cur); }
        if (!has_next) break;
#pragma unroll
        for (int a = 0; a < 2; ++a)
#pragma unroll
            for (int b = 0; b < 2; ++b)
#pragma unroll
                for (int m = 0; m < 4; ++m)
#pragma unroll
                    for (int n = 0; n < 2; ++n) acc[a][b][m][n] = (f32x4){0.f, 0.f, 0.f, 0.f};
        cur = nxt; cA = nA; cB = nB; ++ui;
        if constexpr (ALIGN_EPI) { if (wr == 1) PG8_BAR; }
    }
    PG8_WAIT_V(0);
    if constexpr (!ALIGN_EPI) { if (wr == 0) PG8_BAR; }
    PG8_BAR;
    if constexpr (Epi::AFTER_DRAIN) { E.fused(acc, cur, wr, wc, fr, fq, lds, wid, lane); S.done(cur); }
#undef PG8_SA
#undef PG8_SB
#undef PG8_STAGE
#undef PG8_LDA
#undef PG8_LDB
#undef PG8_MMA
#undef PG8_WAIT_V
#undef PG8_WAIT_L
#undef PG8_BAR
#undef PG8_SCHED
}
}
namespace pg8 {
__device__ __forceinline__ u32x4 pack8bf(const f32x4 a, const f32x4 b) { u32x4 w; w.x = cvt_pk_bf16(a[0], a[1]); w.y = cvt_pk_bf16(a[2], a[3]); w.z = cvt_pk_bf16(b[0], b[1]); w.w = cvt_pk_bf16(b[2], b[3]); return w; }
__device__ __forceinline__ void rope8(f32x4& v0, f32x4& v1, const f32x4 cs, const f32x4 sn) {
    float a, b;
    a = v0[0]; b = v0[1]; v0[0] = a * cs[0] - b * sn[0]; v0[1] = b * cs[0] + a * sn[0];
    a = v0[2]; b = v0[3]; v0[2] = a * cs[1] - b * sn[1]; v0[3] = b * cs[1] + a * sn[1];
    a = v1[0]; b = v1[1]; v1[0] = a * cs[2] - b * sn[2]; v1[1] = b * cs[2] + a * sn[2];
    a = v1[2]; b = v1[3]; v1[2] = a * cs[3] - b * sn[3]; v1[3] = b * cs[3] + a * sn[3];
}
__device__ __forceinline__ float silu_f(float x) { return x * __builtin_amdgcn_rcpf(1.0f + __builtin_amdgcn_exp2f(-1.4426950408889634f * x)); }
__device__ __forceinline__ float sq4(const f32x4 v) { return (v[0] * v[0] + v[1] * v[1]) + (v[2] * v[2] + v[3] * v[3]); }
template <int NP> __device__ __forceinline__ float row_scale(const float* SS, size_t row, float inv_n, float eps, int fq) {
    const float* p = SS + row * NP; float s;
    if constexpr (NP == 32) { const f32x4 a = *(const f32x4*)(p + fq * 8), b = *(const f32x4*)(p + fq * 8 + 4); s = ((a[0] + a[1]) + (a[2] + a[3])) + ((b[0] + b[1]) + (b[2] + b[3])); s += __shfl_xor(s, 16); s += __shfl_xor(s, 32); }
    else if constexpr (NP == 8) { const f32x4 a = *(const f32x4*)p, b = *(const f32x4*)(p + 4); s = ((a[0] + a[1]) + (a[2] + a[3])) + ((b[0] + b[1]) + (b[2] + b[3])); }
    else { const f32x4 a = *(const f32x4*)p; s = (a[0] + a[1]) + (a[2] + a[3]); }
    return 1.0f / sqrtf(s * inv_n + eps);
}

struct EpiIn {
    static constexpr bool PERM = true, AFTER_DRAIN = false;
    const float* XSS; bf16_t* CQ; bf16_t* CKV; float* CQSS; float* CKVSS; bf16_t* Kb; const float* c64; const float* s64;
    bf16_t* RQ; bf16_t* RK; bf16_t* RV; bf16_t* RG; const float* c128; const float* s128;
    const PG8_LAS float* rtab; int rpm;
    __device__ __forceinline__ void operator()(const f32x4 (&acc)[2][2][4][2], const Unit& u, int wr, int wc, int fr, int fq) const {
        const int pn = u.pn, row0 = u.pm * BM + wr * 64 + fr, cw = wc * 32 + 8 * fq;
#pragma unroll
        for (int ai = 0; ai < 2; ++ai) {
            float r4[4];
#pragma unroll
            for (int m = 0; m < 4; ++m) r4[m] = (u.pm == rpm) ? rtab[wr * 64 + fr + ai * HALF + m * 16] : row_scale<32>(XSS, (size_t)(row0 + ai * HALF + m * 16), 1.0f / 2048.0f, 1e-6f, fq);
            asm volatile("" : "+v"(r4[0]), "+v"(r4[1]), "+v"(r4[2]), "+v"(r4[3]));
            if (pn < 3) {
#pragma unroll
                for (int m = 0; m < 4; ++m) { const size_t row = (size_t)(row0 + ai * HALF + m * 16); const float r = r4[m];
                    const f32x4 a0 = acc[ai][0][m][0] * r, a1 = acc[ai][0][m][1] * r, b0 = acc[ai][1][m][0] * r, b1 = acc[ai][1][m][1] * r;
                    float s = (sq4(a0) + sq4(a1)) + (sq4(b0) + sq4(b1)); s += __shfl_xor(s, 16); s += __shfl_xor(s, 32);
                    if (pn < 2) { bf16_t* rp = CQ + row * 512 + pn * 256 + cw; *(u32x4*)rp = pack8bf(a0, a1); *(u32x4*)(rp + HALF) = pack8bf(b0, b1); if (fq == 0) CQSS[row * 8 + pn * 4 + wc] = s; }
                    else { bf16_t* rp = CKV + row * 256 + cw; *(u32x4*)rp = pack8bf(a0, a1); *(u32x4*)(rp + HALF) = pack8bf(b0, b1); if (fq == 0) CKVSS[row * 4 + wc] = s; } }
            } else if (pn == 3) {
                if (wc < 2) { const int j0 = cw >> 1;
#pragma unroll
                    for (int m = 0; m < 4; ++m) { const size_t row = (size_t)(row0 + ai * HALF + m * 16); const float r = r4[m];
                        const f32x4 cs = *(const f32x4*)(c64 + row * 32 + j0), sn = *(const f32x4*)(s64 + row * 32 + j0);
                        f32x4 v0 = acc[ai][0][m][0] * r, v1 = acc[ai][0][m][1] * r; rope8(v0, v1, cs, sn); const u32x4 w = pack8bf(v0, v1);
                        bf16_t* kp = Kb + row * 1536 + 128 + cw;
#pragma unroll
                        for (int h = 0; h < 8; ++h) *(u32x4*)(kp + h * 192) = w; } }
            } else if (pn < 12) {
                bf16_t* T = pn < 8 ? RQ : RK; const float sc = pn < 8 ? 0.08838834764831845f : 1.0f; const int ct = ((pn - 4) & 3) * 256 + cw, j0 = cw >> 1;
#pragma unroll
                for (int m = 0; m < 4; ++m) { const size_t row = (size_t)(row0 + ai * HALF + m * 16); const float r = r4[m] * sc;
                    const f32x4 cs = *(const f32x4*)(c128 + row * 64 + j0), sn = *(const f32x4*)(s128 + row * 64 + j0);
#pragma unroll
                    for (int bj = 0; bj < 2; ++bj) { f32x4 v0 = acc[ai][bj][m][0] * r, v1 = acc[ai][bj][m][1] * r; rope8(v0, v1, cs, sn);
                        *(u32x4*)(T + row * 1024 + ct + bj * HALF) = pack8bf(v0, v1); } }
            } else if (pn < 16) {
                const int ct = (pn - 12) * 256 + cw;
#pragma unroll
                for (int m = 0; m < 4; ++m) { const size_t row = (size_t)(row0 + ai * HALF + m * 16); bf16_t* rp = RV + row * 1024 + ct; const float r = r4[m];
#pragma unroll
                    for (int bj = 0; bj < 2; ++bj) *(u32x4*)(rp + bj * HALF) = pack8bf(acc[ai][bj][m][0] * r, acc[ai][bj][m][1] * r); }
            } else {
                const int ct = (pn - 16) * 256 + cw;
#pragma unroll
                for (int m = 0; m < 4; ++m) { const size_t row = (size_t)(row0 + ai * HALF + m * 16); bf16_t* rp = RG + row * 1024 + ct; const float r = r4[m];
#pragma unroll
                    for (int bj = 0; bj < 2; ++bj) { f32x4 v0 = acc[ai][bj][m][0] * r, v1 = acc[ai][bj][m][1] * r;
#pragma unroll
                        for (int e = 0; e < 4; ++e) { v0[e] = silu_f(v0[e]); v1[e] = silu_f(v1[e]); }
                        *(u32x4*)(rp + bj * HALF) = pack8bf(v0, v1); } }
            }
        }
    }
};
struct EpiQ {
    static constexpr bool PERM = true, AFTER_DRAIN = false;
    const float* CQSS; bf16_t* Q; const float* c64; const float* s64; float sc;
    __device__ __forceinline__ void operator()(const f32x4 (&acc)[2][2][4][2], const Unit& u, int wr, int wc, int fr, int fq) const {
        const int row0 = u.pm * BM + wr * 64 + fr, cw = wc * 32 + 8 * fq;
#pragma unroll
        for (int ai = 0; ai < 2; ++ai)
#pragma unroll
            for (int m = 0; m < 4; ++m) { const size_t row = (size_t)(row0 + ai * HALF + m * 16); const float r = row_scale<8>(CQSS, row, 1.0f / 512.0f, 1e-6f, fq) * sc;
#pragma unroll
                for (int bj = 0; bj < 2; ++bj) { const int c0 = u.pn * 256 + bj * HALF + cw, dd = c0 % 192; const bool rp = dd >= 128; const int j0 = rp ? ((dd - 128) >> 1) : 0;
                    f32x4 v0 = acc[ai][bj][m][0] * r, v1 = acc[ai][bj][m][1] * r;
                    if (rp) { const f32x4 cs = *(const f32x4*)(c64 + row * 32 + j0), sn = *(const f32x4*)(s64 + row * 32 + j0); rope8(v0, v1, cs, sn); }
                    *(u32x4*)(Q + row * 1536 + c0) = pack8bf(v0, v1); } }
    }
};
struct EpiKV {
    static constexpr bool PERM = true, AFTER_DRAIN = false;
    const float* CKVSS; bf16_t* K; bf16_t* V;
    __device__ __forceinline__ void operator()(const f32x4 (&acc)[2][2][4][2], const Unit& u, int wr, int wc, int fr, int fq) const {
        const int row0 = u.pm * BM + wr * 64 + fr, cw = wc * 32 + 8 * fq;
#pragma unroll
        for (int ai = 0; ai < 2; ++ai)
#pragma unroll
            for (int m = 0; m < 4; ++m) { const size_t row = (size_t)(row0 + ai * HALF + m * 16); const float r = row_scale<4>(CKVSS, row, 1.0f / 256.0f, 1e-6f, fq);
                *(u32x4*)(K + row * 1536 + u.pn * 192 + cw) = pack8bf(acc[ai][0][m][0] * r, acc[ai][0][m][1] * r);
                *(u32x4*)(V + row * 1024 + u.pn * 128 + cw) = pack8bf(acc[ai][1][m][0] * r, acc[ai][1][m][1] * r); }
    }
};
template <bool SCALE2  , bool WRITE_XB>
struct EpiResT {
    static constexpr bool PERM = true, AFTER_DRAIN = false;
    const float* base; float* out; bf16_t* XB; float* XSS; const float* RS; const PG8_LAS float* rtab; int rpm;
    __device__ __forceinline__ void operator()(const f32x4 (&acc)[2][2][4][2], const Unit& u, int wr, int wc, int fr, int fq) const {
        const int row0 = u.pm * BM + wr * 64 + fr, c0 = u.pn * BM + wc * 32 + 8 * fq;
#pragma unroll
        for (int ai = 0; ai < 2; ++ai) {
            float r2[4];
#pragma unroll
            for (int m = 0; m < 4; ++m) { if constexpr (SCALE2) { const float r = (u.pm == rpm) ? rtab[wr * 64 + fr + ai * HALF + m * 16] : row_scale<32>(RS, (size_t)(row0 + ai * HALF + m * 16), 1.0f / 2048.0f, 1e-6f, fq); r2[m] = r * r; } else r2[m] = 1.0f; }
            if constexpr (SCALE2) asm volatile("" : "+v"(r2[0]), "+v"(r2[1]), "+v"(r2[2]), "+v"(r2[3]));
            f32x4 pre[4][4];
#pragma unroll
            for (int m = 0; m < 4; ++m) { const size_t off = (size_t)(row0 + ai * HALF + m * 16) * 2048 + c0;
                pre[m][0] = *(const f32x4*)(base + off); pre[m][1] = *(const f32x4*)(base + off + 4); pre[m][2] = *(const f32x4*)(base + off + HALF); pre[m][3] = *(const f32x4*)(base + off + HALF + 4); }
#pragma unroll
            for (int m = 0; m < 4; ++m) asm volatile("" : "+v"(pre[m][0]), "+v"(pre[m][1]), "+v"(pre[m][2]), "+v"(pre[m][3]));
#pragma unroll
            for (int m = 0; m < 4; ++m) { const size_t row = (size_t)(row0 + ai * HALF + m * 16); const size_t off = row * 2048 + c0;
                f32x4 a0, a1, b0, b1;
                if constexpr (SCALE2) { a0 = pre[m][0] + acc[ai][0][m][0] * r2[m]; a1 = pre[m][1] + acc[ai][0][m][1] * r2[m]; b0 = pre[m][2] + acc[ai][1][m][0] * r2[m]; b1 = pre[m][3] + acc[ai][1][m][1] * r2[m]; }
                else { a0 = pre[m][0] + acc[ai][0][m][0]; a1 = pre[m][1] + acc[ai][0][m][1]; b0 = pre[m][2] + acc[ai][1][m][0]; b1 = pre[m][3] + acc[ai][1][m][1]; }
                *(f32x4*)(out + off) = a0; *(f32x4*)(out + off + 4) = a1; *(f32x4*)(out + off + HALF) = b0; *(f32x4*)(out + off + HALF + 4) = b1;
                if constexpr (WRITE_XB) { *(u32x4*)(XB + off) = pack8bf(a0, a1); *(u32x4*)(XB + off + HALF) = pack8bf(b0, b1); }
                float s = (sq4(a0) + sq4(a1)) + (sq4(b0) + sq4(b1)); s += __shfl_xor(s, 16); s += __shfl_xor(s, 32);
                if (fq == 0) XSS[row * 32 + u.pn * 4 + wc] = s; }
        }
    }
};
struct EpiRelu2 {
    static constexpr bool PERM = true, AFTER_DRAIN = false;
    bf16_t* O; int ldc;
    __device__ __forceinline__ void operator()(const f32x4 (&acc)[2][2][4][2], const Unit& u, int wr, int wc, int fr, int fq) const {
        const int row0 = u.pm * BM + wr * 64 + fr, c0 = u.pn * BM + wc * 32 + 8 * fq;
#pragma unroll
        for (int ai = 0; ai < 2; ++ai)
#pragma unroll
            for (int m = 0; m < 4; ++m) { bf16_t* rp = O + (size_t)(row0 + ai * HALF + m * 16) * ldc + c0;
#pragma unroll
                for (int bj = 0; bj < 2; ++bj) { f32x4 v0 = acc[ai][bj][m][0], v1 = acc[ai][bj][m][1];
#pragma unroll
                    for (int e = 0; e < 4; ++e) { v0[e] = __int_as_float(max(__float_as_int(v0[e]), 0)); v1[e] = __int_as_float(max(__float_as_int(v1[e]), 0)); }
                    v0 = v0 * v0; v1 = v1 * v1;
                    *(u32x4*)(rp + bj * HALF) = pack8bf(v0, v1); } }
    }
};
}
constexpr int NWAVES = 8;
constexpr int BATCH = 2, SEQ = 8192, DM = 2048, DEPTH = 4, M = BATCH * SEQ;
constexpr int NH = 8, QLORA = 512, KVLORA = 256, DQK = 192, DNOPE = 128, DROPE = 64, DV = 128, FF = 8192;
constexpr int IN_SRC = 4928, IN_PAD = 5120;
constexpr int RCH = 128, NCH = SEQ / RCH;
constexpr float NORM_EPS = 1e-6f, GN_EPS = 1e-6f;
constexpr float QSCALE = 0.07216878364870323f * 1.4426950408889634f;

constexpr size_t MiB = 1u << 20;
constexpr size_t WS_CTL = 0, CTL_ZERO_BYTES = 128 * 1024;
constexpr size_t WS_C64 = 2 * MiB, WS_S64 = 4 * MiB, WS_C128 = 6 * MiB, WS_S128 = 10 * MiB;
constexpr size_t WS_XSS = 14 * MiB;
constexpr size_t WS_W = 16 * MiB, W_STRIDE = 96 * MiB;
constexpr size_t WO_WIN = 0, WO_WUQ = 20 * MiB, WO_WUKV = 22 * MiB, WO_WO = 24 * MiB, WO_WUP = 32 * MiB, WO_WDN = 64 * MiB;
constexpr size_t WS_XB = 208 * MiB;
constexpr size_t WS_MIX = 272 * MiB;
constexpr size_t WS_CQSS = 336 * MiB, WS_CKVSS = 337 * MiB;
constexpr size_t WS_RQ = 338 * MiB, WS_RK = 370 * MiB, WS_RV = 402 * MiB, WS_RG = 434 * MiB;
constexpr size_t WS_CQ = 466 * MiB, WS_CKV = 482 * MiB;
constexpr size_t WS_Q = 490 * MiB, WS_K = 538 * MiB, WS_V = 586 * MiB;
constexpr size_t WS_U = 618 * MiB, WS_S = 682 * MiB;
constexpr size_t WS_UF = 338 * MiB;
constexpr size_t WS_XSS2 = 714 * MiB;
constexpr size_t WS_END = 716 * MiB;
static_assert(WS_UF + (size_t)M * FF * 2 <= WS_U && WS_S + (size_t)16 * 64 * 16384 * 2 <= WS_END && WS_U + (size_t)16 * 64 * 16384 * 4 <= WS_S, "d_ws map");
static_assert(WO_WIN + (size_t)IN_PAD * DM * 2 <= WO_WUQ && WO_WUQ + (size_t)1536 * 512 * 2 <= WO_WUKV && WO_WUKV + (size_t)2048 * 256 * 2 <= WO_WO && WO_WO + (size_t)DM * DM * 2 <= WO_WUP && WO_WUP + (size_t)FF * DM * 2 <= WO_WDN && WO_WDN + (size_t)FF * DM * 2 <= W_STRIDE && WS_W + 2 * W_STRIDE <= WS_XB, "weights map");
constexpr int CW_TMO = 0, CW_CODE = 1, CW_BAR = 4096;
constexpr int CW_AQ = 12288;
constexpr int CW_SRDY = 12544, CW_RQ = 12800;
constexpr int CW_PC = 13312 + DEPTH * 2 * 64 * 16;
static_assert((CW_PC + 2 * 64 * 16) * 4 <= (int)CTL_ZERO_BYTES, "panel census inside the per-call memset");
constexpr int CW_PB = 13312;
static_assert((CW_PB + DEPTH * 2 * 64 * 16) * 4 <= (int)CTL_ZERO_BYTES && CW_PB >= CW_RQ + 64 * DEPTH, "panel counters inside the per-call memset");
constexpr int CW_WQ = 8192;
static_assert(CW_BAR + 3456 <= CW_WQ && (CW_WQ + 64 * DEPTH) <= CW_AQ && (CW_AQ + 64 * DEPTH) <= CW_SRDY && (CW_SRDY + 64 * DEPTH) <= CW_RQ && (CW_RQ + 64 * DEPTH) * 4 <= (int)CTL_ZERO_BYTES, "control words inside the per-call memset");

constexpr int RING_OFF = 0, RING_BYTES = 131072;
constexpr int LDSCTL_OFF = RING_BYTES, MISC_OFF = LDSCTL_OFF + 320;
constexpr int LDS_BYTES = 147456;
static_assert(MISC_OFF + 128 <= LDS_BYTES, "LDS map");

#define GAS __attribute__((address_space(1)))
#define LAS __attribute__((address_space(3)))
typedef unsigned short bf16;
typedef unsigned v4u __attribute__((ext_vector_type(4)));
typedef float f32x4 __attribute__((ext_vector_type(4)));
typedef short bf16x8 __attribute__((ext_vector_type(8)));
typedef GAS unsigned gu32;
typedef GAS unsigned long long gu64;
#define RLX_AGENT __ATOMIC_RELAXED, __HIP_MEMORY_SCOPE_AGENT
#define LDS_WAIT() asm volatile("s_waitcnt lgkmcnt(0)" ::: "memory")
#define VM_WAIT() asm volatile("s_waitcnt vmcnt(0)" ::: "memory")
__device__ __forceinline__ unsigned long long rt() { return __builtin_amdgcn_s_memrealtime(); }
__device__ __forceinline__ unsigned f2bf(float f) { unsigned u = __builtin_bit_cast(unsigned, f); return (u + 0x7fffu + ((u >> 16) & 1u)) >> 16; }
__device__ __forceinline__ unsigned pk2(float lo, float hi) { return f2bf(lo) | (f2bf(hi) << 16); }

#define XB_TMO      128
#define XB_XCNT(j)  (256  + 64 * (j))
#define XB_XSUB(j)  (1280 + 64 * (j))
#define XB_XGEN(j)  (2304 + 64 * (j))
#define XB_TOP      3328
#define XB_TOPGEN   3392
#define XCD_BAR_WORDS 3456
#define XB_SPIN_CAP (1u << 18)

__device__ __forceinline__ unsigned xb_ld(unsigned* p)              { return __hip_atomic_load(p, __ATOMIC_RELAXED, __HIP_MEMORY_SCOPE_AGENT); }
__device__ __forceinline__ unsigned xb_add(unsigned* p, unsigned v) { return __hip_atomic_fetch_add(p, v, __ATOMIC_RELAXED, __HIP_MEMORY_SCOPE_AGENT); }
__device__ __forceinline__ unsigned xb_xcc_id() { return (unsigned)__builtin_amdgcn_s_getreg((3 << 11) | 20) & 0xFu; }
#define XB_SPIN(cond, bar) do { unsigned _sp = 0; while (cond) { __builtin_amdgcn_s_sleep(1); \
    if ((++_sp & 255u) == 0u) { if (xb_ld(&(bar)[XB_TMO])) break; if (_sp > XB_SPIN_CAP) { atomicAdd(&(bar)[XB_TMO], 1u); break; } } } } while (0)

struct XcdBarrier {
    unsigned* bar; unsigned x;
    volatile LAS unsigned* st;
};

__device__ __forceinline__ XcdBarrier xcd_barrier_post(unsigned* bar, volatile LAS unsigned* st) {
    XcdBarrier b; b.bar = bar; b.x = xb_xcc_id(); b.st = st;
    if (threadIdx.x == 0) (void)xb_add(&bar[XB_XCNT(b.x)], 1u);
    return b;
}
__device__ __forceinline__ void xcd_barrier_complete(unsigned* bar, unsigned x, unsigned& nloc, unsigned& nx) {
    const unsigned G = gridDim.x * gridDim.y * gridDim.z;
    unsigned sum, cnt, mine, sp = 0u;
    for (;;) {
        sum = 0u; cnt = 0u; mine = 0u;
#pragma unroll
        for (unsigned j = 0; j < 16; ++j) { const unsigned c = xb_ld(&bar[XB_XCNT(j)]); sum += c; cnt += (c > 0u) ? 1u : 0u; mine = (j == x) ? c : mine; }
        if (sum == G) break;
        __builtin_amdgcn_s_sleep(1);
        if ((++sp & 255u) == 0u) { if (xb_ld(&bar[XB_TMO])) break; if (sp > XB_SPIN_CAP) { atomicAdd(&bar[XB_TMO], 1u); break; } }
    }
    nloc = mine > 0u ? mine : 1u; nx = cnt > 0u ? cnt : 1u;
}

__device__ __forceinline__ void xcd_barrier(const XcdBarrier& b) {
    asm volatile("s_waitcnt vmcnt(0)" ::: "memory");
    __syncthreads();
    if (threadIdx.x == 0) {
        unsigned* bar = b.bar;
        __builtin_amdgcn_s_waitcnt(0);
        unsigned nloc = b.st[0], nx = b.st[1];
        if (nloc == 0u) { xcd_barrier_complete(bar, b.x, nloc, nx); b.st[0] = nloc; b.st[1] = nx; }
        const unsigned old = xb_add(&bar[XB_XSUB(b.x)], 1u);
        const unsigned gen = old / nloc;
        if (old + 1u == (gen + 1u) * nloc) {
            __builtin_amdgcn_fence(__ATOMIC_RELEASE, "agent");
            asm volatile("s_waitcnt vmcnt(0)" ::: "memory");
            const unsigned og = xb_add(&bar[XB_TOP], 1u);
            const unsigned tg = og / nx;
            if (og + 1u == (tg + 1u) * nx) xb_add(&bar[XB_TOPGEN], 1u);
            else XB_SPIN(xb_ld(&bar[XB_TOPGEN]) == tg, bar);
            __builtin_amdgcn_fence(__ATOMIC_ACQUIRE, "agent");
            xb_add(&bar[XB_XGEN(b.x)], 1u);
            asm volatile("s_waitcnt vmcnt(0)" ::: "memory");
        } else {
            XB_SPIN(xb_ld(&bar[XB_XGEN(b.x)]) == gen, bar);
            __builtin_amdgcn_fence(__ATOMIC_ACQUIRE, "agent");
            asm volatile("s_waitcnt vmcnt(0)" ::: "memory");
        }
    }
    __syncthreads();
}

__device__ __forceinline__ void panel_census(unsigned* cons, const pg8::StaticOrder& S, unsigned xcc) {
    if (threadIdx.x == 0) { pg8::Unit u; for (int i = 0; S.next(i, u); ++i) { (void)__hip_atomic_fetch_or(&cons[u.pm * 16], 0x10000u << xcc, RLX_AGENT); (void)xb_add(&cons[u.pm * 16], 1u); } }
}
__device__ __forceinline__ void panel_post(unsigned* cnt, const pg8::StaticOrder& S, unsigned* cons, unsigned ncons, unsigned xcc) {
    asm volatile("s_waitcnt vmcnt(0)" ::: "memory");
    __syncthreads();
    if (threadIdx.x == 0) {
        pg8::Unit u; bool local = true;
        for (int i = 0; S.next(i, u); ++i) local = local && (xb_ld(&cons[u.pm * 16]) == ((0x10000u << xcc) | ncons));
        if (!local) { __builtin_amdgcn_fence(__ATOMIC_RELEASE, "agent"); asm volatile("s_waitcnt vmcnt(0)" ::: "memory"); }
        for (int i = 0; S.next(i, u); ++i) (void)xb_add(&cnt[u.pm * 16], 1u);
    }
}
__device__ __forceinline__ void panel_wait(unsigned* cnt, const pg8::StaticOrder& S, unsigned need, unsigned* bar) {
    if (threadIdx.x == 0) {
        pg8::Unit u; for (int i = 0; S.next(i, u); ++i) XB_SPIN(xb_ld(&cnt[u.pm * 16]) < need, bar);
        __builtin_amdgcn_fence(__ATOMIC_ACQUIRE, "agent"); asm volatile("s_waitcnt vmcnt(0)" ::: "memory");
    }
    __syncthreads();
}

typedef short s16x4 __attribute__((ext_vector_type(4)));
typedef float f32x16 __attribute__((ext_vector_type(16)));
typedef float f32x2 __attribute__((ext_vector_type(2)));
typedef LAS unsigned char* ldsp;
typedef const LAS unsigned char* cldsp;
#define SBARRIER() do { __builtin_amdgcn_s_barrier(); asm volatile("" ::: "memory"); } while (0)
__device__ __forceinline__ float wave_sum(float v) {
#pragma unroll
    for (int o = 1; o < 64; o <<= 1) v += __shfl_xor(v, o);
    return v;
}
__device__ __forceinline__ unsigned cvtpk(float lo, float hi) { unsigned r; asm volatile("v_cvt_pk_bf16_f32 %0, %1, %2" : "=v"(r) : "v"(lo), "v"(hi)); return r; }
__device__ __forceinline__ float bf_lo(unsigned w) { return __builtin_bit_cast(float, w << 16); }
__device__ __forceinline__ float bf_hi(unsigned w) { return __builtin_bit_cast(float, w & 0xffff0000u); }
__device__ __forceinline__ int crow(int r, int hi) { return (r & 3) + 8 * (r >> 2) + 4 * hi; }
__device__ __forceinline__ void glds16(const void* g, ldsp l) { __builtin_amdgcn_global_load_lds((const unsigned*)g, (LAS unsigned*)l, 16, 0, 0); }
typedef short v4i16_t __attribute__((ext_vector_type(4)));
__device__ __forceinline__ s16x4 trrd(cldsp p) { return __builtin_bit_cast(s16x4, __builtin_amdgcn_ds_read_tr16_b64_v4i16((LAS v4i16_t*)p)); }
#define MK8(lo, hi) ((bf16x8){(lo)[0], (lo)[1], (lo)[2], (lo)[3], (hi)[0], (hi)[1], (hi)[2], (hi)[3]})
__device__ __forceinline__ bf16x8 pack8f(const f32x16& p, int b) {
    v4u w; w.x = cvtpk(p[b], p[b + 1]); w.y = cvtpk(p[b + 2], p[b + 3]); w.z = cvtpk(p[b + 4], p[b + 5]); w.w = cvtpk(p[b + 6], p[b + 7]); return __builtin_bit_cast(bf16x8, w);
}
#define MFMA32(a, b, c) __builtin_amdgcn_mfma_f32_32x32x16_bf16((a), (b), (c), 0, 0, 0)
__device__ __forceinline__ int tr_att_base(int lane) { return (4 * (lane >> 5) + ((lane & 15) >> 2)) * 64 + ((lane >> 4) & 1) * 32 + (lane & 3) * 8; }
__device__ __forceinline__ int tr_nat_base(int lane) { return (8 * (lane >> 5) + ((lane & 15) >> 2)) * 64 + ((lane >> 4) & 1) * 32 + (lane & 3) * 8; }

struct Args {
    const float* x; const int* pos; const float* attn_norm; const float* w_in; const float* q_norm; const float* kv_norm; const float* w_uq; const float* w_ukv;
    const float* beta_attn; const float* beta_ret; const float* w_o; const float* mlp_norm; const float* w_up; const float* w_down; const float* final_norm;
    float* out; unsigned char* ws;
    double invf64[32]; double invf128[64];
    float lg2g[8];
};
static_assert(sizeof(Args) == 17 * 8 + 96 * 8 + 32, "Args has no padding");
typedef const __attribute__((address_space(4))) Args* cargs_t;
__device__ __forceinline__ cargs_t get_args() { cargs_t p = (cargs_t)__builtin_amdgcn_kernarg_segment_ptr(); asm volatile("" : "+s"(p)); return p; }

__device__ __forceinline__ void sincos_d(double ang, float& s, float& c) {
    const double k = __builtin_rint(ang * 0.63661977236758134308);
    double y = __builtin_fma(-k, 1.57079632679489655800e+00, ang); y = __builtin_fma(-k, 6.12323399573676603587e-17, y);
    const double z = y * y;
    double sp = 1.0 / 6227020800.0; sp = sp * z - 1.0 / 39916800.0; sp = sp * z + 1.0 / 362880.0; sp = sp * z - 1.0 / 5040.0; sp = sp * z + 1.0 / 120.0; sp = sp * z - 1.0 / 6.0; sp = sp * z + 1.0; sp = sp * y;
    double cp = -1.0 / 87178291200.0; cp = cp * z + 1.0 / 479001600.0; cp = cp * z - 1.0 / 3628800.0; cp = cp * z + 1.0 / 40320.0; cp = cp * z - 1.0 / 720.0; cp = cp * z + 1.0 / 24.0; cp = cp * z - 0.5; cp = cp * z + 1.0;
    const int q = (int)((long long)k & 3);
    const double ss = (q == 0) ? sp : (q == 1) ? cp : (q == 2) ? -sp : -cp;
    const double cc = (q == 0) ? cp : (q == 1) ? -sp : (q == 2) ? -cp : sp;
    s = (float)ss; c = (float)cc;
}
__device__ __forceinline__ void rope_tables(cargs_t a, int gtid, int nthr) {
    unsigned char* ws = a->ws; const int* pos = a->pos;
    float* c64 = (float*)(ws + WS_C64); float* s64 = (float*)(ws + WS_S64); float* c128 = (float*)(ws + WS_C128); float* s128 = (float*)(ws + WS_S128);
    for (int i = gtid; i < M * 96; i += nthr) { const int m = i / 96, j = i - m * 96; const double p = (double)pos[m]; float s, c;
        if (j < 32) { sincos_d(p * a->invf64[j], s, c); c64[m * 32 + j] = c; s64[m * 32 + j] = s; }
        else { sincos_d(p * a->invf128[j - 32], s, c); c128[m * 64 + j - 32] = c; s128[m * 64 + j - 32] = s; } }
}
template <class Map, class Gain>
__device__ __forceinline__ void transpose_item(const float* W, int K, int N, bf16* WT, const Map& map, const Gain& gain, LAS float* scr, int item, int lane) {
    const int nblk = N / 32, kb = item / nblk, nb = item % nblk, k0 = 64 * kb, n0 = 32 * nb;
#pragma unroll 8
    for (int i = 0; i < 32; ++i) { const int kk = 2 * i + (lane >> 5); scr[kk * 33 + (lane & 31)] = W[(size_t)(k0 + kk) * N + n0 + (lane & 31)] * gain(k0 + kk); }
    LDS_WAIT(); asm volatile("" ::: "memory");
    const int c = lane & 7;
#pragma unroll
    for (int j = 0; j < 4; ++j) { const int n = (lane >> 3) + 8 * j; const LAS float* s = scr + (8 * c) * 33 + n;
        v4u o; o.x = pk2(s[0 * 33], s[1 * 33]); o.y = pk2(s[2 * 33], s[3 * 33]); o.z = pk2(s[4 * 33], s[5 * 33]); o.w = pk2(s[6 * 33], s[7 * 33]);
        *(GAS v4u*)(WT + (size_t)map(n0 + n) * K + k0 + 8 * c) = o; }
    LDS_WAIT(); asm volatile("" ::: "memory");
}
struct GainNone { __device__ __forceinline__ float operator()(int) const { return 1.0f; } };
struct GainVec { const float* g; __device__ __forceinline__ float operator()(int k) const { return g[k]; } };
struct GainVec2 { const float* g0; const float* g1; int split; __device__ __forceinline__ float operator()(int k) const { return k < split ? g0[k] : g1[k - split]; } };
struct MapId { __device__ __forceinline__ int operator()(int n) const { return n; } };
struct MapWin {
    __device__ __forceinline__ int operator()(int n) const {
        if (n < 768) return n;
        if (n < 832) { const int d = n - 768; return 768 + (d < 32 ? 2 * d : 2 * (d - 32) + 1); }
        if (n < 2880) { const int e = n - 832, g = e >> 7, d = e & 127; return 1024 + g * 128 + (d < 64 ? 2 * d : 2 * (d - 64) + 1); }
        return n + 192;
    }
};
struct MapWuq {
    __device__ __forceinline__ int operator()(int n) const { const int h = n / 192, d = n - h * 192; if (d < 128) return n; const int e = d - 128; return h * 192 + 128 + (e < 32 ? 2 * e : 2 * (e - 32) + 1); }
};
template <bool DYN>
__device__ __forceinline__ void convert_weights(cargs_t a, int l, ldsp lds, int gw, int ngw, int wave, int lane, int gtid, int nthr, unsigned* qctr) {
    unsigned char* wb = a->ws + WS_W + (size_t)(l & 1) * W_STRIDE;
    LAS float* scr = (LAS float*)(lds + RING_OFF + wave * 16384);
    bf16* Win = (bf16*)(wb + WO_WIN); bf16* Wuq = (bf16*)(wb + WO_WUQ); bf16* Wukv = (bf16*)(wb + WO_WUKV); bf16* Wo = (bf16*)(wb + WO_WO); bf16* Wup = (bf16*)(wb + WO_WUP); bf16* Wdn = (bf16*)(wb + WO_WDN);
    const float* w_in = a->w_in + (size_t)l * DM * IN_SRC; const float* w_uq = a->w_uq + (size_t)l * QLORA * 1536; const float* w_ukv = a->w_ukv + (size_t)l * KVLORA * 2048;
    const float* w_o = a->w_o + (size_t)l * DM * DM; const float* w_up = a->w_up + (size_t)l * DM * FF; const float* w_dn = a->w_down + (size_t)l * FF * DM;
    const GainVec g_in{a->attn_norm + l * DM}, g_uq{a->q_norm + l * QLORA}, g_ukv{a->kv_norm + l * KVLORA}, g_up{a->mlp_norm + l * DM}; const GainVec2 g_o{a->beta_attn + l * 1024, a->beta_ret + l * 1024, 1024};
    constexpr int I_IN = (DM / 64) * (IN_SRC / 32), I_UQ = (QLORA / 64) * (1536 / 32), I_UKV = (KVLORA / 64) * (2048 / 32), I_O = (DM / 64) * (DM / 32), I_UP = (DM / 64) * (FF / 32), I_DN = (FF / 64) * (DM / 32);
    constexpr int NITEMS = I_IN + I_UQ + I_UKV + I_O + I_UP + I_DN, CH = 16;
    GAS v4u* pz = (GAS v4u*)(Win + (size_t)832 * DM);
    for (int i = gtid; i < 192 * DM / 8; i += nthr) pz[i] = (v4u){0u, 0u, 0u, 0u};
    int it = DYN ? 0 : gw, it_end = 0;
    for (;;) {
        if constexpr (DYN) { if (it >= it_end) { unsigned c = 0u; if (lane == 0) c = __hip_atomic_fetch_add(qctr, 1u, __ATOMIC_RELAXED, __HIP_MEMORY_SCOPE_AGENT);
                it = (int)__builtin_amdgcn_readfirstlane(c) * CH; it_end = it + CH; if (it >= NITEMS) break; }
            if (it >= NITEMS) break; }
        else { if (it >= NITEMS) break; }
        int r = it;
        if (r < I_IN) transpose_item(w_in, DM, IN_SRC, Win, MapWin(), g_in, scr, r, lane);
        else if ((r -= I_IN) < I_UQ) transpose_item(w_uq, QLORA, 1536, Wuq, MapWuq(), g_uq, scr, r, lane);
        else if ((r -= I_UQ) < I_UKV) transpose_item(w_ukv, KVLORA, 2048, Wukv, MapId(), g_ukv, scr, r, lane);
        else if ((r -= I_UKV) < I_O) transpose_item(w_o, DM, DM, Wo, MapId(), g_o, scr, r, lane);
        else if ((r -= I_O) < I_UP) transpose_item(w_up, DM, FF, Wup, MapId(), g_up, scr, r, lane);
        else { r -= I_UP; transpose_item(w_dn, FF, DM, Wdn, MapId(), GainNone(), scr, r, lane); }
        it += DYN ? 1 : ngw;
    }
}
constexpr int RTAB_OFF = LDSCTL_OFF + 1024;
static_assert(RTAB_OFF + 1024 <= LDS_BYTES, "row-scale table inside the LDS allocation");
__device__ __forceinline__ void fill_rtab(const float* SS, int pm, ldsp lds, int tid) {
    if (tid < 256) { const GAS f32x4* p = (const GAS f32x4*)(SS + (size_t)(pm * 256 + tid) * 32); float s = 0.f;
#pragma unroll
        for (int j = 0; j < 8; ++j) { const f32x4 v = p[j]; s += (v.x + v.y) + (v.z + v.w); }
        ((LAS float*)(lds + RTAB_OFF))[tid] = 1.0f / sqrtf(s * (1.0f / DM) + NORM_EPS); }
    __syncthreads();
}
template <int NR> __device__ __forceinline__ void prep_rows(const float* x, bf16* XB, float* XSS, int row, int stride, int lane) {
    f32x4 v[NR][8]; float s[NR];
#pragma unroll
    for (int q = 0; q < NR; ++q) { const GAS f32x4* xr = (const GAS f32x4*)(x + (size_t)(row + q * stride) * DM) + lane;
#pragma unroll
        for (int j = 0; j < 8; ++j) v[q][j] = xr[64 * j]; }
#pragma unroll
    for (int q = 0; q < NR; ++q) { float t = 0.f;
#pragma unroll
        for (int j = 0; j < 8; ++j) t += (v[q][j].x * v[q][j].x + v[q][j].y * v[q][j].y) + (v[q][j].z * v[q][j].z + v[q][j].w * v[q][j].w);
        s[q] = wave_sum(t); }
#pragma unroll
    for (int q = 0; q < NR; ++q) { GAS unsigned long long* o8 = (GAS unsigned long long*)(XB + (size_t)(row + q * stride) * DM) + lane;
#pragma unroll
        for (int j = 0; j < 8; ++j) o8[64 * j] = (unsigned long long)cvtpk(v[q][j].x, v[q][j].y) | ((unsigned long long)cvtpk(v[q][j].z, v[q][j].w) << 32);
        if (lane < 32) XSS[(size_t)(row + q * stride) * 32 + lane] = (lane == 0) ? s[q] : 0.f; }
}
template <int NR> __device__ __forceinline__ void rms_rows_final(float* xo, const float* XSS, const float* g, int row, int stride, int lane) {
    f32x4 v[NR][8]; float r[NR]; const GAS f32x4* gr = (const GAS f32x4*)g + lane;
#pragma unroll
    for (int q = 0; q < NR; ++q) { const GAS f32x4* xr = (const GAS f32x4*)(xo + (size_t)(row + q * stride) * DM) + lane;
#pragma unroll
        for (int j = 0; j < 8; ++j) v[q][j] = xr[64 * j];
        r[q] = (lane < 32) ? XSS[(size_t)(row + q * stride) * 32 + lane] : 0.f; }
#pragma unroll
    for (int q = 0; q < NR; ++q) r[q] = 1.0f / sqrtf(wave_sum(r[q]) * (1.0f / DM) + NORM_EPS);
#pragma unroll
    for (int q = 0; q < NR; ++q) { GAS f32x4* xr = (GAS f32x4*)(xo + (size_t)(row + q * stride) * DM) + lane;
#pragma unroll
        for (int j = 0; j < 8; ++j) { const f32x4 gg = gr[64 * j]; const float rr = r[q]; xr[64 * j] = (f32x4){v[q][j].x * rr * gg.x, v[q][j].y * rr * gg.y, v[q][j].z * rr * gg.z, v[q][j].w * rr * gg.w}; } }
}
template <int NR> __device__ __forceinline__ void attn_norm_rows(bf16* mix, int row, int stride, int lane) {
    v4u w[NR][2]; float r[NR];
#pragma unroll
    for (int q = 0; q < NR; ++q) { const bf16* p = mix + (size_t)(row + q * stride) * DM; w[q][0] = *(const GAS v4u*)(p + lane * 8); w[q][1] = *(const GAS v4u*)(p + 512 + lane * 8); }
#pragma unroll
    for (int q = 0; q < NR; ++q) { float s = 0.f;
#pragma unroll
        for (int j = 0; j < 2; ++j) { const v4u u = w[q][j]; const float f0 = bf_lo(u.x), f1 = bf_hi(u.x), f2 = bf_lo(u.y), f3 = bf_hi(u.y), f4 = bf_lo(u.z), f5 = bf_hi(u.z), f6 = bf_lo(u.w), f7 = bf_hi(u.w);
            s += ((f0 * f0 + f1 * f1) + (f2 * f2 + f3 * f3)) + ((f4 * f4 + f5 * f5) + (f6 * f6 + f7 * f7)); }
        r[q] = 1.0f / sqrtf(wave_sum(s) * (1.0f / 1024.0f) + NORM_EPS); }
#pragma unroll
    for (int q = 0; q < NR; ++q) { bf16* p = mix + (size_t)(row + q * stride) * DM; const float rr = r[q];
#pragma unroll
        for (int j = 0; j < 2; ++j) { const v4u u = w[q][j]; v4u o; o.x = cvtpk(bf_lo(u.x) * rr, bf_hi(u.x) * rr); o.y = cvtpk(bf_lo(u.y) * rr, bf_hi(u.y) * rr); o.z = cvtpk(bf_lo(u.z) * rr, bf_hi(u.z) * rr); o.w = cvtpk(bf_lo(u.w) * rr, bf_hi(u.w) * rr);
            *(GAS v4u*)(p + j * 512 + lane * 8) = o; } }
}

#ifdef PROBE_ATT
#ifndef PROBE_ATT_WAVE
#define PROBE_ATT_WAVE 0
#endif
#define ATP_DECL() unsigned long long atp_t_ = __builtin_readcyclecounter(), atp_acc_ = 0ull; const bool atp_on_ = (blockIdx.x == 0) && (wid == PROBE_ATT_WAVE)
#define ATP(k) do { if (atp_on_) { const unsigned long long n_ = __builtin_readcyclecounter(); if ((k) == ((PROBE_ATT) + 1) % 4) atp_acc_ += n_ - atp_t_; atp_t_ = n_; } } while (0)
#define ATP_END() do { if (atp_on_ && lane == 0) { volatile LAS unsigned long long* q_ = (volatile LAS unsigned long long*)(lds + LDSCTL_OFF + 80); q_[0] += atp_acc_; } } while (0)
#else
#define ATP_DECL() do { } while (0)
#define ATP(k) do { } while (0)
#define ATP_END() do { } while (0)
#endif
__device__ __forceinline__ float max3f(float a, float b, float c) { float r; asm("v_max3_f32 %0, %1, %2, %3" : "=v"(r) : "v"(a), "v"(b), "v"(c)); return r; }
__device__ __forceinline__ float max2f(float a, float b) { float r; asm("v_max_f32_e32 %0, %1, %2" : "=v"(r) : "v"(a), "v"(b)); return r; }
constexpr int AT_KSLOT = 64 * DQK * 2, AT_VSLOT = 64 * DV * 2, AT_K = 0, AT_V = 2 * AT_KSLOT, AT_WS = AT_V + 2 * AT_VSLOT, AT_BYTES = AT_WS + NWAVES * 256;
static_assert(AT_BYTES <= RING_BYTES, "attention LDS");
__device__ __forceinline__ void attn_unit(const bf16* Qg, const bf16* Kg, const bf16* Vg, bf16* Og, int b, int h, int qb, ldsp lds, int tid) {
    const int lane = tid & 63, r32 = lane & 31, hi = lane >> 5; const int wid = __builtin_amdgcn_readfirstlane(tid >> 6);
    const size_t rowbase = (size_t)b * SEQ; const int q0 = qb * 256, NT = (q0 + 256) / 64, qw0 = q0 + wid * 32;
    const bf16* Kh = Kg + rowbase * 1536 + h * DQK; const bf16* Vh = Vg + rowbase * 1024 + h * DV;
    LAS float* wsf = (LAS float*)(lds + AT_WS) + wid * 64;
    const int krow_ = lane >> 2, kpiece_ = (lane & 3) ^ (((krow_ >> 2) ^ krow_) & 3);
#define AT_DMA(t, s) do { \
        _Pragma("unroll") for (int i_ = 0; i_ < 3; ++i_) { const int c_ = wid + 8 * i_; \
            glds16(Kh + (size_t)((t) * 64 + 16 * (c_ & 3) + krow_) * 1536 + (c_ >> 2) * 32 + kpiece_ * 8, lds + AT_K + (s) * AT_KSLOT + c_ * 1024); } \
        _Pragma("unroll") for (int i_ = 0; i_ < 2; ++i_) { const int c_ = wid + 8 * i_; \
            glds16(Vh + (size_t)((t) * 64 + 16 * (c_ & 3) + (lane >> 2)) * 1024 + (c_ >> 2) * 32 + (lane & 3) * 8, lds + AT_V + (s) * AT_VSLOT + c_ * 1024); } } while (0)
    AT_DMA(0, 0);
    bf16x8 qr[12];
    { const bf16* qp = Qg + (rowbase + qw0 + r32) * 1536 + h * DQK + hi * 8;
#pragma unroll
      for (int d0 = 0; d0 < 12; ++d0) qr[d0] = *(const GAS bf16x8*)(qp + d0 * 16); }
    float m_run = 0.f, l_run = 0.f; f32x16 o[4];
#pragma unroll
    for (int d = 0; d < 4; ++d)
#pragma unroll
        for (int r = 0; r < 16; ++r) o[d][r] = 0.f;
    const int vlane = tr_att_base(lane);
    const int kfr_ = r32 & 15, kfrag_ = (r32 >> 4) * 1024 + kfr_ * 64 + ((hi ^ (((kfr_ >> 2) ^ kfr_) & 3)) << 4), kfx_ = ((kfrag_ ^ 32) - kfrag_);
    ATP_DECL();
    for (int t = 0; t < NT; ++t) {
        const int s = t & 1;
        ATP(0);
        asm volatile("s_waitcnt vmcnt(0)" ::: "memory"); SBARRIER();
        if (t + 1 < NT) AT_DMA(t + 1, s ^ 1);
        ATP(1);
        const int kbase = t * 64;
        if (kbase <= qw0 + 31) {
            f32x16 p0, p1;
            cldsp kb = lds + AT_K + s * AT_KSLOT + kfrag_;
#pragma unroll
            for (int r = 0; r < 16; ++r) { p0[r] = 0.f; p1[r] = 0.f; }
#define KFA(d) (kb + ((d) >> 1) * 4096 + (((d) & 1) ? kfx_ : 0))
            bf16x8 ka0 = *(const LAS bf16x8*)(KFA(0)), ka1 = *(const LAS bf16x8*)(KFA(0) + 2048), kb0 = *(const LAS bf16x8*)(KFA(1)), kb1 = *(const LAS bf16x8*)(KFA(1) + 2048);
#pragma unroll
            for (int d0 = 0; d0 < 12; ++d0) {
                bf16x8 kc0 = ka0, kc1 = ka1;
                if (d0 + 2 < 12) { kc0 = *(const LAS bf16x8*)(KFA(d0 + 2)); kc1 = *(const LAS bf16x8*)(KFA(d0 + 2) + 2048); }
                __builtin_amdgcn_sched_barrier(0);
                p0 = MFMA32(ka0, qr[d0], p0); p1 = MFMA32(ka1, qr[d0], p1);
                __builtin_amdgcn_sched_barrier(0);
                ka0 = kb0; ka1 = kb1; kb0 = kc0; kb1 = kc1;
            }
#undef KFA
            if (kbase + 63 > qw0) {
                const int qi = qw0 + r32; const float NEG = -__builtin_inff();
#pragma unroll
                for (int r = 0; r < 16; ++r) { const int kv = kbase + crow(r, hi); if (kv > qi) p0[r] = NEG; if (kv + 32 > qi) p1[r] = NEG; }
            }
            asm volatile("s_nop 15\n\ts_nop 7" : "+v"(p0), "+v"(p1));
            float mx;
            { float xa = max3f(p0[0], p0[1], p1[0]), xb = max3f(p0[2], p0[3], p1[1]); xa = max3f(xa, p1[2], p1[3]);
#pragma unroll
              for (int r = 4; r < 16; r += 4) { xa = max3f(xa, p0[r], p0[r + 1]); xb = max3f(xb, p0[r + 2], p0[r + 3]); xa = max3f(xa, p1[r], p1[r + 1]); xb = max3f(xb, p1[r + 2], p1[r + 3]); }
              mx = max2f(xa, xb); }
            { const auto sw_ = __builtin_amdgcn_permlane32_swap(__float_as_uint(mx), __float_as_uint(mx), false, false); mx = max2f(__uint_as_float(sw_[0]), __uint_as_float(sw_[1])); }
            asm volatile("" : "+v"(mx)); ATP(2);
            cldsp vb = lds + AT_V + s * AT_VSLOT + vlane;
            s16x4 vpre[4]; vpre[0] = trrd(vb); vpre[1] = trrd(vb + 512); vpre[2] = trrd(vb + 1024); vpre[3] = trrd(vb + 1024 + 512);
            const bool first = (t == 0);
            if (first || !__all(mx - m_run <= 8.0f)) {
                const float mn = first ? mx : fmaxf(m_run, mx);
                if (!first) { const float alpha = __builtin_amdgcn_exp2f(m_run - mn); l_run *= alpha;
                    if (hi == 0) wsf[r32] = alpha;
                    asm volatile("s_waitcnt lgkmcnt(0)" ::: "memory");
#pragma unroll
                    for (int r = 0; r < 16; ++r) { const float al = wsf[crow(r, hi)];
#pragma unroll
                        for (int d = 0; d < 4; ++d) o[d][r] *= al; } }
                m_run = mn;
            }
            float rs = 0.f;
#pragma unroll
            for (int r = 0; r < 16; ++r) { p0[r] = __builtin_amdgcn_exp2f(p0[r] - m_run); p1[r] = __builtin_amdgcn_exp2f(p1[r] - m_run); rs += p0[r] + p1[r]; }
            l_run += rs;
            bf16x8 pa[4]; pa[0] = pack8f(p0, 0); pa[1] = pack8f(p0, 8); pa[2] = pack8f(p1, 0); pa[3] = pack8f(p1, 8);
            ATP(3);
            { s16x4 c0 = vpre[0], c1 = vpre[1], c2 = vpre[2], c3 = vpre[3];
#pragma unroll
              for (int st = 0; st < 8; ++st) { const int d0 = st >> 1, k2 = (st & 1) * 2;
                s16x4 n0 = c0, n1 = c1, n2 = c2, n3 = c3;
                if (st + 1 < 8) { const int dn = (st + 1) >> 1, kn = ((st + 1) & 1) * 2; cldsp q = vb + (dn * 4 + kn) * 1024; n0 = trrd(q); n1 = trrd(q + 512); n2 = trrd(q + 1024); n3 = trrd(q + 1024 + 512); }
                __builtin_amdgcn_sched_barrier(0);
                o[d0] = MFMA32(pa[k2], MK8(c0, c1), o[d0]); o[d0] = MFMA32(pa[k2 + 1], MK8(c2, c3), o[d0]);
                __builtin_amdgcn_sched_barrier(0);
                c0 = n0; c1 = n1; c2 = n2; c3 = n3; } }
        }
    }
    ATP(0); ATP_END();
    l_run += __shfl_xor(l_run, 32);
    if (hi == 0) wsf[32 + r32] = l_run;
    asm volatile("s_waitcnt lgkmcnt(0)" ::: "memory");
    bf16* Ow = Og + (rowbase + qw0) * DM + h * DV;
#pragma unroll
    for (int r = 0; r < 16; ++r) { const int orow = crow(r, hi); const float rl = 1.0f / wsf[32 + orow];
#pragma unroll
        for (int d0 = 0; d0 < 4; ++d0) { const float v = o[d0][r] * rl; const float vn = __shfl_xor(v, 1);
            if ((r32 & 1) == 0) *(GAS unsigned*)(Ow + (size_t)orow * DM + d0 * 32 + r32) = cvtpk(v, vn); } }
    asm volatile("s_waitcnt lgkmcnt(0)" ::: "memory"); SBARRIER();
#undef AT_DMA
}

constexpr int RT_K = 0, RT_V = 32768, RT_S = 65536, RT_O = 0, RT_OSTRIDE = 132;
static_assert(RT_S + 32768 <= RING_BYTES && RT_O + 128 * RT_OSTRIDE * 4 + 1024 <= RING_BYTES, "retention LDS");
__device__ __forceinline__ void ret_state_unit(const bf16* RK, const bf16* RV, float* U, int bh, int c, float lg2g, ldsp lds, int tid) {
    const int lane = tid & 63, r32 = lane & 31, hi = lane >> 5; const int wid = __builtin_amdgcn_readfirstlane(tid >> 6);
    const int b = bh >> 3, h = bh & 7; const size_t row0 = (size_t)b * SEQ + (size_t)c * RCH;
#pragma unroll
    for (int i = 0; i < 4; ++i) { const int ch = wid * 4 + i, cb = ch >> 3, ks = ch & 7; const size_t tok = row0 + 16 * ks + (lane >> 2); const int col = h * 128 + cb * 32 + (lane & 3) * 8;
        glds16(RK + tok * 1024 + col, lds + RT_K + ch * 1024);
        const v4u w = *(const GAS v4u*)(RV + tok * 1024 + col); const float z = __builtin_amdgcn_exp2f(lg2g * (float)(127 - (16 * ks + (lane >> 2))));
        v4u o; o.x = cvtpk(bf_lo(w.x) * z, bf_hi(w.x) * z); o.y = cvtpk(bf_lo(w.y) * z, bf_hi(w.y) * z); o.z = cvtpk(bf_lo(w.z) * z, bf_hi(w.z) * z); o.w = cvtpk(bf_lo(w.w) * z, bf_hi(w.w) * z);
        *(LAS v4u*)(lds + RT_V + ch * 1024 + lane * 16) = o; }
    asm volatile("s_waitcnt vmcnt(0) lgkmcnt(0)" ::: "memory"); SBARRIER();
    const int dkb = wid >> 1, dvb0 = (wid & 1) * 2; const int nb = tr_nat_base(lane);
    f32x16 acc[2];
#pragma unroll
    for (int r = 0; r < 16; ++r) { acc[0][r] = 0.f; acc[1][r] = 0.f; }
#pragma unroll
    for (int ks = 0; ks < 8; ++ks) { cldsp ka = lds + RT_K + (dkb * 8 + ks) * 1024 + nb; const s16x4 al = trrd(ka), ah = trrd(ka + 256); const bf16x8 A = MK8(al, ah);
#pragma unroll
        for (int j = 0; j < 2; ++j) { cldsp vb = lds + RT_V + ((dvb0 + j) * 8 + ks) * 1024 + nb; const s16x4 bl = trrd(vb), bh2 = trrd(vb + 256); acc[j] = MFMA32(A, MK8(bl, bh2), acc[j]); } }
    float* Uu = U + ((size_t)bh * NCH + c) * 16384;
#pragma unroll
    for (int j = 0; j < 2; ++j)
#pragma unroll
        for (int r = 0; r < 16; ++r) Uu[(dkb * 32 + crow(r, hi)) * 128 + (dvb0 + j) * 32 + r32] = acc[j][r];
    asm volatile("s_waitcnt lgkmcnt(0)" ::: "memory"); SBARRIER();
}
__device__ __forceinline__ void ret_scan(const float* U, bf16* S, cargs_t a, int gtid, int nthr) {
    for (int it = gtid; it < 16 * 8192; it += nthr) { const int bh = it >> 13, e2 = it & 8191; const float g = __builtin_amdgcn_exp2f(128.0f * a->lg2g[bh & 7]);
        const float* up = U + (size_t)bh * NCH * 16384 + e2 * 2; bf16* sp = S + (size_t)bh * NCH * 16384 + e2 * 2; float s0 = 0.f, s1 = 0.f;
#pragma unroll 8
        for (int c = 0; c < NCH; ++c) { *(GAS unsigned*)(sp + (size_t)c * 16384) = cvtpk(s0, s1); const f32x2 u = *(const GAS f32x2*)(up + (size_t)c * 16384); s0 = s0 * g + u.x; s1 = s1 * g + u.y; } }
}
__device__ __forceinline__ void ret_out_unit(const bf16* RQ, const bf16* RK, const bf16* RV, const bf16* RG, const bf16* S, bf16* MIX, int bh, int c, float lg2g, ldsp lds, int tid) {
    const int lane = tid & 63, r32 = lane & 31, hi = lane >> 5; const int wid = __builtin_amdgcn_readfirstlane(tid >> 6);
    const int b = bh >> 3, h = bh & 7; const size_t row0 = (size_t)b * SEQ + (size_t)c * RCH;
    const int rb = wid & 3, dh = wid >> 2;
    const bf16* Ss = S + ((size_t)bh * NCH + c) * 16384;
#pragma unroll
    for (int i = 0; i < 4; ++i) { const int id = wid * 4 + i;
        glds16(RK + (row0 + (id & 1) * 64 + lane) * 1024 + h * 128 + (id >> 1) * 8, lds + RT_K + id * 1024);
        const int cb = id >> 3, ks = id & 7;
        glds16(RV + (row0 + 16 * ks + (lane >> 2)) * 1024 + h * 128 + cb * 32 + (lane & 3) * 8, lds + RT_V + id * 1024);
        glds16(Ss + (16 * ks + (lane >> 2)) * 128 + cb * 32 + (lane & 3) * 8, lds + RT_S + id * 1024); }
    unsigned gate[16];
#pragma unroll
    for (int i = 0; i < 16; ++i) gate[i] = *(const GAS unsigned*)(RG + (row0 + wid * 16 + i) * 1024 + h * 128 + 2 * lane);
    bf16x8 qr[8];
    { const bf16* qp = RQ + (row0 + rb * 32 + r32) * 1024 + h * 128 + hi * 8;
#pragma unroll
      for (int d0 = 0; d0 < 8; ++d0) qr[d0] = *(const GAS bf16x8*)(qp + d0 * 16); }
    asm volatile("s_waitcnt vmcnt(0)" ::: "memory"); SBARRIER();
    f32x16 o[2];
#pragma unroll
    for (int r = 0; r < 16; ++r) { o[0][r] = 0.f; o[1][r] = 0.f; }
    { const int nb = tr_nat_base(lane);
#pragma unroll
      for (int ks = 0; ks < 8; ++ks)
#pragma unroll
          for (int j = 0; j < 2; ++j) { cldsp sb = lds + RT_S + ((dh * 2 + j) * 8 + ks) * 1024 + nb; const s16x4 bl = trrd(sb), bh2 = trrd(sb + 256); o[j] = MFMA32(qr[ks], MK8(bl, bh2), o[j]); }
#pragma unroll
      for (int r = 0; r < 16; ++r) { const float xi = __builtin_amdgcn_exp2f(lg2g * (float)(rb * 32 + crow(r, hi) + 1)); o[0][r] *= xi; o[1][r] *= xi; } }
    const int ab = tr_att_base(lane);
    for (int kb = 0; kb <= rb; ++kb) {
        f32x16 p;
#pragma unroll
        for (int r = 0; r < 16; ++r) p[r] = 0.f;
        cldsp kp = lds + RT_K + hi * 2048 + (kb * 32 + r32) * 16;
#pragma unroll
        for (int d0 = 0; d0 < 8; ++d0) { const bf16x8 ka = *(const LAS bf16x8*)(kp + d0 * 4096); p = MFMA32(ka, qr[d0], p); }
        const int qi = rb * 32 + r32;
#pragma unroll
        for (int r = 0; r < 16; ++r) { const int kj = kb * 32 + crow(r, hi); const float dcy = __builtin_amdgcn_exp2f(lg2g * (float)(qi - kj)); p[r] = (qi >= kj) ? p[r] * dcy : 0.f; }
        const bf16x8 pa0 = pack8f(p, 0), pa1 = pack8f(p, 8);
#pragma unroll
        for (int j = 0; j < 2; ++j) { cldsp vb = lds + RT_V + ((dh * 2 + j) * 8 + kb * 2) * 1024 + ab;
            { const s16x4 lo = trrd(vb), hh = trrd(vb + 512); o[j] = MFMA32(pa0, MK8(lo, hh), o[j]); }
            { const s16x4 lo = trrd(vb + 1024), hh = trrd(vb + 1024 + 512); o[j] = MFMA32(pa1, MK8(lo, hh), o[j]); } }
    }
    asm volatile("s_waitcnt lgkmcnt(0)" ::: "memory"); SBARRIER();
    LAS float* ob = (LAS float*)(lds + RT_O);
#pragma unroll
    for (int j = 0; j < 2; ++j)
#pragma unroll
        for (int r = 0; r < 16; ++r) ob[(rb * 32 + crow(r, hi)) * RT_OSTRIDE + (dh * 2 + j) * 32 + r32] = o[j][r];
    asm volatile("s_waitcnt lgkmcnt(0)" ::: "memory"); SBARRIER();
    { const int srow = tid >> 2, sq = tid & 3; const LAS float* rp = ob + srow * RT_OSTRIDE + 16 * sq; float s1 = 0.f, s2 = 0.f;
#pragma unroll
      for (int j = 0; j < 2; ++j)
#pragma unroll
          for (int i = 0; i < 4; ++i) { const f32x4 v = *(const LAS f32x4*)(rp + 64 * j + 4 * i); s1 += (v.x + v.y) + (v.z + v.w); s2 += (v.x * v.x + v.y * v.y) + (v.z * v.z + v.w * v.w); }
      s1 += __builtin_bit_cast(float, __builtin_amdgcn_mov_dpp(__builtin_bit_cast(int, s1), 0xB1, 0xf, 0xf, true)); s2 += __builtin_bit_cast(float, __builtin_amdgcn_mov_dpp(__builtin_bit_cast(int, s2), 0xB1, 0xf, 0xf, true));
      s1 += __builtin_bit_cast(float, __builtin_amdgcn_mov_dpp(__builtin_bit_cast(int, s1), 0x4E, 0xf, 0xf, true)); s2 += __builtin_bit_cast(float, __builtin_amdgcn_mov_dpp(__builtin_bit_cast(int, s2), 0x4E, 0xf, 0xf, true));
      const float mu = s1 * (1.0f / 128.0f), var = fmaxf(s2 * (1.0f / 128.0f) - mu * mu, 0.f);
      if (sq == 0) *(LAS f32x2*)(ob + 128 * RT_OSTRIDE + 2 * srow) = (f32x2){mu, 1.0f / sqrtf(var + GN_EPS)}; }
    asm volatile("s_waitcnt lgkmcnt(0)" ::: "memory"); SBARRIER();
#pragma unroll
    for (int i = 0; i < 16; ++i) { const int rr = wid * 16 + i; const f32x2 v = *(const LAS f32x2*)(ob + rr * RT_OSTRIDE + 2 * lane); const f32x2 st = *(const LAS f32x2*)(ob + 128 * RT_OSTRIDE + 2 * rr);
        *(GAS unsigned*)(MIX + (row0 + rr) * DM + 1024 + h * 128 + 2 * lane) = cvtpk((v.x - st.x) * st.y * bf_lo(gate[i]), (v.y - st.x) * st.y * bf_hi(gate[i])); }
    asm volatile("s_waitcnt lgkmcnt(0)" ::: "memory"); SBARRIER();
}


#define PHASE_IDS() int tid = tid0; asm volatile("" : "+v"(tid)); int G = G0, bx = bx0; asm volatile("" : "+s"(G), "+s"(bx)); \
    const int lane = tid & 63; const int wave = __builtin_amdgcn_readfirstlane(tid >> 6); const int vcu = (G % 8 == 0) ? (bx % 8) * (G / 8) + bx / 8 : bx; (void)lane; (void)wave; (void)vcu
#define GW (vcu * NWAVES + wave)
#define NGW (G * NWAVES)
#define GTID (vcu * (NWAVES * 64) + tid)
#define NTHR (G * NWAVES * 64)
#ifndef PG_ALIGN
#define PG_ALIGN true
#endif
#define XBAR() xcd_barrier(bar)
#ifdef PROBE_SPAN
#ifndef PROBE_BLOCK
#define PROBE_BLOCK 0
#endif
#ifdef PROBE_CLK
#define PTIME() __builtin_readcyclecounter()
#else
#define PTIME() __builtin_amdgcn_s_memrealtime()
#endif
#ifdef PROBE_PRE
#define STAMP(k) do { if (tid0 == 0 && bx0 == PROBE_BLOCK) { volatile LAS unsigned long long* ts_ = (volatile LAS unsigned long long*)(lds + LDSCTL_OFF + 64); if ((k) == PROBE_SPAN) ts_[0] = PTIME(); } } while (0)
#define STAMP_PRE(k) do { if (tid0 == 0 && bx0 == PROBE_BLOCK) { volatile LAS unsigned long long* ts_ = (volatile LAS unsigned long long*)(lds + LDSCTL_OFF + 64); if ((k) == PROBE_SPAN + 1) ts_[1] += PTIME() - ts_[0]; } } while (0)
#else
#define STAMP(k) do { if (tid0 == 0 && bx0 == PROBE_BLOCK) { volatile LAS unsigned long long* ts_ = (volatile LAS unsigned long long*)(lds + LDSCTL_OFF + 64); const unsigned long long t_ = PTIME(); \
    if ((k) == PROBE_SPAN) ts_[0] = t_; if ((k) == PROBE_SPAN + 1) ts_[1] += t_ - ts_[0]; } } while (0)
#define STAMP_PRE(k) do { } while (0)
#endif
#else
#define STAMP(k) do { } while (0)
#define STAMP_PRE(k) do { } while (0)
#endif
template <int l> __device__ __forceinline__ void layer_body(const int tid0, const int G0, const int bx0, const ldsp lds, const XcdBarrier& bar) {
    STAMP(0);
#ifdef PROBE_IDLE
    { const unsigned long long t0_ = __builtin_amdgcn_s_memrealtime(); while (__builtin_amdgcn_s_memrealtime() - t0_ < (unsigned long long)(PROBE_IDLE) * 100ull) __builtin_amdgcn_s_sleep(32); }
#endif
    { PHASE_IDS(); cargs_t a = get_args(); unsigned char* ws = a->ws; unsigned char* wb = ws + WS_W + (size_t)(l & 1) * W_STRIDE;
      pg8::Gemm g{(bf16*)(ws + WS_XB), (bf16*)(wb + WO_WIN), M, IN_PAD, DM}; pg8::StaticOrder S; S.init(M, IN_PAD, G, bx);
      pg8::Unit u0_; const int pm0_ = S.next(0, u0_) ? u0_.pm : 0; fill_rtab((const float*)(ws + WS_XSS2), pm0_, lds, tid);
      pg8::EpiIn E{(const float*)(ws + WS_XSS2), (bf16*)(ws + WS_CQ), (bf16*)(ws + WS_CKV), (float*)(ws + WS_CQSS), (float*)(ws + WS_CKVSS), (bf16*)(ws + WS_K), (const float*)(ws + WS_C64), (const float*)(ws + WS_S64),
                   (bf16*)(ws + WS_RQ), (bf16*)(ws + WS_RK), (bf16*)(ws + WS_RV), (bf16*)(ws + WS_RG), (const float*)(ws + WS_C128), (const float*)(ws + WS_S128), (const LAS float*)(lds + RTAB_OFF), pm0_};
      pg8::gemm_phase<pg8::EpiIn, pg8::StaticOrder, PG_ALIGN, true>(lds + RING_OFF, g, S, E); }
    STAMP_PRE(1); XBAR(); STAMP(1);
    { PHASE_IDS(); cargs_t a = get_args(); unsigned char* ws = a->ws; unsigned char* wb = ws + WS_W + (size_t)(l & 1) * W_STRIDE;
      pg8::Gemm g{(bf16*)(ws + WS_CQ), (bf16*)(wb + WO_WUQ), M, 1536, QLORA}; pg8::StaticOrder S; S.init(M, 1536, G, bx);
      pg8::EpiQ E{(const float*)(ws + WS_CQSS), (bf16*)(ws + WS_Q), (const float*)(ws + WS_C64), (const float*)(ws + WS_S64), QSCALE};
      pg8::gemm_phase<pg8::EpiQ, pg8::StaticOrder, PG_ALIGN, true>(lds + RING_OFF, g, S, E); }
    __syncthreads();
    { PHASE_IDS(); cargs_t a = get_args(); unsigned char* ws = a->ws; unsigned char* wb = ws + WS_W + (size_t)(l & 1) * W_STRIDE;
      pg8::Gemm g{(bf16*)(ws + WS_CKV), (bf16*)(wb + WO_WUKV), M, 2048, KVLORA}; pg8::StaticOrder S; S.init(M, 2048, G, bx);
      pg8::EpiKV E{(const float*)(ws + WS_CKVSS), (bf16*)(ws + WS_K), (bf16*)(ws + WS_V)};
      pg8::gemm_phase<pg8::EpiKV, pg8::StaticOrder, PG_ALIGN, true>(lds + RING_OFF, g, S, E); }
    __syncthreads();
    { PHASE_IDS(); cargs_t a = get_args(); unsigned char* ws = a->ws;
      for (int u = vcu; u < 16 * NCH; u += G) ret_state_unit((const bf16*)(ws + WS_RK), (const bf16*)(ws + WS_RV), (float*)(ws + WS_U), u >> 6, u & 63, a->lg2g[(u >> 6) & 7], lds + RING_OFF, tid); }
    STAMP_PRE(2); XBAR(); STAMP(2);
    { PHASE_IDS(); cargs_t a = get_args(); unsigned char* ws = a->ws;
      for (int u = vcu; u < 256; u += G) { const int bh = u >> 4, x = u & 15;
        attn_unit((const bf16*)(ws + WS_Q), (const bf16*)(ws + WS_K), (const bf16*)(ws + WS_V), (bf16*)(ws + WS_MIX), bh >> 3, bh & 7, 31 - x, lds + RING_OFF, tid);
        attn_unit((const bf16*)(ws + WS_Q), (const bf16*)(ws + WS_K), (const bf16*)(ws + WS_V), (bf16*)(ws + WS_MIX), bh >> 3, bh & 7, x, lds + RING_OFF, tid); } }
    { PHASE_IDS(); cargs_t a = get_args(); unsigned char* ws = a->ws; ret_scan((const float*)(ws + WS_U), (bf16*)(ws + WS_S), a, GTID, NTHR); }
    if (l + 1 < DEPTH) { PHASE_IDS(); cargs_t a = get_args(); __syncthreads(); convert_weights<true>(a, l + 1, lds, GW, NGW, wave, lane, GTID, NTHR, (unsigned*)((gu32*)(a->ws + WS_CTL) + CW_WQ + l * 64)); }
    STAMP_PRE(3); XBAR(); STAMP(3);
    { PHASE_IDS(); cargs_t a = get_args(); unsigned char* ws = a->ws;
      for (int u = vcu; u < 16 * NCH; u += G) ret_out_unit((const bf16*)(ws + WS_RQ), (const bf16*)(ws + WS_RK), (const bf16*)(ws + WS_RV), (const bf16*)(ws + WS_RG), (const bf16*)(ws + WS_S), (bf16*)(ws + WS_MIX),
                                                          u >> 6, u & 63, a->lg2g[(u >> 6) & 7], lds + RING_OFF, tid); }
    { PHASE_IDS(); cargs_t a = get_args(); bf16* mix = (bf16*)(a->ws + WS_MIX);
      { int m = GW; for (; m + 3 * NGW < M; m += 4 * NGW) attn_norm_rows<4>(mix, m, NGW, lane); for (; m < M; m += NGW) attn_norm_rows<1>(mix, m, NGW, lane); } }
    STAMP_PRE(4); XBAR(); STAMP(4);
    { PHASE_IDS(); cargs_t a = get_args(); unsigned char* ws = a->ws; unsigned char* wb = ws + WS_W + (size_t)(l & 1) * W_STRIDE;
      pg8::Gemm g{(bf16*)(ws + WS_MIX), (bf16*)(wb + WO_WO), M, DM, DM}; pg8::StaticOrder S; S.init(M, DM, G, bx);
      typedef pg8::EpiResT<false, true> EpiR; EpiR E{(l == 0) ? a->x : (const float*)a->out, a->out, (bf16*)(ws + WS_XB), (float*)(ws + WS_XSS), nullptr, nullptr, -1};
      pg8::gemm_phase<EpiR, pg8::StaticOrder, PG_ALIGN, true>(lds + RING_OFF, g, S, E); }
    { PHASE_IDS(); cargs_t a = get_args(); pg8::StaticOrder S; S.init(M, DM, G, bx); panel_post((unsigned*)((gu32*)(a->ws + WS_CTL) + CW_PB + (l * 2 + 0) * 1024), S, (unsigned*)((gu32*)(a->ws + WS_CTL) + CW_PC), FF / 256, xb_xcc_id()); }
    STAMP_PRE(5); STAMP(5);
    { PHASE_IDS(); cargs_t a = get_args(); pg8::StaticOrder S; S.init(M, FF, G, bx);
      panel_wait((unsigned*)((gu32*)(a->ws + WS_CTL) + CW_PB + (l * 2 + 0) * 1024), S, DM / 256, (unsigned*)((gu32*)(a->ws + WS_CTL) + CW_BAR)); }
    { PHASE_IDS(); cargs_t a = get_args(); unsigned char* ws = a->ws; unsigned char* wb = ws + WS_W + (size_t)(l & 1) * W_STRIDE;
      pg8::Gemm g{(bf16*)(ws + WS_XB), (bf16*)(wb + WO_WUP), M, FF, DM}; pg8::StaticOrder S; S.init(M, FF, G, bx);
      pg8::EpiRelu2 E{(bf16*)(ws + WS_UF), FF};
      pg8::gemm_phase<pg8::EpiRelu2, pg8::StaticOrder, PG_ALIGN, true>(lds + RING_OFF, g, S, E); }
    { PHASE_IDS(); cargs_t a = get_args(); pg8::StaticOrder S; S.init(M, FF, G, bx); panel_post((unsigned*)((gu32*)(a->ws + WS_CTL) + CW_PB + (l * 2 + 1) * 1024), S, (unsigned*)((gu32*)(a->ws + WS_CTL) + CW_PC + 1024), DM / 256, xb_xcc_id()); }
    STAMP_PRE(6); STAMP(6);
    { PHASE_IDS(); cargs_t a = get_args(); pg8::StaticOrder S; S.init(M, DM, G, bx);
      panel_wait((unsigned*)((gu32*)(a->ws + WS_CTL) + CW_PB + (l * 2 + 1) * 1024), S, FF / 256, (unsigned*)((gu32*)(a->ws + WS_CTL) + CW_BAR)); }
    { PHASE_IDS(); cargs_t a = get_args(); unsigned char* ws = a->ws; unsigned char* wb = ws + WS_W + (size_t)(l & 1) * W_STRIDE;
      pg8::Gemm g{(bf16*)(ws + WS_UF), (bf16*)(wb + WO_WDN), M, DM, FF}; pg8::StaticOrder S; S.init(M, DM, G, bx);
      pg8::Unit u0_; const int pm0_ = S.next(0, u0_) ? u0_.pm : 0; fill_rtab((const float*)(ws + WS_XSS), pm0_, lds, tid);
      typedef pg8::EpiResT<true, (l + 1 < DEPTH)> EpiR; EpiR E{a->out, a->out, (bf16*)(ws + WS_XB), (float*)(ws + WS_XSS2), (const float*)(ws + WS_XSS), (const LAS float*)(lds + RTAB_OFF), pm0_};
      pg8::gemm_phase<EpiR, pg8::StaticOrder, PG_ALIGN, true>(lds + RING_OFF, g, S, E); }
    STAMP_PRE(7); XBAR(); STAMP(7);
}

__global__ void __launch_bounds__(NWAVES * 64, 2) fwd_kernel(Args args_in_kernarg) {
    extern __shared__ __attribute__((aligned(16))) unsigned char lds_raw[];
    const ldsp lds = (ldsp)lds_raw;
    volatile LAS unsigned* MISC = (volatile LAS unsigned*)(lds + MISC_OFF);
    const int tid0 = threadIdx.x; const int G0 = gridDim.x, bx0 = blockIdx.x;
    for (int u = tid0; u < (LDS_BYTES - LDSCTL_OFF) / 4; u += NWAVES * 64) ((LAS unsigned*)(lds + LDSCTL_OFF))[u] = 0u;
    __syncthreads();
    XcdBarrier bar;
    { PHASE_IDS(); cargs_t a = get_args(); bar = xcd_barrier_post((unsigned*)((gu32*)(a->ws + WS_CTL) + CW_BAR), MISC + 8); }
    { PHASE_IDS(); cargs_t a = get_args(); pg8::StaticOrder S; const unsigned xcc = xb_xcc_id();
      S.init(M, FF, G, bx); panel_census((unsigned*)((gu32*)(a->ws + WS_CTL) + CW_PC), S, xcc);
      S.init(M, DM, G, bx); panel_census((unsigned*)((gu32*)(a->ws + WS_CTL) + CW_PC + 1024), S, xcc); }
    { PHASE_IDS(); cargs_t a = get_args();
      rope_tables(a, GTID, NTHR);
      convert_weights<false>(a, 0, lds, GW, NGW, wave, lane, GTID, NTHR, nullptr);
      const float* x = a->x; bf16* XB = (bf16*)(a->ws + WS_XB); float* XSS = (float*)(a->ws + WS_XSS2);
      { int m = GW; for (; m + NGW < M; m += 2 * NGW) prep_rows<2>(x, XB, XSS, m, NGW, lane); for (; m < M; m += NGW) prep_rows<1>(x, XB, XSS, m, NGW, lane); } }
    XBAR();

    layer_body<0>(tid0, G0, bx0, lds, bar);
    layer_body<1>(tid0, G0, bx0, lds, bar);
    layer_body<2>(tid0, G0, bx0, lds, bar);
    layer_body<3>(tid0, G0, bx0, lds, bar);
    { PHASE_IDS(); cargs_t a = get_args(); float* xo = a->out; const float* g = a->final_norm; const float* XSS = (const float*)(a->ws + WS_XSS2);
      { int m = GW; for (; m + NGW < M; m += 2 * NGW) rms_rows_final<2>(xo, XSS, g, m, NGW, lane); for (; m < M; m += NGW) rms_rows_final<1>(xo, XSS, g, m, NGW, lane); } }
#if defined(PROBE_ATT) || defined(PROBE_R3)
    if (tid0 == 0 && bx0 == 0) { volatile LAS unsigned long long* q_ = (volatile LAS unsigned long long*)(lds + LDSCTL_OFF + 80); const unsigned long long T_ = q_[0] / 3ull, t0_ = __builtin_amdgcn_s_memrealtime();
        while (__builtin_amdgcn_s_memrealtime() - t0_ < T_) __builtin_amdgcn_s_sleep(8); }
#endif
#ifdef PROBE_SPAN
    if (tid0 == 0 && bx0 == PROBE_BLOCK) { volatile LAS unsigned long long* ts_ = (volatile LAS unsigned long long*)(lds + LDSCTL_OFF + 64);
#ifdef PROBE_CLK
        const unsigned long long T_ = ts_[1] / 3ull,
#else
        const unsigned long long T_ = ts_[1] * 8ull,
#endif
        t0_ = __builtin_amdgcn_s_memrealtime();
        while (__builtin_amdgcn_s_memrealtime() - t0_ < T_) __builtin_amdgcn_s_sleep(8); }
#endif
}

extern "C" void kernel_launch(void* const* d_in, const int* in_sizes, int n_in, void* d_out, int out_size, void* d_ws, size_t ws_size, hipStream_t stream) {
    static int grid = 0;
    if (grid == 0) {
        if (n_in != 15 || in_sizes[0] != M * DM || out_size != M * DM || ws_size < WS_END) { fprintf(stderr, "kernel_launch: unexpected shapes (n_in %d, in0 %d, out %d, ws %zu, need %zu); nothing launched\n", n_in, n_in > 0 ? in_sizes[0] : -1, out_size, ws_size, (size_t)WS_END); grid = -1; return; }
        int dev = 0, cus = 0, per_cu = 0;
        if (hipGetDevice(&dev) != hipSuccess || hipDeviceGetAttribute(&cus, hipDeviceAttributeMultiprocessorCount, dev) != hipSuccess) { fprintf(stderr, "kernel_launch: device query failed\n"); grid = -1; return; }
        if (hipFuncSetAttribute((const void*)fwd_kernel, hipFuncAttributeMaxDynamicSharedMemorySize, LDS_BYTES) != hipSuccess) { fprintf(stderr, "kernel_launch: hipFuncSetAttribute failed\n"); grid = -1; return; }
        if (hipOccupancyMaxActiveBlocksPerMultiprocessor(&per_cu, (const void*)fwd_kernel, NWAVES * 64, LDS_BYTES) != hipSuccess || per_cu < 1)
            fprintf(stderr, "kernel_launch: note: occupancy query reports %d workgroups per CU\n", per_cu);
        (void)hipGetLastError();
        grid = cus;
    }
    if (grid < 0) return;
    if (hipMemsetAsync((char*)d_ws + WS_CTL, 0, CTL_ZERO_BYTES, stream) != hipSuccess) { fprintf(stderr, "kernel_launch: hipMemsetAsync failed\n"); return; }
    Args a{};
    a.x = (const float*)d_in[0]; a.pos = (const int*)d_in[1]; a.attn_norm = (const float*)d_in[2]; a.w_in = (const float*)d_in[3]; a.q_norm = (const float*)d_in[4]; a.kv_norm = (const float*)d_in[5];
    a.w_uq = (const float*)d_in[6]; a.w_ukv = (const float*)d_in[7]; a.beta_attn = (const float*)d_in[8]; a.beta_ret = (const float*)d_in[9]; a.w_o = (const float*)d_in[10]; a.mlp_norm = (const float*)d_in[11];
    a.w_up = (const float*)d_in[12]; a.w_down = (const float*)d_in[13]; a.final_norm = (const float*)d_in[14];
    a.out = (float*)d_out; a.ws = (unsigned char*)d_ws;
    for (int j = 0; j < 32; ++j) a.invf64[j] = pow(10000.0, -(double)(2 * j) / 64.0);
    for (int j = 0; j < 64; ++j) a.invf128[j] = pow(10000.0, -(double)(2 * j) / 128.0);
    for (int h = 0; h < 8; ++h) a.lg2g[h] = (float)(log1p(-exp2(-5.0 - (double)h)) / log(2.0));
    hipLaunchKernelGGL(fwd_kernel, dim3(grid), dim3(NWAVES * 64), LDS_BYTES, stream, a);
    const hipError_t le = hipPeekAtLastError();
    if (le != hipSuccess) fprintf(stderr, "kernel_launch: launch failed: %s\n", hipGetErrorName(le));
}
```

```cpp
#include <hip/hip_runtime.h>
#include <cstdio>
#include <cstdint>
#include <cmath>
namespace pg8 {
#define PG8_LAS __attribute__((address_space(3)))
typedef unsigned short bf16_t;
typedef short bf16x8 __attribute__((ext_vector_type(8)));
typedef float f32x4 __attribute__((ext_vector_type(4)));
typedef unsigned u32x4 __attribute__((ext_vector_type(4)));
constexpr int BM = 256, BK = 64, HALF = 128, HTB = HALF * BK * 2  , STAGE_BYTES = 8 * HTB, NXCD = 8, WGM = 8;

__host__ __device__ __forceinline__ int lds_byte(int r, int c) { const int st = (r >> 4) * 2 + (c >> 5), rr = r & 15, cc = c & 31, ob = rr * 64 + cc * 2; return st * 1024 + (ob ^ (((ob >> 9) & 1) << 5)); }
__host__ __device__ __forceinline__ void stage_rc(int b, int& R, int& C) { const int st = b / 1024, sb = b % 1024, swz = sb ^ (((sb >> 9) & 1) << 5); R = (st >> 1) * 16 + swz / 64; C = (st & 1) * 32 + (swz % 64) / 2; }
__host__ __device__ __forceinline__ int perm32(int rho) { const int n = rho >> 4, i = rho & 15; return 8 * (i >> 2) + 4 * n + (i & 3); }

struct Unit { int pm, pn; };
struct Gemm { const bf16_t* A; const bf16_t* Bt; int M, N, K; };

struct StaticOrder {
    int nM, nN, nwg, G, c;
    __host__ __device__ void init(int M, int N, int G_, int c_) { nM = M / BM; nN = N / BM; nwg = nM * nN; G = G_; c = c_; }
    __host__ __device__ bool next(int i, Unit& u) const {
        const long L = (long)i * G + c; if (L >= nwg) return false;
        int wgid = (int)L; { const int q = nwg / NXCD, r = nwg % NXCD, xcd = wgid % NXCD, off = wgid / NXCD; wgid = (xcd < r ? xcd * (q + 1) : r * (q + 1) + (xcd - r) * q) + off; }
        const int nig = WGM * nN, gid = wgid / nig, fm = gid * WGM, gsz = (nM - fm) < WGM ? (nM - fm) : WGM;
        u.pm = fm + ((wgid % nig) % gsz); u.pn = (wgid % nig) / gsz; return true;
    }
    __device__ __forceinline__ void a_ready(const Unit&) const {}
    __device__ __forceinline__ void done(const Unit&) const {}
    __device__ __forceinline__ void align() const {}
};

__device__ __forceinline__ unsigned cvt_pk_bf16(float lo, float hi) { unsigned r; asm volatile("v_cvt_pk_bf16_f32 %0, %1, %2" : "=v"(r) : "v"(lo), "v"(hi)); return r; }
typedef float f32x2 __attribute__((ext_vector_type(2)));
__device__ __forceinline__ f32x2 gelu_pk(f32x2 v) {
    const f32x2 av = __builtin_elementwise_abs(v), d = av * 0.2316418882f + 1.0f;
    f32x2 t; t.x = __builtin_amdgcn_rcpf(d.x); t.y = __builtin_amdgcn_rcpf(d.y);
    f32x2 q = t * 0.5307027145f + (-0.7265760135f); q = q * t + 0.7107068705f; q = q * t + (-0.142248368f); q = q * t + 0.127414796f; q = q * t;
    const f32x2 s = (v * v) * (-0.72134752044f);
    f32x2 e; e.x = __builtin_amdgcn_exp2f(s.x); e.y = __builtin_amdgcn_exp2f(s.y);
    const f32x2 m = v * (q * e), r = v - m;
    f32x2 o; o.x = v.x < 0.f ? m.x : r.x; o.y = v.y < 0.f ? m.y : r.y; return o;
}

template <int ACT  > struct EpiBf16 {
    static constexpr bool PERM = true, AFTER_DRAIN = false; static_assert(ACT == 0 || ACT == 1, "EpiBf16: ACT is 0 (none) or 1 (gelu_pk)");
    bf16_t* O; int ldc; const float* bias; int split_cols; size_t split_stride; float scale0;
    __device__ __forceinline__ void operator()(const f32x4 (&acc)[2][2][4][2], const Unit& u, int wr, int wc, int fr, int fq) const {
        const int row0 = u.pm * BM + wr * 64 + fr; int colt = u.pn * BM; bf16_t* base = O;
        float sc = 1.f; if (split_cols) { const int t = colt / split_cols; base += (size_t)t * split_stride; colt -= t * split_cols; if (t == 0) sc = scale0; }
        const int col0 = colt + wc * 32 + 8 * fq, bcol0 = u.pn * BM + wc * 32 + 8 * fq;
        f32x4 bv[2][2];
#pragma unroll
        for (int bj = 0; bj < 2; ++bj)
#pragma unroll
            for (int n = 0; n < 2; ++n) bv[bj][n] = bias ? *(const f32x4*)(bias + bcol0 + bj * HALF + 4 * n) : (f32x4){0.f, 0.f, 0.f, 0.f};
#pragma unroll
        for (int ai = 0; ai < 2; ++ai)
#pragma unroll
            for (int m = 0; m < 4; ++m) { bf16_t* rowp = base + (size_t)(row0 + ai * HALF + m * 16) * ldc + col0;
#pragma unroll
                for (int bj = 0; bj < 2; ++bj) { f32x4 v0 = acc[ai][bj][m][0] + bv[bj][0], v1 = acc[ai][bj][m][1] + bv[bj][1];
                    if (ACT == 1) { f32x2 a = gelu_pk((f32x2){v0[0], v0[1]}), b = gelu_pk((f32x2){v0[2], v0[3]}), c = gelu_pk((f32x2){v1[0], v1[1]}), d = gelu_pk((f32x2){v1[2], v1[3]});
                        v0 = (f32x4){a.x, a.y, b.x, b.y}; v1 = (f32x4){c.x, c.y, d.x, d.y}; }
                    v0 = v0 * sc; v1 = v1 * sc; u32x4 w; w.x = cvt_pk_bf16(v0[0], v0[1]); w.y = cvt_pk_bf16(v0[2], v0[3]); w.z = cvt_pk_bf16(v1[0], v1[1]); w.w = cvt_pk_bf16(v1[2], v1[3]);
                    *(u32x4*)(rowp + bj * HALF) = w; } }
    }
};

struct PanelStats {
    unsigned* xbuf;
    unsigned* cnt;
    unsigned* tmo;
    int ntn; float eps;
    unsigned code;
    __device__ __forceinline__ bool run(const f32x4 (&v)[2][2][4][2], const Unit& u, int wr, int wc, int fr, int fq, PG8_LAS unsigned char* lds, int wid, int lane) const {
        typedef float f32x2v __attribute__((ext_vector_type(2)));
        PG8_LAS f32x2v* P = (PG8_LAS f32x2v*)lds;
        PG8_LAS f32x2v* S = (PG8_LAS f32x2v*)(lds + 8192);
        PG8_LAS unsigned* flag = (PG8_LAS unsigned*)(lds + 8192 + 2048);
#pragma unroll
        for (int ai = 0; ai < 2; ++ai)
#pragma unroll
            for (int m = 0; m < 4; ++m) {
                float s = 0.f;
#pragma unroll
                for (int bj = 0; bj < 2; ++bj)
#pragma unroll
                    for (int n = 0; n < 2; ++n) { const f32x4 x = v[ai][bj][m][n]; s += (x[0] + x[1]) + (x[2] + x[3]); }
                s += __shfl_xor(s, 16); s += __shfl_xor(s, 32);
                const float mw = s * (1.0f / 64.0f); float q = 0.f;
#pragma unroll
                for (int bj = 0; bj < 2; ++bj)
#pragma unroll
                    for (int n = 0; n < 2; ++n) { const f32x4 d = v[ai][bj][m][n] - mw; q += (d[0] * d[0] + d[1] * d[1]) + (d[2] * d[2] + d[3] * d[3]); }
                q += __shfl_xor(q, 16); q += __shfl_xor(q, 32);
                if (fq == 0) P[(ai * HALF + wr * 64 + m * 16 + fr) * 4 + wc] = (f32x2v){mw, q};
            }
        asm volatile("s_waitcnt lgkmcnt(0)" ::: "memory"); __builtin_amdgcn_s_barrier(); asm volatile("" ::: "memory");
#if defined(BROKEN_EXCHANGE_NO_WAIT)
#warning BROKEN CONTROL BUILD: the row-statistics exchange does not wait; results are wrong by design
        if (blockIdx.x >= 64) { const long long t0_ = clock64(); while (clock64() - t0_ < 60000) __builtin_amdgcn_s_sleep(8); }
#endif
        const int row = wid * 32 + (lane & 31);
        if (lane < 32) {
            const f32x2v a = P[row * 4 + 0], b = P[row * 4 + 1], c = P[row * 4 + 2], d = P[row * 4 + 3];
            const float mt = (a.x + b.x + c.x + d.x) * 0.25f;
            const float da = a.x - mt, db = b.x - mt, dc = c.x - mt, dd = d.x - mt;
            const float m2 = (a.y + b.y) + (c.y + d.y) + 64.0f * ((da * da + db * db) + (dc * dc + dd * dd));
            unsigned long long* slot = (unsigned long long*)xbuf + ((size_t)(u.pm * BM + row) * 4 + u.pn);
            __hip_atomic_store(slot, ((unsigned long long)__float_as_uint(m2) << 32) | __float_as_uint(mt), __ATOMIC_RELAXED, __HIP_MEMORY_SCOPE_AGENT);
        }
        asm volatile("s_waitcnt vmcnt(0)" ::: "memory");
        if (lane == 0) __hip_atomic_fetch_add(cnt + 64 * u.pm, 1u, __ATOMIC_RELAXED, __HIP_MEMORY_SCOPE_AGENT);
        if (wid == 0) {
            bool dead = false; const unsigned long long t0 = __builtin_amdgcn_s_memrealtime(); const unsigned want = 8u * (unsigned)ntn;
            for (;;) {
#if defined(BROKEN_EXCHANGE_NO_WAIT)
                break;
#endif
                if ((unsigned)__builtin_amdgcn_readfirstlane(__hip_atomic_load(cnt + 64 * u.pm, __ATOMIC_RELAXED, __HIP_MEMORY_SCOPE_AGENT)) >= want) break;
                if (__builtin_amdgcn_s_memrealtime() - t0 > 2000000ull) {
                    if (lane == 0) { unsigned expect = 0u; __hip_atomic_compare_exchange_strong(tmo + 1, &expect, code | (unsigned)(u.pm & 0xff), __ATOMIC_RELAXED, __ATOMIC_RELAXED, __HIP_MEMORY_SCOPE_AGENT);
                                     __hip_atomic_store(tmo, 1u, __ATOMIC_RELAXED, __HIP_MEMORY_SCOPE_AGENT); }
                    dead = true; break; }
                __builtin_amdgcn_s_sleep(2);
            }
            __builtin_amdgcn_fence(__ATOMIC_ACQUIRE, "agent");
            if (lane == 0) flag[0] = dead ? 1u : 0u;
        }
        asm volatile("s_waitcnt vmcnt(0) lgkmcnt(0)" ::: "memory"); __builtin_amdgcn_s_barrier(); asm volatile("" ::: "memory");
        const bool bad = flag[0] != 0u;
        if (lane < 32) {
            const unsigned long long* slot = (const unsigned long long*)xbuf + (size_t)(u.pm * BM + row) * 4; float mt[4], m2[4]; float ms = 0.f;
#pragma unroll
            for (int t = 0; t < 4; ++t) { if (t < ntn) { const unsigned long long w = __hip_atomic_load(slot + t, __ATOMIC_RELAXED, __HIP_MEMORY_SCOPE_AGENT); mt[t] = __uint_as_float((unsigned)w); m2[t] = __uint_as_float((unsigned)(w >> 32)); } else { mt[t] = 0.f; m2[t] = 0.f; } ms += mt[t]; }
            const float mean = ms / (float)ntn; float q = 0.f;
#pragma unroll
            for (int t = 0; t < 4; ++t) if (t < ntn) { const float dm = mt[t] - mean; q += m2[t] + 256.0f * dm * dm; }
            S[row] = (f32x2v){mean, 1.0f / sqrtf(q / (256.0f * (float)ntn) + eps)};
        }
        asm volatile("s_waitcnt lgkmcnt(0)" ::: "memory"); __builtin_amdgcn_s_barrier(); asm volatile("" ::: "memory");
        return bad;
    }
};
struct EpiLnRes {
    static constexpr bool PERM = false, AFTER_DRAIN = true;
    const float* base; float* out; int ldc; const float* bias; PanelStats st; unsigned poison;
    __device__ __forceinline__ void fused(f32x4 (&acc)[2][2][4][2], const Unit& u, int wr, int wc, int fr, int fq, PG8_LAS unsigned char* lds, int wid, int lane) const {
        typedef float f32x2v __attribute__((ext_vector_type(2)));
        const PG8_LAS f32x2v* S = (const PG8_LAS f32x2v*)(lds + 8192);
        const int col0 = u.pn * BM + wc * 32 + 4 * fq;
#pragma unroll
        for (int bj = 0; bj < 2; ++bj)
#pragma unroll
            for (int n = 0; n < 2; ++n) { const f32x4 bv = bias ? *(const f32x4*)(bias + col0 + bj * HALF + n * 16) : (f32x4){0.f, 0.f, 0.f, 0.f};
#pragma unroll
                for (int ai = 0; ai < 2; ++ai)
#pragma unroll
                    for (int m = 0; m < 4; ++m) acc[ai][bj][m][n] += bv; }
        f32x4 pre[4][2][2];
#pragma unroll
        for (int m = 0; m < 4; ++m) { const size_t off = (size_t)(u.pm * BM + wr * 64 + m * 16 + fr) * ldc + col0;
#pragma unroll
            for (int bj = 0; bj < 2; ++bj)
#pragma unroll
                for (int n = 0; n < 2; ++n) pre[m][bj][n] = *(const f32x4*)(base + off + bj * HALF + n * 16); }
        const bool bad = st.run(acc, u, wr, wc, fr, fq, lds, wid, lane) || poison != 0u;
        const float qnan = __builtin_nanf("");
#pragma unroll
        for (int ai = 0; ai < 2; ++ai)
#pragma unroll
            for (int m = 0; m < 4; ++m) { const int r = ai * HALF + wr * 64 + m * 16 + fr; const f32x2v sr = S[r]; const size_t off = (size_t)(u.pm * BM + r) * ldc + col0;
#pragma unroll
                for (int bj = 0; bj < 2; ++bj)
#pragma unroll
                    for (int n = 0; n < 2; ++n) { const f32x4 bs = ai == 0 ? pre[m][bj][n] : *(const f32x4*)(base + off + bj * HALF + n * 16); f32x4 o = bs + (acc[ai][bj][m][n] - sr.x) * sr.y;
                        if (bad) o = (f32x4){qnan, qnan, qnan, qnan}; *(f32x4*)(out + off + bj * HALF + n * 16) = o; }
                if (m & 1) asm volatile("" ::: "memory"); }
    }
};
struct EpiLnResLn {
    static constexpr bool PERM = false, AFTER_DRAIN = true;
    const float* base; float* out; bf16_t* xn; int ldc; const float* bias; PanelStats st1, st2; unsigned poison;
    __device__ __forceinline__ void fused(f32x4 (&acc)[2][2][4][2], const Unit& u, int wr, int wc, int fr, int fq, PG8_LAS unsigned char* lds, int wid, int lane) const {
        typedef float f32x2v __attribute__((ext_vector_type(2))); typedef unsigned u32x2v __attribute__((ext_vector_type(2)));
        const PG8_LAS f32x2v* S = (const PG8_LAS f32x2v*)(lds + 8192);
        const int col0 = u.pn * BM + wc * 32 + 4 * fq;
#pragma unroll
        for (int bj = 0; bj < 2; ++bj)
#pragma unroll
            for (int n = 0; n < 2; ++n) { const f32x4 bv = bias ? *(const f32x4*)(bias + col0 + bj * HALF + n * 16) : (f32x4){0.f, 0.f, 0.f, 0.f};
#pragma unroll
                for (int ai = 0; ai < 2; ++ai)
#pragma unroll
                    for (int m = 0; m < 4; ++m) acc[ai][bj][m][n] += bv; }
        bool bad = st1.run(acc, u, wr, wc, fr, fq, lds, wid, lane) || poison != 0u;
        const float qnan = __builtin_nanf("");
#pragma unroll
        for (int ai = 0; ai < 2; ++ai)
#pragma unroll
            for (int m = 0; m < 4; ++m) { const int r = ai * HALF + wr * 64 + m * 16 + fr; const f32x2v sr = S[r]; const size_t off = (size_t)(u.pm * BM + r) * ldc + col0;
#pragma unroll
                for (int bj = 0; bj < 2; ++bj)
#pragma unroll
                    for (int n = 0; n < 2; ++n) { const f32x4 bs = *(const f32x4*)(base + off + bj * HALF + n * 16); acc[ai][bj][m][n] = bs + (acc[ai][bj][m][n] - sr.x) * sr.y; }
                asm volatile("" : "+v"(acc[ai][0][m][0]), "+v"(acc[ai][0][m][1]), "+v"(acc[ai][1][m][0]), "+v"(acc[ai][1][m][1]));
                if (m & 1) asm volatile("" ::: "memory"); }
        const bool bad1 = bad;
        bad = st2.run(acc, u, wr, wc, fr, fq, lds, wid, lane) || bad;
#pragma unroll
        for (int ai = 0; ai < 2; ++ai)
#pragma unroll
            for (int m = 0; m < 4; ++m) { const int r = ai * HALF + wr * 64 + m * 16 + fr; const f32x2v sr = S[r]; const size_t off = (size_t)(u.pm * BM + r) * ldc + col0;
#pragma unroll
                for (int bj = 0; bj < 2; ++bj)
#pragma unroll
                    for (int n = 0; n < 2; ++n) { const f32x4 x1 = acc[ai][bj][m][n]; *(f32x4*)(out + off + bj * HALF + n * 16) = bad1 ? (f32x4){qnan, qnan, qnan, qnan} : x1;
                        const f32x4 o = (x1 - sr.x) * sr.y; u32x2v w; w.x = cvt_pk_bf16(o[0], o[1]); w.y = cvt_pk_bf16(o[2], o[3]);
                        if (bad) { w.x = 0x7fc07fc0u; w.y = 0x7fc07fc0u; } *(u32x2v*)(xn + off + bj * HALF + n * 16) = w; }
                asm volatile("" ::: "memory"); }
    }
};

template <class Epi, class Sched, bool ALIGN_EPI = false, bool SP2 = false>
__device__ __forceinline__ void gemm_phase(PG8_LAS unsigned char* lds, const Gemm g, const Sched& S, const Epi& E) {
    int tid_l = threadIdx.x; asm volatile("" : "+v"(tid_l));
    const int tid = tid_l, wid = __builtin_amdgcn_readfirstlane(tid >> 6), lane = tid & 63, wr = wid >> 2, wc = wid & 3, fr = lane & 15, fq = lane >> 4;
    const int K = g.K, nt = K / BK;
    unsigned voffA[2], voffB[2];
#pragma unroll
    for (int i = 0; i < 2; ++i) { int R, C; stage_rc(tid * 16 + i * 8192, R, C); const int Rb = Epi::PERM ? ((R & ~31) + perm32(R & 31)) : R;
        voffA[i] = (unsigned)(R * K + C) * 2u; voffB[i] = (unsigned)(Rb * K + C) * 2u; }
    const size_t kstep = (size_t)(BK * 2);
    const size_t hstep = (size_t)HALF * K * 2;
    const size_t tstep = 2 * hstep;
    const unsigned ldsw = (unsigned)wid * 1024u;
    const int aoff = lds_byte(wr * 64 + fr, fq * 8), boff = lds_byte(wc * 32 + fr, fq * 8);
#define PG8_SA(b, h) (((b) * 2 + (h)) * HTB)
#define PG8_SB(b, h) ((4 + (b) * 2 + (h)) * HTB)
#define PG8_STAGE(bufoff, gbase, voff) do { _Pragma("unroll") for (int _i = 0; _i < 2; ++_i) \
        __builtin_amdgcn_global_load_lds((const unsigned*)((const char*)(gbase) + (voff)[_i]), (PG8_LAS unsigned*)(lds + (bufoff) + ldsw + _i * 8192), 16, 0, 0); } while (0)
#define PG8_LDA(dst, b, h) do { _Pragma("unroll") for (int m = 0; m < 4; ++m) _Pragma("unroll") for (int k = 0; k < 2; ++k) dst[m][k] = *(const PG8_LAS bf16x8*)(lds + PG8_SA(b, h) + aoff + m * 2048 + k * 1024); } while (0)
#define PG8_LDB(dst, b, h) do { _Pragma("unroll") for (int n = 0; n < 2; ++n) _Pragma("unroll") for (int k = 0; k < 2; ++k) dst[n][k] = *(const PG8_LAS bf16x8*)(lds + PG8_SB(b, h) + boff + n * 2048 + k * 1024); } while (0)
#define PG8_MMA(ai, bj, At, Bt) do { __builtin_amdgcn_s_setprio(1); _Pragma("unroll") for (int m = 0; m < 4; ++m) _Pragma("unroll") for (int n = 0; n < 2; ++n) _Pragma("unroll") for (int k = 0; k < 2; ++k) \
        acc[ai][bj][m][n] = __builtin_amdgcn_mfma_f32_16x16x32_bf16(Bt[n][k], At[m][k], acc[ai][bj][m][n], 0, 0, 0); __builtin_amdgcn_s_setprio(0); } while (0)
#define PG8_WAIT_V(n) asm volatile("s_waitcnt vmcnt(" #n ")" ::: "memory")
#define PG8_WAIT_L(n) asm volatile("s_waitcnt lgkmcnt(" #n ")" ::: "memory")
#define PG8_BAR __builtin_amdgcn_s_barrier()
#define PG8_SCHED __builtin_amdgcn_sched_barrier(0)
    Unit cur, nxt; int ui = 0;
    if (!S.next(0, cur)) return;
    f32x4 acc[2][2][4][2];
#pragma unroll
    for (int a = 0; a < 2; ++a)
#pragma unroll
        for (int b = 0; b < 2; ++b)
#pragma unroll
            for (int m = 0; m < 4; ++m)
#pragma unroll
                for (int n = 0; n < 2; ++n) acc[a][b][m][n] = (f32x4){0.f, 0.f, 0.f, 0.f};
    bf16x8 At[4][2], B0[2][2], B1[2][2];
    const char* cA = (const char*)g.A + (size_t)cur.pm * tstep; const char* cB = (const char*)g.Bt + (size_t)cur.pn * tstep;
    S.a_ready(cur);
    if constexpr (SP2) {
        PG8_STAGE(PG8_SB(0, 0), cB, voffB); PG8_STAGE(PG8_SB(0, 1), cB + hstep, voffB); PG8_STAGE(PG8_SA(0, 0), cA, voffA); PG8_STAGE(PG8_SA(0, 1), cA + hstep, voffA);
        if (wr == 1) PG8_BAR;
        PG8_WAIT_V(2); PG8_BAR;
        PG8_STAGE(PG8_SB(1, 0), cB + kstep, voffB); PG8_STAGE(PG8_SA(1, 0), cA + kstep, voffA); PG8_STAGE(PG8_SB(1, 1), cB + hstep + kstep, voffB);
        PG8_WAIT_V(6); PG8_BAR;
    } else {
        PG8_STAGE(PG8_SB(0, 0), cB, voffB); PG8_STAGE(PG8_SA(0, 0), cA, voffA); PG8_STAGE(PG8_SB(0, 1), cB + hstep, voffB); PG8_STAGE(PG8_SA(0, 1), cA + hstep, voffA);
        if (wr == 1) PG8_BAR;
        PG8_WAIT_V(4); PG8_BAR;
        PG8_STAGE(PG8_SB(1, 0), cB + kstep, voffB); PG8_STAGE(PG8_SA(1, 0), cA + kstep, voffA); PG8_STAGE(PG8_SB(1, 1), cB + hstep + kstep, voffB);
        PG8_WAIT_V(6); PG8_BAR;
    }
    for (;;) {
        const bool has_next = S.next(ui + 1, nxt);
        const char* nA = has_next ? (const char*)g.A + (size_t)nxt.pm * tstep : cA; const char* nB = has_next ? (const char*)g.Bt + (size_t)nxt.pn * tstep : cB;
        for (int t = 0; t < nt; t += 2) {
            const bool last = (t == nt - 2);
            const char* a1 = cA + (size_t)(t + 1) * kstep;
            const char* a2 = last ? nA : cA + (size_t)(t + 2) * kstep; const char* b2 = last ? nB : cB + (size_t)(t + 2) * kstep;
            const char* a3 = a2 + kstep; const char* b3 = b2 + kstep;
            if (last && has_next) S.a_ready(nxt);
            if constexpr (SP2) {
            PG8_LDB(B0, 0, 0); PG8_LDB(B1, 0, 1); PG8_SCHED; PG8_LDA(At, 0, 0); PG8_STAGE(PG8_SA(1, 1), a1 + hstep, voffA);
            PG8_WAIT_V(8); PG8_WAIT_L(0); PG8_BAR; PG8_MMA(0, 0, At, B0); PG8_MMA(0, 1, At, B1); PG8_BAR; PG8_SCHED;
            PG8_LDA(At, 0, 1); PG8_STAGE(PG8_SB(0, 0), b2, voffB); PG8_STAGE(PG8_SB(0, 1), b2 + hstep, voffB); PG8_STAGE(PG8_SA(0, 0), a2, voffA);
            PG8_WAIT_V(8); PG8_WAIT_L(0); PG8_BAR; PG8_MMA(1, 0, At, B0); PG8_MMA(1, 1, At, B1); PG8_BAR; PG8_SCHED;
            PG8_LDB(B0, 1, 0); PG8_LDB(B1, 1, 1); PG8_SCHED; PG8_LDA(At, 1, 0); PG8_STAGE(PG8_SA(0, 1), a2 + hstep, voffA);
            PG8_WAIT_V(8); PG8_WAIT_L(0); PG8_BAR; PG8_MMA(0, 0, At, B0); PG8_MMA(0, 1, At, B1); PG8_BAR; PG8_SCHED;
            PG8_LDA(At, 1, 1); PG8_STAGE(PG8_SB(1, 0), b3, voffB); PG8_STAGE(PG8_SB(1, 1), b3 + hstep, voffB); PG8_STAGE(PG8_SA(1, 0), a3, voffA);
            PG8_WAIT_V(8); PG8_WAIT_L(0); PG8_BAR; PG8_MMA(1, 0, At, B0); PG8_MMA(1, 1, At, B1); PG8_BAR; PG8_SCHED;
            } else {
            PG8_LDB(B0, 0, 0); PG8_SCHED; PG8_LDA(At, 0, 0); PG8_STAGE(PG8_SA(1, 1), a1 + hstep, voffA);
            PG8_WAIT_L(8); PG8_BAR; PG8_WAIT_L(0); PG8_MMA(0, 0, At, B0); PG8_BAR; PG8_SCHED;
            PG8_LDB(B1, 0, 1); PG8_STAGE(PG8_SB(0, 0), b2, voffB);
            PG8_BAR; PG8_WAIT_L(0); PG8_MMA(0, 1, At, B1); PG8_BAR;
            PG8_LDA(At, 0, 1); PG8_STAGE(PG8_SA(0, 0), a2, voffA);
            PG8_BAR; PG8_WAIT_L(0); PG8_MMA(1, 0, At, B0); PG8_BAR; PG8_SCHED;
            PG8_STAGE(PG8_SB(0, 1), b2 + hstep, voffB);
            PG8_WAIT_V(6); PG8_BAR; PG8_MMA(1, 1, At, B1); PG8_BAR;
            PG8_LDB(B0, 1, 0); PG8_SCHED; PG8_LDA(At, 1, 0); PG8_STAGE(PG8_SA(0, 1), a2 + hstep, voffA);
            PG8_WAIT_L(8); PG8_BAR; PG8_WAIT_L(0); PG8_MMA(0, 0, At, B0); PG8_BAR; PG8_SCHED;
            PG8_LDB(B1, 1, 1); PG8_STAGE(PG8_SB(1, 0), b3, voffB);
            PG8_BAR; PG8_WAIT_L(0); PG8_MMA(0, 1, At, B1); PG8_BAR;
            PG8_LDA(At, 1, 1); PG8_STAGE(PG8_SA(1, 0), a3, voffA);
            PG8_BAR; PG8_WAIT_L(0); PG8_MMA(1, 0, At, B0); PG8_BAR; PG8_SCHED;
            PG8_STAGE(PG8_SB(1, 1), b3 + hstep, voffB);
            PG8_WAIT_V(6); PG8_BAR; PG8_MMA(1, 1, At, B1); PG8_BAR;
            }
        }
        if constexpr (ALIGN_EPI) { if (wr == 0) PG8_BAR; }
        if constexpr (!Epi::AFTER_DRAIN) { E(acc, cur, wr, wc, fr, fq); S.done(cur); }
        if (!has_next) break;
        S.align();
#pragma unroll
        for (int a = 0; a < 2; ++a)
#pragma unroll
            for (int b = 0; b < 2; ++b)
#pragma unroll
                for (int m = 0; m < 4; ++m)
#pragma unroll
                    for (int n = 0; n < 2; ++n) acc[a][b][m][n] = (f32x4){0.f, 0.f, 0.f, 0.f};
        cur = nxt; cA = nA; cB = nB; ++ui;
        if constexpr (ALIGN_EPI) { if (wr == 1) PG8_BAR; }
    }
    PG8_WAIT_V(0);
    if constexpr (!ALIGN_EPI) { if (wr == 0) PG8_BAR; }
    PG8_BAR;
    if constexpr (Epi::AFTER_DRAIN) { E.fused(acc, cur, wr, wc, fr, fq, lds, wid, lane); S.done(cur); }
#undef PG8_SA
#undef PG8_SB
#undef PG8_STAGE
#undef PG8_LDA
#undef PG8_LDB
#undef PG8_MMA
#undef PG8_WAIT_V
#undef PG8_WAIT_L
#undef PG8_BAR
#undef PG8_SCHED
}
}
namespace pg8 {
__device__ __forceinline__ u32x4 pack8bf(const f32x4 a, const f32x4 b) { u32x4 w; w.x = cvt_pk_bf16(a[0], a[1]); w.y = cvt_pk_bf16(a[2], a[3]); w.z = cvt_pk_bf16(b[0], b[1]); w.w = cvt_pk_bf16(b[2], b[3]); return w; }
__device__ __forceinline__ void rope8(f32x4& v0, f32x4& v1, const f32x4 cs, const f32x4 sn) {
    float a, b;
    a = v0[0]; b = v0[1]; v0[0] = a * cs[0] - b * sn[0]; v0[1] = b * cs[0] + a * sn[0];
    a = v0[2]; b = v0[3]; v0[2] = a * cs[1] - b * sn[1]; v0[3] = b * cs[1] + a * sn[1];
    a = v1[0]; b = v1[1]; v1[0] = a * cs[2] - b * sn[2]; v1[1] = b * cs[2] + a * sn[2];
    a = v1[2]; b = v1[3]; v1[2] = a * cs[3] - b * sn[3]; v1[3] = b * cs[3] + a * sn[3];
}
__device__ __forceinline__ float silu_f(float x) { return x * __builtin_amdgcn_rcpf(1.0f + __builtin_amdgcn_exp2f(-1.4426950408889634f * x)); }
__device__ __forceinline__ float sq4(const f32x4 v) { return (v[0] * v[0] + v[1] * v[1]) + (v[2] * v[2] + v[3] * v[3]); }
template <int NP> __device__ __forceinline__ float row_scale(const float* SS, size_t row, float inv_n, float eps, int fq) {
    const float* p = SS + row * NP; float s;
    if constexpr (NP == 32) { const f32x4 a = *(const f32x4*)(p + fq * 8), b = *(const f32x4*)(p + fq * 8 + 4); s = ((a[0] + a[1]) + (a[2] + a[3])) + ((b[0] + b[1]) + (b[2] + b[3])); s += __shfl_xor(s, 16); s += __shfl_xor(s, 32); }
    else if constexpr (NP == 8) { const f32x4 a = *(const f32x4*)p, b = *(const f32x4*)(p + 4); s = ((a[0] + a[1]) + (a[2] + a[3])) + ((b[0] + b[1]) + (b[2] + b[3])); }
    else { const f32x4 a = *(const f32x4*)p; s = (a[0] + a[1]) + (a[2] + a[3]); }
    return 1.0f / sqrtf(s * inv_n + eps);
}

struct EpiIn {
    static constexpr bool PERM = true, AFTER_DRAIN = false;
    const float* XSS; bf16_t* CQ; bf16_t* CKV; float* CQSS; float* CKVSS; bf16_t* Kb; const float* c64; const float* s64;
    bf16_t* RQ; bf16_t* RK; bf16_t* RV; bf16_t* RG; const float* c128; const float* s128;
    const PG8_LAS float* rtab; int rpm;
    __device__ __forceinline__ void operator()(const f32x4 (&acc)[2][2][4][2], const Unit& u, int wr, int wc, int fr, int fq) const {
        const int pn = u.pn, row0 = u.pm * BM + wr * 64 + fr, cw = wc * 32 + 8 * fq;
#pragma unroll
        for (int ai = 0; ai < 2; ++ai) {
            float r4[4];
#pragma unroll
            for (int m = 0; m < 4; ++m) r4[m] = (u.pm == rpm) ? rtab[wr * 64 + fr + ai * HALF + m * 16] : row_scale<32>(XSS, (size_t)(row0 + ai * HALF + m * 16), 1.0f / 2048.0f, 1e-6f, fq);
            asm volatile("" : "+v"(r4[0]), "+v"(r4[1]), "+v"(r4[2]), "+v"(r4[3]));
            if (pn < 3) {
#pragma unroll
                for (int m = 0; m < 4; ++m) { const size_t row = (size_t)(row0 + ai * HALF + m * 16); const float r = r4[m];
                    const f32x4 a0 = acc[ai][0][m][0] * r, a1 = acc[ai][0][m][1] * r, b0 = acc[ai][1][m][0] * r, b1 = acc[ai][1][m][1] * r;
                    float s = (sq4(a0) + sq4(a1)) + (sq4(b0) + sq4(b1)); s += __shfl_xor(s, 16); s += __shfl_xor(s, 32);
                    if (pn < 2) { bf16_t* rp = CQ + row * 512 + pn * 256 + cw; *(u32x4*)rp = pack8bf(a0, a1); *(u32x4*)(rp + HALF) = pack8bf(b0, b1); if (fq == 0) CQSS[row * 8 + pn * 4 + wc] = s; }
                    else { bf16_t* rp = CKV + row * 256 + cw; *(u32x4*)rp = pack8bf(a0, a1); *(u32x4*)(rp + HALF) = pack8bf(b0, b1); if (fq == 0) CKVSS[row * 4 + wc] = s; } }
            } else if (pn == 3) {
                if (wc < 2) { const int j0 = cw >> 1;
#pragma unroll
                    for (int m = 0; m < 4; ++m) { const size_t row = (size_t)(row0 + ai * HALF + m * 16); const float r = r4[m];
                        const f32x4 cs = *(const f32x4*)(c64 + row * 32 + j0), sn = *(const f32x4*)(s64 + row * 32 + j0);
                        f32x4 v0 = acc[ai][0][m][0] * r, v1 = acc[ai][0][m][1] * r; rope8(v0, v1, cs, sn); const u32x4 w = pack8bf(v0, v1);
                        bf16_t* kp = Kb + row * 1536 + 128 + cw;
#pragma unroll
                        for (int h = 0; h < 8; ++h) *(u32x4*)(kp + h * 192) = w; } }
            } else if (pn < 12) {
                bf16_t* T = pn < 8 ? RQ : RK; const float sc = pn < 8 ? 0.08838834764831845f : 1.0f; const int ct = ((pn - 4) & 3) * 256 + cw, j0 = cw >> 1;
#pragma unroll
                for (int m = 0; m < 4; ++m) { const size_t row = (size_t)(row0 + ai * HALF + m * 16); const float r = r4[m] * sc;
                    const f32x4 cs = *(const f32x4*)(c128 + row * 64 + j0), sn = *(const f32x4*)(s128 + row * 64 + j0);
#pragma unroll
                    for (int bj = 0; bj < 2; ++bj) { f32x4 v0 = acc[ai][bj][m][0] * r, v1 = acc[ai][bj][m][1] * r; rope8(v0, v1, cs, sn);
                        *(u32x4*)(T + row * 1024 + ct + bj * HALF) = pack8bf(v0, v1); } }
            } else if (pn < 16) {
                const int ct = (pn - 12) * 256 + cw;
#pragma unroll
                for (int m = 0; m < 4; ++m) { const size_t row = (size_t)(row0 + ai * HALF + m * 16); bf16_t* rp = RV + row * 1024 + ct; const float r = r4[m];
#pragma unroll
                    for (int bj = 0; bj < 2; ++bj) *(u32x4*)(rp + bj * HALF) = pack8bf(acc[ai][bj][m][0] * r, acc[ai][bj][m][1] * r); }
            } else {
                const int ct = (pn - 16) * 256 + cw;
#pragma unroll
                for (int m = 0; m < 4; ++m) { const size_t row = (size_t)(row0 + ai * HALF + m * 16); bf16_t* rp = RG + row * 1024 + ct; const float r = r4[m];
#pragma unroll
                    for (int bj = 0; bj < 2; ++bj) { f32x4 v0 = acc[ai][bj][m][0] * r, v1 = acc[ai][bj][m][1] * r;
#pragma unroll
                        for (int e = 0; e < 4; ++e) { v0[e] = silu_f(v0[e]); v1[e] = silu_f(v1[e]); }
                        *(u32x4*)(rp + bj * HALF) = pack8bf(v0, v1); } }
            }
        }
    }
};
struct EpiQ {
    static constexpr bool PERM = true, AFTER_DRAIN = false;
    const float* CQSS; bf16_t* Q; const float* c64; const float* s64; float sc;
    __device__ __forceinline__ void operator()(const f32x4 (&acc)[2][2][4][2], const Unit& u, int wr, int wc, int fr, int fq) const {
        const int row0 = u.pm * BM + wr * 64 + fr, cw = wc * 32 + 8 * fq;
#pragma unroll
        for (int ai = 0; ai < 2; ++ai)
#pragma unroll
            for (int m = 0; m < 4; ++m) { const size_t row = (size_t)(row0 + ai * HALF + m * 16); const float r = row_scale<8>(CQSS, row, 1.0f / 512.0f, 1e-6f, fq) * sc;
#pragma unroll
                for (int bj = 0; bj < 2; ++bj) { const int c0 = u.pn * 256 + bj * HALF + cw, dd = c0 % 192; const bool rp = dd >= 128; const int j0 = rp ? ((dd - 128) >> 1) : 0;
                    f32x4 v0 = acc[ai][bj][m][0] * r, v1 = acc[ai][bj][m][1] * r;
                    if (rp) { const f32x4 cs = *(const f32x4*)(c64 + row * 32 + j0), sn = *(const f32x4*)(s64 + row * 32 + j0); rope8(v0, v1, cs, sn); }
                    *(u32x4*)(Q + row * 1536 + c0) = pack8bf(v0, v1); } }
    }
};
struct EpiKV {
    static constexpr bool PERM = true, AFTER_DRAIN = false;
    const float* CKVSS; bf16_t* K; bf16_t* V;
    __device__ __forceinline__ void operator()(const f32x4 (&acc)[2][2][4][2], const Unit& u, int wr, int wc, int fr, int fq) const {
        const int row0 = u.pm * BM + wr * 64 + fr, cw = wc * 32 + 8 * fq;
#pragma unroll
        for (int ai = 0; ai < 2; ++ai)
#pragma unroll
            for (int m = 0; m < 4; ++m) { const size_t row = (size_t)(row0 + ai * HALF + m * 16); const float r = row_scale<4>(CKVSS, row, 1.0f / 256.0f, 1e-6f, fq);
                *(u32x4*)(K + row * 1536 + u.pn * 192 + cw) = pack8bf(acc[ai][0][m][0] * r, acc[ai][0][m][1] * r);
                *(u32x4*)(V + row * 1024 + u.pn * 128 + cw) = pack8bf(acc[ai][1][m][0] * r, acc[ai][1][m][1] * r); }
    }
};
template <bool SCALE2  , bool WRITE_XB>
struct EpiResT {
    static constexpr bool PERM = true, AFTER_DRAIN = false;
    const float* base; float* out; bf16_t* XB; float* XSS; const float* RS; const PG8_LAS float* rtab; int rpm;
    __device__ __forceinline__ void operator()(const f32x4 (&acc)[2][2][4][2], const Unit& u, int wr, int wc, int fr, int fq) const {
        const int row0 = u.pm * BM + wr * 64 + fr, c0 = u.pn * BM + wc * 32 + 8 * fq;
#pragma unroll
        for (int ai = 0; ai < 2; ++ai) {
            float r2[4];
#pragma unroll
            for (int m = 0; m < 4; ++m) { if constexpr (SCALE2) { const float r = (u.pm == rpm) ? rtab[wr * 64 + fr + ai * HALF + m * 16] : row_scale<32>(RS, (size_t)(row0 + ai * HALF + m * 16), 1.0f / 2048.0f, 1e-6f, fq); r2[m] = r * r; } else r2[m] = 1.0f; }
            if constexpr (SCALE2) asm volatile("" : "+v"(r2[0]), "+v"(r2[1]), "+v"(r2[2]), "+v"(r2[3]));
            f32x4 pre[4][4];
#pragma unroll
            for (int m = 0; m < 4; ++m) { const size_t off = (size_t)(row0 + ai * HALF + m * 16) * 2048 + c0;
                pre[m][0] = *(const f32x4*)(base + off); pre[m][1] = *(const f32x4*)(base + off + 4); pre[m][2] = *(const f32x4*)(base + off + HALF); pre[m][3] = *(const f32x4*)(base + off + HALF + 4); }
#pragma unroll
            for (int m = 0; m < 4; ++m) asm volatile("" : "+v"(pre[m][0]), "+v"(pre[m][1]), "+v"(pre[m][2]), "+v"(pre[m][3]));
#pragma unroll
            for (int m = 0; m < 4; ++m) { const size_t row = (size_t)(row0 + ai * HALF + m * 16); const size_t off = row * 2048 + c0;
                f32x4 a0, a1, b0, b1;
                if constexpr (SCALE2) { a0 = pre[m][0] + acc[ai][0][m][0] * r2[m]; a1 = pre[m][1] + acc[ai][0][m][1] * r2[m]; b0 = pre[m][2] + acc[ai][1][m][0] * r2[m]; b1 = pre[m][3] + acc[ai][1][m][1] * r2[m]; }
                else { a0 = pre[m][0] + acc[ai][0][m][0]; a1 = pre[m][1] + acc[ai][0][m][1]; b0 = pre[m][2] + acc[ai][1][m][0]; b1 = pre[m][3] + acc[ai][1][m][1]; }
                *(f32x4*)(out + off) = a0; *(f32x4*)(out + off + 4) = a1; *(f32x4*)(out + off + HALF) = b0; *(f32x4*)(out + off + HALF + 4) = b1;
                if constexpr (WRITE_XB) { *(u32x4*)(XB + off) = pack8bf(a0, a1); *(u32x4*)(XB + off + HALF) = pack8bf(b0, b1); }
                float s = (sq4(a0) + sq4(a1)) + (sq4(b0) + sq4(b1)); s += __shfl_xor(s, 16); s += __shfl_xor(s, 32);
                if (fq == 0) XSS[row * 32 + u.pn * 4 + wc] = s; }
        }
    }
};
struct EpiRelu2 {
    static constexpr bool PERM = true, AFTER_DRAIN = false;
    bf16_t* O; int ldc;
    __device__ __forceinline__ void operator()(const f32x4 (&acc)[2][2][4][2], const Unit& u, int wr, int wc, int fr, int fq) const {
        const int row0 = u.pm * BM + wr * 64 + fr, c0 = u.pn * BM + wc * 32 + 8 * fq;
#pragma unroll
        for (int ai = 0; ai < 2; ++ai)
#pragma unroll
            for (int m = 0; m < 4; ++m) { bf16_t* rp = O + (size_t)(row0 + ai * HALF + m * 16) * ldc + c0;
#pragma unroll
                for (int bj = 0; bj < 2; ++bj) { f32x4 v0 = acc[ai][bj][m][0], v1 = acc[ai][bj][m][1];
#pragma unroll
                    for (int e = 0; e < 4; ++e) { const float a = fmaxf(v0[e], 0.f), b = fmaxf(v1[e], 0.f); v0[e] = a * a; v1[e] = b * b; }
                    *(u32x4*)(rp + bj * HALF) = pack8bf(v0, v1); } }
    }
};
}
constexpr int NWAVES = 8;
constexpr int BATCH = 2, SEQ = 8192, DM = 2048, DEPTH = 4, M = BATCH * SEQ;
constexpr int NH = 8, QLORA = 512, KVLORA = 256, DQK = 192, DNOPE = 128, DROPE = 64, DV = 128, FF = 8192;
constexpr int IN_SRC = 4928, IN_PAD = 5120;
constexpr int RCH = 128, NCH = SEQ / RCH;
constexpr float NORM_EPS = 1e-6f, GN_EPS = 1e-6f;
constexpr float QSCALE = 0.07216878364870323f * 1.4426950408889634f;

constexpr size_t MiB = 1u << 20;
constexpr size_t WS_CTL = 0, CTL_ZERO_BYTES = 128 * 1024;
constexpr size_t WS_C64 = 2 * MiB, WS_S64 = 4 * MiB, WS_C128 = 6 * MiB, WS_S128 = 10 * MiB;
constexpr size_t WS_XSS = 14 * MiB;
constexpr size_t WS_W = 16 * MiB, W_STRIDE = 96 * MiB;
constexpr size_t WO_WIN = 0, WO_WUQ = 20 * MiB, WO_WUKV = 22 * MiB, WO_WO = 24 * MiB, WO_WUP = 32 * MiB, WO_WDN = 64 * MiB;
constexpr size_t WS_XB = 208 * MiB;
constexpr size_t WS_MIX = 272 * MiB;
constexpr size_t WS_CQSS = 336 * MiB, WS_CKVSS = 337 * MiB;
constexpr size_t WS_RQ = 338 * MiB, WS_RK = 370 * MiB, WS_RV = 402 * MiB, WS_RG = 434 * MiB;
constexpr size_t WS_CQ = 466 * MiB, WS_CKV = 482 * MiB;
constexpr size_t WS_Q = 490 * MiB, WS_K = 538 * MiB, WS_V = 586 * MiB;
constexpr size_t WS_U = 618 * MiB, WS_S = 682 * MiB;
constexpr size_t WS_UF = 338 * MiB;
constexpr size_t WS_XSS2 = 714 * MiB;
constexpr size_t WS_END = 716 * MiB;
static_assert(WS_UF + (size_t)M * FF * 2 <= WS_U && WS_S + (size_t)16 * 64 * 16384 * 2 <= WS_END && WS_U + (size_t)16 * 64 * 16384 * 4 <= WS_S, "d_ws map");
static_assert(WO_WIN + (size_t)IN_PAD * DM * 2 <= WO_WUQ && WO_WUQ + (size_t)1536 * 512 * 2 <= WO_WUKV && WO_WUKV + (size_t)2048 * 256 * 2 <= WO_WO && WO_WO + (size_t)DM * DM * 2 <= WO_WUP && WO_WUP + (size_t)FF * DM * 2 <= WO_WDN && WO_WDN + (size_t)FF * DM * 2 <= W_STRIDE && WS_W + 2 * W_STRIDE <= WS_XB, "weights map");
constexpr int CW_TMO = 0, CW_CODE = 1, CW_BAR = 4096;
constexpr int CW_AQ = 12288;
constexpr int CW_SRDY = 12544, CW_RQ = 12800;
constexpr int CW_AL = 13312;
static_assert((CW_AL + 64 * 16) * 4 <= (int)CTL_ZERO_BYTES && CW_AL >= CW_RQ + 64 * DEPTH, "rendezvous counters inside the per-call memset");
constexpr int CW_WQ = 8192;
static_assert(CW_BAR + 3456 <= CW_WQ && (CW_WQ + 64 * DEPTH) <= CW_AQ && (CW_AQ + 64 * DEPTH) <= CW_SRDY && (CW_SRDY + 64 * DEPTH) <= CW_RQ && (CW_RQ + 64 * DEPTH) * 4 <= (int)CTL_ZERO_BYTES, "control words inside the per-call memset");

constexpr int RING_OFF = 0, RING_BYTES = 131072;
constexpr int LDSCTL_OFF = RING_BYTES, MISC_OFF = LDSCTL_OFF + 320;
constexpr int LDS_BYTES = 147456;
static_assert(MISC_OFF + 128 <= LDS_BYTES, "LDS map");

#define GAS __attribute__((address_space(1)))
#define LAS __attribute__((address_space(3)))
typedef unsigned short bf16;
typedef unsigned v4u __attribute__((ext_vector_type(4)));
typedef float f32x4 __attribute__((ext_vector_type(4)));
typedef short bf16x8 __attribute__((ext_vector_type(8)));
typedef GAS unsigned gu32;
typedef GAS unsigned long long gu64;
#define RLX_AGENT __ATOMIC_RELAXED, __HIP_MEMORY_SCOPE_AGENT
#define LDS_WAIT() asm volatile("s_waitcnt lgkmcnt(0)" ::: "memory")
#define VM_WAIT() asm volatile("s_waitcnt vmcnt(0)" ::: "memory")
__device__ __forceinline__ unsigned long long rt() { return __builtin_amdgcn_s_memrealtime(); }
__device__ __forceinline__ unsigned f2bf(float f) { unsigned u = __builtin_bit_cast(unsigned, f); return (u + 0x7fffu + ((u >> 16) & 1u)) >> 16; }
__device__ __forceinline__ unsigned pk2(float lo, float hi) { return f2bf(lo) | (f2bf(hi) << 16); }

#define XB_TMO      128
#define XB_XCNT(j)  (256  + 64 * (j))
#define XB_XSUB(j)  (1280 + 64 * (j))
#define XB_XGEN(j)  (2304 + 64 * (j))
#define XB_TOP      3328
#define XB_TOPGEN   3392
#define XCD_BAR_WORDS 3456
#define XB_SPIN_CAP (1u << 18)

__device__ __forceinline__ unsigned xb_ld(unsigned* p)              { return __hip_atomic_load(p, __ATOMIC_RELAXED, __HIP_MEMORY_SCOPE_AGENT); }
__device__ __forceinline__ unsigned xb_add(unsigned* p, unsigned v) { return __hip_atomic_fetch_add(p, v, __ATOMIC_RELAXED, __HIP_MEMORY_SCOPE_AGENT); }
__device__ __forceinline__ unsigned xb_xcc_id() { return (unsigned)__builtin_amdgcn_s_getreg((3 << 11) | 20) & 0xFu; }
#define XB_SPIN(cond, bar) do { unsigned _sp = 0; while (cond) { __builtin_amdgcn_s_sleep(1); \
    if ((++_sp & 255u) == 0u) { if (xb_ld(&(bar)[XB_TMO])) break; if (_sp > XB_SPIN_CAP) { atomicAdd(&(bar)[XB_TMO], 1u); break; } } } } while (0)

struct XcdBarrier {
    unsigned* bar; unsigned x;
    volatile LAS unsigned* st;
};

__device__ __forceinline__ XcdBarrier xcd_barrier_post(unsigned* bar, volatile LAS unsigned* st) {
    XcdBarrier b; b.bar = bar; b.x = xb_xcc_id(); b.st = st;
    if (threadIdx.x == 0) (void)xb_add(&bar[XB_XCNT(b.x)], 1u);
    return b;
}
__device__ __forceinline__ void xcd_barrier_complete(unsigned* bar, unsigned x, unsigned& nloc, unsigned& nx) {
    const unsigned G = gridDim.x * gridDim.y * gridDim.z;
    unsigned sum, cnt, mine, sp = 0u;
    for (;;) {
        sum = 0u; cnt = 0u; mine = 0u;
#pragma unroll
        for (unsigned j = 0; j < 16; ++j) { const unsigned c = xb_ld(&bar[XB_XCNT(j)]); sum += c; cnt += (c > 0u) ? 1u : 0u; mine = (j == x) ? c : mine; }
        if (sum == G) break;
        __builtin_amdgcn_s_sleep(1);
        if ((++sp & 255u) == 0u) { if (xb_ld(&bar[XB_TMO])) break; if (sp > XB_SPIN_CAP) { atomicAdd(&bar[XB_TMO], 1u); break; } }
    }
    nloc = mine > 0u ? mine : 1u; nx = cnt > 0u ? cnt : 1u;
}

__device__ __forceinline__ void xcd_barrier(const XcdBarrier& b) {
    asm volatile("s_waitcnt vmcnt(0)" ::: "memory");
    __syncthreads();
    if (threadIdx.x == 0) {
        unsigned* bar = b.bar;
        __builtin_amdgcn_s_waitcnt(0);
        unsigned nloc = b.st[0], nx = b.st[1];
        if (nloc == 0u) { xcd_barrier_complete(bar, b.x, nloc, nx); b.st[0] = nloc; b.st[1] = nx; }
        const unsigned old = xb_add(&bar[XB_XSUB(b.x)], 1u);
        const unsigned gen = old / nloc;
        if (old + 1u == (gen + 1u) * nloc) {
            __builtin_amdgcn_fence(__ATOMIC_RELEASE, "agent");
            asm volatile("s_waitcnt vmcnt(0)" ::: "memory");
            const unsigned og = xb_add(&bar[XB_TOP], 1u);
            const unsigned tg = og / nx;
            if (og + 1u == (tg + 1u) * nx) xb_add(&bar[XB_TOPGEN], 1u);
            else XB_SPIN(xb_ld(&bar[XB_TOPGEN]) == tg, bar);
            __builtin_amdgcn_fence(__ATOMIC_ACQUIRE, "agent");
            xb_add(&bar[XB_XGEN(b.x)], 1u);
            asm volatile("s_waitcnt vmcnt(0)" ::: "memory");
        } else {
            XB_SPIN(xb_ld(&bar[XB_XGEN(b.x)]) == gen, bar);
            __builtin_amdgcn_fence(__ATOMIC_ACQUIRE, "agent");
            asm volatile("s_waitcnt vmcnt(0)" ::: "memory");
        }
    }
    __syncthreads();
}

typedef short s16x4 __attribute__((ext_vector_type(4)));
typedef float f32x16 __attribute__((ext_vector_type(16)));
typedef float f32x2 __attribute__((ext_vector_type(2)));
typedef LAS unsigned char* ldsp;
typedef const LAS unsigned char* cldsp;
#define SBARRIER() do { __builtin_amdgcn_s_barrier(); asm volatile("" ::: "memory"); } while (0)
__device__ __forceinline__ float wave_sum(float v) {
#pragma unroll
    for (int o = 1; o < 64; o <<= 1) v += __shfl_xor(v, o);
    return v;
}
__device__ __forceinline__ unsigned cvtpk(float lo, float hi) { unsigned r; asm volatile("v_cvt_pk_bf16_f32 %0, %1, %2" : "=v"(r) : "v"(lo), "v"(hi)); return r; }
__device__ __forceinline__ float bf_lo(unsigned w) { return __builtin_bit_cast(float, w << 16); }
__device__ __forceinline__ float bf_hi(unsigned w) { return __builtin_bit_cast(float, w & 0xffff0000u); }
__device__ __forceinline__ int crow(int r, int hi) { return (r & 3) + 8 * (r >> 2) + 4 * hi; }
__device__ __forceinline__ void glds16(const void* g, ldsp l) { __builtin_amdgcn_global_load_lds((const unsigned*)g, (LAS unsigned*)l, 16, 0, 0); }
typedef short v4i16_t __attribute__((ext_vector_type(4)));
__device__ __forceinline__ s16x4 trrd(cldsp p) { return __builtin_bit_cast(s16x4, __builtin_amdgcn_ds_read_tr16_b64_v4i16((LAS v4i16_t*)p)); }
#define MK8(lo, hi) ((bf16x8){(lo)[0], (lo)[1], (lo)[2], (lo)[3], (hi)[0], (hi)[1], (hi)[2], (hi)[3]})
__device__ __forceinline__ bf16x8 pack8f(const f32x16& p, int b) {
    v4u w; w.x = cvtpk(p[b], p[b + 1]); w.y = cvtpk(p[b + 2], p[b + 3]); w.z = cvtpk(p[b + 4], p[b + 5]); w.w = cvtpk(p[b + 6], p[b + 7]); return __builtin_bit_cast(bf16x8, w);
}
#define MFMA32(a, b, c) __builtin_amdgcn_mfma_f32_32x32x16_bf16((a), (b), (c), 0, 0, 0)
__device__ __forceinline__ int tr_att_base(int lane) { return (4 * (lane >> 5) + ((lane & 15) >> 2)) * 64 + ((lane >> 4) & 1) * 32 + (lane & 3) * 8; }
__device__ __forceinline__ int tr_nat_base(int lane) { return (8 * (lane >> 5) + ((lane & 15) >> 2)) * 64 + ((lane >> 4) & 1) * 32 + (lane & 3) * 8; }

struct Args {
    const float* x; const int* pos; const float* attn_norm; const float* w_in; const float* q_norm; const float* kv_norm; const float* w_uq; const float* w_ukv;
    const float* beta_attn; const float* beta_ret; const float* w_o; const float* mlp_norm; const float* w_up; const float* w_down; const float* final_norm;
    float* out; unsigned char* ws;
    double invf64[32]; double invf128[64];
    float lg2g[8];
};
static_assert(sizeof(Args) == 17 * 8 + 96 * 8 + 32, "Args has no padding");
typedef const __attribute__((address_space(4))) Args* cargs_t;
__device__ __forceinline__ cargs_t get_args() { cargs_t p = (cargs_t)__builtin_amdgcn_kernarg_segment_ptr(); asm volatile("" : "+s"(p)); return p; }

struct AlignedOrder : pg8::StaticOrder {
    __device__ __forceinline__ void align() const {
        if (threadIdx.x == 0 && (nwg % G) == 0) {
            extern __shared__ __attribute__((aligned(16))) unsigned char lds_al_[];
            const unsigned nloc = ((volatile LAS unsigned*)((LAS unsigned char*)lds_al_ + MISC_OFF))[8];
            if (nloc) { cargs_t a = get_args(); unsigned* ctr = (unsigned*)((gu32*)(a->ws + WS_CTL) + CW_AL + 64 * xb_xcc_id());
                const unsigned old = xb_add(ctr, 1u), tgt = (old / nloc + 1u) * nloc;
                for (unsigned sp = 0; sp < 8192u && xb_ld(ctr) < tgt; ++sp) __builtin_amdgcn_s_sleep(1); }
        }
        __builtin_amdgcn_s_barrier();
    }
};

__device__ __forceinline__ void sincos_d(double ang, float& s, float& c) {
    const double k = __builtin_rint(ang * 0.63661977236758134308);
    double y = __builtin_fma(-k, 1.57079632679489655800e+00, ang); y = __builtin_fma(-k, 6.12323399573676603587e-17, y);
    const double z = y * y;
    double sp = 1.0 / 6227020800.0; sp = sp * z - 1.0 / 39916800.0; sp = sp * z + 1.0 / 362880.0; sp = sp * z - 1.0 / 5040.0; sp = sp * z + 1.0 / 120.0; sp = sp * z - 1.0 / 6.0; sp = sp * z + 1.0; sp = sp * y;
    double cp = -1.0 / 87178291200.0; cp = cp * z + 1.0 / 479001600.0; cp = cp * z - 1.0 / 3628800.0; cp = cp * z + 1.0 / 40320.0; cp = cp * z - 1.0 / 720.0; cp = cp * z + 1.0 / 24.0; cp = cp * z - 0.5; cp = cp * z + 1.0;
    const int q = (int)((long long)k & 3);
    const double ss = (q == 0) ? sp : (q == 1) ? cp : (q == 2) ? -sp : -cp;
    const double cc = (q == 0) ? cp : (q == 1) ? -sp : (q == 2) ? -cp : sp;
    s = (float)ss; c = (float)cc;
}
__device__ __forceinline__ void rope_tables(cargs_t a, int gtid, int nthr) {
    unsigned char* ws = a->ws; const int* pos = a->pos;
    float* c64 = (float*)(ws + WS_C64); float* s64 = (float*)(ws + WS_S64); float* c128 = (float*)(ws + WS_C128); float* s128 = (float*)(ws + WS_S128);
    for (int i = gtid; i < M * 96; i += nthr) { const int m = i / 96, j = i - m * 96; const double p = (double)pos[m]; float s, c;
        if (j < 32) { sincos_d(p * a->invf64[j], s, c); c64[m * 32 + j] = c; s64[m * 32 + j] = s; }
        else { sincos_d(p * a->invf128[j - 32], s, c); c128[m * 64 + j - 32] = c; s128[m * 64 + j - 32] = s; } }
}
template <class Map, class Gain>
__device__ __forceinline__ void transpose_item(const float* W, int K, int N, bf16* WT, const Map& map, const Gain& gain, LAS float* scr, int item, int lane) {
    const int nblk = N / 32, kb = item / nblk, nb = item % nblk, k0 = 64 * kb, n0 = 32 * nb;
#pragma unroll 8
    for (int i = 0; i < 32; ++i) { const int kk = 2 * i + (lane >> 5); scr[kk * 33 + (lane & 31)] = W[(size_t)(k0 + kk) * N + n0 + (lane & 31)] * gain(k0 + kk); }
    LDS_WAIT(); asm volatile("" ::: "memory");
    const int c = lane & 7;
#pragma unroll
    for (int j = 0; j < 4; ++j) { const int n = (lane >> 3) + 8 * j; const LAS float* s = scr + (8 * c) * 33 + n;
        v4u o; o.x = pk2(s[0 * 33], s[1 * 33]); o.y = pk2(s[2 * 33], s[3 * 33]); o.z = pk2(s[4 * 33], s[5 * 33]); o.w = pk2(s[6 * 33], s[7 * 33]);
        *(GAS v4u*)(WT + (size_t)map(n0 + n) * K + k0 + 8 * c) = o; }
    LDS_WAIT(); asm volatile("" ::: "memory");
}
struct GainNone { __device__ __forceinline__ float operator()(int) const { return 1.0f; } };
struct GainVec { const float* g; __device__ __forceinline__ float operator()(int k) const { return g[k]; } };
struct GainVec2 { const float* g0; const float* g1; int split; __device__ __forceinline__ float operator()(int k) const { return k < split ? g0[k] : g1[k - split]; } };
struct MapId { __device__ __forceinline__ int operator()(int n) const { return n; } };
struct MapWin {
    __device__ __forceinline__ int operator()(int n) const {
        if (n < 768) return n;
        if (n < 832) { const int d = n - 768; return 768 + (d < 32 ? 2 * d : 2 * (d - 32) + 1); }
        if (n < 2880) { const int e = n - 832, g = e >> 7, d = e & 127; return 1024 + g * 128 + (d < 64 ? 2 * d : 2 * (d - 64) + 1); }
        return n + 192;
    }
};
struct MapWuq {
    __device__ __forceinline__ int operator()(int n) const { const int h = n / 192, d = n - h * 192; if (d < 128) return n; const int e = d - 128; return h * 192 + 128 + (e < 32 ? 2 * e : 2 * (e - 32) + 1); }
};
template <bool DYN>
__device__ __forceinline__ void convert_weights(cargs_t a, int l, ldsp lds, int gw, int ngw, int wave, int lane, int gtid, int nthr, unsigned* qctr) {
    unsigned char* wb = a->ws + WS_W + (size_t)(l & 1) * W_STRIDE;
    LAS float* scr = (LAS float*)(lds + RING_OFF + wave * 16384);
    bf16* Win = (bf16*)(wb + WO_WIN); bf16* Wuq = (bf16*)(wb + WO_WUQ); bf16* Wukv = (bf16*)(wb + WO_WUKV); bf16* Wo = (bf16*)(wb + WO_WO); bf16* Wup = (bf16*)(wb + WO_WUP); bf16* Wdn = (bf16*)(wb + WO_WDN);
    const float* w_in = a->w_in + (size_t)l * DM * IN_SRC; const float* w_uq = a->w_uq + (size_t)l * QLORA * 1536; const float* w_ukv = a->w_ukv + (size_t)l * KVLORA * 2048;
    const float* w_o = a->w_o + (size_t)l * DM * DM; const float* w_up = a->w_up + (size_t)l * DM * FF; const float* w_dn = a->w_down + (size_t)l * FF * DM;
    const GainVec g_in{a->attn_norm + l * DM}, g_uq{a->q_norm + l * QLORA}, g_ukv{a->kv_norm + l * KVLORA}, g_up{a->mlp_norm + l * DM}; const GainVec2 g_o{a->beta_attn + l * 1024, a->beta_ret + l * 1024, 1024};
    constexpr int I_IN = (DM / 64) * (IN_SRC / 32), I_UQ = (QLORA / 64) * (1536 / 32), I_UKV = (KVLORA / 64) * (2048 / 32), I_O = (DM / 64) * (DM / 32), I_UP = (DM / 64) * (FF / 32), I_DN = (FF / 64) * (DM / 32);
    constexpr int NITEMS = I_IN + I_UQ + I_UKV + I_O + I_UP + I_DN, CH = 16;
    GAS v4u* pz = (GAS v4u*)(Win + (size_t)832 * DM);
    for (int i = gtid; i < 192 * DM / 8; i += nthr) pz[i] = (v4u){0u, 0u, 0u, 0u};
    int it = DYN ? 0 : gw, it_end = 0;
    for (;;) {
        if constexpr (DYN) { if (it >= it_end) { unsigned c = 0u; if (lane == 0) c = __hip_atomic_fetch_add(qctr, 1u, __ATOMIC_RELAXED, __HIP_MEMORY_SCOPE_AGENT);
                it = (int)__builtin_amdgcn_readfirstlane(c) * CH; it_end = it + CH; if (it >= NITEMS) break; }
            if (it >= NITEMS) break; }
        else { if (it >= NITEMS) break; }
        int r = it;
        if (r < I_IN) transpose_item(w_in, DM, IN_SRC, Win, MapWin(), g_in, scr, r, lane);
        else if ((r -= I_IN) < I_UQ) transpose_item(w_uq, QLORA, 1536, Wuq, MapWuq(), g_uq, scr, r, lane);
        else if ((r -= I_UQ) < I_UKV) transpose_item(w_ukv, KVLORA, 2048, Wukv, MapId(), g_ukv, scr, r, lane);
        else if ((r -= I_UKV) < I_O) transpose_item(w_o, DM, DM, Wo, MapId(), g_o, scr, r, lane);
        else if ((r -= I_O) < I_UP) transpose_item(w_up, DM, FF, Wup, MapId(), g_up, scr, r, lane);
        else { r -= I_UP; transpose_item(w_dn, FF, DM, Wdn, MapId(), GainNone(), scr, r, lane); }
        it += DYN ? 1 : ngw;
    }
}
constexpr int RTAB_OFF = LDSCTL_OFF + 1024;
static_assert(RTAB_OFF + 1024 <= LDS_BYTES, "row-scale table inside the LDS allocation");
__device__ __forceinline__ void fill_rtab(const float* SS, int pm, ldsp lds, int tid) {
    if (tid < 256) { const GAS f32x4* p = (const GAS f32x4*)(SS + (size_t)(pm * 256 + tid) * 32); float s = 0.f;
#pragma unroll
        for (int j = 0; j < 8; ++j) { const f32x4 v = p[j]; s += (v.x + v.y) + (v.z + v.w); }
        ((LAS float*)(lds + RTAB_OFF))[tid] = 1.0f / sqrtf(s * (1.0f / DM) + NORM_EPS); }
    __syncthreads();
}
template <int NR> __device__ __forceinline__ void prep_rows(const float* x, bf16* XB, float* XSS, int row, int stride, int lane) {
    f32x4 v[NR][8]; float s[NR];
#pragma unroll
    for (int q = 0; q < NR; ++q) { const GAS f32x4* xr = (const GAS f32x4*)(x + (size_t)(row + q * stride) * DM) + lane;
#pragma unroll
        for (int j = 0; j < 8; ++j) v[q][j] = xr[64 * j]; }
#pragma unroll
    for (int q = 0; q < NR; ++q) { float t = 0.f;
#pragma unroll
        for (int j = 0; j < 8; ++j) t += (v[q][j].x * v[q][j].x + v[q][j].y * v[q][j].y) + (v[q][j].z * v[q][j].z + v[q][j].w * v[q][j].w);
        s[q] = wave_sum(t); }
#pragma unroll
    for (int q = 0; q < NR; ++q) { GAS unsigned long long* o8 = (GAS unsigned long long*)(XB + (size_t)(row + q * stride) * DM) + lane;
#pragma unroll
        for (int j = 0; j < 8; ++j) o8[64 * j] = (unsigned long long)cvtpk(v[q][j].x, v[q][j].y) | ((unsigned long long)cvtpk(v[q][j].z, v[q][j].w) << 32);
        if (lane < 32) XSS[(size_t)(row + q * stride) * 32 + lane] = (lane == 0) ? s[q] : 0.f; }
}
template <int NR> __device__ __forceinline__ void rms_rows_final(float* xo, const float* XSS, const float* g, int row, int stride, int lane) {
    f32x4 v[NR][8]; float r[NR]; const GAS f32x4* gr = (const GAS f32x4*)g + lane;
#pragma unroll
    for (int q = 0; q < NR; ++q) { const GAS f32x4* xr = (const GAS f32x4*)(xo + (size_t)(row + q * stride) * DM) + lane;
#pragma unroll
        for (int j = 0; j < 8; ++j) v[q][j] = xr[64 * j];
        r[q] = (lane < 32) ? XSS[(size_t)(row + q * stride) * 32 + lane] : 0.f; }
#pragma unroll
    for (int q = 0; q < NR; ++q) r[q] = 1.0f / sqrtf(wave_sum(r[q]) * (1.0f / DM) + NORM_EPS);
#pragma unroll
    for (int q = 0; q < NR; ++q) { GAS f32x4* xr = (GAS f32x4*)(xo + (size_t)(row + q * stride) * DM) + lane;
#pragma unroll
        for (int j = 0; j < 8; ++j) { const f32x4 gg = gr[64 * j]; const float rr = r[q]; xr[64 * j] = (f32x4){v[q][j].x * rr * gg.x, v[q][j].y * rr * gg.y, v[q][j].z * rr * gg.z, v[q][j].w * rr * gg.w}; } }
}
template <int NR> __device__ __forceinline__ void attn_norm_rows(bf16* mix, int row, int stride, int lane) {
    v4u w[NR][2]; float r[NR];
#pragma unroll
    for (int q = 0; q < NR; ++q) { const bf16* p = mix + (size_t)(row + q * stride) * DM; w[q][0] = *(const GAS v4u*)(p + lane * 8); w[q][1] = *(const GAS v4u*)(p + 512 + lane * 8); }
#pragma unroll
    for (int q = 0; q < NR; ++q) { float s = 0.f;
#pragma unroll
        for (int j = 0; j < 2; ++j) { const v4u u = w[q][j]; const float f0 = bf_lo(u.x), f1 = bf_hi(u.x), f2 = bf_lo(u.y), f3 = bf_hi(u.y), f4 = bf_lo(u.z), f5 = bf_hi(u.z), f6 = bf_lo(u.w), f7 = bf_hi(u.w);
            s += ((f0 * f0 + f1 * f1) + (f2 * f2 + f3 * f3)) + ((f4 * f4 + f5 * f5) + (f6 * f6 + f7 * f7)); }
        r[q] = 1.0f / sqrtf(wave_sum(s) * (1.0f / 1024.0f) + NORM_EPS); }
#pragma unroll
    for (int q = 0; q < NR; ++q) { bf16* p = mix + (size_t)(row + q * stride) * DM; const float rr = r[q];
#pragma unroll
        for (int j = 0; j < 2; ++j) { const v4u u = w[q][j]; v4u o; o.x = cvtpk(bf_lo(u.x) * rr, bf_hi(u.x) * rr); o.y = cvtpk(bf_lo(u.y) * rr, bf_hi(u.y) * rr); o.z = cvtpk(bf_lo(u.z) * rr, bf_hi(u.z) * rr); o.w = cvtpk(bf_lo(u.w) * rr, bf_hi(u.w) * rr);
            *(GAS v4u*)(p + j * 512 + lane * 8) = o; } }
}

#ifdef PROBE_ATT
#ifndef PROBE_ATT_WAVE
#define PROBE_ATT_WAVE 0
#endif
#define ATP_DECL() unsigned long long atp_t_ = __builtin_readcyclecounter(), atp_acc_ = 0ull; const bool atp_on_ = (blockIdx.x == 0) && (wid == PROBE_ATT_WAVE)
#define ATP(k) do { if (atp_on_) { const unsigned long long n_ = __builtin_readcyclecounter(); if ((k) == ((PROBE_ATT) + 1) % 4) atp_acc_ += n_ - atp_t_; atp_t_ = n_; } } while (0)
#define ATP_END() do { if (atp_on_ && lane == 0) { volatile LAS unsigned long long* q_ = (volatile LAS unsigned long long*)(lds + LDSCTL_OFF + 80); q_[0] += atp_acc_; } } while (0)
#else
#define ATP_DECL() do { } while (0)
#define ATP(k) do { } while (0)
#define ATP_END() do { } while (0)
#endif
__device__ __forceinline__ float max3f(float a, float b, float c) { float r; asm("v_max3_f32 %0, %1, %2, %3" : "=v"(r) : "v"(a), "v"(b), "v"(c)); return r; }
__device__ __forceinline__ float max2f(float a, float b) { float r; asm("v_max_f32_e32 %0, %1, %2" : "=v"(r) : "v"(a), "v"(b)); return r; }
constexpr int AT_KSLOT = 64 * DQK * 2, AT_VSLOT = 64 * DV * 2, AT_K = 0, AT_V = 2 * AT_KSLOT, AT_WS = AT_V + 2 * AT_VSLOT, AT_BYTES = AT_WS + NWAVES * 256;
static_assert(AT_BYTES <= RING_BYTES, "attention LDS");
__device__ __forceinline__ void attn_unit(const bf16* Qg, const bf16* Kg, const bf16* Vg, bf16* Og, int b, int h, int qb, ldsp lds, int tid) {
    const int lane = tid & 63, r32 = lane & 31, hi = lane >> 5; const int wid = __builtin_amdgcn_readfirstlane(tid >> 6);
    const size_t rowbase = (size_t)b * SEQ; const int q0 = qb * 256, NT = (q0 + 256) / 64, qw0 = q0 + wid * 32;
    const bf16* Kh = Kg + rowbase * 1536 + h * DQK; const bf16* Vh = Vg + rowbase * 1024 + h * DV;
    LAS float* wsf = (LAS float*)(lds + AT_WS) + wid * 64;
    const int krow_ = lane >> 2, kpiece_ = (lane & 3) ^ (((krow_ >> 2) ^ krow_) & 3);
#define AT_DMA(t, s) do { \
        _Pragma("unroll") for (int i_ = 0; i_ < 3; ++i_) { const int c_ = wid + 8 * i_; \
            glds16(Kh + (size_t)((t) * 64 + 16 * (c_ & 3) + krow_) * 1536 + (c_ >> 2) * 32 + kpiece_ * 8, lds + AT_K + (s) * AT_KSLOT + c_ * 1024); } \
        _Pragma("unroll") for (int i_ = 0; i_ < 2; ++i_) { const int c_ = wid + 8 * i_; \
            glds16(Vh + (size_t)((t) * 64 + 16 * (c_ & 3) + (lane >> 2)) * 1024 + (c_ >> 2) * 32 + (lane & 3) * 8, lds + AT_V + (s) * AT_VSLOT + c_ * 1024); } } while (0)
    AT_DMA(0, 0);
    bf16x8 qr[12];
    { const bf16* qp = Qg + (rowbase + qw0 + r32) * 1536 + h * DQK + hi * 8;
#pragma unroll
      for (int d0 = 0; d0 < 12; ++d0) qr[d0] = *(const GAS bf16x8*)(qp + d0 * 16); }
    float m_run = 0.f, l_run = 0.f; f32x16 o[4];
#pragma unroll
    for (int d = 0; d < 4; ++d)
#pragma unroll
        for (int r = 0; r < 16; ++r) o[d][r] = 0.f;
    const int vlane = tr_att_base(lane);
    const int kfr_ = r32 & 15, kfrag_ = (r32 >> 4) * 1024 + kfr_ * 64 + ((hi ^ (((kfr_ >> 2) ^ kfr_) & 3)) << 4), kfx_ = ((kfrag_ ^ 32) - kfrag_);
    ATP_DECL();
    for (int t = 0; t < NT; ++t) {
        const int s = t & 1;
        ATP(0);
        asm volatile("s_waitcnt vmcnt(0)" ::: "memory"); SBARRIER();
        if (t + 1 < NT) AT_DMA(t + 1, s ^ 1);
        ATP(1);
        const int kbase = t * 64;
        if (kbase <= qw0 + 31) {
            f32x16 p0, p1;
            cldsp kb = lds + AT_K + s * AT_KSLOT + kfrag_;
#pragma unroll
            for (int r = 0; r < 16; ++r) { p0[r] = 0.f; p1[r] = 0.f; }
#define KFA(d) (kb + ((d) >> 1) * 4096 + (((d) & 1) ? kfx_ : 0))
            bf16x8 ka0 = *(const LAS bf16x8*)(KFA(0)), ka1 = *(const LAS bf16x8*)(KFA(0) + 2048), kb0 = *(const LAS bf16x8*)(KFA(1)), kb1 = *(const LAS bf16x8*)(KFA(1) + 2048);
#pragma unroll
            for (int d0 = 0; d0 < 12; ++d0) {
                bf16x8 kc0 = ka0, kc1 = ka1;
                if (d0 + 2 < 12) { kc0 = *(const LAS bf16x8*)(KFA(d0 + 2)); kc1 = *(const LAS bf16x8*)(KFA(d0 + 2) + 2048); }
                __builtin_amdgcn_sched_barrier(0);
                p0 = MFMA32(ka0, qr[d0], p0); p1 = MFMA32(ka1, qr[d0], p1);
                __builtin_amdgcn_sched_barrier(0);
                ka0 = kb0; ka1 = kb1; kb0 = kc0; kb1 = kc1;
            }
#undef KFA
            if (kbase + 63 > qw0) {
                const int qi = qw0 + r32; const float NEG = -__builtin_inff();
#pragma unroll
                for (int r = 0; r < 16; ++r) { const int kv = kbase + crow(r, hi); if (kv > qi) p0[r] = NEG; if (kv + 32 > qi) p1[r] = NEG; }
            }
            asm volatile("s_nop 15\n\ts_nop 7" : "+v"(p0), "+v"(p1));
            float mx;
            { float xa = max3f(p0[0], p0[1], p1[0]), xb = max3f(p0[2], p0[3], p1[1]); xa = max3f(xa, p1[2], p1[3]);
#pragma unroll
              for (int r = 4; r < 16; r += 4) { xa = max3f(xa, p0[r], p0[r + 1]); xb = max3f(xb, p0[r + 2], p0[r + 3]); xa = max3f(xa, p1[r], p1[r + 1]); xb = max3f(xb, p1[r + 2], p1[r + 3]); }
              mx = max2f(xa, xb); }
            { const auto sw_ = __builtin_amdgcn_permlane32_swap(__float_as_uint(mx), __float_as_uint(mx), false, false); mx = max2f(__uint_as_float(sw_[0]), __uint_as_float(sw_[1])); }
            asm volatile("" : "+v"(mx)); ATP(2);
            cldsp vb = lds + AT_V + s * AT_VSLOT + vlane;
            s16x4 vpre[4]; vpre[0] = trrd(vb); vpre[1] = trrd(vb + 512); vpre[2] = trrd(vb + 1024); vpre[3] = trrd(vb + 1024 + 512);
            const bool first = (t == 0);
            if (first || !__all(mx - m_run <= 8.0f)) {
                const float mn = first ? mx : fmaxf(m_run, mx);
                if (!first) { const float alpha = __builtin_amdgcn_exp2f(m_run - mn); l_run *= alpha;
                    if (hi == 0) wsf[r32] = alpha;
                    asm volatile("s_waitcnt lgkmcnt(0)" ::: "memory");
#pragma unroll
                    for (int r = 0; r < 16; ++r) { const float al = wsf[crow(r, hi)];
#pragma unroll
                        for (int d = 0; d < 4; ++d) o[d][r] *= al; } }
                m_run = mn;
            }
            float rs = 0.f;
#pragma unroll
            for (int r = 0; r < 16; ++r) { p0[r] = __builtin_amdgcn_exp2f(p0[r] - m_run); p1[r] = __builtin_amdgcn_exp2f(p1[r] - m_run); rs += p0[r] + p1[r]; }
            l_run += rs;
            bf16x8 pa[4]; pa[0] = pack8f(p0, 0); pa[1] = pack8f(p0, 8); pa[2] = pack8f(p1, 0); pa[3] = pack8f(p1, 8);
            ATP(3);
            { s16x4 c0 = vpre[0], c1 = vpre[1], c2 = vpre[2], c3 = vpre[3];
#pragma unroll
              for (int st = 0; st < 8; ++st) { const int d0 = st >> 1, k2 = (st & 1) * 2;
                s16x4 n0 = c0, n1 = c1, n2 = c2, n3 = c3;
                if (st + 1 < 8) { const int dn = (st + 1) >> 1, kn = ((st + 1) & 1) * 2; cldsp q = vb + (dn * 4 + kn) * 1024; n0 = trrd(q); n1 = trrd(q + 512); n2 = trrd(q + 1024); n3 = trrd(q + 1024 + 512); }
                __builtin_amdgcn_sched_barrier(0);
                o[d0] = MFMA32(pa[k2], MK8(c0, c1), o[d0]); o[d0] = MFMA32(pa[k2 + 1], MK8(c2, c3), o[d0]);
                __builtin_amdgcn_sched_barrier(0);
                c0 = n0; c1 = n1; c2 = n2; c3 = n3; } }
        }
    }
    ATP(0); ATP_END();
    l_run += __shfl_xor(l_run, 32);
    if (hi == 0) wsf[32 + r32] = l_run;
    asm volatile("s_waitcnt lgkmcnt(0)" ::: "memory");
    bf16* Ow = Og + (rowbase + qw0) * DM + h * DV;
#pragma unroll
    for (int r = 0; r < 16; ++r) { const int orow = crow(r, hi); const float rl = 1.0f / wsf[32 + orow];
#pragma unroll
        for (int d0 = 0; d0 < 4; ++d0) { const float v = o[d0][r] * rl; const float vn = __shfl_xor(v, 1);
            if ((r32 & 1) == 0) *(GAS unsigned*)(Ow + (size_t)orow * DM + d0 * 32 + r32) = cvtpk(v, vn); } }
    asm volatile("s_waitcnt lgkmcnt(0)" ::: "memory"); SBARRIER();
#undef AT_DMA
}

constexpr int RT_K = 0, RT_V = 32768, RT_S = 65536, RT_O = 0, RT_OSTRIDE = 132;
static_assert(RT_S + 32768 <= RING_BYTES && RT_O + 128 * RT_OSTRIDE * 4 + 1024 <= RING_BYTES, "retention LDS");
__device__ __forceinline__ void ret_state_unit(const bf16* RK, const bf16* RV, float* U, int bh, int c, float lg2g, ldsp lds, int tid) {
    const int lane = tid & 63, r32 = lane & 31, hi = lane >> 5; const int wid = __builtin_amdgcn_readfirstlane(tid >> 6);
    const int b = bh >> 3, h = bh & 7; const size_t row0 = (size_t)b * SEQ + (size_t)c * RCH;
#pragma unroll
    for (int i = 0; i < 4; ++i) { const int ch = wid * 4 + i, cb = ch >> 3, ks = ch & 7; const size_t tok = row0 + 16 * ks + (lane >> 2); const int col = h * 128 + cb * 32 + (lane & 3) * 8;
        glds16(RK + tok * 1024 + col, lds + RT_K + ch * 1024);
        const v4u w = *(const GAS v4u*)(RV + tok * 1024 + col); const float z = __builtin_amdgcn_exp2f(lg2g * (float)(127 - (16 * ks + (lane >> 2))));
        v4u o; o.x = cvtpk(bf_lo(w.x) * z, bf_hi(w.x) * z); o.y = cvtpk(bf_lo(w.y) * z, bf_hi(w.y) * z); o.z = cvtpk(bf_lo(w.z) * z, bf_hi(w.z) * z); o.w = cvtpk(bf_lo(w.w) * z, bf_hi(w.w) * z);
        *(LAS v4u*)(lds + RT_V + ch * 1024 + lane * 16) = o; }
    asm volatile("s_waitcnt vmcnt(0) lgkmcnt(0)" ::: "memory"); SBARRIER();
    const int dkb = wid >> 1, dvb0 = (wid & 1) * 2; const int nb = tr_nat_base(lane);
    f32x16 acc[2];
#pragma unroll
    for (int r = 0; r < 16; ++r) { acc[0][r] = 0.f; acc[1][r] = 0.f; }
#pragma unroll
    for (int ks = 0; ks < 8; ++ks) { cldsp ka = lds + RT_K + (dkb * 8 + ks) * 1024 + nb; const s16x4 al = trrd(ka), ah = trrd(ka + 256); const bf16x8 A = MK8(al, ah);
#pragma unroll
        for (int j = 0; j < 2; ++j) { cldsp vb = lds + RT_V + ((dvb0 + j) * 8 + ks) * 1024 + nb; const s16x4 bl = trrd(vb), bh2 = trrd(vb + 256); acc[j] = MFMA32(A, MK8(bl, bh2), acc[j]); } }
    float* Uu = U + ((size_t)bh * NCH + c) * 16384;
#pragma unroll
    for (int j = 0; j < 2; ++j)
#pragma unroll
        for (int r = 0; r < 16; ++r) Uu[(dkb * 32 + crow(r, hi)) * 128 + (dvb0 + j) * 32 + r32] = acc[j][r];
    asm volatile("s_waitcnt lgkmcnt(0)" ::: "memory"); SBARRIER();
}
__device__ __forceinline__ void ret_scan(const float* U, bf16* S, cargs_t a, int gtid, int nthr) {
    for (int it = gtid; it < 16 * 8192; it += nthr) { const int bh = it >> 13, e2 = it & 8191; const float g = __builtin_amdgcn_exp2f(128.0f * a->lg2g[bh & 7]);
        const float* up = U + (size_t)bh * NCH * 16384 + e2 * 2; bf16* sp = S + (size_t)bh * NCH * 16384 + e2 * 2; float s0 = 0.f, s1 = 0.f;
#pragma unroll 8
        for (int c = 0; c < NCH; ++c) { *(GAS unsigned*)(sp + (size_t)c * 16384) = cvtpk(s0, s1); const f32x2 u = *(const GAS f32x2*)(up + (size_t)c * 16384); s0 = s0 * g + u.x; s1 = s1 * g + u.y; } }
}
__device__ __forceinline__ void ret_out_unit(const bf16* RQ, const bf16* RK, const bf16* RV, const bf16* RG, const bf16* S, bf16* MIX, int bh, int c, float lg2g, ldsp lds, int tid) {
    const int lane = tid & 63, r32 = lane & 31, hi = lane >> 5; const int wid = __builtin_amdgcn_readfirstlane(tid >> 6);
    const int b = bh >> 3, h = bh & 7; const size_t row0 = (size_t)b * SEQ + (size_t)c * RCH;
    const int rb = wid & 3, dh = wid >> 2;
    const bf16* Ss = S + ((size_t)bh * NCH + c) * 16384;
#pragma unroll
    for (int i = 0; i < 4; ++i) { const int id = wid * 4 + i;
        glds16(RK + (row0 + (id & 1) * 64 + lane) * 1024 + h * 128 + (id >> 1) * 8, lds + RT_K + id * 1024);
        const int cb = id >> 3, ks = id & 7;
        glds16(RV + (row0 + 16 * ks + (lane >> 2)) * 1024 + h * 128 + cb * 32 + (lane & 3) * 8, lds + RT_V + id * 1024);
        glds16(Ss + (16 * ks + (lane >> 2)) * 128 + cb * 32 + (lane & 3) * 8, lds + RT_S + id * 1024); }
    unsigned gate[16];
#pragma unroll
    for (int i = 0; i < 16; ++i) gate[i] = *(const GAS unsigned*)(RG + (row0 + wid * 16 + i) * 1024 + h * 128 + 2 * lane);
    bf16x8 qr[8];
    { const bf16* qp = RQ + (row0 + rb * 32 + r32) * 1024 + h * 128 + hi * 8;
#pragma unroll
      for (int d0 = 0; d0 < 8; ++d0) qr[d0] = *(const GAS bf16x8*)(qp + d0 * 16); }
    asm volatile("s_waitcnt vmcnt(0)" ::: "memory"); SBARRIER();
    f32x16 o[2];
#pragma unroll
    for (int r = 0; r < 16; ++r) { o[0][r] = 0.f; o[1][r] = 0.f; }
    { const int nb = tr_nat_base(lane);
#pragma unroll
      for (int ks = 0; ks < 8; ++ks)
#pragma unroll
          for (int j = 0; j < 2; ++j) { cldsp sb = lds + RT_S + ((dh * 2 + j) * 8 + ks) * 1024 + nb; const s16x4 bl = trrd(sb), bh2 = trrd(sb + 256); o[j] = MFMA32(qr[ks], MK8(bl, bh2), o[j]); }
#pragma unroll
      for (int r = 0; r < 16; ++r) { const float xi = __builtin_amdgcn_exp2f(lg2g * (float)(rb * 32 + crow(r, hi) + 1)); o[0][r] *= xi; o[1][r] *= xi; } }
    const int ab = tr_att_base(lane);
    for (int kb = 0; kb <= rb; ++kb) {
        f32x16 p;
#pragma unroll
        for (int r = 0; r < 16; ++r) p[r] = 0.f;
        cldsp kp = lds + RT_K + hi * 2048 + (kb * 32 + r32) * 16;
#pragma unroll
        for (int d0 = 0; d0 < 8; ++d0) { const bf16x8 ka = *(const LAS bf16x8*)(kp + d0 * 4096); p = MFMA32(ka, qr[d0], p); }
        const int qi = rb * 32 + r32;
#pragma unroll
        for (int r = 0; r < 16; ++r) { const int kj = kb * 32 + crow(r, hi); const float dcy = __builtin_amdgcn_exp2f(lg2g * (float)(qi - kj)); p[r] = (qi >= kj) ? p[r] * dcy : 0.f; }
        const bf16x8 pa0 = pack8f(p, 0), pa1 = pack8f(p, 8);
#pragma unroll
        for (int j = 0; j < 2; ++j) { cldsp vb = lds + RT_V + ((dh * 2 + j) * 8 + kb * 2) * 1024 + ab;
            { const s16x4 lo = trrd(vb), hh = trrd(vb + 512); o[j] = MFMA32(pa0, MK8(lo, hh), o[j]); }
            { const s16x4 lo = trrd(vb + 1024), hh = trrd(vb + 1024 + 512); o[j] = MFMA32(pa1, MK8(lo, hh), o[j]); } }
    }
    asm volatile("s_waitcnt lgkmcnt(0)" ::: "memory"); SBARRIER();
    LAS float* ob = (LAS float*)(lds + RT_O);
#pragma unroll
    for (int j = 0; j < 2; ++j)
#pragma unroll
        for (int r = 0; r < 16; ++r) ob[(rb * 32 + crow(r, hi)) * RT_OSTRIDE + (dh * 2 + j) * 32 + r32] = o[j][r];
    asm volatile("s_waitcnt lgkmcnt(0)" ::: "memory"); SBARRIER();
    { const int srow = tid >> 2, sq = tid & 3; const LAS float* rp = ob + srow * RT_OSTRIDE + 16 * sq; float s1 = 0.f, s2 = 0.f;
#pragma unroll
      for (int j = 0; j < 2; ++j)
#pragma unroll
          for (int i = 0; i < 4; ++i) { const f32x4 v = *(const LAS f32x4*)(rp + 64 * j + 4 * i); s1 += (v.x + v.y) + (v.z + v.w); s2 += (v.x * v.x + v.y * v.y) + (v.z * v.z + v.w * v.w); }
      s1 += __builtin_bit_cast(float, __builtin_amdgcn_mov_dpp(__builtin_bit_cast(int, s1), 0xB1, 0xf, 0xf, true)); s2 += __builtin_bit_cast(float, __builtin_amdgcn_mov_dpp(__builtin_bit_cast(int, s2), 0xB1, 0xf, 0xf, true));
      s1 += __builtin_bit_cast(float, __builtin_amdgcn_mov_dpp(__builtin_bit_cast(int, s1), 0x4E, 0xf, 0xf, true)); s2 += __builtin_bit_cast(float, __builtin_amdgcn_mov_dpp(__builtin_bit_cast(int, s2), 0x4E, 0xf, 0xf, true));
      const float mu = s1 * (1.0f / 128.0f), var = fmaxf(s2 * (1.0f / 128.0f) - mu * mu, 0.f);
      if (sq == 0) *(LAS f32x2*)(ob + 128 * RT_OSTRIDE + 2 * srow) = (f32x2){mu, 1.0f / sqrtf(var + GN_EPS)}; }
    asm volatile("s_waitcnt lgkmcnt(0)" ::: "memory"); SBARRIER();
#pragma unroll
    for (int i = 0; i < 16; ++i) { const int rr = wid * 16 + i; const f32x2 v = *(const LAS f32x2*)(ob + rr * RT_OSTRIDE + 2 * lane); const f32x2 st = *(const LAS f32x2*)(ob + 128 * RT_OSTRIDE + 2 * rr);
        *(GAS unsigned*)(MIX + (row0 + rr) * DM + 1024 + h * 128 + 2 * lane) = cvtpk((v.x - st.x) * st.y * bf_lo(gate[i]), (v.y - st.x) * st.y * bf_hi(gate[i])); }
    asm volatile("s_waitcnt lgkmcnt(0)" ::: "memory"); SBARRIER();
}


#define PHASE_IDS() int tid = tid0; asm volatile("" : "+v"(tid)); int G = G0, bx = bx0; asm volatile("" : "+s"(G), "+s"(bx)); \
    const int lane = tid & 63; const int wave = __builtin_amdgcn_readfirstlane(tid >> 6); const int vcu = (G % 8 == 0) ? (bx % 8) * (G / 8) + bx / 8 : bx; (void)lane; (void)wave; (void)vcu
#define GW (vcu * NWAVES + wave)
#define NGW (G * NWAVES)
#define GTID (vcu * (NWAVES * 64) + tid)
#define NTHR (G * NWAVES * 64)
#ifndef PG_ALIGN
#define PG_ALIGN true
#endif
#define XBAR() xcd_barrier(bar)
#ifdef PROBE_SPAN
#ifndef PROBE_BLOCK
#define PROBE_BLOCK 0
#endif
#ifdef PROBE_CLK
#define PTIME() __builtin_readcyclecounter()
#else
#define PTIME() __builtin_amdgcn_s_memrealtime()
#endif
#ifdef PROBE_PRE
#define STAMP(k) do { if (tid0 == 0 && bx0 == PROBE_BLOCK) { volatile LAS unsigned long long* ts_ = (volatile LAS unsigned long long*)(lds + LDSCTL_OFF + 64); if ((k) == PROBE_SPAN) ts_[0] = PTIME(); } } while (0)
#define STAMP_PRE(k) do { if (tid0 == 0 && bx0 == PROBE_BLOCK) { volatile LAS unsigned long long* ts_ = (volatile LAS unsigned long long*)(lds + LDSCTL_OFF + 64); if ((k) == PROBE_SPAN + 1) ts_[1] += PTIME() - ts_[0]; } } while (0)
#else
#define STAMP(k) do { if (tid0 == 0 && bx0 == PROBE_BLOCK) { volatile LAS unsigned long long* ts_ = (volatile LAS unsigned long long*)(lds + LDSCTL_OFF + 64); const unsigned long long t_ = PTIME(); \
    if ((k) == PROBE_SPAN) ts_[0] = t_; if ((k) == PROBE_SPAN + 1) ts_[1] += t_ - ts_[0]; } } while (0)
#define STAMP_PRE(k) do { } while (0)
#endif
#else
#define STAMP(k) do { } while (0)
#define STAMP_PRE(k) do { } while (0)
#endif
template <int l> __device__ __forceinline__ void layer_body(const int tid0, const int G0, const int bx0, const ldsp lds, const XcdBarrier& bar) {
    STAMP(0);
#ifdef PROBE_IDLE
    { const unsigned long long t0_ = __builtin_amdgcn_s_memrealtime(); while (__builtin_amdgcn_s_memrealtime() - t0_ < (unsigned long long)(PROBE_IDLE) * 100ull) __builtin_amdgcn_s_sleep(32); }
#endif
    { PHASE_IDS(); cargs_t a = get_args(); unsigned char* ws = a->ws; unsigned char* wb = ws + WS_W + (size_t)(l & 1) * W_STRIDE;
      pg8::Gemm g{(bf16*)(ws + WS_XB), (bf16*)(wb + WO_WIN), M, IN_PAD, DM}; pg8::StaticOrder S; S.init(M, IN_PAD, G, bx);
      pg8::Unit u0_; const int pm0_ = S.next(0, u0_) ? u0_.pm : 0; fill_rtab((const float*)(ws + WS_XSS2), pm0_, lds, tid);
      pg8::EpiIn E{(const float*)(ws + WS_XSS2), (bf16*)(ws + WS_CQ), (bf16*)(ws + WS_CKV), (float*)(ws + WS_CQSS), (float*)(ws + WS_CKVSS), (bf16*)(ws + WS_K), (const float*)(ws + WS_C64), (const float*)(ws + WS_S64),
                   (bf16*)(ws + WS_RQ), (bf16*)(ws + WS_RK), (bf16*)(ws + WS_RV), (bf16*)(ws + WS_RG), (const float*)(ws + WS_C128), (const float*)(ws + WS_S128), (const LAS float*)(lds + RTAB_OFF), pm0_};
      pg8::gemm_phase<pg8::EpiIn, pg8::StaticOrder, PG_ALIGN, true>(lds + RING_OFF, g, S, E); }
    STAMP_PRE(1); XBAR(); STAMP(1);
    { PHASE_IDS(); cargs_t a = get_args(); unsigned char* ws = a->ws; unsigned char* wb = ws + WS_W + (size_t)(l & 1) * W_STRIDE;
      pg8::Gemm g{(bf16*)(ws + WS_CQ), (bf16*)(wb + WO_WUQ), M, 1536, QLORA}; pg8::StaticOrder S; S.init(M, 1536, G, bx);
      pg8::EpiQ E{(const float*)(ws + WS_CQSS), (bf16*)(ws + WS_Q), (const float*)(ws + WS_C64), (const float*)(ws + WS_S64), QSCALE};
      pg8::gemm_phase<pg8::EpiQ, pg8::StaticOrder, PG_ALIGN, true>(lds + RING_OFF, g, S, E); }
    __syncthreads();
    { PHASE_IDS(); cargs_t a = get_args(); unsigned char* ws = a->ws; unsigned char* wb = ws + WS_W + (size_t)(l & 1) * W_STRIDE;
      pg8::Gemm g{(bf16*)(ws + WS_CKV), (bf16*)(wb + WO_WUKV), M, 2048, KVLORA}; pg8::StaticOrder S; S.init(M, 2048, G, bx);
      pg8::EpiKV E{(const float*)(ws + WS_CKVSS), (bf16*)(ws + WS_K), (bf16*)(ws + WS_V)};
      pg8::gemm_phase<pg8::EpiKV, pg8::StaticOrder, PG_ALIGN, true>(lds + RING_OFF, g, S, E); }
    __syncthreads();
    { PHASE_IDS(); cargs_t a = get_args(); unsigned char* ws = a->ws;
      for (int u = vcu; u < 16 * NCH; u += G) ret_state_unit((const bf16*)(ws + WS_RK), (const bf16*)(ws + WS_RV), (float*)(ws + WS_U), u >> 6, u & 63, a->lg2g[(u >> 6) & 7], lds + RING_OFF, tid); }
    STAMP_PRE(2); XBAR(); STAMP(2);
    { PHASE_IDS(); cargs_t a = get_args(); unsigned char* ws = a->ws;
      for (int u = vcu; u < 256; u += G) { const int bh = u >> 4, x = u & 15;
        attn_unit((const bf16*)(ws + WS_Q), (const bf16*)(ws + WS_K), (const bf16*)(ws + WS_V), (bf16*)(ws + WS_MIX), bh >> 3, bh & 7, 31 - x, lds + RING_OFF, tid);
        attn_unit((const bf16*)(ws + WS_Q), (const bf16*)(ws + WS_K), (const bf16*)(ws + WS_V), (bf16*)(ws + WS_MIX), bh >> 3, bh & 7, x, lds + RING_OFF, tid); } }
    { PHASE_IDS(); cargs_t a = get_args(); unsigned char* ws = a->ws; ret_scan((const float*)(ws + WS_U), (bf16*)(ws + WS_S), a, GTID, NTHR); }
    if (l + 1 < DEPTH) { PHASE_IDS(); cargs_t a = get_args(); __syncthreads(); convert_weights<true>(a, l + 1, lds, GW, NGW, wave, lane, GTID, NTHR, (unsigned*)((gu32*)(a->ws + WS_CTL) + CW_WQ + l * 64)); }
    STAMP_PRE(3); XBAR(); STAMP(3);
    { PHASE_IDS(); cargs_t a = get_args(); unsigned char* ws = a->ws;
      for (int u = vcu; u < 16 * NCH; u += G) ret_out_unit((const bf16*)(ws + WS_RQ), (const bf16*)(ws + WS_RK), (const bf16*)(ws + WS_RV), (const bf16*)(ws + WS_RG), (const bf16*)(ws + WS_S), (bf16*)(ws + WS_MIX),
                                                          u >> 6, u & 63, a->lg2g[(u >> 6) & 7], lds + RING_OFF, tid); }
    { PHASE_IDS(); cargs_t a = get_args(); bf16* mix = (bf16*)(a->ws + WS_MIX);
      { int m = GW; for (; m + 3 * NGW < M; m += 4 * NGW) attn_norm_rows<4>(mix, m, NGW, lane); for (; m < M; m += NGW) attn_norm_rows<1>(mix, m, NGW, lane); } }
    STAMP_PRE(4); XBAR(); STAMP(4);
    { PHASE_IDS(); cargs_t a = get_args(); unsigned char* ws = a->ws; unsigned char* wb = ws + WS_W + (size_t)(l & 1) * W_STRIDE;
      pg8::Gemm g{(bf16*)(ws + WS_MIX), (bf16*)(wb + WO_WO), M, DM, DM}; pg8::StaticOrder S; S.init(M, DM, G, bx);
      typedef pg8::EpiResT<false, true> EpiR; EpiR E{(l == 0) ? a->x : (const float*)a->out, a->out, (bf16*)(ws + WS_XB), (float*)(ws + WS_XSS), nullptr, nullptr, -1};
      pg8::gemm_phase<EpiR, pg8::StaticOrder, PG_ALIGN, true>(lds + RING_OFF, g, S, E); }
    STAMP_PRE(5); XBAR(); STAMP(5);
    { PHASE_IDS(); cargs_t a = get_args(); unsigned char* ws = a->ws; unsigned char* wb = ws + WS_W + (size_t)(l & 1) * W_STRIDE;
      pg8::Gemm g{(bf16*)(ws + WS_XB), (bf16*)(wb + WO_WUP), M, FF, DM}; AlignedOrder S; S.init(M, FF, G, bx);
      pg8::EpiRelu2 E{(bf16*)(ws + WS_UF), FF};
      pg8::gemm_phase<pg8::EpiRelu2, AlignedOrder, PG_ALIGN, true>(lds + RING_OFF, g, S, E); }
    STAMP_PRE(6); XBAR(); STAMP(6);
    { PHASE_IDS(); cargs_t a = get_args(); unsigned char* ws = a->ws; unsigned char* wb = ws + WS_W + (size_t)(l & 1) * W_STRIDE;
      pg8::Gemm g{(bf16*)(ws + WS_UF), (bf16*)(wb + WO_WDN), M, DM, FF}; pg8::StaticOrder S; S.init(M, DM, G, bx);
      pg8::Unit u0_; const int pm0_ = S.next(0, u0_) ? u0_.pm : 0; fill_rtab((const float*)(ws + WS_XSS), pm0_, lds, tid);
      typedef pg8::EpiResT<true, (l + 1 < DEPTH)> EpiR; EpiR E{a->out, a->out, (bf16*)(ws + WS_XB), (float*)(ws + WS_XSS2), (const float*)(ws + WS_XSS), (const LAS float*)(lds + RTAB_OFF), pm0_};
      pg8::gemm_phase<EpiR, pg8::StaticOrder, PG_ALIGN, true>(lds + RING_OFF, g, S, E); }
    STAMP_PRE(7); XBAR(); STAMP(7);
}

__global__ void __launch_bounds__(NWAVES * 64, 2) fwd_kernel(Args args_in_kernarg) {
    extern __shared__ __attribute__((aligned(16))) unsigned char lds_raw[];
    const ldsp lds = (ldsp)lds_raw;
    volatile LAS unsigned* MISC = (volatile LAS unsigned*)(lds + MISC_OFF);
    const int tid0 = threadIdx.x; const int G0 = gridDim.x, bx0 = blockIdx.x;
    for (int u = tid0; u < (LDS_BYTES - LDSCTL_OFF) / 4; u += NWAVES * 64) ((LAS unsigned*)(lds + LDSCTL_OFF))[u] = 0u;
    __syncthreads();
    XcdBarrier bar;
    { PHASE_IDS(); cargs_t a = get_args(); bar = xcd_barrier_post((unsigned*)((gu32*)(a->ws + WS_CTL) + CW_BAR), MISC + 8); }
    { PHASE_IDS(); cargs_t a = get_args();
      rope_tables(a, GTID, NTHR);
      convert_weights<false>(a, 0, lds, GW, NGW, wave, lane, GTID, NTHR, nullptr);
      const float* x = a->x; bf16* XB = (bf16*)(a->ws + WS_XB); float* XSS = (float*)(a->ws + WS_XSS2);
      { int m = GW; for (; m + NGW < M; m += 2 * NGW) prep_rows<2>(x, XB, XSS, m, NGW, lane); for (; m < M; m += NGW) prep_rows<1>(x, XB, XSS, m, NGW, lane); } }
    XBAR();

    layer_body<0>(tid0, G0, bx0, lds, bar);
    layer_body<1>(tid0, G0, bx0, lds, bar);
    layer_body<2>(tid0, G0, bx0, lds, bar);
    layer_body<3>(tid0, G0, bx0, lds, bar);
    { PHASE_IDS(); cargs_t a = get_args(); float* xo = a->out; const float* g = a->final_norm; const float* XSS = (const float*)(a->ws + WS_XSS2);
      { int m = GW; for (; m + NGW < M; m += 2 * NGW) rms_rows_final<2>(xo, XSS, g, m, NGW, lane); for (; m < M; m += NGW) rms_rows_final<1>(xo, XSS, g, m, NGW, lane); } }
#if defined(PROBE_ATT) || defined(PROBE_R3)
    if (tid0 == 0 && bx0 == 0) { volatile LAS unsigned long long* q_ = (volatile LAS unsigned long long*)(lds + LDSCTL_OFF + 80); const unsigned long long T_ = q_[0] / 3ull, t0_ = __builtin_amdgcn_s_memrealtime();
        while (__builtin_amdgcn_s_memrealtime() - t0_ < T_) __builtin_amdgcn_s_sleep(8); }
#endif
#ifdef PROBE_SPAN
    if (tid0 == 0 && bx0 == PROBE_BLOCK) { volatile LAS unsigned long long* ts_ = (volatile LAS unsigned long long*)(lds + LDSCTL_OFF + 64);
#ifdef PROBE_CLK
        const unsigned long long T_ = ts_[1] / 3ull,
#else
        const unsigned long long T_ = ts_[1] * 8ull,
#endif
        t0_ = __builtin_amdgcn_s_memrealtime();
        while (__builtin_amdgcn_s_memrealtime() - t0_ < T_) __builtin_amdgcn_s_sleep(8); }
#endif
}

extern "C" void kernel_launch(void* const* d_in, const int* in_sizes, int n_in, void* d_out, int out_size, void* d_ws, size_t ws_size, hipStream_t stream) {
    static int grid = 0;
    if (grid == 0) {
        if (n_in != 15 || in_sizes[0] != M * DM || out_size != M * DM || ws_size < WS_END) { fprintf(stderr, "kernel_launch: unexpected shapes (n_in %d, in0 %d, out %d, ws %zu, need %zu); nothing launched\n", n_in, n_in > 0 ? in_sizes[0] : -1, out_size, ws_size, (size_t)WS_END); grid = -1; return; }
        int dev = 0, cus = 0, per_cu = 0;
        if (hipGetDevice(&dev) != hipSuccess || hipDeviceGetAttribute(&cus, hipDeviceAttributeMultiprocessorCount, dev) != hipSuccess) { fprintf(stderr, "kernel_launch: device query failed\n"); grid = -1; return; }
        if (hipFuncSetAttribute((const void*)fwd_kernel, hipFuncAttributeMaxDynamicSharedMemorySize, LDS_BYTES) != hipSuccess) { fprintf(stderr, "kernel_launch: hipFuncSetAttribute failed\n"); grid = -1; return; }
        if (hipOccupancyMaxActiveBlocksPerMultiprocessor(&per_cu, (const void*)fwd_kernel, NWAVES * 64, LDS_BYTES) != hipSuccess || per_cu < 1)
            fprintf(stderr, "kernel_launch: note: occupancy query reports %d workgroups per CU\n", per_cu);
        (void)hipGetLastError();
        grid = cus;
    }
    if (grid < 0) return;
    if (hipMemsetAsync((char*)d_ws + WS_CTL, 0, CTL_ZERO_BYTES, stream) != hipSuccess) { fprintf(stderr, "kernel_launch: hipMemsetAsync failed\n"); return; }
    Args a{};
    a.x = (const float*)d_in[0]; a.pos = (const int*)d_in[1]; a.attn_norm = (const float*)d_in[2]; a.w_in = (const float*)d_in[3]; a.q_norm = (const float*)d_in[4]; a.kv_norm = (const float*)d_in[5];
    a.w_uq = (const float*)d_in[6]; a.w_ukv = (const float*)d_in[7]; a.beta_attn = (const float*)d_in[8]; a.beta_ret = (const float*)d_in[9]; a.w_o = (const float*)d_in[10]; a.mlp_norm = (const float*)d_in[11];
    a.w_up = (const float*)d_in[12]; a.w_down = (const float*)d_in[13]; a.final_norm = (const float*)d_in[14];
    a.out = (float*)d_out; a.ws = (unsigned char*)d_ws;
    for (int j = 0; j < 32; ++j) a.invf64[j] = pow(10000.0, -(double)(2 * j) / 64.0);
    for (int j = 0; j < 64; ++j) a.invf128[j] = pow(10000.0, -(double)(2 * j) / 128.0);
    for (int h = 0; h < 8; ++h) a.lg2g[h] = (float)(log1p(-exp2(-5.0 - (double)h)) / log(2.0));
    hipLaunchKernelGGL(fwd_kernel, dim3(grid), dim3(NWAVES * 64), LDS_BYTES, stream, a);
    const hipError_t le = hipPeekAtLastError();
    if (le != hipSuccess) fprintf(stderr, "kernel_launch: launch failed: %s\n", hipGetErrorName(le));
}
```

```cpp
#include <hip/hip_runtime.h>
#include <cstdio>
#include <cstdint>
#include <cmath>
namespace pg8 {
#define PG8_LAS __attribute__((address_space(3)))
typedef unsigned short bf16_t;
typedef short bf16x8 __attribute__((ext_vector_type(8)));
typedef float f32x4 __attribute__((ext_vector_type(4)));
typedef unsigned u32x4 __attribute__((ext_vector_type(4)));
constexpr int BM = 256, BK = 64, HALF = 128, HTB = HALF * BK * 2  , STAGE_BYTES = 8 * HTB, NXCD = 8, WGM = 8;

__host__ __device__ __forceinline__ int lds_byte(int r, int c) { const int st = (r >> 4) * 2 + (c >> 5), rr = r & 15, cc = c & 31, ob = rr * 64 + cc * 2; return st * 1024 + (ob ^ (((ob >> 9) & 1) << 5)); }
__host__ __device__ __forceinline__ void stage_rc(int b, int& R, int& C) { const int st = b / 1024, sb = b % 1024, swz = sb ^ (((sb >> 9) & 1) << 5); R = (st >> 1) * 16 + swz / 64; C = (st & 1) * 32 + (swz % 64) / 2; }
__host__ __device__ __forceinline__ int perm32(int rho) { const int n = rho >> 4, i = rho & 15; return 8 * (i >> 2) + 4 * n + (i & 3); }

struct Unit { int pm, pn; };
struct Gemm { const bf16_t* A; const bf16_t* Bt; int M, N, K; };

struct StaticOrder {
    int nM, nN, nwg, G, c;
    __host__ __device__ void init(int M, int N, int G_, int c_) { nM = M / BM; nN = N / BM; nwg = nM * nN; G = G_; c = c_; }
    __host__ __device__ bool next(int i, Unit& u) const {
        const long L = (long)i * G + c; if (L >= nwg) return false;
        int wgid = (int)L; { const int q = nwg / NXCD, r = nwg % NXCD, xcd = wgid % NXCD, off = wgid / NXCD; wgid = (xcd < r ? xcd * (q + 1) : r * (q + 1) + (xcd - r) * q) + off; }
        const int nig = WGM * nN, gid = wgid / nig, fm = gid * WGM, gsz = (nM - fm) < WGM ? (nM - fm) : WGM;
        u.pm = fm + ((wgid % nig) % gsz); u.pn = (wgid % nig) / gsz; return true;
    }
    __device__ __forceinline__ void a_ready(const Unit&) const {}
    __device__ __forceinline__ void done(const Unit&) const {}
};

__device__ __forceinline__ unsigned cvt_pk_bf16(float lo, float hi) { unsigned r; asm volatile("v_cvt_pk_bf16_f32 %0, %1, %2" : "=v"(r) : "v"(lo), "v"(hi)); return r; }
typedef float f32x2 __attribute__((ext_vector_type(2)));
__device__ __forceinline__ f32x2 gelu_pk(f32x2 v) {
    const f32x2 av = __builtin_elementwise_abs(v), d = av * 0.2316418882f + 1.0f;
    f32x2 t; t.x = __builtin_amdgcn_rcpf(d.x); t.y = __builtin_amdgcn_rcpf(d.y);
    f32x2 q = t * 0.5307027145f + (-0.7265760135f); q = q * t + 0.7107068705f; q = q * t + (-0.142248368f); q = q * t + 0.127414796f; q = q * t;
    const f32x2 s = (v * v) * (-0.72134752044f);
    f32x2 e; e.x = __builtin_amdgcn_exp2f(s.x); e.y = __builtin_amdgcn_exp2f(s.y);
    const f32x2 m = v * (q * e), r = v - m;
    f32x2 o; o.x = v.x < 0.f ? m.x : r.x; o.y = v.y < 0.f ? m.y : r.y; return o;
}

template <int ACT  > struct EpiBf16 {
    static constexpr bool PERM = true, AFTER_DRAIN = false; static_assert(ACT == 0 || ACT == 1, "EpiBf16: ACT is 0 (none) or 1 (gelu_pk)");
    bf16_t* O; int ldc; const float* bias; int split_cols; size_t split_stride; float scale0;
    __device__ __forceinline__ void operator()(const f32x4 (&acc)[2][2][4][2], const Unit& u, int wr, int wc, int fr, int fq) const {
        const int row0 = u.pm * BM + wr * 64 + fr; int colt = u.pn * BM; bf16_t* base = O;
        float sc = 1.f; if (split_cols) { const int t = colt / split_cols; base += (size_t)t * split_stride; colt -= t * split_cols; if (t == 0) sc = scale0; }
        const int col0 = colt + wc * 32 + 8 * fq, bcol0 = u.pn * BM + wc * 32 + 8 * fq;
        f32x4 bv[2][2];
#pragma unroll
        for (int bj = 0; bj < 2; ++bj)
#pragma unroll
            for (int n = 0; n < 2; ++n) bv[bj][n] = bias ? *(const f32x4*)(bias + bcol0 + bj * HALF + 4 * n) : (f32x4){0.f, 0.f, 0.f, 0.f};
#pragma unroll
        for (int ai = 0; ai < 2; ++ai)
#pragma unroll
            for (int m = 0; m < 4; ++m) { bf16_t* rowp = base + (size_t)(row0 + ai * HALF + m * 16) * ldc + col0;
#pragma unroll
                for (int bj = 0; bj < 2; ++bj) { f32x4 v0 = acc[ai][bj][m][0] + bv[bj][0], v1 = acc[ai][bj][m][1] + bv[bj][1];
                    if (ACT == 1) { f32x2 a = gelu_pk((f32x2){v0[0], v0[1]}), b = gelu_pk((f32x2){v0[2], v0[3]}), c = gelu_pk((f32x2){v1[0], v1[1]}), d = gelu_pk((f32x2){v1[2], v1[3]});
                        v0 = (f32x4){a.x, a.y, b.x, b.y}; v1 = (f32x4){c.x, c.y, d.x, d.y}; }
                    v0 = v0 * sc; v1 = v1 * sc; u32x4 w; w.x = cvt_pk_bf16(v0[0], v0[1]); w.y = cvt_pk_bf16(v0[2], v0[3]); w.z = cvt_pk_bf16(v1[0], v1[1]); w.w = cvt_pk_bf16(v1[2], v1[3]);
                    *(u32x4*)(rowp + bj * HALF) = w; } }
    }
};

struct PanelStats {
    unsigned* xbuf;
    unsigned* cnt;
    unsigned* tmo;
    int ntn; float eps;
    unsigned code;
    __device__ __forceinline__ bool run(const f32x4 (&v)[2][2][4][2], const Unit& u, int wr, int wc, int fr, int fq, PG8_LAS unsigned char* lds, int wid, int lane) const {
        typedef float f32x2v __attribute__((ext_vector_type(2)));
        PG8_LAS f32x2v* P = (PG8_LAS f32x2v*)lds;
        PG8_LAS f32x2v* S = (PG8_LAS f32x2v*)(lds + 8192);
        PG8_LAS unsigned* flag = (PG8_LAS unsigned*)(lds + 8192 + 2048);
#pragma unroll
        for (int ai = 0; ai < 2; ++ai)
#pragma unroll
            for (int m = 0; m < 4; ++m) {
                float s = 0.f;
#pragma unroll
                for (int bj = 0; bj < 2; ++bj)
#pragma unroll
                    for (int n = 0; n < 2; ++n) { const f32x4 x = v[ai][bj][m][n]; s += (x[0] + x[1]) + (x[2] + x[3]); }
                s += __shfl_xor(s, 16); s += __shfl_xor(s, 32);
                const float mw = s * (1.0f / 64.0f); float q = 0.f;
#pragma unroll
                for (int bj = 0; bj < 2; ++bj)
#pragma unroll
                    for (int n = 0; n < 2; ++n) { const f32x4 d = v[ai][bj][m][n] - mw; q += (d[0] * d[0] + d[1] * d[1]) + (d[2] * d[2] + d[3] * d[3]); }
                q += __shfl_xor(q, 16); q += __shfl_xor(q, 32);
                if (fq == 0) P[(ai * HALF + wr * 64 + m * 16 + fr) * 4 + wc] = (f32x2v){mw, q};
            }
        asm volatile("s_waitcnt lgkmcnt(0)" ::: "memory"); __builtin_amdgcn_s_barrier(); asm volatile("" ::: "memory");
#if defined(BROKEN_EXCHANGE_NO_WAIT)
#warning BROKEN CONTROL BUILD: the row-statistics exchange does not wait; results are wrong by design
        if (blockIdx.x >= 64) { const long long t0_ = clock64(); while (clock64() - t0_ < 60000) __builtin_amdgcn_s_sleep(8); }
#endif
        const int row = wid * 32 + (lane & 31);
        if (lane < 32) {
            const f32x2v a = P[row * 4 + 0], b = P[row * 4 + 1], c = P[row * 4 + 2], d = P[row * 4 + 3];
            const float mt = (a.x + b.x + c.x + d.x) * 0.25f;
            const float da = a.x - mt, db = b.x - mt, dc = c.x - mt, dd = d.x - mt;
            const float m2 = (a.y + b.y) + (c.y + d.y) + 64.0f * ((da * da + db * db) + (dc * dc + dd * dd));
            unsigned long long* slot = (unsigned long long*)xbuf + ((size_t)(u.pm * BM + row) * 4 + u.pn);
            __hip_atomic_store(slot, ((unsigned long long)__float_as_uint(m2) << 32) | __float_as_uint(mt), __ATOMIC_RELAXED, __HIP_MEMORY_SCOPE_AGENT);
        }
        asm volatile("s_waitcnt vmcnt(0)" ::: "memory");
        if (lane == 0) __hip_atomic_fetch_add(cnt + 64 * u.pm, 1u, __ATOMIC_RELAXED, __HIP_MEMORY_SCOPE_AGENT);
        if (wid == 0) {
            bool dead = false; const unsigned long long t0 = __builtin_amdgcn_s_memrealtime(); const unsigned want = 8u * (unsigned)ntn;
            for (;;) {
#if defined(BROKEN_EXCHANGE_NO_WAIT)
                break;
#endif
                if ((unsigned)__builtin_amdgcn_readfirstlane(__hip_atomic_load(cnt + 64 * u.pm, __ATOMIC_RELAXED, __HIP_MEMORY_SCOPE_AGENT)) >= want) break;
                if (__builtin_amdgcn_s_memrealtime() - t0 > 2000000ull) {
                    if (lane == 0) { unsigned expect = 0u; __hip_atomic_compare_exchange_strong(tmo + 1, &expect, code | (unsigned)(u.pm & 0xff), __ATOMIC_RELAXED, __ATOMIC_RELAXED, __HIP_MEMORY_SCOPE_AGENT);
                                     __hip_atomic_store(tmo, 1u, __ATOMIC_RELAXED, __HIP_MEMORY_SCOPE_AGENT); }
                    dead = true; break; }
                __builtin_amdgcn_s_sleep(2);
            }
            __builtin_amdgcn_fence(__ATOMIC_ACQUIRE, "agent");
            if (lane == 0) flag[0] = dead ? 1u : 0u;
        }
        asm volatile("s_waitcnt vmcnt(0) lgkmcnt(0)" ::: "memory"); __builtin_amdgcn_s_barrier(); asm volatile("" ::: "memory");
        const bool bad = flag[0] != 0u;
        if (lane < 32) {
            const unsigned long long* slot = (const unsigned long long*)xbuf + (size_t)(u.pm * BM + row) * 4; float mt[4], m2[4]; float ms = 0.f;
#pragma unroll
            for (int t = 0; t < 4; ++t) { if (t < ntn) { const unsigned long long w = __hip_atomic_load(slot + t, __ATOMIC_RELAXED, __HIP_MEMORY_SCOPE_AGENT); mt[t] = __uint_as_float((unsigned)w); m2[t] = __uint_as_float((unsigned)(w >> 32)); } else { mt[t] = 0.f; m2[t] = 0.f; } ms += mt[t]; }
            const float mean = ms / (float)ntn; float q = 0.f;
#pragma unroll
            for (int t = 0; t < 4; ++t) if (t < ntn) { const float dm = mt[t] - mean; q += m2[t] + 256.0f * dm * dm; }
            S[row] = (f32x2v){mean, 1.0f / sqrtf(q / (256.0f * (float)ntn) + eps)};
        }
        asm volatile("s_waitcnt lgkmcnt(0)" ::: "memory"); __builtin_amdgcn_s_barrier(); asm volatile("" ::: "memory");
        return bad;
    }
};
struct EpiLnRes {
    static constexpr bool PERM = false, AFTER_DRAIN = true;
    const float* base; float* out; int ldc; const float* bias; PanelStats st; unsigned poison;
    __device__ __forceinline__ void fused(f32x4 (&acc)[2][2][4][2], const Unit& u, int wr, int wc, int fr, int fq, PG8_LAS unsigned char* lds, int wid, int lane) const {
        typedef float f32x2v __attribute__((ext_vector_type(2)));
        const PG8_LAS f32x2v* S = (const PG8_LAS f32x2v*)(lds + 8192);
        const int col0 = u.pn * BM + wc * 32 + 4 * fq;
#pragma unroll
        for (int bj = 0; bj < 2; ++bj)
#pragma unroll
            for (int n = 0; n < 2; ++n) { const f32x4 bv = bias ? *(const f32x4*)(bias + col0 + bj * HALF + n * 16) : (f32x4){0.f, 0.f, 0.f, 0.f};
#pragma unroll
                for (int ai = 0; ai < 2; ++ai)
#pragma unroll
                    for (int m = 0; m < 4; ++m) acc[ai][bj][m][n] += bv; }
        f32x4 pre[4][2][2];
#pragma unroll
        for (int m = 0; m < 4; ++m) { const size_t off = (size_t)(u.pm * BM + wr * 64 + m * 16 + fr) * ldc + col0;
#pragma unroll
            for (int bj = 0; bj < 2; ++bj)
#pragma unroll
                for (int n = 0; n < 2; ++n) pre[m][bj][n] = *(const f32x4*)(base + off + bj * HALF + n * 16); }
        const bool bad = st.run(acc, u, wr, wc, fr, fq, lds, wid, lane) || poison != 0u;
        const float qnan = __builtin_nanf("");
#pragma unroll
        for (int ai = 0; ai < 2; ++ai)
#pragma unroll
            for (int m = 0; m < 4; ++m) { const int r = ai * HALF + wr * 64 + m * 16 + fr; const f32x2v sr = S[r]; const size_t off = (size_t)(u.pm * BM + r) * ldc + col0;
#pragma unroll
                for (int bj = 0; bj < 2; ++bj)
#pragma unroll
                    for (int n = 0; n < 2; ++n) { const f32x4 bs = ai == 0 ? pre[m][bj][n] : *(const f32x4*)(base + off + bj * HALF + n * 16); f32x4 o = bs + (acc[ai][bj][m][n] - sr.x) * sr.y;
                        if (bad) o = (f32x4){qnan, qnan, qnan, qnan}; *(f32x4*)(out + off + bj * HALF + n * 16) = o; }
                if (m & 1) asm volatile("" ::: "memory"); }
    }
};
struct EpiLnResLn {
    static constexpr bool PERM = false, AFTER_DRAIN = true;
    const float* base; float* out; bf16_t* xn; int ldc; const float* bias; PanelStats st1, st2; unsigned poison;
    __device__ __forceinline__ void fused(f32x4 (&acc)[2][2][4][2], const Unit& u, int wr, int wc, int fr, int fq, PG8_LAS unsigned char* lds, int wid, int lane) const {
        typedef float f32x2v __attribute__((ext_vector_type(2))); typedef unsigned u32x2v __attribute__((ext_vector_type(2)));
        const PG8_LAS f32x2v* S = (const PG8_LAS f32x2v*)(lds + 8192);
        const int col0 = u.pn * BM + wc * 32 + 4 * fq;
#pragma unroll
        for (int bj = 0; bj < 2; ++bj)
#pragma unroll
            for (int n = 0; n < 2; ++n) { const f32x4 bv = bias ? *(const f32x4*)(bias + col0 + bj * HALF + n * 16) : (f32x4){0.f, 0.f, 0.f, 0.f};
#pragma unroll
                for (int ai = 0; ai < 2; ++ai)
#pragma unroll
                    for (int m = 0; m < 4; ++m) acc[ai][bj][m][n] += bv; }
        bool bad = st1.run(acc, u, wr, wc, fr, fq, lds, wid, lane) || poison != 0u;
        const float qnan = __builtin_nanf("");
#pragma unroll
        for (int ai = 0; ai < 2; ++ai)
#pragma unroll
            for (int m = 0; m < 4; ++m) { const int r = ai * HALF + wr * 64 + m * 16 + fr; const f32x2v sr = S[r]; const size_t off = (size_t)(u.pm * BM + r) * ldc + col0;
#pragma unroll
                for (int bj = 0; bj < 2; ++bj)
#pragma unroll
                    for (int n = 0; n < 2; ++n) { const f32x4 bs = *(const f32x4*)(base + off + bj * HALF + n * 16); acc[ai][bj][m][n] = bs + (acc[ai][bj][m][n] - sr.x) * sr.y; }
                asm volatile("" : "+v"(acc[ai][0][m][0]), "+v"(acc[ai][0][m][1]), "+v"(acc[ai][1][m][0]), "+v"(acc[ai][1][m][1]));
                if (m & 1) asm volatile("" ::: "memory"); }
        const bool bad1 = bad;
        bad = st2.run(acc, u, wr, wc, fr, fq, lds, wid, lane) || bad;
#pragma unroll
        for (int ai = 0; ai < 2; ++ai)
#pragma unroll
            for (int m = 0; m < 4; ++m) { const int r = ai * HALF + wr * 64 + m * 16 + fr; const f32x2v sr = S[r]; const size_t off = (size_t)(u.pm * BM + r) * ldc + col0;
#pragma unroll
                for (int bj = 0; bj < 2; ++bj)
#pragma unroll
                    for (int n = 0; n < 2; ++n) { const f32x4 x1 = acc[ai][bj][m][n]; *(f32x4*)(out + off + bj * HALF + n * 16) = bad1 ? (f32x4){qnan, qnan, qnan, qnan} : x1;
                        const f32x4 o = (x1 - sr.x) * sr.y; u32x2v w; w.x = cvt_pk_bf16(o[0], o[1]); w.y = cvt_pk_bf16(o[2], o[3]);
                        if (bad) { w.x = 0x7fc07fc0u; w.y = 0x7fc07fc0u; } *(u32x2v*)(xn + off + bj * HALF + n * 16) = w; }
                asm volatile("" ::: "memory"); }
    }
};

template <class Epi, class Sched, bool ALIGN_EPI = false, bool SP2 = false>
__device__ __forceinline__ void gemm_phase(PG8_LAS unsigned char* lds, const Gemm g, const Sched& S, const Epi& E) {
    int tid_l = threadIdx.x; asm volatile("" : "+v"(tid_l));
    const int tid = tid_l, wid = __builtin_amdgcn_readfirstlane(tid >> 6), lane = tid & 63, wr = wid >> 2, wc = wid & 3, fr = lane & 15, fq = lane >> 4;
    const int K = g.K, nt = K / BK;
    unsigned voffA[2], voffB[2];
#pragma unroll
    for (int i = 0; i < 2; ++i) { int R, C; stage_rc(tid * 16 + i * 8192, R, C); const int Rb = Epi::PERM ? ((R & ~31) + perm32(R & 31)) : R;
        voffA[i] = (unsigned)(R * K + C) * 2u; voffB[i] = (unsigned)(Rb * K + C) * 2u; }
    const size_t kstep = (size_t)(BK * 2);
    const size_t hstep = (size_t)HALF * K * 2;
    const size_t tstep = 2 * hstep;
    const unsigned ldsw = (unsigned)wid * 1024u;
    const int aoff = lds_byte(wr * 64 + fr, fq * 8), boff = lds_byte(wc * 32 + fr, fq * 8);
#define PG8_SA(b, h) (((b) * 2 + (h)) * HTB)
#define PG8_SB(b, h) ((4 + (b) * 2 + (h)) * HTB)
#define PG8_STAGE(bufoff, gbase, voff) do { _Pragma("unroll") for (int _i = 0; _i < 2; ++_i) \
        __builtin_amdgcn_global_load_lds((const unsigned*)((const char*)(gbase) + (voff)[_i]), (PG8_LAS unsigned*)(lds + (bufoff) + ldsw + _i * 8192), 16, 0, 0); } while (0)
#define PG8_LDA(dst, b, h) do { _Pragma("unroll") for (int m = 0; m < 4; ++m) _Pragma("unroll") for (int k = 0; k < 2; ++k) dst[m][k] = *(const PG8_LAS bf16x8*)(lds + PG8_SA(b, h) + aoff + m * 2048 + k * 1024); } while (0)
#define PG8_LDB(dst, b, h) do { _Pragma("unroll") for (int n = 0; n < 2; ++n) _Pragma("unroll") for (int k = 0; k < 2; ++k) dst[n][k] = *(const PG8_LAS bf16x8*)(lds + PG8_SB(b, h) + boff + n * 2048 + k * 1024); } while (0)
#define PG8_MMA(ai, bj, At, Bt) do { __builtin_amdgcn_s_setprio(1); _Pragma("unroll") for (int m = 0; m < 4; ++m) _Pragma("unroll") for (int n = 0; n < 2; ++n) _Pragma("unroll") for (int k = 0; k < 2; ++k) \
        acc[ai][bj][m][n] = __builtin_amdgcn_mfma_f32_16x16x32_bf16(Bt[n][k], At[m][k], acc[ai][bj][m][n], 0, 0, 0); __builtin_amdgcn_s_setprio(0); } while (0)
#define PG8_WAIT_V(n) asm volatile("s_waitcnt vmcnt(" #n ")" ::: "memory")
#define PG8_WAIT_L(n) asm volatile("s_waitcnt lgkmcnt(" #n ")" ::: "memory")
#define PG8_BAR __builtin_amdgcn_s_barrier()
#define PG8_SCHED __builtin_amdgcn_sched_barrier(0)
    Unit cur, nxt; int ui = 0;
    if (!S.next(0, cur)) return;
    f32x4 acc[2][2][4][2];
#pragma unroll
    for (int a = 0; a < 2; ++a)
#pragma unroll
        for (int b = 0; b < 2; ++b)
#pragma unroll
            for (int m = 0; m < 4; ++m)
#pragma unroll
                for (int n = 0; n < 2; ++n) acc[a][b][m][n] = (f32x4){0.f, 0.f, 0.f, 0.f};
    bf16x8 At[4][2], B0[2][2], B1[2][2];
    const char* cA = (const char*)g.A + (size_t)cur.pm * tstep; const char* cB = (const char*)g.Bt + (size_t)cur.pn * tstep;
    S.a_ready(cur);
    if constexpr (SP2) {
        PG8_STAGE(PG8_SB(0, 0), cB, voffB); PG8_STAGE(PG8_SB(0, 1), cB + hstep, voffB); PG8_STAGE(PG8_SA(0, 0), cA, voffA); PG8_STAGE(PG8_SA(0, 1), cA + hstep, voffA);
        if (wr == 1) PG8_BAR;
        PG8_WAIT_V(2); PG8_BAR;
        PG8_STAGE(PG8_SB(1, 0), cB + kstep, voffB); PG8_STAGE(PG8_SA(1, 0), cA + kstep, voffA); PG8_STAGE(PG8_SB(1, 1), cB + hstep + kstep, voffB);
        PG8_WAIT_V(6); PG8_BAR;
    } else {
        PG8_STAGE(PG8_SB(0, 0), cB, voffB); PG8_STAGE(PG8_SA(0, 0), cA, voffA); PG8_STAGE(PG8_SB(0, 1), cB + hstep, voffB); PG8_STAGE(PG8_SA(0, 1), cA + hstep, voffA);
        if (wr == 1) PG8_BAR;
        PG8_WAIT_V(4); PG8_BAR;
        PG8_STAGE(PG8_SB(1, 0), cB + kstep, voffB); PG8_STAGE(PG8_SA(1, 0), cA + kstep, voffA); PG8_STAGE(PG8_SB(1, 1), cB + hstep + kstep, voffB);
        PG8_WAIT_V(6); PG8_BAR;
    }
    for (;;) {
        const bool has_next = S.next(ui + 1, nxt);
        const char* nA = has_next ? (const char*)g.A + (size_t)nxt.pm * tstep : cA; const char* nB = has_next ? (const char*)g.Bt + (size_t)nxt.pn * tstep : cB;
        for (int t = 0; t < nt; t += 2) {
            const bool last = (t == nt - 2);
            const char* a1 = cA + (size_t)(t + 1) * kstep;
            const char* a2 = last ? nA : cA + (size_t)(t + 2) * kstep; const char* b2 = last ? nB : cB + (size_t)(t + 2) * kstep;
            const char* a3 = a2 + kstep; const char* b3 = b2 + kstep;
            if (last && has_next) S.a_ready(nxt);
            if constexpr (SP2) {
            PG8_LDB(B0, 0, 0); PG8_LDB(B1, 0, 1); PG8_SCHED; PG8_LDA(At, 0, 0); PG8_STAGE(PG8_SA(1, 1), a1 + hstep, voffA);
            PG8_WAIT_V(8); PG8_WAIT_L(0); PG8_BAR; PG8_MMA(0, 0, At, B0); PG8_MMA(0, 1, At, B1); PG8_BAR; PG8_SCHED;
            PG8_LDA(At, 0, 1); PG8_STAGE(PG8_SB(0, 0), b2, voffB); PG8_STAGE(PG8_SB(0, 1), b2 + hstep, voffB); PG8_STAGE(PG8_SA(0, 0), a2, voffA);
            PG8_WAIT_V(8); PG8_WAIT_L(0); PG8_BAR; PG8_MMA(1, 0, At, B0); PG8_MMA(1, 1, At, B1); PG8_BAR; PG8_SCHED;
            PG8_LDB(B0, 1, 0); PG8_LDB(B1, 1, 1); PG8_SCHED; PG8_LDA(At, 1, 0); PG8_STAGE(PG8_SA(0, 1), a2 + hstep, voffA);
            PG8_WAIT_V(8); PG8_WAIT_L(0); PG8_BAR; PG8_MMA(0, 0, At, B0); PG8_MMA(0, 1, At, B1); PG8_BAR; PG8_SCHED;
            PG8_LDA(At, 1, 1); PG8_STAGE(PG8_SB(1, 0), b3, voffB); PG8_STAGE(PG8_SB(1, 1), b3 + hstep, voffB); PG8_STAGE(PG8_SA(1, 0), a3, voffA);
            PG8_WAIT_V(8); PG8_WAIT_L(0); PG8_BAR; PG8_MMA(1, 0, At, B0); PG8_MMA(1, 1, At, B1); PG8_BAR; PG8_SCHED;
            } else {
            PG8_LDB(B0, 0, 0); PG8_SCHED; PG8_LDA(At, 0, 0); PG8_STAGE(PG8_SA(1, 1), a1 + hstep, voffA);
            PG8_WAIT_L(8); PG8_BAR; PG8_WAIT_L(0); PG8_MMA(0, 0, At, B0); PG8_BAR; PG8_SCHED;
            PG8_LDB(B1, 0, 1); PG8_STAGE(PG8_SB(0, 0), b2, voffB);
            PG8_BAR; PG8_WAIT_L(0); PG8_MMA(0, 1, At, B1); PG8_BAR;
            PG8_LDA(At, 0, 1); PG8_STAGE(PG8_SA(0, 0), a2, voffA);
            PG8_BAR; PG8_WAIT_L(0); PG8_MMA(1, 0, At, B0); PG8_BAR; PG8_SCHED;
            PG8_STAGE(PG8_SB(0, 1), b2 + hstep, voffB);
            PG8_WAIT_V(6); PG8_BAR; PG8_MMA(1, 1, At, B1); PG8_BAR;
            PG8_LDB(B0, 1, 0); PG8_SCHED; PG8_LDA(At, 1, 0); PG8_STAGE(PG8_SA(0, 1), a2 + hstep, voffA);
            PG8_WAIT_L(8); PG8_BAR; PG8_WAIT_L(0); PG8_MMA(0, 0, At, B0); PG8_BAR; PG8_SCHED;
            PG8_LDB(B1, 1, 1); PG8_STAGE(PG8_SB(1, 0), b3, voffB);
            PG8_BAR; PG8_WAIT_L(0); PG8_MMA(0, 1, At, B1); PG8_BAR;
            PG8_LDA(At, 1, 1); PG8_STAGE(PG8_SA(1, 0), a3, voffA);
            PG8_BAR; PG8_WAIT_L(0); PG8_MMA(1, 0, At, B0); PG8_BAR; PG8_SCHED;
            PG8_STAGE(PG8_SB(1, 1), b3 + hstep, voffB);
            PG8_WAIT_V(6); PG8_BAR; PG8_MMA(1, 1, At, B1); PG8_BAR;
            }
        }
        if constexpr (ALIGN_EPI) { if (wr == 0) PG8_BAR; }
        if constexpr (!Epi::AFTER_DRAIN) { E(acc, cur, wr, wc, fr, fq); S.done(cur); }
        if (!has_next) break;
#pragma unroll
        for (int a = 0; a < 2; ++a)
#pragma unroll
            for (int b = 0; b < 2; ++b)
#pragma unroll
                for (int m = 0; m < 4; ++m)
#pragma unroll
                    for (int n = 0; n < 2; ++n) acc[a][b][m][n] = (f32x4){0.f, 0.f, 0.f, 0.f};
        cur = nxt; cA = nA; cB = nB; ++ui;
        if constexpr (ALIGN_EPI) { if (wr == 1) PG8_BAR; }
    }
    PG8_WAIT_V(0);
    if constexpr (!ALIGN_EPI) { if (wr == 0) PG8_BAR; }
    PG8_BAR;
    if constexpr (Epi::AFTER_DRAIN) { E.fused(acc, cur, wr, wc, fr, fq, lds, wid, lane); S.done(cur); }
#undef PG8_SA
#undef PG8_SB
#undef PG8_STAGE
#undef PG8_LDA
#undef PG8_LDB
#undef PG8_MMA
#undef PG8_WAIT_V
#undef PG8_WAIT_L
#undef PG8_BAR
#undef PG8_SCHED
}
}
namespace pg8 {
__device__ __forceinline__ u32x4 pack8bf(const f32x4 a, const f32x4 b) { u32x4 w; w.x = cvt_pk_bf16(a[0], a[1]); w.y = cvt_pk_bf16(a[2], a[3]); w.z = cvt_pk_bf16(b[0], b[1]); w.w = cvt_pk_bf16(b[2], b[3]); return w; }
__device__ __forceinline__ void rope8(f32x4& v0, f32x4& v1, const f32x4 cs, const f32x4 sn) {
    float a, b;
    a = v0[0]; b = v0[1]; v0[0] = a * cs[0] - b * sn[0]; v0[1] = b * cs[0] + a * sn[0];
    a = v0[2]; b = v0[3]; v0[2] = a * cs[1] - b * sn[1]; v0[3] = b * cs[1] + a * sn[1];
    a = v1[0]; b = v1[1]; v1[0] = a * cs[2] - b * sn[2]; v1[1] = b * cs[2] + a * sn[2];
    a = v1[2]; b = v1[3]; v1[2] = a * cs[3] - b * sn[3]; v1[3] = b * cs[3] + a * sn[3];
}
__device__ __forceinline__ float silu_f(float x) { return x * __builtin_amdgcn_rcpf(1.0f + __builtin_amdgcn_exp2f(-1.4426950408889634f * x)); }
__device__ __forceinline__ float sq4(const f32x4 v) { return (v[0] * v[0] + v[1] * v[1]) + (v[2] * v[2] + v[3] * v[3]); }
template <int NP> __device__ __forceinline__ float row_scale(const float* SS, size_t row, float inv_n, float eps, int fq) {
    const float* p = SS + row * NP; float s;
    if constexpr (NP == 32) { const f32x4 a = *(const f32x4*)(p + fq * 8), b = *(const f32x4*)(p + fq * 8 + 4); s = ((a[0] + a[1]) + (a[2] + a[3])) + ((b[0] + b[1]) + (b[2] + b[3])); s += __shfl_xor(s, 16); s += __shfl_xor(s, 32); }
    else if constexpr (NP == 8) { const f32x4 a = *(const f32x4*)p, b = *(const f32x4*)(p + 4); s = ((a[0] + a[1]) + (a[2] + a[3])) + ((b[0] + b[1]) + (b[2] + b[3])); }
    else { const f32x4 a = *(const f32x4*)p; s = (a[0] + a[1]) + (a[2] + a[3]); }
    return 1.0f / sqrtf(s * inv_n + eps);
}

struct EpiIn {
    static constexpr bool PERM = true, AFTER_DRAIN = false;
    const float* XSS; bf16_t* CQ; bf16_t* CKV; float* CQSS; float* CKVSS; bf16_t* Kb; const float* c64; const float* s64;
    bf16_t* RQ; bf16_t* RK; bf16_t* RV; bf16_t* RG; const float* c128; const float* s128;
    const PG8_LAS float* rtab; int rpm;
    __device__ __forceinline__ void operator()(const f32x4 (&acc)[2][2][4][2], const Unit& u, int wr, int wc, int fr, int fq) const {
        const int pn = u.pn, row0 = u.pm * BM + wr * 64 + fr, cw = wc * 32 + 8 * fq;
#pragma unroll
        for (int ai = 0; ai < 2; ++ai) {
            float r4[4];
#pragma unroll
            for (int m = 0; m < 4; ++m) r4[m] = (u.pm == rpm) ? rtab[wr * 64 + fr + ai * HALF + m * 16] : row_scale<32>(XSS, (size_t)(row0 + ai * HALF + m * 16), 1.0f / 2048.0f, 1e-6f, fq);
            asm volatile("" : "+v"(r4[0]), "+v"(r4[1]), "+v"(r4[2]), "+v"(r4[3]));
            if (pn < 3) {
#pragma unroll
                for (int m = 0; m < 4; ++m) { const size_t row = (size_t)(row0 + ai * HALF + m * 16); const float r = r4[m];
                    const f32x4 a0 = acc[ai][0][m][0] * r, a1 = acc[ai][0][m][1] * r, b0 = acc[ai][1][m][0] * r, b1 = acc[ai][1][m][1] * r;
                    float s = (sq4(a0) + sq4(a1)) + (sq4(b0) + sq4(b1)); s += __shfl_xor(s, 16); s += __shfl_xor(s, 32);
                    if (pn < 2) { bf16_t* rp = CQ + row * 512 + pn * 256 + cw; *(u32x4*)rp = pack8bf(a0, a1); *(u32x4*)(rp + HALF) = pack8bf(b0, b1); if (fq == 0) CQSS[row * 8 + pn * 4 + wc] = s; }
                    else { bf16_t* rp = CKV + row * 256 + cw; *(u32x4*)rp = pack8bf(a0, a1); *(u32x4*)(rp + HALF) = pack8bf(b0, b1); if (fq == 0) CKVSS[row * 4 + wc] = s; } }
            } else if (pn == 3) {
                if (wc < 2) { const int j0 = cw >> 1;
#pragma unroll
                    for (int m = 0; m < 4; ++m) { const size_t row = (size_t)(row0 + ai * HALF + m * 16); const float r = r4[m];
                        const f32x4 cs = *(const f32x4*)(c64 + row * 32 + j0), sn = *(const f32x4*)(s64 + row * 32 + j0);
                        f32x4 v0 = acc[ai][0][m][0] * r, v1 = acc[ai][0][m][1] * r; rope8(v0, v1, cs, sn); const u32x4 w = pack8bf(v0, v1);
                        bf16_t* kp = Kb + row * 1536 + 128 + cw;
#pragma unroll
                        for (int h = 0; h < 8; ++h) *(u32x4*)(kp + h * 192) = w; } }
            } else if (pn < 12) {
                bf16_t* T = pn < 8 ? RQ : RK; const float sc = pn < 8 ? 0.08838834764831845f : 1.0f; const int ct = ((pn - 4) & 3) * 256 + cw, j0 = cw >> 1;
#pragma unroll
                for (int m = 0; m < 4; ++m) { const size_t row = (size_t)(row0 + ai * HALF + m * 16); const float r = r4[m] * sc;
                    const f32x4 cs = *(const f32x4*)(c128 + row * 64 + j0), sn = *(const f32x4*)(s128 + row * 64 + j0);
#pragma unroll
                    for (int bj = 0; bj < 2; ++bj) { f32x4 v0 = acc[ai][bj][m][0] * r, v1 = acc[ai][bj][m][1] * r; rope8(v0, v1, cs, sn);
                        *(u32x4*)(T + row * 1024 + ct + bj * HALF) = pack8bf(v0, v1); } }
            } else if (pn < 16) {
                const int ct = (pn - 12) * 256 + cw;
#pragma unroll
                for (int m = 0; m < 4; ++m) { const size_t row = (size_t)(row0 + ai * HALF + m * 16); bf16_t* rp = RV + row * 1024 + ct; const float r = r4[m];
#pragma unroll
                    for (int bj = 0; bj < 2; ++bj) *(u32x4*)(rp + bj * HALF) = pack8bf(acc[ai][bj][m][0] * r, acc[ai][bj][m][1] * r); }
            } else {
                const int ct = (pn - 16) * 256 + cw;
#pragma unroll
                for (int m = 0; m < 4; ++m) { const size_t row = (size_t)(row0 + ai * HALF + m * 16); bf16_t* rp = RG + row * 1024 + ct; const float r = r4[m];
#pragma unroll
                    for (int bj = 0; bj < 2; ++bj) { f32x4 v0 = acc[ai][bj][m][0] * r, v1 = acc[ai][bj][m][1] * r;
#pragma unroll
                        for (int e = 0; e < 4; ++e) { v0[e] = silu_f(v0[e]); v1[e] = silu_f(v1[e]); }
                        *(u32x4*)(rp + bj * HALF) = pack8bf(v0, v1); } }
            }
        }
    }
};
struct EpiQ {
    static constexpr bool PERM = true, AFTER_DRAIN = false;
    const float* CQSS; bf16_t* Q; const float* c64; const float* s64; float sc;
    __device__ __forceinline__ void operator()(const f32x4 (&acc)[2][2][4][2], const Unit& u, int wr, int wc, int fr, int fq) const {
        const int row0 = u.pm * BM + wr * 64 + fr, cw = wc * 32 + 8 * fq;
#pragma unroll
        for (int ai = 0; ai < 2; ++ai)
#pragma unroll
            for (int m = 0; m < 4; ++m) { const size_t row = (size_t)(row0 + ai * HALF + m * 16); const float r = row_scale<8>(CQSS, row, 1.0f / 512.0f, 1e-6f, fq) * sc;
#pragma unroll
                for (int bj = 0; bj < 2; ++bj) { const int c0 = u.pn * 256 + bj * HALF + cw, dd = c0 % 192; const bool rp = dd >= 128; const int j0 = rp ? ((dd - 128) >> 1) : 0;
                    f32x4 v0 = acc[ai][bj][m][0] * r, v1 = acc[ai][bj][m][1] * r;
                    if (rp) { const f32x4 cs = *(const f32x4*)(c64 + row * 32 + j0), sn = *(const f32x4*)(s64 + row * 32 + j0); rope8(v0, v1, cs, sn); }
                    *(u32x4*)(Q + row * 1536 + c0) = pack8bf(v0, v1); } }
    }
};
struct EpiKV {
    static constexpr bool PERM = true, AFTER_DRAIN = false;
    const float* CKVSS; bf16_t* K; bf16_t* V;
    __device__ __forceinline__ void operator()(const f32x4 (&acc)[2][2][4][2], const Unit& u, int wr, int wc, int fr, int fq) const {
        const int row0 = u.pm * BM + wr * 64 + fr, cw = wc * 32 + 8 * fq;
#pragma unroll
        for (int ai = 0; ai < 2; ++ai)
#pragma unroll
            for (int m = 0; m < 4; ++m) { const size_t row = (size_t)(row0 + ai * HALF + m * 16); const float r = row_scale<4>(CKVSS, row, 1.0f / 256.0f, 1e-6f, fq);
                *(u32x4*)(K + row * 1536 + u.pn * 192 + cw) = pack8bf(acc[ai][0][m][0] * r, acc[ai][0][m][1] * r);
                *(u32x4*)(V + row * 1024 + u.pn * 128 + cw) = pack8bf(acc[ai][1][m][0] * r, acc[ai][1][m][1] * r); }
    }
};
template <bool SCALE2  , bool WRITE_XB>
struct EpiResT {
    static constexpr bool PERM = true, AFTER_DRAIN = false;
    const float* base; float* out; bf16_t* XB; float* XSS; const float* RS; const PG8_LAS float* rtab; int rpm;
    __device__ __forceinline__ void operator()(const f32x4 (&acc)[2][2][4][2], const Unit& u, int wr, int wc, int fr, int fq) const {
        const int row0 = u.pm * BM + wr * 64 + fr, c0 = u.pn * BM + wc * 32 + 8 * fq;
#pragma unroll
        for (int ai = 0; ai < 2; ++ai) {
            float r2[4];
#pragma unroll
            for (int m = 0; m < 4; ++m) { if constexpr (SCALE2) { const float r = (u.pm == rpm) ? rtab[wr * 64 + fr + ai * HALF + m * 16] : row_scale<32>(RS, (size_t)(row0 + ai * HALF + m * 16), 1.0f / 2048.0f, 1e-6f, fq); r2[m] = r * r; } else r2[m] = 1.0f; }
            if constexpr (SCALE2) asm volatile("" : "+v"(r2[0]), "+v"(r2[1]), "+v"(r2[2]), "+v"(r2[3]));
            f32x4 pre[4][4];
#pragma unroll
            for (int m = 0; m < 4; ++m) { const size_t off = (size_t)(row0 + ai * HALF + m * 16) * 2048 + c0;
                pre[m][0] = *(const f32x4*)(base + off); pre[m][1] = *(const f32x4*)(base + off + 4); pre[m][2] = *(const f32x4*)(base + off + HALF); pre[m][3] = *(const f32x4*)(base + off + HALF + 4); }
#pragma unroll
            for (int m = 0; m < 4; ++m) asm volatile("" : "+v"(pre[m][0]), "+v"(pre[m][1]), "+v"(pre[m][2]), "+v"(pre[m][3]));
#pragma unroll
            for (int m = 0; m < 4; ++m) { const size_t row = (size_t)(row0 + ai * HALF + m * 16); const size_t off = row * 2048 + c0;
                f32x4 a0, a1, b0, b1;
                if constexpr (SCALE2) { a0 = pre[m][0] + acc[ai][0][m][0] * r2[m]; a1 = pre[m][1] + acc[ai][0][m][1] * r2[m]; b0 = pre[m][2] + acc[ai][1][m][0] * r2[m]; b1 = pre[m][3] + acc[ai][1][m][1] * r2[m]; }
                else { a0 = pre[m][0] + acc[ai][0][m][0]; a1 = pre[m][1] + acc[ai][0][m][1]; b0 = pre[m][2] + acc[ai][1][m][0]; b1 = pre[m][3] + acc[ai][1][m][1]; }
                *(f32x4*)(out + off) = a0; *(f32x4*)(out + off + 4) = a1; *(f32x4*)(out + off + HALF) = b0; *(f32x4*)(out + off + HALF + 4) = b1;
                if constexpr (WRITE_XB) { *(u32x4*)(XB + off) = pack8bf(a0, a1); *(u32x4*)(XB + off + HALF) = pack8bf(b0, b1); }
                float s = (sq4(a0) + sq4(a1)) + (sq4(b0) + sq4(b1)); s += __shfl_xor(s, 16); s += __shfl_xor(s, 32);
                if (fq == 0) XSS[row * 32 + u.pn * 4 + wc] = s; }
        }
    }
};
struct EpiRelu2 {
    static constexpr bool PERM = true, AFTER_DRAIN = false;
    bf16_t* O; int ldc;
    __device__ __forceinline__ void operator()(const f32x4 (&acc)[2][2][4][2], const Unit& u, int wr, int wc, int fr, int fq) const {
        const int row0 = u.pm * BM + wr * 64 + fr, c0 = u.pn * BM + wc * 32 + 8 * fq;
#pragma unroll
        for (int ai = 0; ai < 2; ++ai)
#pragma unroll
            for (int m = 0; m < 4; ++m) { bf16_t* rp = O + (size_t)(row0 + ai * HALF + m * 16) * ldc + c0;
#pragma unroll
                for (int bj = 0; bj < 2; ++bj) { f32x4 v0 = acc[ai][bj][m][0], v1 = acc[ai][bj][m][1];
#pragma unroll
                    for (int e = 0; e < 4; ++e) { const float a = fmaxf(v0[e], 0.f), b = fmaxf(v1[e], 0.f); v0[e] = a * a; v1[e] = b * b; }
                    *(u32x4*)(rp + bj * HALF) = pack8bf(v0, v1); } }
    }
};
}
constexpr int NWAVES = 8;
constexpr int BATCH = 2, SEQ = 8192, DM = 2048, DEPTH = 4, M = BATCH * SEQ;
constexpr int NH = 8, QLORA = 512, KVLORA = 256, DQK = 192, DNOPE = 128, DROPE = 64, DV = 128, FF = 8192;
constexpr int IN_SRC = 4928, IN_PAD = 5120;
constexpr int RCH = 128, NCH = SEQ / RCH;
constexpr float NORM_EPS = 1e-6f, GN_EPS = 1e-6f;
constexpr float QSCALE = 0.07216878364870323f * 1.4426950408889634f;

constexpr size_t MiB = 1u << 20;
constexpr size_t WS_CTL = 0, CTL_ZERO_BYTES = 128 * 1024;
constexpr size_t WS_C64 = 2 * MiB, WS_S64 = 4 * MiB, WS_C128 = 6 * MiB, WS_S128 = 10 * MiB;
constexpr size_t WS_XSS = 14 * MiB;
constexpr size_t WS_W = 16 * MiB, W_STRIDE = 96 * MiB;
constexpr size_t WO_WIN = 0, WO_WUQ = 20 * MiB, WO_WUKV = 22 * MiB, WO_WO = 24 * MiB, WO_WUP = 32 * MiB, WO_WDN = 64 * MiB;
constexpr size_t WS_XB = 208 * MiB;
constexpr size_t WS_MIX = 272 * MiB;
constexpr size_t WS_CQSS = 336 * MiB, WS_CKVSS = 337 * MiB;
constexpr size_t WS_RQ = 338 * MiB, WS_RK = 370 * MiB, WS_RV = 402 * MiB, WS_RG = 434 * MiB;
constexpr size_t WS_CQ = 466 * MiB, WS_CKV = 482 * MiB;
constexpr size_t WS_Q = 490 * MiB, WS_K = 538 * MiB, WS_V = 586 * MiB;
constexpr size_t WS_U = 618 * MiB, WS_S = 682 * MiB;
constexpr size_t WS_UF = 338 * MiB;
constexpr size_t WS_XSS2 = 714 * MiB;
constexpr size_t WS_END = 716 * MiB;
static_assert(WS_UF + (size_t)M * FF * 2 <= WS_U && WS_S + (size_t)16 * 64 * 16384 * 2 <= WS_END && WS_U + (size_t)16 * 64 * 16384 * 4 <= WS_S, "d_ws map");
static_assert(WO_WIN + (size_t)IN_PAD * DM * 2 <= WO_WUQ && WO_WUQ + (size_t)1536 * 512 * 2 <= WO_WUKV && WO_WUKV + (size_t)2048 * 256 * 2 <= WO_WO && WO_WO + (size_t)DM * DM * 2 <= WO_WUP && WO_WUP + (size_t)FF * DM * 2 <= WO_WDN && WO_WDN + (size_t)FF * DM * 2 <= W_STRIDE && WS_W + 2 * W_STRIDE <= WS_XB, "weights map");
constexpr int CW_TMO = 0, CW_CODE = 1, CW_BAR = 4096;
constexpr int CW_AQ = 12288;
constexpr int CW_SRDY = 12544, CW_RQ = 12800;
constexpr int CW_WQ = 8192;
static_assert(CW_BAR + 3456 <= CW_WQ && (CW_WQ + 64 * DEPTH) <= CW_AQ && (CW_AQ + 64 * DEPTH) <= CW_SRDY && (CW_SRDY + 64 * DEPTH) <= CW_RQ && (CW_RQ + 64 * DEPTH) * 4 <= (int)CTL_ZERO_BYTES, "control words inside the per-call memset");

constexpr int RING_OFF = 0, RING_BYTES = 131072;
constexpr int LDSCTL_OFF = RING_BYTES, MISC_OFF = LDSCTL_OFF + 320;
constexpr int LDS_BYTES = 147456;
static_assert(MISC_OFF + 128 <= LDS_BYTES, "LDS map");

#define GAS __attribute__((address_space(1)))
#define LAS __attribute__((address_space(3)))
typedef unsigned short bf16;
typedef unsigned v4u __attribute__((ext_vector_type(4)));
typedef float f32x4 __attribute__((ext_vector_type(4)));
typedef short bf16x8 __attribute__((ext_vector_type(8)));
typedef GAS unsigned gu32;
typedef GAS unsigned long long gu64;
#define RLX_AGENT __ATOMIC_RELAXED, __HIP_MEMORY_SCOPE_AGENT
#define LDS_WAIT() asm volatile("s_waitcnt lgkmcnt(0)" ::: "memory")
#define VM_WAIT() asm volatile("s_waitcnt vmcnt(0)" ::: "memory")
__device__ __forceinline__ unsigned long long rt() { return __builtin_amdgcn_s_memrealtime(); }
__device__ __forceinline__ unsigned f2bf(float f) { unsigned u = __builtin_bit_cast(unsigned, f); return (u + 0x7fffu + ((u >> 16) & 1u)) >> 16; }
__device__ __forceinline__ unsigned pk2(float lo, float hi) { return f2bf(lo) | (f2bf(hi) << 16); }

#define XB_TMO      128
#define XB_XCNT(j)  (256  + 64 * (j))
#define XB_XSUB(j)  (1280 + 64 * (j))
#define XB_XGEN(j)  (2304 + 64 * (j))
#define XB_TOP      3328
#define XB_TOPGEN   3392
#define XCD_BAR_WORDS 3456
#define XB_SPIN_CAP (1u << 18)

__device__ __forceinline__ unsigned xb_ld(unsigned* p)              { return __hip_atomic_load(p, __ATOMIC_RELAXED, __HIP_MEMORY_SCOPE_AGENT); }
__device__ __forceinline__ unsigned xb_add(unsigned* p, unsigned v) { return __hip_atomic_fetch_add(p, v, __ATOMIC_RELAXED, __HIP_MEMORY_SCOPE_AGENT); }
__device__ __forceinline__ unsigned xb_xcc_id() { return (unsigned)__builtin_amdgcn_s_getreg((3 << 11) | 20) & 0xFu; }
#define XB_SPIN(cond, bar) do { unsigned _sp = 0; while (cond) { __builtin_amdgcn_s_sleep(1); \
    if ((++_sp & 255u) == 0u) { if (xb_ld(&(bar)[XB_TMO])) break; if (_sp > XB_SPIN_CAP) { atomicAdd(&(bar)[XB_TMO], 1u); break; } } } } while (0)

struct XcdBarrier {
    unsigned* bar; unsigned x;
    volatile LAS unsigned* st;
};

__device__ __forceinline__ XcdBarrier xcd_barrier_post(unsigned* bar, volatile LAS unsigned* st) {
    XcdBarrier b; b.bar = bar; b.x = xb_xcc_id(); b.st = st;
    if (threadIdx.x == 0) (void)xb_add(&bar[XB_XCNT(b.x)], 1u);
    return b;
}
__device__ __forceinline__ void xcd_barrier_complete(unsigned* bar, unsigned x, unsigned& nloc, unsigned& nx) {
    const unsigned G = gridDim.x * gridDim.y * gridDim.z;
    unsigned sum, cnt, mine, sp = 0u;
    for (;;) {
        sum = 0u; cnt = 0u; mine = 0u;
#pragma unroll
        for (unsigned j = 0; j < 16; ++j) { const unsigned c = xb_ld(&bar[XB_XCNT(j)]); sum += c; cnt += (c > 0u) ? 1u : 0u; mine = (j == x) ? c : mine; }
        if (sum == G) break;
        __builtin_amdgcn_s_sleep(1);
        if ((++sp & 255u) == 0u) { if (xb_ld(&bar[XB_TMO])) break; if (sp > XB_SPIN_CAP) { atomicAdd(&bar[XB_TMO], 1u); break; } }
    }
    nloc = mine > 0u ? mine : 1u; nx = cnt > 0u ? cnt : 1u;
}

__device__ __forceinline__ void xcd_barrier(const XcdBarrier& b) {
    asm volatile("s_waitcnt vmcnt(0)" ::: "memory");
    __syncthreads();
    if (threadIdx.x == 0) {
        unsigned* bar = b.bar;
        __builtin_amdgcn_s_waitcnt(0);
        unsigned nloc = b.st[0], nx = b.st[1];
        if (nloc == 0u) { xcd_barrier_complete(bar, b.x, nloc, nx); b.st[0] = nloc; b.st[1] = nx; }
        const unsigned old = xb_add(&bar[XB_XSUB(b.x)], 1u);
        const unsigned gen = old / nloc;
        if (old + 1u == (gen + 1u) * nloc) {
            __builtin_amdgcn_fence(__ATOMIC_RELEASE, "agent");
            asm volatile("s_waitcnt vmcnt(0)" ::: "memory");
            const unsigned og = xb_add(&bar[XB_TOP], 1u);
            const unsigned tg = og / nx;
            if (og + 1u == (tg + 1u) * nx) xb_add(&bar[XB_TOPGEN], 1u);
            else XB_SPIN(xb_ld(&bar[XB_TOPGEN]) == tg, bar);
            __builtin_amdgcn_fence(__ATOMIC_ACQUIRE, "agent");
            xb_add(&bar[XB_XGEN(b.x)], 1u);
            asm volatile("s_waitcnt vmcnt(0)" ::: "memory");
        } else {
            XB_SPIN(xb_ld(&bar[XB_XGEN(b.x)]) == gen, bar);
            __builtin_amdgcn_fence(__ATOMIC_ACQUIRE, "agent");
            asm volatile("s_waitcnt vmcnt(0)" ::: "memory");
        }
    }
    __syncthreads();
}

typedef short s16x4 __attribute__((ext_vector_type(4)));
typedef float f32x16 __attribute__((ext_vector_type(16)));
typedef float f32x2 __attribute__((ext_vector_type(2)));
typedef LAS unsigned char* ldsp;
typedef const LAS unsigned char* cldsp;
#define SBARRIER() do { __builtin_amdgcn_s_barrier(); asm volatile("" ::: "memory"); } while (0)
__device__ __forceinline__ float wave_sum(float v) {
#pragma unroll
    for (int o = 1; o < 64; o <<= 1) v += __shfl_xor(v, o);
    return v;
}
__device__ __forceinline__ unsigned cvtpk(float lo, float hi) { unsigned r; asm volatile("v_cvt_pk_bf16_f32 %0, %1, %2" : "=v"(r) : "v"(lo), "v"(hi)); return r; }
__device__ __forceinline__ float bf_lo(unsigned w) { return __builtin_bit_cast(float, w << 16); }
__device__ __forceinline__ float bf_hi(unsigned w) { return __builtin_bit_cast(float, w & 0xffff0000u); }
__device__ __forceinline__ int crow(int r, int hi) { return (r & 3) + 8 * (r >> 2) + 4 * hi; }
__device__ __forceinline__ void glds16(const void* g, ldsp l) { __builtin_amdgcn_global_load_lds((const unsigned*)g, (LAS unsigned*)l, 16, 0, 0); }
typedef short v4i16_t __attribute__((ext_vector_type(4)));
__device__ __forceinline__ s16x4 trrd(cldsp p) { return __builtin_bit_cast(s16x4, __builtin_amdgcn_ds_read_tr16_b64_v4i16((LAS v4i16_t*)p)); }
#define MK8(lo, hi) ((bf16x8){(lo)[0], (lo)[1], (lo)[2], (lo)[3], (hi)[0], (hi)[1], (hi)[2], (hi)[3]})
__device__ __forceinline__ bf16x8 pack8f(const f32x16& p, int b) {
    v4u w; w.x = cvtpk(p[b], p[b + 1]); w.y = cvtpk(p[b + 2], p[b + 3]); w.z = cvtpk(p[b + 4], p[b + 5]); w.w = cvtpk(p[b + 6], p[b + 7]); return __builtin_bit_cast(bf16x8, w);
}
#define MFMA32(a, b, c) __builtin_amdgcn_mfma_f32_32x32x16_bf16((a), (b), (c), 0, 0, 0)
__device__ __forceinline__ int tr_att_base(int lane) { return (4 * (lane >> 5) + ((lane & 15) >> 2)) * 64 + ((lane >> 4) & 1) * 32 + (lane & 3) * 8; }
__device__ __forceinline__ int tr_nat_base(int lane) { return (8 * (lane >> 5) + ((lane & 15) >> 2)) * 64 + ((lane >> 4) & 1) * 32 + (lane & 3) * 8; }

struct Args {
    const float* x; const int* pos; const float* attn_norm; const float* w_in; const float* q_norm; const float* kv_norm; const float* w_uq; const float* w_ukv;
    const float* beta_attn; const float* beta_ret; const float* w_o; const float* mlp_norm; const float* w_up; const float* w_down; const float* final_norm;
    float* out; unsigned char* ws;
    double invf64[32]; double invf128[64];
    float lg2g[8];
};
static_assert(sizeof(Args) == 17 * 8 + 96 * 8 + 32, "Args has no padding");
typedef const __attribute__((address_space(4))) Args* cargs_t;
__device__ __forceinline__ cargs_t get_args() { cargs_t p = (cargs_t)__builtin_amdgcn_kernarg_segment_ptr(); asm volatile("" : "+s"(p)); return p; }

__device__ __forceinline__ void sincos_d(double ang, float& s, float& c) {
    const double k = __builtin_rint(ang * 0.63661977236758134308);
    double y = __builtin_fma(-k, 1.57079632679489655800e+00, ang); y = __builtin_fma(-k, 6.12323399573676603587e-17, y);
    const double z = y * y;
    double sp = 1.0 / 6227020800.0; sp = sp * z - 1.0 / 39916800.0; sp = sp * z + 1.0 / 362880.0; sp = sp * z - 1.0 / 5040.0; sp = sp * z + 1.0 / 120.0; sp = sp * z - 1.0 / 6.0; sp = sp * z + 1.0; sp = sp * y;
    double cp = -1.0 / 87178291200.0; cp = cp * z + 1.0 / 479001600.0; cp = cp * z - 1.0 / 3628800.0; cp = cp * z + 1.0 / 40320.0; cp = cp * z - 1.0 / 720.0; cp = cp * z + 1.0 / 24.0; cp = cp * z - 0.5; cp = cp * z + 1.0;
    const int q = (int)((long long)k & 3);
    const double ss = (q == 0) ? sp : (q == 1) ? cp : (q == 2) ? -sp : -cp;
    const double cc = (q == 0) ? cp : (q == 1) ? -sp : (q == 2) ? -cp : sp;
    s = (float)ss; c = (float)cc;
}
__device__ __forceinline__ void rope_tables(cargs_t a, int gtid, int nthr) {
    unsigned char* ws = a->ws; const int* pos = a->pos;
    float* c64 = (float*)(ws + WS_C64); float* s64 = (float*)(ws + WS_S64); float* c128 = (float*)(ws + WS_C128); float* s128 = (float*)(ws + WS_S128);
    for (int i = gtid; i < M * 96; i += nthr) { const int m = i / 96, j = i - m * 96; const double p = (double)pos[m]; float s, c;
        if (j < 32) { sincos_d(p * a->invf64[j], s, c); c64[m * 32 + j] = c; s64[m * 32 + j] = s; }
        else { sincos_d(p * a->invf128[j - 32], s, c); c128[m * 64 + j - 32] = c; s128[m * 64 + j - 32] = s; } }
}
template <class Map, class Gain>
__device__ __forceinline__ void transpose_item(const float* W, int K, int N, bf16* WT, const Map& map, const Gain& gain, LAS float* scr, int item, int lane) {
    const int nblk = N / 32, kb = item / nblk, nb = item % nblk, k0 = 64 * kb, n0 = 32 * nb;
#pragma unroll 8
    for (int i = 0; i < 32; ++i) { const int kk = 2 * i + (lane >> 5); scr[kk * 33 + (lane & 31)] = W[(size_t)(k0 + kk) * N + n0 + (lane & 31)] * gain(k0 + kk); }
    LDS_WAIT(); asm volatile("" ::: "memory");
    const int c = lane & 7;
#pragma unroll
    for (int j = 0; j < 4; ++j) { const int n = (lane >> 3) + 8 * j; const LAS float* s = scr + (8 * c) * 33 + n;
        v4u o; o.x = pk2(s[0 * 33], s[1 * 33]); o.y = pk2(s[2 * 33], s[3 * 33]); o.z = pk2(s[4 * 33], s[5 * 33]); o.w = pk2(s[6 * 33], s[7 * 33]);
        *(GAS v4u*)(WT + (size_t)map(n0 + n) * K + k0 + 8 * c) = o; }
    LDS_WAIT(); asm volatile("" ::: "memory");
}
struct GainNone { __device__ __forceinline__ float operator()(int) const { return 1.0f; } };
struct GainVec { const float* g; __device__ __forceinline__ float operator()(int k) const { return g[k]; } };
struct GainVec2 { const float* g0; const float* g1; int split; __device__ __forceinline__ float operator()(int k) const { return k < split ? g0[k] : g1[k - split]; } };
struct MapId { __device__ __forceinline__ int operator()(int n) const { return n; } };
struct MapWin {
    __device__ __forceinline__ int operator()(int n) const {
        if (n < 768) return n;
        if (n < 832) { const int d = n - 768; return 768 + (d < 32 ? 2 * d : 2 * (d - 32) + 1); }
        if (n < 2880) { const int e = n - 832, g = e >> 7, d = e & 127; return 1024 + g * 128 + (d < 64 ? 2 * d : 2 * (d - 64) + 1); }
        return n + 192;
    }
};
struct MapWuq {
    __device__ __forceinline__ int operator()(int n) const { const int h = n / 192, d = n - h * 192; if (d < 128) return n; const int e = d - 128; return h * 192 + 128 + (e < 32 ? 2 * e : 2 * (e - 32) + 1); }
};
template <bool DYN>
__device__ __forceinline__ void convert_weights(cargs_t a, int l, ldsp lds, int gw, int ngw, int wave, int lane, int gtid, int nthr, unsigned* qctr) {
    unsigned char* wb = a->ws + WS_W + (size_t)(l & 1) * W_STRIDE;
    LAS float* scr = (LAS float*)(lds + RING_OFF + wave * 16384);
    bf16* Win = (bf16*)(wb + WO_WIN); bf16* Wuq = (bf16*)(wb + WO_WUQ); bf16* Wukv = (bf16*)(wb + WO_WUKV); bf16* Wo = (bf16*)(wb + WO_WO); bf16* Wup = (bf16*)(wb + WO_WUP); bf16* Wdn = (bf16*)(wb + WO_WDN);
    const float* w_in = a->w_in + (size_t)l * DM * IN_SRC; const float* w_uq = a->w_uq + (size_t)l * QLORA * 1536; const float* w_ukv = a->w_ukv + (size_t)l * KVLORA * 2048;
    const float* w_o = a->w_o + (size_t)l * DM * DM; const float* w_up = a->w_up + (size_t)l * DM * FF; const float* w_dn = a->w_down + (size_t)l * FF * DM;
    const GainVec g_in{a->attn_norm + l * DM}, g_uq{a->q_norm + l * QLORA}, g_ukv{a->kv_norm + l * KVLORA}, g_up{a->mlp_norm + l * DM}; const GainVec2 g_o{a->beta_attn + l * 1024, a->beta_ret + l * 1024, 1024};
    constexpr int I_IN = (DM / 64) * (IN_SRC / 32), I_UQ = (QLORA / 64) * (1536 / 32), I_UKV = (KVLORA / 64) * (2048 / 32), I_O = (DM / 64) * (DM / 32), I_UP = (DM / 64) * (FF / 32), I_DN = (FF / 64) * (DM / 32);
    constexpr int NITEMS = I_IN + I_UQ + I_UKV + I_O + I_UP + I_DN, CH = 16;
    GAS v4u* pz = (GAS v4u*)(Win + (size_t)832 * DM);
    for (int i = gtid; i < 192 * DM / 8; i += nthr) pz[i] = (v4u){0u, 0u, 0u, 0u};
    int it = DYN ? 0 : gw, it_end = 0;
    for (;;) {
        if constexpr (DYN) { if (it >= it_end) { unsigned c = 0u; if (lane == 0) c = __hip_atomic_fetch_add(qctr, 1u, __ATOMIC_RELAXED, __HIP_MEMORY_SCOPE_AGENT);
                it = (int)__builtin_amdgcn_readfirstlane(c) * CH; it_end = it + CH; if (it >= NITEMS) break; }
            if (it >= NITEMS) break; }
        else { if (it >= NITEMS) break; }
        int r = it;
        if (r < I_IN) transpose_item(w_in, DM, IN_SRC, Win, MapWin(), g_in, scr, r, lane);
        else if ((r -= I_IN) < I_UQ) transpose_item(w_uq, QLORA, 1536, Wuq, MapWuq(), g_uq, scr, r, lane);
        else if ((r -= I_UQ) < I_UKV) transpose_item(w_ukv, KVLORA, 2048, Wukv, MapId(), g_ukv, scr, r, lane);
        else if ((r -= I_UKV) < I_O) transpose_item(w_o, DM, DM, Wo, MapId(), g_o, scr, r, lane);
        else if ((r -= I_O) < I_UP) transpose_item(w_up, DM, FF, Wup, MapId(), g_up, scr, r, lane);
        else { r -= I_UP; transpose_item(w_dn, FF, DM, Wdn, MapId(), GainNone(), scr, r, lane); }
        it += DYN ? 1 : ngw;
    }
}
constexpr int RTAB_OFF = LDSCTL_OFF + 1024;
static_assert(RTAB_OFF + 1024 <= LDS_BYTES, "row-scale table inside the LDS allocation");
__device__ __forceinline__ void fill_rtab(const float* SS, int pm, ldsp lds, int tid) {
    if (tid < 256) { const GAS f32x4* p = (const GAS f32x4*)(SS + (size_t)(pm * 256 + tid) * 32); float s = 0.f;
#pragma unroll
        for (int j = 0; j < 8; ++j) { const f32x4 v = p[j]; s += (v.x + v.y) + (v.z + v.w); }
        ((LAS float*)(lds + RTAB_OFF))[tid] = 1.0f / sqrtf(s * (1.0f / DM) + NORM_EPS); }
    __syncthreads();
}
template <int NR> __device__ __forceinline__ void prep_rows(const float* x, bf16* XB, float* XSS, int row, int stride, int lane) {
    f32x4 v[NR][8]; float s[NR];
#pragma unroll
    for (int q = 0; q < NR; ++q) { const GAS f32x4* xr = (const GAS f32x4*)(x + (size_t)(row + q * stride) * DM) + lane;
#pragma unroll
        for (int j = 0; j < 8; ++j) v[q][j] = xr[64 * j]; }
#pragma unroll
    for (int q = 0; q < NR; ++q) { float t = 0.f;
#pragma unroll
        for (int j = 0; j < 8; ++j) t += (v[q][j].x * v[q][j].x + v[q][j].y * v[q][j].y) + (v[q][j].z * v[q][j].z + v[q][j].w * v[q][j].w);
        s[q] = wave_sum(t); }
#pragma unroll
    for (int q = 0; q < NR; ++q) { GAS unsigned long long* o8 = (GAS unsigned long long*)(XB + (size_t)(row + q * stride) * DM) + lane;
#pragma unroll
        for (int j = 0; j < 8; ++j) o8[64 * j] = (unsigned long long)cvtpk(v[q][j].x, v[q][j].y) | ((unsigned long long)cvtpk(v[q][j].z, v[q][j].w) << 32);
        if (lane < 32) XSS[(size_t)(row + q * stride) * 32 + lane] = (lane == 0) ? s[q] : 0.f; }
}
template <int NR> __device__ __forceinline__ void rms_rows_final(float* xo, const float* XSS, const float* g, int row, int stride, int lane) {
    f32x4 v[NR][8]; float r[NR]; const GAS f32x4* gr = (const GAS f32x4*)g + lane;
#pragma unroll
    for (int q = 0; q < NR; ++q) { const GAS f32x4* xr = (const GAS f32x4*)(xo + (size_t)(row + q * stride) * DM) + lane;
#pragma unroll
        for (int j = 0; j < 8; ++j) v[q][j] = xr[64 * j];
        r[q] = (lane < 32) ? XSS[(size_t)(row + q * stride) * 32 + lane] : 0.f; }
#pragma unroll
    for (int q = 0; q < NR; ++q) r[q] = 1.0f / sqrtf(wave_sum(r[q]) * (1.0f / DM) + NORM_EPS);
#pragma unroll
    for (int q = 0; q < NR; ++q) { GAS f32x4* xr = (GAS f32x4*)(xo + (size_t)(row + q * stride) * DM) + lane;
#pragma unroll
        for (int j = 0; j < 8; ++j) { const f32x4 gg = gr[64 * j]; const float rr = r[q]; xr[64 * j] = (f32x4){v[q][j].x * rr * gg.x, v[q][j].y * rr * gg.y, v[q][j].z * rr * gg.z, v[q][j].w * rr * gg.w}; } }
}
template <int NR> __device__ __forceinline__ void attn_norm_rows(bf16* mix, int row, int stride, int lane) {
    v4u w[NR][2]; float r[NR];
#pragma unroll
    for (int q = 0; q < NR; ++q) { const bf16* p = mix + (size_t)(row + q * stride) * DM; w[q][0] = *(const GAS v4u*)(p + lane * 8); w[q][1] = *(const GAS v4u*)(p + 512 + lane * 8); }
#pragma unroll
    for (int q = 0; q < NR; ++q) { float s = 0.f;
#pragma unroll
        for (int j = 0; j < 2; ++j) { const v4u u = w[q][j]; const float f0 = bf_lo(u.x), f1 = bf_hi(u.x), f2 = bf_lo(u.y), f3 = bf_hi(u.y), f4 = bf_lo(u.z), f5 = bf_hi(u.z), f6 = bf_lo(u.w), f7 = bf_hi(u.w);
            s += ((f0 * f0 + f1 * f1) + (f2 * f2 + f3 * f3)) + ((f4 * f4 + f5 * f5) + (f6 * f6 + f7 * f7)); }
        r[q] = 1.0f / sqrtf(wave_sum(s) * (1.0f / 1024.0f) + NORM_EPS); }
#pragma unroll
    for (int q = 0; q < NR; ++q) { bf16* p = mix + (size_t)(row + q * stride) * DM; const float rr = r[q];
#pragma unroll
        for (int j = 0; j < 2; ++j) { const v4u u = w[q][j]; v4u o; o.x = cvtpk(bf_lo(u.x) * rr, bf_hi(u.x) * rr); o.y = cvtpk(bf_lo(u.y) * rr, bf_hi(u.y) * rr); o.z = cvtpk(bf_lo(u.z) * rr, bf_hi(u.z) * rr); o.w = cvtpk(bf_lo(u.w) * rr, bf_hi(u.w) * rr);
            *(GAS v4u*)(p + j * 512 + lane * 8) = o; } }
}

#ifdef PROBE_ATT
#ifndef PROBE_ATT_WAVE
#define PROBE_ATT_WAVE 0
#endif
#define ATP_DECL() unsigned long long atp_t_ = __builtin_readcyclecounter(), atp_acc_ = 0ull; const bool atp_on_ = (blockIdx.x == 0) && (wid == PROBE_ATT_WAVE)
#define ATP(k) do { if (atp_on_) { const unsigned long long n_ = __builtin_readcyclecounter(); if ((k) == ((PROBE_ATT) + 1) % 4) atp_acc_ += n_ - atp_t_; atp_t_ = n_; } } while (0)
#define ATP_END() do { if (atp_on_ && lane == 0) { volatile LAS unsigned long long* q_ = (volatile LAS unsigned long long*)(lds + LDSCTL_OFF + 80); q_[0] += atp_acc_; } } while (0)
#else
#define ATP_DECL() do { } while (0)
#define ATP(k) do { } while (0)
#define ATP_END() do { } while (0)
#endif
__device__ __forceinline__ float max3f(float a, float b, float c) { float r; asm("v_max3_f32 %0, %1, %2, %3" : "=v"(r) : "v"(a), "v"(b), "v"(c)); return r; }
__device__ __forceinline__ float max2f(float a, float b) { float r; asm("v_max_f32_e32 %0, %1, %2" : "=v"(r) : "v"(a), "v"(b)); return r; }
constexpr int AT_KSLOT = 64 * DQK * 2, AT_VSLOT = 64 * DV * 2, AT_K = 0, AT_V = 2 * AT_KSLOT, AT_WS = AT_V + 2 * AT_VSLOT, AT_BYTES = AT_WS + NWAVES * 256;
static_assert(AT_BYTES <= RING_BYTES, "attention LDS");
__device__ __forceinline__ void attn_unit(const bf16* Qg, const bf16* Kg, const bf16* Vg, bf16* Og, int b, int h, int qb, ldsp lds, int tid) {
    const int lane = tid & 63, r32 = lane & 31, hi = lane >> 5; const int wid = __builtin_amdgcn_readfirstlane(tid >> 6);
    const size_t rowbase = (size_t)b * SEQ; const int q0 = qb * 256, NT = (q0 + 256) / 64, qw0 = q0 + wid * 32;
    const bf16* Kh = Kg + rowbase * 1536 + h * DQK; const bf16* Vh = Vg + rowbase * 1024 + h * DV;
    LAS float* wsf = (LAS float*)(lds + AT_WS) + wid * 64;
    const int krow_ = lane >> 2, kpiece_ = (lane & 3) ^ (((krow_ >> 2) ^ krow_) & 3);
#define AT_DMA(t, s) do { \
        _Pragma("unroll") for (int i_ = 0; i_ < 3; ++i_) { const int c_ = wid + 8 * i_; \
            glds16(Kh + (size_t)((t) * 64 + 16 * (c_ & 3) + krow_) * 1536 + (c_ >> 2) * 32 + kpiece_ * 8, lds + AT_K + (s) * AT_KSLOT + c_ * 1024); } \
        _Pragma("unroll") for (int i_ = 0; i_ < 2; ++i_) { const int c_ = wid + 8 * i_; \
            glds16(Vh + (size_t)((t) * 64 + 16 * (c_ & 3) + (lane >> 2)) * 1024 + (c_ >> 2) * 32 + (lane & 3) * 8, lds + AT_V + (s) * AT_VSLOT + c_ * 1024); } } while (0)
    AT_DMA(0, 0);
    bf16x8 qr[12];
    { const bf16* qp = Qg + (rowbase + qw0 + r32) * 1536 + h * DQK + hi * 8;
#pragma unroll
      for (int d0 = 0; d0 < 12; ++d0) qr[d0] = *(const GAS bf16x8*)(qp + d0 * 16); }
    float m_run = 0.f, l_run = 0.f; f32x16 o[4];
#pragma unroll
    for (int d = 0; d < 4; ++d)
#pragma unroll
        for (int r = 0; r < 16; ++r) o[d][r] = 0.f;
    const int vlane = tr_att_base(lane);
    const int kfr_ = r32 & 15, kfrag_ = (r32 >> 4) * 1024 + kfr_ * 64 + ((hi ^ (((kfr_ >> 2) ^ kfr_) & 3)) << 4), kfx_ = ((kfrag_ ^ 32) - kfrag_);
    ATP_DECL();
    for (int t = 0; t < NT; ++t) {
        const int s = t & 1;
        ATP(0);
        asm volatile("s_waitcnt vmcnt(0)" ::: "memory"); SBARRIER();
        if (t + 1 < NT) AT_DMA(t + 1, s ^ 1);
        ATP(1);
        const int kbase = t * 64;
        if (kbase <= qw0 + 31) {
            f32x16 p0, p1;
            cldsp kb = lds + AT_K + s * AT_KSLOT + kfrag_;
#pragma unroll
            for (int r = 0; r < 16; ++r) { p0[r] = 0.f; p1[r] = 0.f; }
#define KFA(d) (kb + ((d) >> 1) * 4096 + (((d) & 1) ? kfx_ : 0))
            bf16x8 ka0 = *(const LAS bf16x8*)(KFA(0)), ka1 = *(const LAS bf16x8*)(KFA(0) + 2048), kb0 = *(const LAS bf16x8*)(KFA(1)), kb1 = *(const LAS bf16x8*)(KFA(1) + 2048);
#pragma unroll
            for (int d0 = 0; d0 < 12; ++d0) {
                bf16x8 kc0 = ka0, kc1 = ka1;
                if (d0 + 2 < 12) { kc0 = *(const LAS bf16x8*)(KFA(d0 + 2)); kc1 = *(const LAS bf16x8*)(KFA(d0 + 2) + 2048); }
                __builtin_amdgcn_sched_barrier(0);
                p0 = MFMA32(ka0, qr[d0], p0); p1 = MFMA32(ka1, qr[d0], p1);
                __builtin_amdgcn_sched_barrier(0);
                ka0 = kb0; ka1 = kb1; kb0 = kc0; kb1 = kc1;
            }
#undef KFA
            if (kbase + 63 > qw0) {
                const int qi = qw0 + r32; const float NEG = -__builtin_inff();
#pragma unroll
                for (int r = 0; r < 16; ++r) { const int kv = kbase + crow(r, hi); if (kv > qi) p0[r] = NEG; if (kv + 32 > qi) p1[r] = NEG; }
            }
            asm volatile("s_nop 15\n\ts_nop 7" : "+v"(p0), "+v"(p1));
            float mx;
            { float xa = max3f(p0[0], p0[1], p1[0]), xb = max3f(p0[2], p0[3], p1[1]); xa = max3f(xa, p1[2], p1[3]);
#pragma unroll
              for (int r = 4; r < 16; r += 4) { xa = max3f(xa, p0[r], p0[r + 1]); xb = max3f(xb, p0[r + 2], p0[r + 3]); xa = max3f(xa, p1[r], p1[r + 1]); xb = max3f(xb, p1[r + 2], p1[r + 3]); }
              mx = max2f(xa, xb); }
            { const auto sw_ = __builtin_amdgcn_permlane32_swap(__float_as_uint(mx), __float_as_uint(mx), false, false); mx = max2f(__uint_as_float(sw_[0]), __uint_as_float(sw_[1])); }
            asm volatile("" : "+v"(mx)); ATP(2);
            cldsp vb = lds + AT_V + s * AT_VSLOT + vlane;
            s16x4 vpre[4]; vpre[0] = trrd(vb); vpre[1] = trrd(vb + 512); vpre[2] = trrd(vb + 1024); vpre[3] = trrd(vb + 1024 + 512);
            const bool first = (t == 0);
            if (first || !__all(mx - m_run <= 8.0f)) {
                const float mn = first ? mx : fmaxf(m_run, mx);
                if (!first) { const float alpha = __builtin_amdgcn_exp2f(m_run - mn); l_run *= alpha;
                    if (hi == 0) wsf[r32] = alpha;
                    asm volatile("s_waitcnt lgkmcnt(0)" ::: "memory");
#pragma unroll
                    for (int r = 0; r < 16; ++r) { const float al = wsf[crow(r, hi)];
#pragma unroll
                        for (int d = 0; d < 4; ++d) o[d][r] *= al; } }
                m_run = mn;
            }
            float rs = 0.f;
#pragma unroll
            for (int r = 0; r < 16; ++r) { p0[r] = __builtin_amdgcn_exp2f(p0[r] - m_run); p1[r] = __builtin_amdgcn_exp2f(p1[r] - m_run); rs += p0[r] + p1[r]; }
            l_run += rs;
            bf16x8 pa[4]; pa[0] = pack8f(p0, 0); pa[1] = pack8f(p0, 8); pa[2] = pack8f(p1, 0); pa[3] = pack8f(p1, 8);
            ATP(3);
            { s16x4 c0 = vpre[0], c1 = vpre[1], c2 = vpre[2], c3 = vpre[3];
#pragma unroll
              for (int st = 0; st < 8; ++st) { const int d0 = st >> 1, k2 = (st & 1) * 2;
                s16x4 n0 = c0, n1 = c1, n2 = c2, n3 = c3;
                if (st + 1 < 8) { const int dn = (st + 1) >> 1, kn = ((st + 1) & 1) * 2; cldsp q = vb + (dn * 4 + kn) * 1024; n0 = trrd(q); n1 = trrd(q + 512); n2 = trrd(q + 1024); n3 = trrd(q + 1024 + 512); }
                __builtin_amdgcn_sched_barrier(0);
                o[d0] = MFMA32(pa[k2], MK8(c0, c1), o[d0]); o[d0] = MFMA32(pa[k2 + 1], MK8(c2, c3), o[d0]);
                __builtin_amdgcn_sched_barrier(0);
                c0 = n0; c1 = n1; c2 = n2; c3 = n3; } }
        }
    }
    ATP(0); ATP_END();
    l_run += __shfl_xor(l_run, 32);
    if (hi == 0) wsf[32 + r32] = l_run;
    asm volatile("s_waitcnt lgkmcnt(0)" ::: "memory");
    bf16* Ow = Og + (rowbase + qw0) * DM + h * DV;
#pragma unroll
    for (int r = 0; r < 16; ++r) { const int orow = crow(r, hi); const float rl = 1.0f / wsf[32 + orow];
#pragma unroll
        for (int d0 = 0; d0 < 4; ++d0) { const float v = o[d0][r] * rl; const float vn = __shfl_xor(v, 1);
            if ((r32 & 1) == 0) *(GAS unsigned*)(Ow + (size_t)orow * DM + d0 * 32 + r32) = cvtpk(v, vn); } }
    asm volatile("s_waitcnt lgkmcnt(0)" ::: "memory"); SBARRIER();
#undef AT_DMA
}

constexpr int RT_K = 0, RT_V = 32768, RT_S = 65536, RT_O = 0, RT_OSTRIDE = 132;
static_assert(RT_S + 32768 <= RING_BYTES && RT_O + 128 * RT_OSTRIDE * 4 + 1024 <= RING_BYTES, "retention LDS");
__device__ __forceinline__ void ret_state_unit(const bf16* RK, const bf16* RV, float* U, int bh, int c, float lg2g, ldsp lds, int tid) {
    const int lane = tid & 63, r32 = lane & 31, hi = lane >> 5; const int wid = __builtin_amdgcn_readfirstlane(tid >> 6);
    const int b = bh >> 3, h = bh & 7; const size_t row0 = (size_t)b * SEQ + (size_t)c * RCH;
#pragma unroll
    for (int i = 0; i < 4; ++i) { const int ch = wid * 4 + i, cb = ch >> 3, ks = ch & 7; const size_t tok = row0 + 16 * ks + (lane >> 2); const int col = h * 128 + cb * 32 + (lane & 3) * 8;
        glds16(RK + tok * 1024 + col, lds + RT_K + ch * 1024);
        const v4u w = *(const GAS v4u*)(RV + tok * 1024 + col); const float z = __builtin_amdgcn_exp2f(lg2g * (float)(127 - (16 * ks + (lane >> 2))));
        v4u o; o.x = cvtpk(bf_lo(w.x) * z, bf_hi(w.x) * z); o.y = cvtpk(bf_lo(w.y) * z, bf_hi(w.y) * z); o.z = cvtpk(bf_lo(w.z) * z, bf_hi(w.z) * z); o.w = cvtpk(bf_lo(w.w) * z, bf_hi(w.w) * z);
        *(LAS v4u*)(lds + RT_V + ch * 1024 + lane * 16) = o; }
    asm volatile("s_waitcnt vmcnt(0) lgkmcnt(0)" ::: "memory"); SBARRIER();
    const int dkb = wid >> 1, dvb0 = (wid & 1) * 2; const int nb = tr_nat_base(lane);
    f32x16 acc[2];
#pragma unroll
    for (int r = 0; r < 16; ++r) { acc[0][r] = 0.f; acc[1][r] = 0.f; }
#pragma unroll
    for (int ks = 0; ks < 8; ++ks) { cldsp ka = lds + RT_K + (dkb * 8 + ks) * 1024 + nb; const s16x4 al = trrd(ka), ah = trrd(ka + 256); const bf16x8 A = MK8(al, ah);
#pragma unroll
        for (int j = 0; j < 2; ++j) { cldsp vb = lds + RT_V + ((dvb0 + j) * 8 + ks) * 1024 + nb; const s16x4 bl = trrd(vb), bh2 = trrd(vb + 256); acc[j] = MFMA32(A, MK8(bl, bh2), acc[j]); } }
    float* Uu = U + ((size_t)bh * NCH + c) * 16384;
#pragma unroll
    for (int j = 0; j < 2; ++j)
#pragma unroll
        for (int r = 0; r < 16; ++r) Uu[(dkb * 32 + crow(r, hi)) * 128 + (dvb0 + j) * 32 + r32] = acc[j][r];
    asm volatile("s_waitcnt lgkmcnt(0)" ::: "memory"); SBARRIER();
}
__device__ __forceinline__ void ret_scan(const float* U, bf16* S, cargs_t a, int gtid, int nthr) {
    for (int it = gtid; it < 16 * 8192; it += nthr) { const int bh = it >> 13, e2 = it & 8191; const float g = __builtin_amdgcn_exp2f(128.0f * a->lg2g[bh & 7]);
        const float* up = U + (size_t)bh * NCH * 16384 + e2 * 2; bf16* sp = S + (size_t)bh * NCH * 16384 + e2 * 2; float s0 = 0.f, s1 = 0.f;
#pragma unroll 8
        for (int c = 0; c < NCH; ++c) { *(GAS unsigned*)(sp + (size_t)c * 16384) = cvtpk(s0, s1); const f32x2 u = *(const GAS f32x2*)(up + (size_t)c * 16384); s0 = s0 * g + u.x; s1 = s1 * g + u.y; } }
}
__device__ __forceinline__ void ret_out_unit(const bf16* RQ, const bf16* RK, const bf16* RV, const bf16* RG, const bf16* S, bf16* MIX, int bh, int c, float lg2g, ldsp lds, int tid) {
    const int lane = tid & 63, r32 = lane & 31, hi = lane >> 5; const int wid = __builtin_amdgcn_readfirstlane(tid >> 6);
    const int b = bh >> 3, h = bh & 7; const size_t row0 = (size_t)b * SEQ + (size_t)c * RCH;
    const int rb = wid & 3, dh = wid >> 2;
    const bf16* Ss = S + ((size_t)bh * NCH + c) * 16384;
#pragma unroll
    for (int i = 0; i < 4; ++i) { const int id = wid * 4 + i;
        glds16(RK + (row0 + (id & 1) * 64 + lane) * 1024 + h * 128 + (id >> 1) * 8, lds + RT_K + id * 1024);
        const int cb = id >> 3, ks = id & 7;
        glds16(RV + (row0 + 16 * ks + (lane >> 2)) * 1024 + h * 128 + cb * 32 + (lane & 3) * 8, lds + RT_V + id * 1024);
        glds16(Ss + (16 * ks + (lane >> 2)) * 128 + cb * 32 + (lane & 3) * 8, lds + RT_S + id * 1024); }
    unsigned gate[16];
#pragma unroll
    for (int i = 0; i < 16; ++i) gate[i] = *(const GAS unsigned*)(RG + (row0 + wid * 16 + i) * 1024 + h * 128 + 2 * lane);
    bf16x8 qr[8];
    { const bf16* qp = RQ + (row0 + rb * 32 + r32) * 1024 + h * 128 + hi * 8;
#pragma unroll
      for (int d0 = 0; d0 < 8; ++d0) qr[d0] = *(const GAS bf16x8*)(qp + d0 * 16); }
    asm volatile("s_waitcnt vmcnt(0)" ::: "memory"); SBARRIER();
    f32x16 o[2];
#pragma unroll
    for (int r = 0; r < 16; ++r) { o[0][r] = 0.f; o[1][r] = 0.f; }
    { const int nb = tr_nat_base(lane);
#pragma unroll
      for (int ks = 0; ks < 8; ++ks)
#pragma unroll
          for (int j = 0; j < 2; ++j) { cldsp sb = lds + RT_S + ((dh * 2 + j) * 8 + ks) * 1024 + nb; const s16x4 bl = trrd(sb), bh2 = trrd(sb + 256); o[j] = MFMA32(qr[ks], MK8(bl, bh2), o[j]); }
#pragma unroll
      for (int r = 0; r < 16; ++r) { const float xi = __builtin_amdgcn_exp2f(lg2g * (float)(rb * 32 + crow(r, hi) + 1)); o[0][r] *= xi; o[1][r] *= xi; } }
    const int ab = tr_att_base(lane);
    for (int kb = 0; kb <= rb; ++kb) {
        f32x16 p;
#pragma unroll
        for (int r = 0; r < 16; ++r) p[r] = 0.f;
        cldsp kp = lds + RT_K + hi * 2048 + (kb * 32 + r32) * 16;
#pragma unroll
        for (int d0 = 0; d0 < 8; ++d0) { const bf16x8 ka = *(const LAS bf16x8*)(kp + d0 * 4096); p = MFMA32(ka, qr[d0], p); }
        const int qi = rb * 32 + r32;
#pragma unroll
        for (int r = 0; r < 16; ++r) { const int kj = kb * 32 + crow(r, hi); const float dcy = __builtin_amdgcn_exp2f(lg2g * (float)(qi - kj)); p[r] = (qi >= kj) ? p[r] * dcy : 0.f; }
        const bf16x8 pa0 = pack8f(p, 0), pa1 = pack8f(p, 8);
#pragma unroll
        for (int j = 0; j < 2; ++j) { cldsp vb = lds + RT_V + ((dh * 2 + j) * 8 + kb * 2) * 1024 + ab;
            { const s16x4 lo = trrd(vb), hh = trrd(vb + 512); o[j] = MFMA32(pa0, MK8(lo, hh), o[j]); }
            { const s16x4 lo = trrd(vb + 1024), hh = trrd(vb + 1024 + 512); o[j] = MFMA32(pa1, MK8(lo, hh), o[j]); } }
    }
    asm volatile("s_waitcnt lgkmcnt(0)" ::: "memory"); SBARRIER();
    LAS float* ob = (LAS float*)(lds + RT_O);
#pragma unroll
    for (int j = 0; j < 2; ++j)
#pragma unroll
        for (int r = 0; r < 16; ++r) ob[(rb * 32 + crow(r, hi)) * RT_OSTRIDE + (dh * 2 + j) * 32 + r32] = o[j][r];
    asm volatile("s_waitcnt lgkmcnt(0)" ::: "memory"); SBARRIER();
    { const int srow = tid >> 2, sq = tid & 3; const LAS float* rp = ob + srow * RT_OSTRIDE + 16 * sq; float s1 = 0.f, s2 = 0.f;
#pragma unroll
      for (int j = 0; j < 2; ++j)
#pragma unroll
          for (int i = 0; i < 4; ++i) { const f32x4 v = *(const LAS f32x4*)(rp + 64 * j + 4 * i); s1 += (v.x + v.y) + (v.z + v.w); s2 += (v.x * v.x + v.y * v.y) + (v.z * v.z + v.w * v.w); }
      s1 += __builtin_bit_cast(float, __builtin_amdgcn_mov_dpp(__builtin_bit_cast(int, s1), 0xB1, 0xf, 0xf, true)); s2 += __builtin_bit_cast(float, __builtin_amdgcn_mov_dpp(__builtin_bit_cast(int, s2), 0xB1, 0xf, 0xf, true));
      s1 += __builtin_bit_cast(float, __builtin_amdgcn_mov_dpp(__builtin_bit_cast(int, s1), 0x4E, 0xf, 0xf, true)); s2 += __builtin_bit_cast(float, __builtin_amdgcn_mov_dpp(__builtin_bit_cast(int, s2), 0x4E, 0xf, 0xf, true));
      const float mu = s1 * (1.0f / 128.0f), var = fmaxf(s2 * (1.0f / 128.0f) - mu * mu, 0.f);
      if (sq == 0) *(LAS f32x2*)(ob + 128 * RT_OSTRIDE + 2 * srow) = (f32x2){mu, 1.0f / sqrtf(var + GN_EPS)}; }
    asm volatile("s_waitcnt lgkmcnt(0)" ::: "memory"); SBARRIER();
#pragma unroll
    for (int i = 0; i < 16; ++i) { const int rr = wid * 16 + i; const f32x2 v = *(const LAS f32x2*)(ob + rr * RT_OSTRIDE + 2 * lane); const f32x2 st = *(const LAS f32x2*)(ob + 128 * RT_OSTRIDE + 2 * rr);
        *(GAS unsigned*)(MIX + (row0 + rr) * DM + 1024 + h * 128 + 2 * lane) = cvtpk((v.x - st.x) * st.y * bf_lo(gate[i]), (v.y - st.x) * st.y * bf_hi(gate[i])); }
    asm volatile("s_waitcnt lgkmcnt(0)" ::: "memory"); SBARRIER();
}


#define PHASE_IDS() int tid = tid0; asm volatile("" : "+v"(tid)); int G = G0, bx = bx0; asm volatile("" : "+s"(G), "+s"(bx)); \
    const int lane = tid & 63; const int wave = __builtin_amdgcn_readfirstlane(tid >> 6); const int vcu = (G % 8 == 0) ? (bx % 8) * (G / 8) + bx / 8 : bx; (void)lane; (void)wave; (void)vcu
#define GW (vcu * NWAVES + wave)
#define NGW (G * NWAVES)
#define GTID (vcu * (NWAVES * 64) + tid)
#define NTHR (G * NWAVES * 64)
#ifndef PG_ALIGN
#define PG_ALIGN true
#endif
#define XBAR() xcd_barrier(bar)
#ifdef PROBE_SPAN
#ifndef PROBE_BLOCK
#define PROBE_BLOCK 0
#endif
#ifdef PROBE_CLK
#define PTIME() __builtin_readcyclecounter()
#else
#define PTIME() __builtin_amdgcn_s_memrealtime()
#endif
#ifdef PROBE_PRE
#define STAMP(k) do { if (tid0 == 0 && bx0 == PROBE_BLOCK) { volatile LAS unsigned long long* ts_ = (volatile LAS unsigned long long*)(lds + LDSCTL_OFF + 64); if ((k) == PROBE_SPAN) ts_[0] = PTIME(); } } while (0)
#define STAMP_PRE(k) do { if (tid0 == 0 && bx0 == PROBE_BLOCK) { volatile LAS unsigned long long* ts_ = (volatile LAS unsigned long long*)(lds + LDSCTL_OFF + 64); if ((k) == PROBE_SPAN + 1) ts_[1] += PTIME() - ts_[0]; } } while (0)
#else
#define STAMP(k) do { if (tid0 == 0 && bx0 == PROBE_BLOCK) { volatile LAS unsigned long long* ts_ = (volatile LAS unsigned long long*)(lds + LDSCTL_OFF + 64); const unsigned long long t_ = PTIME(); \
    if ((k) == PROBE_SPAN) ts_[0] = t_; if ((k) == PROBE_SPAN + 1) ts_[1] += t_ - ts_[0]; } } while (0)
#define STAMP_PRE(k) do { } while (0)
#endif
#else
#define STAMP(k) do { } while (0)
#define STAMP_PRE(k) do { } while (0)
#endif
template <int l> __device__ __forceinline__ void layer_body(const int tid0, const int G0, const int bx0, const ldsp lds, const XcdBarrier& bar) {
    STAMP(0);
#ifdef PROBE_IDLE
    { const unsigned long long t0_ = __builtin_amdgcn_s_memrealtime(); while (__builtin_amdgcn_s_memrealtime() - t0_ < (unsigned long long)(PROBE_IDLE) * 100ull) __builtin_amdgcn_s_sleep(32); }
#endif
    { PHASE_IDS(); cargs_t a = get_args(); unsigned char* ws = a->ws; unsigned char* wb = ws + WS_W + (size_t)(l & 1) * W_STRIDE;
      pg8::Gemm g{(bf16*)(ws + WS_XB), (bf16*)(wb + WO_WIN), M, IN_PAD, DM}; pg8::StaticOrder S; S.init(M, IN_PAD, G, bx);
      pg8::Unit u0_; const int pm0_ = S.next(0, u0_) ? u0_.pm : 0; fill_rtab((const float*)(ws + WS_XSS2), pm0_, lds, tid);
      pg8::EpiIn E{(const float*)(ws + WS_XSS2), (bf16*)(ws + WS_CQ), (bf16*)(ws + WS_CKV), (float*)(ws + WS_CQSS), (float*)(ws + WS_CKVSS), (bf16*)(ws + WS_K), (const float*)(ws + WS_C64), (const float*)(ws + WS_S64),
                   (bf16*)(ws + WS_RQ), (bf16*)(ws + WS_RK), (bf16*)(ws + WS_RV), (bf16*)(ws + WS_RG), (const float*)(ws + WS_C128), (const float*)(ws + WS_S128), (const LAS float*)(lds + RTAB_OFF), pm0_};
      pg8::gemm_phase<pg8::EpiIn, pg8::StaticOrder, PG_ALIGN, true>(lds + RING_OFF, g, S, E); }
    STAMP_PRE(1); XBAR(); STAMP(1);
    { PHASE_IDS(); cargs_t a = get_args(); unsigned char* ws = a->ws; unsigned char* wb = ws + WS_W + (size_t)(l & 1) * W_STRIDE;
      pg8::Gemm g{(bf16*)(ws + WS_CQ), (bf16*)(wb + WO_WUQ), M, 1536, QLORA}; pg8::StaticOrder S; S.init(M, 1536, G, bx);
      pg8::EpiQ E{(const float*)(ws + WS_CQSS), (bf16*)(ws + WS_Q), (const float*)(ws + WS_C64), (const float*)(ws + WS_S64), QSCALE};
      pg8::gemm_phase<pg8::EpiQ, pg8::StaticOrder, PG_ALIGN, true>(lds + RING_OFF, g, S, E); }
    __syncthreads();
    { PHASE_IDS(); cargs_t a = get_args(); unsigned char* ws = a->ws; unsigned char* wb = ws + WS_W + (size_t)(l & 1) * W_STRIDE;
      pg8::Gemm g{(bf16*)(ws + WS_CKV), (bf16*)(wb + WO_WUKV), M, 2048, KVLORA}; pg8::StaticOrder S; S.init(M, 2048, G, bx);
      pg8::EpiKV E{(const float*)(ws + WS_CKVSS), (bf16*)(ws + WS_K), (bf16*)(ws + WS_V)};
      pg8::gemm_phase<pg8::EpiKV, pg8::StaticOrder, PG_ALIGN, true>(lds + RING_OFF, g, S, E); }
    __syncthreads();
    { PHASE_IDS(); cargs_t a = get_args(); unsigned char* ws = a->ws;
      if (G == 256) { const int heavy = (bx < 128), n = heavy ? 3 : 5, base = heavy ? bx : 384 + (bx - 128);
        for (int i = 0; i < n; ++i) { const int u = base + 128 * i; ret_state_unit((const bf16*)(ws + WS_RK), (const bf16*)(ws + WS_RV), (float*)(ws + WS_U), u >> 6, u & 63, a->lg2g[(u >> 6) & 7], lds + RING_OFF, tid); } }
      else for (int u = vcu; u < 16 * NCH; u += G) ret_state_unit((const bf16*)(ws + WS_RK), (const bf16*)(ws + WS_RV), (float*)(ws + WS_U), u >> 6, u & 63, a->lg2g[(u >> 6) & 7], lds + RING_OFF, tid); }
    STAMP_PRE(2); XBAR(); STAMP(2);
    { PHASE_IDS(); cargs_t a = get_args(); unsigned char* ws = a->ws;
      for (int u = vcu; u < 256; u += G) { const int bh = u >> 4, x = u & 15;
        attn_unit((const bf16*)(ws + WS_Q), (const bf16*)(ws + WS_K), (const bf16*)(ws + WS_V), (bf16*)(ws + WS_MIX), bh >> 3, bh & 7, 31 - x, lds + RING_OFF, tid);
        attn_unit((const bf16*)(ws + WS_Q), (const bf16*)(ws + WS_K), (const bf16*)(ws + WS_V), (bf16*)(ws + WS_MIX), bh >> 3, bh & 7, x, lds + RING_OFF, tid); } }
    { PHASE_IDS(); cargs_t a = get_args(); unsigned char* ws = a->ws; ret_scan((const float*)(ws + WS_U), (bf16*)(ws + WS_S), a, GTID, NTHR); }
    if (l + 1 < DEPTH) { PHASE_IDS(); cargs_t a = get_args(); __syncthreads(); convert_weights<true>(a, l + 1, lds, GW, NGW, wave, lane, GTID, NTHR, (unsigned*)((gu32*)(a->ws + WS_CTL) + CW_WQ + l * 64)); }
    STAMP_PRE(3); XBAR(); STAMP(3);
    { PHASE_IDS(); cargs_t a = get_args(); unsigned char* ws = a->ws;
      for (int u = vcu; u < 16 * NCH; u += G) ret_out_unit((const bf16*)(ws + WS_RQ), (const bf16*)(ws + WS_RK), (const bf16*)(ws + WS_RV), (const bf16*)(ws + WS_RG), (const bf16*)(ws + WS_S), (bf16*)(ws + WS_MIX),
                                                          u >> 6, u & 63, a->lg2g[(u >> 6) & 7], lds + RING_OFF, tid); }
    { PHASE_IDS(); cargs_t a = get_args(); bf16* mix = (bf16*)(a->ws + WS_MIX);
      { int m = GW; for (; m + 3 * NGW < M; m += 4 * NGW) attn_norm_rows<4>(mix, m, NGW, lane); for (; m < M; m += NGW) attn_norm_rows<1>(mix, m, NGW, lane); } }
    STAMP_PRE(4); XBAR(); STAMP(4);
    { PHASE_IDS(); cargs_t a = get_args(); unsigned char* ws = a->ws; unsigned char* wb = ws + WS_W + (size_t)(l & 1) * W_STRIDE;
      pg8::Gemm g{(bf16*)(ws + WS_MIX), (bf16*)(wb + WO_WO), M, DM, DM}; pg8::StaticOrder S; S.init(M, DM, G, bx);
      typedef pg8::EpiResT<false, true> EpiR; EpiR E{(l == 0) ? a->x : (const float*)a->out, a->out, (bf16*)(ws + WS_XB), (float*)(ws + WS_XSS), nullptr, nullptr, -1};
      pg8::gemm_phase<EpiR, pg8::StaticOrder, PG_ALIGN, true>(lds + RING_OFF, g, S, E); }
    STAMP_PRE(5); XBAR(); STAMP(5);
    { PHASE_IDS(); cargs_t a = get_args(); unsigned char* ws = a->ws; unsigned char* wb = ws + WS_W + (size_t)(l & 1) * W_STRIDE;
      pg8::Gemm g{(bf16*)(ws + WS_XB), (bf16*)(wb + WO_WUP), M, FF, DM}; pg8::StaticOrder S; S.init(M, FF, G, bx);
      pg8::EpiRelu2 E{(bf16*)(ws + WS_UF), FF};
      pg8::gemm_phase<pg8::EpiRelu2, pg8::StaticOrder, PG_ALIGN, true>(lds + RING_OFF, g, S, E); }
    STAMP_PRE(6); XBAR(); STAMP(6);
    { PHASE_IDS(); cargs_t a = get_args(); unsigned char* ws = a->ws; unsigned char* wb = ws + WS_W + (size_t)(l & 1) * W_STRIDE;
      pg8::Gemm g{(bf16*)(ws + WS_UF), (bf16*)(wb + WO_WDN), M, DM, FF}; pg8::StaticOrder S; S.init(M, DM, G, bx);
      pg8::Unit u0_; const int pm0_ = S.next(0, u0_) ? u0_.pm : 0; fill_rtab((const float*)(ws + WS_XSS), pm0_, lds, tid);
      typedef pg8::EpiResT<true, (l + 1 < DEPTH)> EpiR; EpiR E{a->out, a->out, (bf16*)(ws + WS_XB), (float*)(ws + WS_XSS2), (const float*)(ws + WS_XSS), (const LAS float*)(lds + RTAB_OFF), pm0_};
      pg8::gemm_phase<EpiR, pg8::StaticOrder, PG_ALIGN, true>(lds + RING_OFF, g, S, E); }
    STAMP_PRE(7); XBAR(); STAMP(7);
}

__global__ void __launch_bounds__(NWAVES * 64, 2) fwd_kernel(Args args_in_kernarg) {
    extern __shared__ __attribute__((aligned(16))) unsigned char lds_raw[];
    const ldsp lds = (ldsp)lds_raw;
    volatile LAS unsigned* MISC = (volatile LAS unsigned*)(lds + MISC_OFF);
    const int tid0 = threadIdx.x; const int G0 = gridDim.x, bx0 = blockIdx.x;
    for (int u = tid0; u < (LDS_BYTES - LDSCTL_OFF) / 4; u += NWAVES * 64) ((LAS unsigned*)(lds + LDSCTL_OFF))[u] = 0u;
    __syncthreads();
    XcdBarrier bar;
    { PHASE_IDS(); cargs_t a = get_args(); bar = xcd_barrier_post((unsigned*)((gu32*)(a->ws + WS_CTL) + CW_BAR), MISC + 8); }
    { PHASE_IDS(); cargs_t a = get_args();
      rope_tables(a, GTID, NTHR);
      convert_weights<false>(a, 0, lds, GW, NGW, wave, lane, GTID, NTHR, nullptr);
      const float* x = a->x; bf16* XB = (bf16*)(a->ws + WS_XB); float* XSS = (float*)(a->ws + WS_XSS2);
      { int m = GW; for (; m + NGW < M; m += 2 * NGW) prep_rows<2>(x, XB, XSS, m, NGW, lane); for (; m < M; m += NGW) prep_rows<1>(x, XB, XSS, m, NGW, lane); } }
    XBAR();

    layer_body<0>(tid0, G0, bx0, lds, bar);
    layer_body<1>(tid0, G0, bx0, lds, bar);
    layer_body<2>(tid0, G0, bx0, lds, bar);
    layer_body<3>(tid0, G0, bx0, lds, bar);
    { PHASE_IDS(); cargs_t a = get_args(); float* xo = a->out; const float* g = a->final_norm; const float* XSS = (const float*)(a->ws + WS_XSS2);
      { int m = GW; for (; m + NGW < M; m += 2 * NGW) rms_rows_final<2>(xo, XSS, g, m, NGW, lane); for (; m < M; m += NGW) rms_rows_final<1>(xo, XSS, g, m, NGW, lane); } }
#if defined(PROBE_ATT) || defined(PROBE_R3)
    if (tid0 == 0 && bx0 == 0) { volatile LAS unsigned long long* q_ = (volatile LAS unsigned long long*)(lds + LDSCTL_OFF + 80); const unsigned long long T_ = q_[0] / 3ull, t0_ = __builtin_amdgcn_s_memrealtime();
        while (__builtin_amdgcn_s_memrealtime() - t0_ < T_) __builtin_amdgcn_s_sleep(8); }
#endif
#ifdef PROBE_SPAN
    if (tid0 == 0 && bx0 == PROBE_BLOCK) { volatile LAS unsigned long long* ts_ = (volatile LAS unsigned long long*)(lds + LDSCTL_OFF + 64);
#ifdef PROBE_CLK
        const unsigned long long T_ = ts_[1] / 3ull,
#else
        const unsigned long long T_ = ts_[1] * 8ull,
#endif
        t0_ = __builtin_amdgcn_s_memrealtime();
        while (__builtin_amdgcn_s_memrealtime() - t0_ < T_) __builtin_amdgcn_s_sleep(8); }
#endif
}

extern "C" void kernel_launch(void* const* d_in, const int* in_sizes, int n_in, void* d_out, int out_size, void* d_ws, size_t ws_size, hipStream_t stream) {
    static int grid = 0;
    if (grid == 0) {
        if (n_in != 15 || in_sizes[0] != M * DM || out_size != M * DM || ws_size < WS_END) { fprintf(stderr, "kernel_launch: unexpected shapes (n_in %d, in0 %d, out %d, ws %zu, need %zu); nothing launched\n", n_in, n_in > 0 ? in_sizes[0] : -1, out_size, ws_size, (size_t)WS_END); grid = -1; return; }
        int dev = 0, cus = 0, per_cu = 0;
        if (hipGetDevice(&dev) != hipSuccess || hipDeviceGetAttribute(&cus, hipDeviceAttributeMultiprocessorCount, dev) != hipSuccess) { fprintf(stderr, "kernel_launch: device query failed\n"); grid = -1; return; }
        if (hipFuncSetAttribute((const void*)fwd_kernel, hipFuncAttributeMaxDynamicSharedMemorySize, LDS_BYTES) != hipSuccess) { fprintf(stderr, "kernel_launch: hipFuncSetAttribute failed\n"); grid = -1; return; }
        if (hipOccupancyMaxActiveBlocksPerMultiprocessor(&per_cu, (const void*)fwd_kernel, NWAVES * 64, LDS_BYTES) != hipSuccess || per_cu < 1)
            fprintf(stderr, "kernel_launch: note: occupancy query reports %d workgroups per CU\n", per_cu);
        (void)hipGetLastError();
        grid = cus;
    }
    if (grid < 0) return;
    if (hipMemsetAsync((char*)d_ws + WS_CTL, 0, CTL_ZERO_BYTES, stream) != hipSuccess) { fprintf(stderr, "kernel_launch: hipMemsetAsync failed\n"); return; }
    Args a{};
    a.x = (const float*)d_in[0]; a.pos = (const int*)d_in[1]; a.attn_norm = (const float*)d_in[2]; a.w_in = (const float*)d_in[3]; a.q_norm = (const float*)d_in[4]; a.kv_norm = (const float*)d_in[5];
    a.w_uq = (const float*)d_in[6]; a.w_ukv = (const float*)d_in[7]; a.beta_attn = (const float*)d_in[8]; a.beta_ret = (const float*)d_in[9]; a.w_o = (const float*)d_in[10]; a.mlp_norm = (const float*)d_in[11];
    a.w_up = (const float*)d_in[12]; a.w_down = (const float*)d_in[13]; a.final_norm = (const float*)d_in[14];
    a.out = (float*)d_out; a.ws = (unsigned char*)d_ws;
    for (int j = 0; j < 32; ++j) a.invf64[j] = pow(10000.0, -(double)(2 * j) / 64.0);
    for (int j = 0; j < 64; ++j) a.invf128[j] = pow(10000.0, -(double)(2 * j) / 128.0);
    for (int h = 0; h < 8; ++h) a.lg2g[h] = (float)(log1p(-exp2(-5.0 - (double)h)) / log(2.0));
    hipLaunchKernelGGL(fwd_kernel, dim3(grid), dim3(NWAVES * 64), LDS_BYTES, stream, a);
    const hipError_t le = hipPeekAtLastError();
    if (le != hipSuccess) fprintf(stderr, "kernel_launch: launch failed: %s\n", hipGetErrorName(le));
}
```

```cpp
#include <hip/hip_runtime.h>
#include <cstdio>
#include <cstdint>
#include <cmath>
namespace pg8 {
#define PG8_LAS __attribute__((address_space(3)))
typedef unsigned short bf16_t;
typedef short bf16x8 __attribute__((ext_vector_type(8)));
typedef float f32x4 __attribute__((ext_vector_type(4)));
typedef unsigned u32x4 __attribute__((ext_vector_type(4)));
constexpr int BM = 256, BK = 64, HALF = 128, HTB = HALF * BK * 2  , STAGE_BYTES = 8 * HTB, NXCD = 8, WGM = 8;

__host__ __device__ __forceinline__ int lds_byte(int r, int c) { const int st = (r >> 4) * 2 + (c >> 5), rr = r & 15, cc = c & 31, ob = rr * 64 + cc * 2; return st * 1024 + (ob ^ (((ob >> 9) & 1) << 5)); }
__host__ __device__ __forceinline__ void stage_rc(int b, int& R, int& C) { const int st = b / 1024, sb = b % 1024, swz = sb ^ (((sb >> 9) & 1) << 5); R = (st >> 1) * 16 + swz / 64; C = (st & 1) * 32 + (swz % 64) / 2; }
__host__ __device__ __forceinline__ int perm32(int rho) { const int n = rho >> 4, i = rho & 15; return 8 * (i >> 2) + 4 * n + (i & 3); }

struct Unit { int pm, pn; };
struct Gemm { const bf16_t* A; const bf16_t* Bt; int M, N, K; };

struct StaticOrder {
    int nM, nN, nwg, G, c;
    __host__ __device__ void init(int M, int N, int G_, int c_) { nM = M / BM; nN = N / BM; nwg = nM * nN; G = G_; c = c_; }
    __host__ __device__ bool next(int i, Unit& u) const {
        const long L = (long)i * G + c; if (L >= nwg) return false;
        int wgid = (int)L; { const int q = nwg / NXCD, r = nwg % NXCD, xcd = wgid % NXCD, off = wgid / NXCD; wgid = (xcd < r ? xcd * (q + 1) : r * (q + 1) + (xcd - r) * q) + off; }
        const int nig = WGM * nN, gid = wgid / nig, fm = gid * WGM, gsz = (nM - fm) < WGM ? (nM - fm) : WGM;
        u.pm = fm + ((wgid % nig) % gsz); u.pn = (wgid % nig) / gsz; return true;
    }
    __device__ __forceinline__ void a_ready(const Unit&) const {}
    __device__ __forceinline__ void done(const Unit&) const {}
};

__device__ __forceinline__ unsigned cvt_pk_bf16(float lo, float hi) { unsigned r; asm volatile("v_cvt_pk_bf16_f32 %0, %1, %2" : "=v"(r) : "v"(lo), "v"(hi)); return r; }
typedef float f32x2 __attribute__((ext_vector_type(2)));
__device__ __forceinline__ f32x2 gelu_pk(f32x2 v) {
    const f32x2 av = __builtin_elementwise_abs(v), d = av * 0.2316418882f + 1.0f;
    f32x2 t; t.x = __builtin_amdgcn_rcpf(d.x); t.y = __builtin_amdgcn_rcpf(d.y);
    f32x2 q = t * 0.5307027145f + (-0.7265760135f); q = q * t + 0.7107068705f; q = q * t + (-0.142248368f); q = q * t + 0.127414796f; q = q * t;
    const f32x2 s = (v * v) * (-0.72134752044f);
    f32x2 e; e.x = __builtin_amdgcn_exp2f(s.x); e.y = __builtin_amdgcn_exp2f(s.y);
    const f32x2 m = v * (q * e), r = v - m;
    f32x2 o; o.x = v.x < 0.f ? m.x : r.x; o.y = v.y < 0.f ? m.y : r.y; return o;
}

template <int ACT  > struct EpiBf16 {
    static constexpr bool PERM = true, AFTER_DRAIN = false; static_assert(ACT == 0 || ACT == 1, "EpiBf16: ACT is 0 (none) or 1 (gelu_pk)");
    bf16_t* O; int ldc; const float* bias; int split_cols; size_t split_stride; float scale0;
    __device__ __forceinline__ void operator()(const f32x4 (&acc)[2][2][4][2], const Unit& u, int wr, int wc, int fr, int fq) const {
        const int row0 = u.pm * BM + wr * 64 + fr; int colt = u.pn * BM; bf16_t* base = O;
        float sc = 1.f; if (split_cols) { const int t = colt / split_cols; base += (size_t)t * split_stride; colt -= t * split_cols; if (t == 0) sc = scale0; }
        const int col0 = colt + wc * 32 + 8 * fq, bcol0 = u.pn * BM + wc * 32 + 8 * fq;
        f32x4 bv[2][2];
#pragma unroll
        for (int bj = 0; bj < 2; ++bj)
#pragma unroll
            for (int n = 0; n < 2; ++n) bv[bj][n] = bias ? *(const f32x4*)(bias + bcol0 + bj * HALF + 4 * n) : (f32x4){0.f, 0.f, 0.f, 0.f};
#pragma unroll
        for (int ai = 0; ai < 2; ++ai)
#pragma unroll
            for (int m = 0; m < 4; ++m) { bf16_t* rowp = base + (size_t)(row0 + ai * HALF + m * 16) * ldc + col0;
#pragma unroll
                for (int bj = 0; bj < 2; ++bj) { f32x4 v0 = acc[ai][bj][m][0] + bv[bj][0], v1 = acc[ai][bj][m][1] + bv[bj][1];
                    if (ACT == 1) { f32x2 a = gelu_pk((f32x2){v0[0], v0[1]}), b = gelu_pk((f32x2){v0[2], v0[3]}), c = gelu_pk((f32x2){v1[0], v1[1]}), d = gelu_pk((f32x2){v1[2], v1[3]});
                        v0 = (f32x4){a.x, a.y, b.x, b.y}; v1 = (f32x4){c.x, c.y, d.x, d.y}; }
                    v0 = v0 * sc; v1 = v1 * sc; u32x4 w; w.x = cvt_pk_bf16(v0[0], v0[1]); w.y = cvt_pk_bf16(v0[2], v0[3]); w.z = cvt_pk_bf16(v1[0], v1[1]); w.w = cvt_pk_bf16(v1[2], v1[3]);
                    *(u32x4*)(rowp + bj * HALF) = w; } }
    }
};

struct PanelStats {
    unsigned* xbuf;
    unsigned* cnt;
    unsigned* tmo;
    int ntn; float eps;
    unsigned code;
    __device__ __forceinline__ bool run(const f32x4 (&v)[2][2][4][2], const Unit& u, int wr, int wc, int fr, int fq, PG8_LAS unsigned char* lds, int wid, int lane) const {
        typedef float f32x2v __attribute__((ext_vector_type(2)));
        PG8_LAS f32x2v* P = (PG8_LAS f32x2v*)lds;
        PG8_LAS f32x2v* S = (PG8_LAS f32x2v*)(lds + 8192);
        PG8_LAS unsigned* flag = (PG8_LAS unsigned*)(lds + 8192 + 2048);
#pragma unroll
        for (int ai = 0; ai < 2; ++ai)
#pragma unroll
            for (int m = 0; m < 4; ++m) {
                float s = 0.f;
#pragma unroll
                for (int bj = 0; bj < 2; ++bj)
#pragma unroll
                    for (int n = 0; n < 2; ++n) { const f32x4 x = v[ai][bj][m][n]; s += (x[0] + x[1]) + (x[2] + x[3]); }
                s += __shfl_xor(s, 16); s += __shfl_xor(s, 32);
                const float mw = s * (1.0f / 64.0f); float q = 0.f;
#pragma unroll
                for (int bj = 0; bj < 2; ++bj)
#pragma unroll
                    for (int n = 0; n < 2; ++n) { const f32x4 d = v[ai][bj][m][n] - mw; q += (d[0] * d[0] + d[1] * d[1]) + (d[2] * d[2] + d[3] * d[3]); }
                q += __shfl_xor(q, 16); q += __shfl_xor(q, 32);
                if (fq == 0) P[(ai * HALF + wr * 64 + m * 16 + fr) * 4 + wc] = (f32x2v){mw, q};
            }
        asm volatile("s_waitcnt lgkmcnt(0)" ::: "memory"); __builtin_amdgcn_s_barrier(); asm volatile("" ::: "memory");
#if defined(BROKEN_EXCHANGE_NO_WAIT)
#warning BROKEN CONTROL BUILD: the row-statistics exchange does not wait; results are wrong by design
        if (blockIdx.x >= 64) { const long long t0_ = clock64(); while (clock64() - t0_ < 60000) __builtin_amdgcn_s_sleep(8); }
#endif
        const int row = wid * 32 + (lane & 31);
        if (lane < 32) {
            const f32x2v a = P[row * 4 + 0], b = P[row * 4 + 1], c = P[row * 4 + 2], d = P[row * 4 + 3];
            const float mt = (a.x + b.x + c.x + d.x) * 0.25f;
            const float da = a.x - mt, db = b.x - mt, dc = c.x - mt, dd = d.x - mt;
            const float m2 = (a.y + b.y) + (c.y + d.y) + 64.0f * ((da * da + db * db) + (dc * dc + dd * dd));
            unsigned long long* slot = (unsigned long long*)xbuf + ((size_t)(u.pm * BM + row) * 4 + u.pn);
            __hip_atomic_store(slot, ((unsigned long long)__float_as_uint(m2) << 32) | __float_as_uint(mt), __ATOMIC_RELAXED, __HIP_MEMORY_SCOPE_AGENT);
        }
        asm volatile("s_waitcnt vmcnt(0)" ::: "memory");
        if (lane == 0) __hip_atomic_fetch_add(cnt + 64 * u.pm, 1u, __ATOMIC_RELAXED, __HIP_MEMORY_SCOPE_AGENT);
        if (wid == 0) {
            bool dead = false; const unsigned long long t0 = __builtin_amdgcn_s_memrealtime(); const unsigned want = 8u * (unsigned)ntn;
            for (;;) {
#if defined(BROKEN_EXCHANGE_NO_WAIT)
                break;
#endif
                if ((unsigned)__builtin_amdgcn_readfirstlane(__hip_atomic_load(cnt + 64 * u.pm, __ATOMIC_RELAXED, __HIP_MEMORY_SCOPE_AGENT)) >= want) break;
                if (__builtin_amdgcn_s_memrealtime() - t0 > 2000000ull) {
                    if (lane == 0) { unsigned expect = 0u; __hip_atomic_compare_exchange_strong(tmo + 1, &expect, code | (unsigned)(u.pm & 0xff), __ATOMIC_RELAXED, __ATOMIC_RELAXED, __HIP_MEMORY_SCOPE_AGENT);
                                     __hip_atomic_store(tmo, 1u, __ATOMIC_RELAXED, __HIP_MEMORY_SCOPE_AGENT); }
                    dead = true; break; }
                __builtin_amdgcn_s_sleep(2);
            }
            __builtin_amdgcn_fence(__ATOMIC_ACQUIRE, "agent");
            if (lane == 0) flag[0] = dead ? 1u : 0u;
        }
        asm volatile("s_waitcnt vmcnt(0) lgkmcnt(0)" ::: "memory"); __builtin_amdgcn_s_barrier(); asm volatile("" ::: "memory");
        const bool bad = flag[0] != 0u;
        if (lane < 32) {
            const unsigned long long* slot = (const unsigned long long*)xbuf + (size_t)(u.pm * BM + row) * 4; float mt[4], m2[4]; float ms = 0.f;
#pragma unroll
            for (int t = 0; t < 4; ++t) { if (t < ntn) { const unsigned long long w = __hip_atomic_load(slot + t, __ATOMIC_RELAXED, __HIP_MEMORY_SCOPE_AGENT); mt[t] = __uint_as_float((unsigned)w); m2[t] = __uint_as_float((unsigned)(w >> 32)); } else { mt[t] = 0.f; m2[t] = 0.f; } ms += mt[t]; }
            const float mean = ms / (float)ntn; float q = 0.f;
#pragma unroll
            for (int t = 0; t < 4; ++t) if (t < ntn) { const float dm = mt[t] - mean; q += m2[t] + 256.0f * dm * dm; }
            S[row] = (f32x2v){mean, 1.0f / sqrtf(q / (256.0f * (float)ntn) + eps)};
        }
        asm volatile("s_waitcnt lgkmcnt(0)" ::: "memory"); __builtin_amdgcn_s_barrier(); asm volatile("" ::: "memory");
        return bad;
    }
};
struct EpiLnRes {
    static constexpr bool PERM = false, AFTER_DRAIN = true;
    const float* base; float* out; int ldc; const float* bias; PanelStats st; unsigned poison;
    __device__ __forceinline__ void fused(f32x4 (&acc)[2][2][4][2], const Unit& u, int wr, int wc, int fr, int fq, PG8_LAS unsigned char* lds, int wid, int lane) const {
        typedef float f32x2v __attribute__((ext_vector_type(2)));
        const PG8_LAS f32x2v* S = (const PG8_LAS f32x2v*)(lds + 8192);
        const int col0 = u.pn * BM + wc * 32 + 4 * fq;
#pragma unroll
        for (int bj = 0; bj < 2; ++bj)
#pragma unroll
            for (int n = 0; n < 2; ++n) { const f32x4 bv = bias ? *(const f32x4*)(bias + col0 + bj * HALF + n * 16) : (f32x4){0.f, 0.f, 0.f, 0.f};
#pragma unroll
                for (int ai = 0; ai < 2; ++ai)
#pragma unroll
                    for (int m = 0; m < 4; ++m) acc[ai][bj][m][n] += bv; }
        f32x4 pre[4][2][2];
#pragma unroll
        for (int m = 0; m < 4; ++m) { const size_t off = (size_t)(u.pm * BM + wr * 64 + m * 16 + fr) * ldc + col0;
#pragma unroll
            for (int bj = 0; bj < 2; ++bj)
#pragma unroll
                for (int n = 0; n < 2; ++n) pre[m][bj][n] = *(const f32x4*)(base + off + bj * HALF + n * 16); }
        const bool bad = st.run(acc, u, wr, wc, fr, fq, lds, wid, lane) || poison != 0u;
        const float qnan = __builtin_nanf("");
#pragma unroll
        for (int ai = 0; ai < 2; ++ai)
#pragma unroll
            for (int m = 0; m < 4; ++m) { const int r = ai * HALF + wr * 64 + m * 16 + fr; const f32x2v sr = S[r]; const size_t off = (size_t)(u.pm * BM + r) * ldc + col0;
#pragma unroll
                for (int bj = 0; bj < 2; ++bj)
#pragma unroll
                    for (int n = 0; n < 2; ++n) { const f32x4 bs = ai == 0 ? pre[m][bj][n] : *(const f32x4*)(base + off + bj * HALF + n * 16); f32x4 o = bs + (acc[ai][bj][m][n] - sr.x) * sr.y;
                        if (bad) o = (f32x4){qnan, qnan, qnan, qnan}; *(f32x4*)(out + off + bj * HALF + n * 16) = o; }
                if (m & 1) asm volatile("" ::: "memory"); }
    }
};
struct EpiLnResLn {
    static constexpr bool PERM = false, AFTER_DRAIN = true;
    const float* base; float* out; bf16_t* xn; int ldc; const float* bias; PanelStats st1, st2; unsigned poison;
    __device__ __forceinline__ void fused(f32x4 (&acc)[2][2][4][2], const Unit& u, int wr, int wc, int fr, int fq, PG8_LAS unsigned char* lds, int wid, int lane) const {
        typedef float f32x2v __attribute__((ext_vector_type(2))); typedef unsigned u32x2v __attribute__((ext_vector_type(2)));
        const PG8_LAS f32x2v* S = (const PG8_LAS f32x2v*)(lds + 8192);
        const int col0 = u.pn * BM + wc * 32 + 4 * fq;
#pragma unroll
        for (int bj = 0; bj < 2; ++bj)
#pragma unroll
            for (int n = 0; n < 2; ++n) { const f32x4 bv = bias ? *(const f32x4*)(bias + col0 + bj * HALF + n * 16) : (f32x4){0.f, 0.f, 0.f, 0.f};
#pragma unroll
                for (int ai = 0; ai < 2; ++ai)
#pragma unroll
                    for (int m = 0; m < 4; ++m) acc[ai][bj][m][n] += bv; }
        bool bad = st1.run(acc, u, wr, wc, fr, fq, lds, wid, lane) || poison != 0u;
        const float qnan = __builtin_nanf("");
#pragma unroll
        for (int ai = 0; ai < 2; ++ai)
#pragma unroll
            for (int m = 0; m < 4; ++m) { const int r = ai * HALF + wr * 64 + m * 16 + fr; const f32x2v sr = S[r]; const size_t off = (size_t)(u.pm * BM + r) * ldc + col0;
#pragma unroll
                for (int bj = 0; bj < 2; ++bj)
#pragma unroll
                    for (int n = 0; n < 2; ++n) { const f32x4 bs = *(const f32x4*)(base + off + bj * HALF + n * 16); acc[ai][bj][m][n] = bs + (acc[ai][bj][m][n] - sr.x) * sr.y; }
                asm volatile("" : "+v"(acc[ai][0][m][0]), "+v"(acc[ai][0][m][1]), "+v"(acc[ai][1][m][0]), "+v"(acc[ai][1][m][1]));
                if (m & 1) asm volatile("" ::: "memory"); }
        const bool bad1 = bad;
        bad = st2.run(acc, u, wr, wc, fr, fq, lds, wid, lane) || bad;
#pragma unroll
        for (int ai = 0; ai < 2; ++ai)
#pragma unroll
            for (int m = 0; m < 4; ++m) { const int r = ai * HALF + wr * 64 + m * 16 + fr; const f32x2v sr = S[r]; const size_t off = (size_t)(u.pm * BM + r) * ldc + col0;
#pragma unroll
                for (int bj = 0; bj < 2; ++bj)
#pragma unroll
                    for (int n = 0; n < 2; ++n) { const f32x4 x1 = acc[ai][bj][m][n]; *(f32x4*)(out + off + bj * HALF + n * 16) = bad1 ? (f32x4){qnan, qnan, qnan, qnan} : x1;
                        const f32x4 o = (x1 - sr.x) * sr.y; u32x2v w; w.x = cvt_pk_bf16(o[0], o[1]); w.y = cvt_pk_bf16(o[2], o[3]);
                        if (bad) { w.x = 0x7fc07fc0u; w.y = 0x7fc07fc0u; } *(u32x2v*)(xn + off + bj * HALF + n * 16) = w; }
                asm volatile("" ::: "memory"); }
    }
};

template <class Epi, class Sched, bool ALIGN_EPI = false, bool SP2 = false>
__device__ __forceinline__ void gemm_phase(PG8_LAS unsigned char* lds, const Gemm g, const Sched& S, const Epi& E) {
    int tid_l = threadIdx.x; asm volatile("" : "+v"(tid_l));
    const int tid = tid_l, wid = __builtin_amdgcn_readfirstlane(tid >> 6), lane = tid & 63, wr = wid >> 2, wc = wid & 3, fr = lane & 15, fq = lane >> 4;
    const int K = g.K, nt = K / BK;
    unsigned voffA[2], voffB[2];
#pragma unroll
    for (int i = 0; i < 2; ++i) { int R, C; stage_rc(tid * 16 + i * 8192, R, C); const int Rb = Epi::PERM ? ((R & ~31) + perm32(R & 31)) : R;
        voffA[i] = (unsigned)(R * K + C) * 2u; voffB[i] = (unsigned)(Rb * K + C) * 2u; }
    const size_t kstep = (size_t)(BK * 2);
    const size_t hstep = (size_t)HALF * K * 2;
    const size_t tstep = 2 * hstep;
    const unsigned ldsw = (unsigned)wid * 1024u;
    const int aoff = lds_byte(wr * 64 + fr, fq * 8), boff = lds_byte(wc * 32 + fr, fq * 8);
#define PG8_SA(b, h) (((b) * 2 + (h)) * HTB)
#define PG8_SB(b, h) ((4 + (b) * 2 + (h)) * HTB)
#define PG8_STAGE(bufoff, gbase, voff) do { _Pragma("unroll") for (int _i = 0; _i < 2; ++_i) \
        __builtin_amdgcn_global_load_lds((const unsigned*)((const char*)(gbase) + (voff)[_i]), (PG8_LAS unsigned*)(lds + (bufoff) + ldsw + _i * 8192), 16, 0, 0); } while (0)
#define PG8_LDA(dst, b, h) do { _Pragma("unroll") for (int m = 0; m < 4; ++m) _Pragma("unroll") for (int k = 0; k < 2; ++k) dst[m][k] = *(const PG8_LAS bf16x8*)(lds + PG8_SA(b, h) + aoff + m * 2048 + k * 1024); } while (0)
#define PG8_LDB(dst, b, h) do { _Pragma("unroll") for (int n = 0; n < 2; ++n) _Pragma("unroll") for (int k = 0; k < 2; ++k) dst[n][k] = *(const PG8_LAS bf16x8*)(lds + PG8_SB(b, h) + boff + n * 2048 + k * 1024); } while (0)
#define PG8_MMA(ai, bj, At, Bt) do { __builtin_amdgcn_s_setprio(1); _Pragma("unroll") for (int m = 0; m < 4; ++m) _Pragma("unroll") for (int n = 0; n < 2; ++n) _Pragma("unroll") for (int k = 0; k < 2; ++k) \
        acc[ai][bj][m][n] = __builtin_amdgcn_mfma_f32_16x16x32_bf16(Bt[n][k], At[m][k], acc[ai][bj][m][n], 0, 0, 0); __builtin_amdgcn_s_setprio(0); } while (0)
#define PG8_WAIT_V(n) asm volatile("s_waitcnt vmcnt(" #n ")" ::: "memory")
#define PG8_WAIT_L(n) asm volatile("s_waitcnt lgkmcnt(" #n ")" ::: "memory")
#define PG8_BAR __builtin_amdgcn_s_barrier()
#define PG8_SCHED __builtin_amdgcn_sched_barrier(0)
    Unit cur, nxt; int ui = 0;
    if (!S.next(0, cur)) return;
    f32x4 acc[2][2][4][2];
#pragma unroll
    for (int a = 0; a < 2; ++a)
#pragma unroll
        for (int b = 0; b < 2; ++b)
#pragma unroll
            for (int m = 0; m < 4; ++m)
#pragma unroll
                for (int n = 0; n < 2; ++n) acc[a][b][m][n] = (f32x4){0.f, 0.f, 0.f, 0.f};
    bf16x8 At[4][2], B0[2][2], B1[2][2];
    const char* cA = (const char*)g.A + (size_t)cur.pm * tstep; const char* cB = (const char*)g.Bt + (size_t)cur.pn * tstep;
    S.a_ready(cur);
    if constexpr (SP2) {
        PG8_STAGE(PG8_SB(0, 0), cB, voffB); PG8_STAGE(PG8_SB(0, 1), cB + hstep, voffB); PG8_STAGE(PG8_SA(0, 0), cA, voffA); PG8_STAGE(PG8_SA(0, 1), cA + hstep, voffA);
        if (wr == 1) PG8_BAR;
        PG8_WAIT_V(2); PG8_BAR;
        PG8_STAGE(PG8_SB(1, 0), cB + kstep, voffB); PG8_STAGE(PG8_SA(1, 0), cA + kstep, voffA); PG8_STAGE(PG8_SB(1, 1), cB + hstep + kstep, voffB);
        PG8_WAIT_V(6); PG8_BAR;
    } else {
        PG8_STAGE(PG8_SB(0, 0), cB, voffB); PG8_STAGE(PG8_SA(0, 0), cA, voffA); PG8_STAGE(PG8_SB(0, 1), cB + hstep, voffB); PG8_STAGE(PG8_SA(0, 1), cA + hstep, voffA);
        if (wr == 1) PG8_BAR;
        PG8_WAIT_V(4); PG8_BAR;
        PG8_STAGE(PG8_SB(1, 0), cB + kstep, voffB); PG8_STAGE(PG8_SA(1, 0), cA + kstep, voffA); PG8_STAGE(PG8_SB(1, 1), cB + hstep + kstep, voffB);
        PG8_WAIT_V(6); PG8_BAR;
    }
    for (;;) {
        const bool has_next = S.next(ui + 1, nxt);
        const char* nA = has_next ? (const char*)g.A + (size_t)nxt.pm * tstep : cA; const char* nB = has_next ? (const char*)g.Bt + (size_t)nxt.pn * tstep : cB;
        for (int t = 0; t < nt; t += 2) {
            const bool last = (t == nt - 2);
            const char* a1 = cA + (size_t)(t + 1) * kstep;
            const char* a2 = last ? nA : cA + (size_t)(t + 2) * kstep; const char* b2 = last ? nB : cB + (size_t)(t + 2) * kstep;
            const char* a3 = a2 + kstep; const char* b3 = b2 + kstep;
            if (last && has_next) S.a_ready(nxt);
            if constexpr (SP2) {
            PG8_LDB(B0, 0, 0); PG8_LDB(B1, 0, 1); PG8_SCHED; PG8_LDA(At, 0, 0); PG8_STAGE(PG8_SA(1, 1), a1 + hstep, voffA);
            PG8_WAIT_V(8); PG8_WAIT_L(0); PG8_BAR; PG8_MMA(0, 0, At, B0); PG8_MMA(0, 1, At, B1); PG8_BAR; PG8_SCHED;
            PG8_LDA(At, 0, 1); PG8_STAGE(PG8_SB(0, 0), b2, voffB); PG8_STAGE(PG8_SB(0, 1), b2 + hstep, voffB); PG8_STAGE(PG8_SA(0, 0), a2, voffA);
            PG8_WAIT_V(8); PG8_WAIT_L(0); PG8_BAR; PG8_MMA(1, 0, At, B0); PG8_MMA(1, 1, At, B1); PG8_BAR; PG8_SCHED;
            PG8_LDB(B0, 1, 0); PG8_LDB(B1, 1, 1); PG8_SCHED; PG8_LDA(At, 1, 0); PG8_STAGE(PG8_SA(0, 1), a2 + hstep, voffA);
            PG8_WAIT_V(8); PG8_WAIT_L(0); PG8_BAR; PG8_MMA(0, 0, At, B0); PG8_MMA(0, 1, At, B1); PG8_BAR; PG8_SCHED;
            PG8_LDA(At, 1, 1); PG8_STAGE(PG8_SB(1, 0), b3, voffB); PG8_STAGE(PG8_SB(1, 1), b3 + hstep, voffB); PG8_STAGE(PG8_SA(1, 0), a3, voffA);
            PG8_WAIT_V(8); PG8_WAIT_L(0); PG8_BAR; PG8_MMA(1, 0, At, B0); PG8_MMA(1, 1, At, B1); PG8_BAR; PG8_SCHED;
            } else {
            PG8_LDB(B0, 0, 0); PG8_SCHED; PG8_LDA(At, 0, 0); PG8_STAGE(PG8_SA(1, 1), a1 + hstep, voffA);
            PG8_WAIT_L(8); PG8_BAR; PG8_WAIT_L(0); PG8_MMA(0, 0, At, B0); PG8_BAR; PG8_SCHED;
            PG8_LDB(B1, 0, 1); PG8_STAGE(PG8_SB(0, 0), b2, voffB);
            PG8_BAR; PG8_WAIT_L(0); PG8_MMA(0, 1, At, B1); PG8_BAR;
            PG8_LDA(At, 0, 1); PG8_STAGE(PG8_SA(0, 0), a2, voffA);
            PG8_BAR; PG8_WAIT_L(0); PG8_MMA(1, 0, At, B0); PG8_BAR; PG8_SCHED;
            PG8_STAGE(PG8_SB(0, 1), b2 + hstep, voffB);
            PG8_WAIT_V(6); PG8_BAR; PG8_MMA(1, 1, At, B1); PG8_BAR;
            PG8_LDB(B0, 1, 0); PG8_SCHED; PG8_LDA(At, 1, 0); PG8_STAGE(PG8_SA(0, 1), a2 + hstep, voffA);
            PG8_WAIT_L(8); PG8_BAR; PG8_WAIT_L(0); PG8_MMA(0, 0, At, B0); PG8_BAR; PG8_SCHED;
            PG8_LDB(B1, 1, 1); PG8_STAGE(PG8_SB(1, 0), b3, voffB);
            PG8_BAR; PG8_WAIT_L(0); PG8_MMA(0, 1, At, B1); PG8_BAR;
            PG8_LDA(At, 1, 1); PG8_STAGE(PG8_SA(1, 0), a3, voffA);
            PG8_BAR; PG8_WAIT_L(0); PG8_MMA(1, 0, At, B0); PG8_BAR; PG8_SCHED;
            PG8_STAGE(PG8_SB(1, 1), b3 + hstep, voffB);
            PG8_WAIT_V(6); PG8_BAR; PG8_MMA(1, 1, At, B1); PG8_BAR;
            }
        }
        if constexpr (ALIGN_EPI) { if (wr == 0) PG8_BAR; }
        if constexpr (!Epi::AFTER_DRAIN) { E(acc, cur, wr, wc, fr, fq); S.done(cur); }
        if (!has_next) break;
#pragma unroll
        for (int a = 0; a < 2; ++a)
#pragma unroll
            for (int b = 0; b < 2; ++b)
#pragma unroll
                for (int m = 0; m < 4; ++m)
#pragma unroll
                    for (int n = 0; n < 2; ++n) acc[a][b][m][n] = (f32x4){0.f, 0.f, 0.f, 0.f};
        cur = nxt; cA = nA; cB = nB; ++ui;
        if constexpr (ALIGN_EPI) { if (wr == 1) PG8_BAR; }
    }
    PG8_WAIT_V(0);
    if constexpr (!ALIGN_EPI) { if (wr == 0) PG8_BAR; }
    PG8_BAR;
    if constexpr (Epi::AFTER_DRAIN) { E.fused(acc, cur, wr, wc, fr, fq, lds, wid, lane); S.done(cur); }
#undef PG8_SA
#undef PG8_SB
#undef PG8_STAGE
#undef PG8_LDA
#undef PG8_LDB
#undef PG8_MMA
#undef PG8_WAIT_V
#undef PG8_WAIT_L
#undef PG8_BAR
#undef PG8_SCHED
}
}
namespace pg8 {
__device__ __forceinline__ u32x4 pack8bf(const f32x4 a, const f32x4 b) { u32x4 w; w.x = cvt_pk_bf16(a[0], a[1]); w.y = cvt_pk_bf16(a[2], a[3]); w.z = cvt_pk_bf16(b[0], b[1]); w.w = cvt_pk_bf16(b[2], b[3]); return w; }
__device__ __forceinline__ void rope8(f32x4& v0, f32x4& v1, const f32x4 cs, const f32x4 sn) {
    float a, b;
    a = v0[0]; b = v0[1]; v0[0] = a * cs[0] - b * sn[0]; v0[1] = b * cs[0] + a * sn[0];
    a = v0[2]; b = v0[3]; v0[2] = a * cs[1] - b * sn[1]; v0[3] = b * cs[1] + a * sn[1];
    a = v1[0]; b = v1[1]; v1[0] = a * cs[2] - b * sn[2]; v1[1] = b * cs[2] + a * sn[2];
    a = v1[2]; b = v1[3]; v1[2] = a * cs[3] - b * sn[3]; v1[3] = b * cs[3] + a * sn[3];
}
__device__ __forceinline__ float silu_f(float x) { return x * __builtin_amdgcn_rcpf(1.0f + __builtin_amdgcn_exp2f(-1.4426950408889634f * x)); }
__device__ __forceinline__ float sq4(const f32x4 v) { return (v[0] * v[0] + v[1] * v[1]) + (v[2] * v[2] + v[3] * v[3]); }
template <int NP> __device__ __forceinline__ float row_scale(const float* SS, size_t row, float inv_n, float eps, int fq) {
    const float* p = SS + row * NP; float s;
    if constexpr (NP == 32) { const f32x4 a = *(const f32x4*)(p + fq * 8), b = *(const f32x4*)(p + fq * 8 + 4); s = ((a[0] + a[1]) + (a[2] + a[3])) + ((b[0] + b[1]) + (b[2] + b[3])); s += __shfl_xor(s, 16); s += __shfl_xor(s, 32); }
    else if constexpr (NP == 8) { const f32x4 a = *(const f32x4*)p, b = *(const f32x4*)(p + 4); s = ((a[0] + a[1]) + (a[2] + a[3])) + ((b[0] + b[1]) + (b[2] + b[3])); }
    else { const f32x4 a = *(const f32x4*)p; s = (a[0] + a[1]) + (a[2] + a[3]); }
    return 1.0f / sqrtf(s * inv_n + eps);
}

struct EpiIn {
    static constexpr bool PERM = true, AFTER_DRAIN = false;
    const float* XSS; bf16_t* CQ; bf16_t* CKV; float* CQSS; float* CKVSS; bf16_t* Kb; const float* c64; const float* s64;
    bf16_t* RQ; bf16_t* RK; bf16_t* RV; bf16_t* RG; const float* c128; const float* s128;
    const PG8_LAS float* rtab; int rpm;
    __device__ __forceinline__ void operator()(const f32x4 (&acc)[2][2][4][2], const Unit& u, int wr, int wc, int fr, int fq) const {
        const int pn = u.pn, row0 = u.pm * BM + wr * 64 + fr, cw = wc * 32 + 8 * fq;
#pragma unroll
        for (int ai = 0; ai < 2; ++ai) {
            float r4[4];
#pragma unroll
            for (int m = 0; m < 4; ++m) r4[m] = (u.pm == rpm) ? rtab[wr * 64 + fr + ai * HALF + m * 16] : row_scale<32>(XSS, (size_t)(row0 + ai * HALF + m * 16), 1.0f / 2048.0f, 1e-6f, fq);
            asm volatile("" : "+v"(r4[0]), "+v"(r4[1]), "+v"(r4[2]), "+v"(r4[3]));
            if (pn < 3) {
#pragma unroll
                for (int m = 0; m < 4; ++m) { const size_t row = (size_t)(row0 + ai * HALF + m * 16); const float r = r4[m];
                    const f32x4 a0 = acc[ai][0][m][0] * r, a1 = acc[ai][0][m][1] * r, b0 = acc[ai][1][m][0] * r, b1 = acc[ai][1][m][1] * r;
                    float s = (sq4(a0) + sq4(a1)) + (sq4(b0) + sq4(b1)); s += __shfl_xor(s, 16); s += __shfl_xor(s, 32);
                    if (pn < 2) { bf16_t* rp = CQ + row * 512 + pn * 256 + cw; *(u32x4*)rp = pack8bf(a0, a1); *(u32x4*)(rp + HALF) = pack8bf(b0, b1); if (fq == 0) CQSS[row * 8 + pn * 4 + wc] = s; }
                    else { bf16_t* rp = CKV + row * 256 + cw; *(u32x4*)rp = pack8bf(a0, a1); *(u32x4*)(rp + HALF) = pack8bf(b0, b1); if (fq == 0) CKVSS[row * 4 + wc] = s; } }
            } else if (pn == 3) {
                if (wc < 2) { const int j0 = cw >> 1;
#pragma unroll
                    for (int m = 0; m < 4; ++m) { const size_t row = (size_t)(row0 + ai * HALF + m * 16); const float r = r4[m];
                        const f32x4 cs = *(const f32x4*)(c64 + row * 32 + j0), sn = *(const f32x4*)(s64 + row * 32 + j0);
                        f32x4 v0 = acc[ai][0][m][0] * r, v1 = acc[ai][0][m][1] * r; rope8(v0, v1, cs, sn); const u32x4 w = pack8bf(v0, v1);
                        bf16_t* kp = Kb + row * 1536 + 128 + cw;
#pragma unroll
                        for (int h = 0; h < 8; ++h) *(u32x4*)(kp + h * 192) = w; } }
            } else if (pn < 12) {
                bf16_t* T = pn < 8 ? RQ : RK; const float sc = pn < 8 ? 0.08838834764831845f : 1.0f; const int ct = ((pn - 4) & 3) * 256 + cw, j0 = cw >> 1;
#pragma unroll
                for (int m = 0; m < 4; ++m) { const size_t row = (size_t)(row0 + ai * HALF + m * 16); const float r = r4[m] * sc;
                    const f32x4 cs = *(const f32x4*)(c128 + row * 64 + j0), sn = *(const f32x4*)(s128 + row * 64 + j0);
#pragma unroll
                    for (int bj = 0; bj < 2; ++bj) { f32x4 v0 = acc[ai][bj][m][0] * r, v1 = acc[ai][bj][m][1] * r; rope8(v0, v1, cs, sn);
                        *(u32x4*)(T + row * 1024 + ct + bj * HALF) = pack8bf(v0, v1); } }
            } else if (pn < 16) {
                const int ct = (pn - 12) * 256 + cw;
#pragma unroll
                for (int m = 0; m < 4; ++m) { const size_t row = (size_t)(row0 + ai * HALF + m * 16); bf16_t* rp = RV + row * 1024 + ct; const float r = r4[m];
#pragma unroll
                    for (int bj = 0; bj < 2; ++bj) *(u32x4*)(rp + bj * HALF) = pack8bf(acc[ai][bj][m][0] * r, acc[ai][bj][m][1] * r); }
            } else {
                const int ct = (pn - 16) * 256 + cw;
#pragma unroll
                for (int m = 0; m < 4; ++m) { const size_t row = (size_t)(row0 + ai * HALF + m * 16); bf16_t* rp = RG + row * 1024 + ct; const float r = r4[m];
#pragma unroll
                    for (int bj = 0; bj < 2; ++bj) { f32x4 v0 = acc[ai][bj][m][0] * r, v1 = acc[ai][bj][m][1] * r;
#pragma unroll
                        for (int e = 0; e < 4; ++e) { v0[e] = silu_f(v0[e]); v1[e] = silu_f(v1[e]); }
                        *(u32x4*)(rp + bj * HALF) = pack8bf(v0, v1); } }
            }
        }
    }
};
struct EpiQ {
    static constexpr bool PERM = true, AFTER_DRAIN = false;
    const float* CQSS; bf16_t* Q; const float* c64; const float* s64; float sc;
    __device__ __forceinline__ void operator()(const f32x4 (&acc)[2][2][4][2], const Unit& u, int wr, int wc, int fr, int fq) const {
        const int row0 = u.pm * BM + wr * 64 + fr, cw = wc * 32 + 8 * fq;
#pragma unroll
        for (int ai = 0; ai < 2; ++ai)
#pragma unroll
            for (int m = 0; m < 4; ++m) { const size_t row = (size_t)(row0 + ai * HALF + m * 16); const float r = row_scale<8>(CQSS, row, 1.0f / 512.0f, 1e-6f, fq) * sc;
#pragma unroll
                for (int bj = 0; bj < 2; ++bj) { const int c0 = u.pn * 256 + bj * HALF + cw, dd = c0 % 192; const bool rp = dd >= 128; const int j0 = rp ? ((dd - 128) >> 1) : 0;
                    f32x4 v0 = acc[ai][bj][m][0] * r, v1 = acc[ai][bj][m][1] * r;
                    if (rp) { const f32x4 cs = *(const f32x4*)(c64 + row * 32 + j0), sn = *(const f32x4*)(s64 + row * 32 + j0); rope8(v0, v1, cs, sn); }
                    *(u32x4*)(Q + row * 1536 + c0) = pack8bf(v0, v1); } }
    }
};
struct EpiKV {
    static constexpr bool PERM = true, AFTER_DRAIN = false;
    const float* CKVSS; bf16_t* K; bf16_t* V;
    __device__ __forceinline__ void operator()(const f32x4 (&acc)[2][2][4][2], const Unit& u, int wr, int wc, int fr, int fq) const {
        const int row0 = u.pm * BM + wr * 64 + fr, cw = wc * 32 + 8 * fq;
#pragma unroll
        for (int ai = 0; ai < 2; ++ai)
#pragma unroll
            for (int m = 0; m < 4; ++m) { const size_t row = (size_t)(row0 + ai * HALF + m * 16); const float r = row_scale<4>(CKVSS, row, 1.0f / 256.0f, 1e-6f, fq);
                *(u32x4*)(K + row * 1536 + u.pn * 192 + cw) = pack8bf(acc[ai][0][m][0] * r, acc[ai][0][m][1] * r);
                *(u32x4*)(V + row * 1024 + u.pn * 128 + cw) = pack8bf(acc[ai][1][m][0] * r, acc[ai][1][m][1] * r); }
    }
};
__device__ __forceinline__ f32x4 bf_lo4(unsigned a, unsigned b) { return (f32x4){__uint_as_float(a << 16), __uint_as_float(a & 0xffff0000u), __uint_as_float(b << 16), __uint_as_float(b & 0xffff0000u)}; }
template <bool SCALE2  , bool BASE_F32>
struct EpiResT {
    static constexpr bool PERM = true, AFTER_DRAIN = false;
    const float* base; bf16_t* XB; bf16_t* XL; float* XSS; const float* RS; const PG8_LAS float* rtab; int rpm;
    __device__ __forceinline__ void operator()(const f32x4 (&acc)[2][2][4][2], const Unit& u, int wr, int wc, int fr, int fq) const {
        const int row0 = u.pm * BM + wr * 64 + fr, c0 = u.pn * BM + wc * 32 + 8 * fq;
#pragma unroll
        for (int ai = 0; ai < 2; ++ai) {
            float r2[4];
#pragma unroll
            for (int m = 0; m < 4; ++m) { if constexpr (SCALE2) { const float r = (u.pm == rpm) ? rtab[wr * 64 + fr + ai * HALF + m * 16] : row_scale<32>(RS, (size_t)(row0 + ai * HALF + m * 16), 1.0f / 2048.0f, 1e-6f, fq); r2[m] = r * r; } else r2[m] = 1.0f; }
            if constexpr (SCALE2) asm volatile("" : "+v"(r2[0]), "+v"(r2[1]), "+v"(r2[2]), "+v"(r2[3]));
            f32x4 pre[4][4];
#pragma unroll
            for (int m = 0; m < 4; ++m) { const size_t off = (size_t)(row0 + ai * HALF + m * 16) * 2048 + c0;
                if constexpr (BASE_F32) { pre[m][0] = *(const f32x4*)(base + off); pre[m][1] = *(const f32x4*)(base + off + 4); pre[m][2] = *(const f32x4*)(base + off + HALF); pre[m][3] = *(const f32x4*)(base + off + HALF + 4); }
                else { pre[m][0] = *(const f32x4*)(XB + off); pre[m][1] = *(const f32x4*)(XL + off); pre[m][2] = *(const f32x4*)(XB + off + HALF); pre[m][3] = *(const f32x4*)(XL + off + HALF); } }
#pragma unroll
            for (int m = 0; m < 4; ++m) asm volatile("" : "+v"(pre[m][0]), "+v"(pre[m][1]), "+v"(pre[m][2]), "+v"(pre[m][3]));
#pragma unroll
            for (int m = 0; m < 4; ++m) { const size_t row = (size_t)(row0 + ai * HALF + m * 16); const size_t off = row * 2048 + c0;
                f32x4 x0, x1, y0, y1;
                if constexpr (BASE_F32) { x0 = pre[m][0]; x1 = pre[m][1]; y0 = pre[m][2]; y1 = pre[m][3]; }
                else { const u32x4 h0 = __builtin_bit_cast(u32x4, pre[m][0]), l0 = __builtin_bit_cast(u32x4, pre[m][1]), h1 = __builtin_bit_cast(u32x4, pre[m][2]), l1 = __builtin_bit_cast(u32x4, pre[m][3]);
                    x0 = bf_lo4(h0.x, h0.y) + bf_lo4(l0.x, l0.y); x1 = bf_lo4(h0.z, h0.w) + bf_lo4(l0.z, l0.w); y0 = bf_lo4(h1.x, h1.y) + bf_lo4(l1.x, l1.y); y1 = bf_lo4(h1.z, h1.w) + bf_lo4(l1.z, l1.w); }
                f32x4 a0, a1, b0, b1;
                if constexpr (SCALE2) { a0 = x0 + acc[ai][0][m][0] * r2[m]; a1 = x1 + acc[ai][0][m][1] * r2[m]; b0 = y0 + acc[ai][1][m][0] * r2[m]; b1 = y1 + acc[ai][1][m][1] * r2[m]; }
                else { a0 = x0 + acc[ai][0][m][0]; a1 = x1 + acc[ai][0][m][1]; b0 = y0 + acc[ai][1][m][0]; b1 = y1 + acc[ai][1][m][1]; }
                const u32x4 ha = pack8bf(a0, a1), hb = pack8bf(b0, b1);
                *(u32x4*)(XB + off) = ha; *(u32x4*)(XB + off + HALF) = hb;
                *(u32x4*)(XL + off) = pack8bf(a0 - bf_lo4(ha.x, ha.y), a1 - bf_lo4(ha.z, ha.w)); *(u32x4*)(XL + off + HALF) = pack8bf(b0 - bf_lo4(hb.x, hb.y), b1 - bf_lo4(hb.z, hb.w));
                float s = (sq4(a0) + sq4(a1)) + (sq4(b0) + sq4(b1)); s += __shfl_xor(s, 16); s += __shfl_xor(s, 32);
                if (fq == 0) XSS[row * 32 + u.pn * 4 + wc] = s; }
        }
    }
};
struct EpiRelu2 {
    static constexpr bool PERM = true, AFTER_DRAIN = false;
    bf16_t* O; int ldc;
    __device__ __forceinline__ void operator()(const f32x4 (&acc)[2][2][4][2], const Unit& u, int wr, int wc, int fr, int fq) const {
        const int row0 = u.pm * BM + wr * 64 + fr, c0 = u.pn * BM + wc * 32 + 8 * fq;
#pragma unroll
        for (int ai = 0; ai < 2; ++ai)
#pragma unroll
            for (int m = 0; m < 4; ++m) { bf16_t* rp = O + (size_t)(row0 + ai * HALF + m * 16) * ldc + c0;
#pragma unroll
                for (int bj = 0; bj < 2; ++bj) { f32x4 v0 = acc[ai][bj][m][0], v1 = acc[ai][bj][m][1];
#pragma unroll
                    for (int e = 0; e < 4; ++e) { const float a = fmaxf(v0[e], 0.f), b = fmaxf(v1[e], 0.f); v0[e] = a * a; v1[e] = b * b; }
                    *(u32x4*)(rp + bj * HALF) = pack8bf(v0, v1); } }
    }
};
}
constexpr int NWAVES = 8;
constexpr int BATCH = 2, SEQ = 8192, DM = 2048, DEPTH = 4, M = BATCH * SEQ;
constexpr int NH = 8, QLORA = 512, KVLORA = 256, DQK = 192, DNOPE = 128, DROPE = 64, DV = 128, FF = 8192;
constexpr int IN_SRC = 4928, IN_PAD = 5120;
constexpr int RCH = 128, NCH = SEQ / RCH;
constexpr float NORM_EPS = 1e-6f, GN_EPS = 1e-6f;
constexpr float QSCALE = 0.07216878364870323f * 1.4426950408889634f;

constexpr size_t MiB = 1u << 20;
constexpr size_t WS_CTL = 0, CTL_ZERO_BYTES = 128 * 1024;
constexpr size_t WS_C64 = 2 * MiB, WS_S64 = 4 * MiB, WS_C128 = 6 * MiB, WS_S128 = 10 * MiB;
constexpr size_t WS_XSS = 14 * MiB;
constexpr size_t WS_W = 16 * MiB, W_STRIDE = 96 * MiB;
constexpr size_t WO_WIN = 0, WO_WUQ = 20 * MiB, WO_WUKV = 22 * MiB, WO_WO = 24 * MiB, WO_WUP = 32 * MiB, WO_WDN = 64 * MiB;
constexpr size_t WS_XB = 208 * MiB;
constexpr size_t WS_MIX = 272 * MiB;
constexpr size_t WS_CQSS = 336 * MiB, WS_CKVSS = 337 * MiB;
constexpr size_t WS_RQ = 338 * MiB, WS_RK = 370 * MiB, WS_RV = 402 * MiB, WS_RG = 434 * MiB;
constexpr size_t WS_CQ = 466 * MiB, WS_CKV = 482 * MiB;
constexpr size_t WS_Q = 490 * MiB, WS_K = 538 * MiB, WS_V = 586 * MiB;
constexpr size_t WS_U = 618 * MiB, WS_S = 682 * MiB;
constexpr size_t WS_UF = 338 * MiB;
constexpr size_t WS_XSS2 = 714 * MiB;
constexpr size_t WS_XL = 716 * MiB;
constexpr size_t WS_END = 780 * MiB;
static_assert(WS_UF + (size_t)M * FF * 2 <= WS_U && WS_S + (size_t)16 * 64 * 16384 * 2 <= WS_END && WS_U + (size_t)16 * 64 * 16384 * 4 <= WS_S, "d_ws map");
static_assert(WO_WIN + (size_t)IN_PAD * DM * 2 <= WO_WUQ && WO_WUQ + (size_t)1536 * 512 * 2 <= WO_WUKV && WO_WUKV + (size_t)2048 * 256 * 2 <= WO_WO && WO_WO + (size_t)DM * DM * 2 <= WO_WUP && WO_WUP + (size_t)FF * DM * 2 <= WO_WDN && WO_WDN + (size_t)FF * DM * 2 <= W_STRIDE && WS_W + 2 * W_STRIDE <= WS_XB, "weights map");
constexpr int CW_TMO = 0, CW_CODE = 1, CW_BAR = 4096;
constexpr int CW_AQ = 12288;
constexpr int CW_SRDY = 12544, CW_RQ = 12800;
constexpr int CW_WQ = 8192;
static_assert(CW_BAR + 3456 <= CW_WQ && (CW_WQ + 64 * DEPTH) <= CW_AQ && (CW_AQ + 64 * DEPTH) <= CW_SRDY && (CW_SRDY + 64 * DEPTH) <= CW_RQ && (CW_RQ + 64 * DEPTH) * 4 <= (int)CTL_ZERO_BYTES, "control words inside the per-call memset");

constexpr int RING_OFF = 0, RING_BYTES = 131072;
constexpr int LDSCTL_OFF = RING_BYTES, MISC_OFF = LDSCTL_OFF + 320;
constexpr int LDS_BYTES = 147456;
static_assert(MISC_OFF + 128 <= LDS_BYTES, "LDS map");

#define GAS __attribute__((address_space(1)))
#define LAS __attribute__((address_space(3)))
typedef unsigned short bf16;
typedef unsigned v4u __attribute__((ext_vector_type(4)));
typedef float f32x4 __attribute__((ext_vector_type(4)));
typedef short bf16x8 __attribute__((ext_vector_type(8)));
typedef GAS unsigned gu32;
typedef GAS unsigned long long gu64;
#define RLX_AGENT __ATOMIC_RELAXED, __HIP_MEMORY_SCOPE_AGENT
#define LDS_WAIT() asm volatile("s_waitcnt lgkmcnt(0)" ::: "memory")
#define VM_WAIT() asm volatile("s_waitcnt vmcnt(0)" ::: "memory")
__device__ __forceinline__ unsigned long long rt() { return __builtin_amdgcn_s_memrealtime(); }
__device__ __forceinline__ unsigned f2bf(float f) { unsigned u = __builtin_bit_cast(unsigned, f); return (u + 0x7fffu + ((u >> 16) & 1u)) >> 16; }
__device__ __forceinline__ unsigned pk2(float lo, float hi) { return f2bf(lo) | (f2bf(hi) << 16); }

#define XB_TMO      128
#define XB_XCNT(j)  (256  + 64 * (j))
#define XB_XSUB(j)  (1280 + 64 * (j))
#define XB_XGEN(j)  (2304 + 64 * (j))
#define XB_TOP      3328
#define XB_TOPGEN   3392
#define XCD_BAR_WORDS 3456
#define XB_SPIN_CAP (1u << 18)

__device__ __forceinline__ unsigned xb_ld(unsigned* p)              { return __hip_atomic_load(p, __ATOMIC_RELAXED, __HIP_MEMORY_SCOPE_AGENT); }
__device__ __forceinline__ unsigned xb_add(unsigned* p, unsigned v) { return __hip_atomic_fetch_add(p, v, __ATOMIC_RELAXED, __HIP_MEMORY_SCOPE_AGENT); }
__device__ __forceinline__ unsigned xb_xcc_id() { return (unsigned)__builtin_amdgcn_s_getreg((3 << 11) | 20) & 0xFu; }
#define XB_SPIN(cond, bar) do { unsigned _sp = 0; while (cond) { __builtin_amdgcn_s_sleep(1); \
    if ((++_sp & 255u) == 0u) { if (xb_ld(&(bar)[XB_TMO])) break; if (_sp > XB_SPIN_CAP) { atomicAdd(&(bar)[XB_TMO], 1u); break; } } } } while (0)

struct XcdBarrier {
    unsigned* bar; unsigned x;
    volatile LAS unsigned* st;
};

__device__ __forceinline__ XcdBarrier xcd_barrier_post(unsigned* bar, volatile LAS unsigned* st) {
    XcdBarrier b; b.bar = bar; b.x = xb_xcc_id(); b.st = st;
    if (threadIdx.x == 0) (void)xb_add(&bar[XB_XCNT(b.x)], 1u);
    return b;
}
__device__ __forceinline__ void xcd_barrier_complete(unsigned* bar, unsigned x, unsigned& nloc, unsigned& nx) {
    const unsigned G = gridDim.x * gridDim.y * gridDim.z;
    unsigned sum, cnt, mine, sp = 0u;
    for (;;) {
        sum = 0u; cnt = 0u; mine = 0u;
#pragma unroll
        for (unsigned j = 0; j < 16; ++j) { const unsigned c = xb_ld(&bar[XB_XCNT(j)]); sum += c; cnt += (c > 0u) ? 1u : 0u; mine = (j == x) ? c : mine; }
        if (sum == G) break;
        __builtin_amdgcn_s_sleep(1);
        if ((++sp & 255u) == 0u) { if (xb_ld(&bar[XB_TMO])) break; if (sp > XB_SPIN_CAP) { atomicAdd(&bar[XB_TMO], 1u); break; } }
    }
    nloc = mine > 0u ? mine : 1u; nx = cnt > 0u ? cnt : 1u;
}

__device__ __forceinline__ void xcd_barrier(const XcdBarrier& b) {
    asm volatile("s_waitcnt vmcnt(0)" ::: "memory");
    __syncthreads();
    if (threadIdx.x == 0) {
        unsigned* bar = b.bar;
        __builtin_amdgcn_s_waitcnt(0);
        unsigned nloc = b.st[0], nx = b.st[1];
        if (nloc == 0u) { xcd_barrier_complete(bar, b.x, nloc, nx); b.st[0] = nloc; b.st[1] = nx; }
        const unsigned old = xb_add(&bar[XB_XSUB(b.x)], 1u);
        const unsigned gen = old / nloc;
        if (old + 1u == (gen + 1u) * nloc) {
            __builtin_amdgcn_fence(__ATOMIC_RELEASE, "agent");
            asm volatile("s_waitcnt vmcnt(0)" ::: "memory");
            const unsigned og = xb_add(&bar[XB_TOP], 1u);
            const unsigned tg = og / nx;
            if (og + 1u == (tg + 1u) * nx) xb_add(&bar[XB_TOPGEN], 1u);
            else XB_SPIN(xb_ld(&bar[XB_TOPGEN]) == tg, bar);
            __builtin_amdgcn_fence(__ATOMIC_ACQUIRE, "agent");
            xb_add(&bar[XB_XGEN(b.x)], 1u);
            asm volatile("s_waitcnt vmcnt(0)" ::: "memory");
        } else {
            XB_SPIN(xb_ld(&bar[XB_XGEN(b.x)]) == gen, bar);
            __builtin_amdgcn_fence(__ATOMIC_ACQUIRE, "agent");
            asm volatile("s_waitcnt vmcnt(0)" ::: "memory");
        }
    }
    __syncthreads();
}

typedef short s16x4 __attribute__((ext_vector_type(4)));
typedef float f32x16 __attribute__((ext_vector_type(16)));
typedef float f32x2 __attribute__((ext_vector_type(2)));
typedef LAS unsigned char* ldsp;
typedef const LAS unsigned char* cldsp;
#define SBARRIER() do { __builtin_amdgcn_s_barrier(); asm volatile("" ::: "memory"); } while (0)
__device__ __forceinline__ float wave_sum(float v) {
#pragma unroll
    for (int o = 1; o < 64; o <<= 1) v += __shfl_xor(v, o);
    return v;
}
__device__ __forceinline__ unsigned cvtpk(float lo, float hi) { unsigned r; asm volatile("v_cvt_pk_bf16_f32 %0, %1, %2" : "=v"(r) : "v"(lo), "v"(hi)); return r; }
__device__ __forceinline__ float bf_lo(unsigned w) { return __builtin_bit_cast(float, w << 16); }
__device__ __forceinline__ float bf_hi(unsigned w) { return __builtin_bit_cast(float, w & 0xffff0000u); }
__device__ __forceinline__ int crow(int r, int hi) { return (r & 3) + 8 * (r >> 2) + 4 * hi; }
__device__ __forceinline__ void glds16(const void* g, ldsp l) { __builtin_amdgcn_global_load_lds((const unsigned*)g, (LAS unsigned*)l, 16, 0, 0); }
typedef short v4i16_t __attribute__((ext_vector_type(4)));
__device__ __forceinline__ s16x4 trrd(cldsp p) { return __builtin_bit_cast(s16x4, __builtin_amdgcn_ds_read_tr16_b64_v4i16((LAS v4i16_t*)p)); }
#define MK8(lo, hi) ((bf16x8){(lo)[0], (lo)[1], (lo)[2], (lo)[3], (hi)[0], (hi)[1], (hi)[2], (hi)[3]})
__device__ __forceinline__ bf16x8 pack8f(const f32x16& p, int b) {
    v4u w; w.x = cvtpk(p[b], p[b + 1]); w.y = cvtpk(p[b + 2], p[b + 3]); w.z = cvtpk(p[b + 4], p[b + 5]); w.w = cvtpk(p[b + 6], p[b + 7]); return __builtin_bit_cast(bf16x8, w);
}
#define MFMA32(a, b, c) __builtin_amdgcn_mfma_f32_32x32x16_bf16((a), (b), (c), 0, 0, 0)
__device__ __forceinline__ int tr_att_base(int lane) { return (4 * (lane >> 5) + ((lane & 15) >> 2)) * 64 + ((lane >> 4) & 1) * 32 + (lane & 3) * 8; }
__device__ __forceinline__ int tr_nat_base(int lane) { return (8 * (lane >> 5) + ((lane & 15) >> 2)) * 64 + ((lane >> 4) & 1) * 32 + (lane & 3) * 8; }

struct Args {
    const float* x; const int* pos; const float* attn_norm; const float* w_in; const float* q_norm; const float* kv_norm; const float* w_uq; const float* w_ukv;
    const float* beta_attn; const float* beta_ret; const float* w_o; const float* mlp_norm; const float* w_up; const float* w_down; const float* final_norm;
    float* out; unsigned char* ws;
    double invf64[32]; double invf128[64];
    float lg2g[8];
};
static_assert(sizeof(Args) == 17 * 8 + 96 * 8 + 32, "Args has no padding");
typedef const __attribute__((address_space(4))) Args* cargs_t;
__device__ __forceinline__ cargs_t get_args() { cargs_t p = (cargs_t)__builtin_amdgcn_kernarg_segment_ptr(); asm volatile("" : "+s"(p)); return p; }

__device__ __forceinline__ void sincos_d(double ang, float& s, float& c) {
    const double k = __builtin_rint(ang * 0.63661977236758134308);
    double y = __builtin_fma(-k, 1.57079632679489655800e+00, ang); y = __builtin_fma(-k, 6.12323399573676603587e-17, y);
    const double z = y * y;
    double sp = 1.0 / 6227020800.0; sp = sp * z - 1.0 / 39916800.0; sp = sp * z + 1.0 / 362880.0; sp = sp * z - 1.0 / 5040.0; sp = sp * z + 1.0 / 120.0; sp = sp * z - 1.0 / 6.0; sp = sp * z + 1.0; sp = sp * y;
    double cp = -1.0 / 87178291200.0; cp = cp * z + 1.0 / 479001600.0; cp = cp * z - 1.0 / 3628800.0; cp = cp * z + 1.0 / 40320.0; cp = cp * z - 1.0 / 720.0; cp = cp * z + 1.0 / 24.0; cp = cp * z - 0.5; cp = cp * z + 1.0;
    const int q = (int)((long long)k & 3);
    const double ss = (q == 0) ? sp : (q == 1) ? cp : (q == 2) ? -sp : -cp;
    const double cc = (q == 0) ? cp : (q == 1) ? -sp : (q == 2) ? -cp : sp;
    s = (float)ss; c = (float)cc;
}
__device__ __forceinline__ void rope_tables(cargs_t a, int gtid, int nthr) {
    unsigned char* ws = a->ws; const int* pos = a->pos;
    float* c64 = (float*)(ws + WS_C64); float* s64 = (float*)(ws + WS_S64); float* c128 = (float*)(ws + WS_C128); float* s128 = (float*)(ws + WS_S128);
    for (int i = gtid; i < M * 96; i += nthr) { const int m = i / 96, j = i - m * 96; const double p = (double)pos[m]; float s, c;
        if (j < 32) { sincos_d(p * a->invf64[j], s, c); c64[m * 32 + j] = c; s64[m * 32 + j] = s; }
        else { sincos_d(p * a->invf128[j - 32], s, c); c128[m * 64 + j - 32] = c; s128[m * 64 + j - 32] = s; } }
}
template <class Map, class Gain>
__device__ __forceinline__ void transpose_item(const float* W, int K, int N, bf16* WT, const Map& map, const Gain& gain, LAS float* scr, int item, int lane) {
    const int nblk = N / 32, kb = item / nblk, nb = item % nblk, k0 = 64 * kb, n0 = 32 * nb;
#pragma unroll 8
    for (int i = 0; i < 32; ++i) { const int kk = 2 * i + (lane >> 5); scr[kk * 33 + (lane & 31)] = W[(size_t)(k0 + kk) * N + n0 + (lane & 31)] * gain(k0 + kk); }
    LDS_WAIT(); asm volatile("" ::: "memory");
    const int c = lane & 7;
#pragma unroll
    for (int j = 0; j < 4; ++j) { const int n = (lane >> 3) + 8 * j; const LAS float* s = scr + (8 * c) * 33 + n;
        v4u o; o.x = pk2(s[0 * 33], s[1 * 33]); o.y = pk2(s[2 * 33], s[3 * 33]); o.z = pk2(s[4 * 33], s[5 * 33]); o.w = pk2(s[6 * 33], s[7 * 33]);
        *(GAS v4u*)(WT + (size_t)map(n0 + n) * K + k0 + 8 * c) = o; }
    LDS_WAIT(); asm volatile("" ::: "memory");
}
struct GainNone { __device__ __forceinline__ float operator()(int) const { return 1.0f; } };
struct GainVec { const float* g; __device__ __forceinline__ float operator()(int k) const { return g[k]; } };
struct GainVec2 { const float* g0; const float* g1; int split; __device__ __forceinline__ float operator()(int k) const { return k < split ? g0[k] : g1[k - split]; } };
struct MapId { __device__ __forceinline__ int operator()(int n) const { return n; } };
struct MapWin {
    __device__ __forceinline__ int operator()(int n) const {
        if (n < 768) return n;
        if (n < 832) { const int d = n - 768; return 768 + (d < 32 ? 2 * d : 2 * (d - 32) + 1); }
        if (n < 2880) { const int e = n - 832, g = e >> 7, d = e & 127; return 1024 + g * 128 + (d < 64 ? 2 * d : 2 * (d - 64) + 1); }
        return n + 192;
    }
};
struct MapWuq {
    __device__ __forceinline__ int operator()(int n) const { const int h = n / 192, d = n - h * 192; if (d < 128) return n; const int e = d - 128; return h * 192 + 128 + (e < 32 ? 2 * e : 2 * (e - 32) + 1); }
};
template <bool DYN>
__device__ __forceinline__ void convert_weights(cargs_t a, int l, ldsp lds, int gw, int ngw, int wave, int lane, int gtid, int nthr, unsigned* qctr) {
    unsigned char* wb = a->ws + WS_W + (size_t)(l & 1) * W_STRIDE;
    LAS float* scr = (LAS float*)(lds + RING_OFF + wave * 16384);
    bf16* Win = (bf16*)(wb + WO_WIN); bf16* Wuq = (bf16*)(wb + WO_WUQ); bf16* Wukv = (bf16*)(wb + WO_WUKV); bf16* Wo = (bf16*)(wb + WO_WO); bf16* Wup = (bf16*)(wb + WO_WUP); bf16* Wdn = (bf16*)(wb + WO_WDN);
    const float* w_in = a->w_in + (size_t)l * DM * IN_SRC; const float* w_uq = a->w_uq + (size_t)l * QLORA * 1536; const float* w_ukv = a->w_ukv + (size_t)l * KVLORA * 2048;
    const float* w_o = a->w_o + (size_t)l * DM * DM; const float* w_up = a->w_up + (size_t)l * DM * FF; const float* w_dn = a->w_down + (size_t)l * FF * DM;
    const GainVec g_in{a->attn_norm + l * DM}, g_uq{a->q_norm + l * QLORA}, g_ukv{a->kv_norm + l * KVLORA}, g_up{a->mlp_norm + l * DM}; const GainVec2 g_o{a->beta_attn + l * 1024, a->beta_ret + l * 1024, 1024};
    constexpr int I_IN = (DM / 64) * (IN_SRC / 32), I_UQ = (QLORA / 64) * (1536 / 32), I_UKV = (KVLORA / 64) * (2048 / 32), I_O = (DM / 64) * (DM / 32), I_UP = (DM / 64) * (FF / 32), I_DN = (FF / 64) * (DM / 32);
    constexpr int NITEMS = I_IN + I_UQ + I_UKV + I_O + I_UP + I_DN, CH = 16;
    GAS v4u* pz = (GAS v4u*)(Win + (size_t)832 * DM);
    for (int i = gtid; i < 192 * DM / 8; i += nthr) pz[i] = (v4u){0u, 0u, 0u, 0u};
    int it = DYN ? 0 : gw, it_end = 0;
    for (;;) {
        if constexpr (DYN) { if (it >= it_end) { unsigned c = 0u; if (lane == 0) c = __hip_atomic_fetch_add(qctr, 1u, __ATOMIC_RELAXED, __HIP_MEMORY_SCOPE_AGENT);
                it = (int)__builtin_amdgcn_readfirstlane(c) * CH; it_end = it + CH; if (it >= NITEMS) break; }
            if (it >= NITEMS) break; }
        else { if (it >= NITEMS) break; }
        int r = it;
        if (r < I_IN) transpose_item(w_in, DM, IN_SRC, Win, MapWin(), g_in, scr, r, lane);
        else if ((r -= I_IN) < I_UQ) transpose_item(w_uq, QLORA, 1536, Wuq, MapWuq(), g_uq, scr, r, lane);
        else if ((r -= I_UQ) < I_UKV) transpose_item(w_ukv, KVLORA, 2048, Wukv, MapId(), g_ukv, scr, r, lane);
        else if ((r -= I_UKV) < I_O) transpose_item(w_o, DM, DM, Wo, MapId(), g_o, scr, r, lane);
        else if ((r -= I_O) < I_UP) transpose_item(w_up, DM, FF, Wup, MapId(), g_up, scr, r, lane);
        else { r -= I_UP; transpose_item(w_dn, FF, DM, Wdn, MapId(), GainNone(), scr, r, lane); }
        it += DYN ? 1 : ngw;
    }
}
constexpr int RTAB_OFF = LDSCTL_OFF + 1024;
static_assert(RTAB_OFF + 1024 <= LDS_BYTES, "row-scale table inside the LDS allocation");
__device__ __forceinline__ void fill_rtab(const float* SS, int pm, ldsp lds, int tid) {
    if (tid < 256) { const GAS f32x4* p = (const GAS f32x4*)(SS + (size_t)(pm * 256 + tid) * 32); float s = 0.f;
#pragma unroll
        for (int j = 0; j < 8; ++j) { const f32x4 v = p[j]; s += (v.x + v.y) + (v.z + v.w); }
        ((LAS float*)(lds + RTAB_OFF))[tid] = 1.0f / sqrtf(s * (1.0f / DM) + NORM_EPS); }
    __syncthreads();
}
template <int NR> __device__ __forceinline__ void prep_rows(const float* x, bf16* XB, float* XSS, int row, int stride, int lane) {
    f32x4 v[NR][8]; float s[NR];
#pragma unroll
    for (int q = 0; q < NR; ++q) { const GAS f32x4* xr = (const GAS f32x4*)(x + (size_t)(row + q * stride) * DM) + lane;
#pragma unroll
        for (int j = 0; j < 8; ++j) v[q][j] = xr[64 * j]; }
#pragma unroll
    for (int q = 0; q < NR; ++q) { float t = 0.f;
#pragma unroll
        for (int j = 0; j < 8; ++j) t += (v[q][j].x * v[q][j].x + v[q][j].y * v[q][j].y) + (v[q][j].z * v[q][j].z + v[q][j].w * v[q][j].w);
        s[q] = wave_sum(t); }
#pragma unroll
    for (int q = 0; q < NR; ++q) { GAS unsigned long long* o8 = (GAS unsigned long long*)(XB + (size_t)(row + q * stride) * DM) + lane;
#pragma unroll
        for (int j = 0; j < 8; ++j) o8[64 * j] = (unsigned long long)cvtpk(v[q][j].x, v[q][j].y) | ((unsigned long long)cvtpk(v[q][j].z, v[q][j].w) << 32);
        if (lane < 32) XSS[(size_t)(row + q * stride) * 32 + lane] = (lane == 0) ? s[q] : 0.f; }
}
template <int NR> __device__ __forceinline__ void rms_rows_final(float* xo, const bf16* XB, const bf16* XL, const float* XSS, const float* g, int row, int stride, int lane) {
    v4u vh[NR][4], vl[NR][4]; float r[NR];
#pragma unroll
    for (int q = 0; q < NR; ++q) { const GAS v4u* ph = (const GAS v4u*)(XB + (size_t)(row + q * stride) * DM) + lane; const GAS v4u* pl = (const GAS v4u*)(XL + (size_t)(row + q * stride) * DM) + lane;
#pragma unroll
        for (int j = 0; j < 4; ++j) { vh[q][j] = ph[64 * j]; vl[q][j] = pl[64 * j]; }
        r[q] = (lane < 32) ? XSS[(size_t)(row + q * stride) * 32 + lane] : 0.f; }
#pragma unroll
    for (int q = 0; q < NR; ++q) r[q] = 1.0f / sqrtf(wave_sum(r[q]) * (1.0f / DM) + NORM_EPS);
#pragma unroll
    for (int q = 0; q < NR; ++q) { GAS f32x4* xr = (GAS f32x4*)(xo + (size_t)(row + q * stride) * DM) + 2 * lane;
#pragma unroll
        for (int j = 0; j < 4; ++j) { const f32x4 g0 = ((const GAS f32x4*)g)[128 * j + 2 * lane], g1 = ((const GAS f32x4*)g)[128 * j + 2 * lane + 1]; const float rr = r[q]; const v4u h = vh[q][j], w = vl[q][j];
            xr[128 * j] = (f32x4){(bf_lo(h.x) + bf_lo(w.x)) * rr * g0.x, (bf_hi(h.x) + bf_hi(w.x)) * rr * g0.y, (bf_lo(h.y) + bf_lo(w.y)) * rr * g0.z, (bf_hi(h.y) + bf_hi(w.y)) * rr * g0.w};
            xr[128 * j + 1] = (f32x4){(bf_lo(h.z) + bf_lo(w.z)) * rr * g1.x, (bf_hi(h.z) + bf_hi(w.z)) * rr * g1.y, (bf_lo(h.w) + bf_lo(w.w)) * rr * g1.z, (bf_hi(h.w) + bf_hi(w.w)) * rr * g1.w}; } }
}
template <int NR> __device__ __forceinline__ void attn_norm_rows(bf16* mix, int row, int stride, int lane) {
    v4u w[NR][2]; float r[NR];
#pragma unroll
    for (int q = 0; q < NR; ++q) { const bf16* p = mix + (size_t)(row + q * stride) * DM; w[q][0] = *(const GAS v4u*)(p + lane * 8); w[q][1] = *(const GAS v4u*)(p + 512 + lane * 8); }
#pragma unroll
    for (int q = 0; q < NR; ++q) { float s = 0.f;
#pragma unroll
        for (int j = 0; j < 2; ++j) { const v4u u = w[q][j]; const float f0 = bf_lo(u.x), f1 = bf_hi(u.x), f2 = bf_lo(u.y), f3 = bf_hi(u.y), f4 = bf_lo(u.z), f5 = bf_hi(u.z), f6 = bf_lo(u.w), f7 = bf_hi(u.w);
            s += ((f0 * f0 + f1 * f1) + (f2 * f2 + f3 * f3)) + ((f4 * f4 + f5 * f5) + (f6 * f6 + f7 * f7)); }
        r[q] = 1.0f / sqrtf(wave_sum(s) * (1.0f / 1024.0f) + NORM_EPS); }
#pragma unroll
    for (int q = 0; q < NR; ++q) { bf16* p = mix + (size_t)(row + q * stride) * DM; const float rr = r[q];
#pragma unroll
        for (int j = 0; j < 2; ++j) { const v4u u = w[q][j]; v4u o; o.x = cvtpk(bf_lo(u.x) * rr, bf_hi(u.x) * rr); o.y = cvtpk(bf_lo(u.y) * rr, bf_hi(u.y) * rr); o.z = cvtpk(bf_lo(u.z) * rr, bf_hi(u.z) * rr); o.w = cvtpk(bf_lo(u.w) * rr, bf_hi(u.w) * rr);
            *(GAS v4u*)(p + j * 512 + lane * 8) = o; } }
}

#ifdef PROBE_ATT
#ifndef PROBE_ATT_WAVE
#define PROBE_ATT_WAVE 0
#endif
#define ATP_DECL() unsigned long long atp_t_ = __builtin_readcyclecounter(), atp_acc_ = 0ull; const bool atp_on_ = (blockIdx.x == 0) && (wid == PROBE_ATT_WAVE)
#define ATP(k) do { if (atp_on_) { const unsigned long long n_ = __builtin_readcyclecounter(); if ((k) == ((PROBE_ATT) + 1) % 4) atp_acc_ += n_ - atp_t_; atp_t_ = n_; } } while (0)
#define ATP_END() do { if (atp_on_ && lane == 0) { volatile LAS unsigned long long* q_ = (volatile LAS unsigned long long*)(lds + LDSCTL_OFF + 80); q_[0] += atp_acc_; } } while (0)
#else
#define ATP_DECL() do { } while (0)
#define ATP(k) do { } while (0)
#define ATP_END() do { } while (0)
#endif
__device__ __forceinline__ float max3f(float a, float b, float c) { float r; asm("v_max3_f32 %0, %1, %2, %3" : "=v"(r) : "v"(a), "v"(b), "v"(c)); return r; }
__device__ __forceinline__ float max2f(float a, float b) { float r; asm("v_max_f32_e32 %0, %1, %2" : "=v"(r) : "v"(a), "v"(b)); return r; }
constexpr int AT_KSLOT = 64 * DQK * 2, AT_VSLOT = 64 * DV * 2, AT_K = 0, AT_V = 2 * AT_KSLOT, AT_WS = AT_V + 2 * AT_VSLOT, AT_BYTES = AT_WS + NWAVES * 256;
static_assert(AT_BYTES <= RING_BYTES, "attention LDS");
__device__ __forceinline__ void attn_unit(const bf16* Qg, const bf16* Kg, const bf16* Vg, bf16* Og, int b, int h, int qb, ldsp lds, int tid) {
    const int lane = tid & 63, r32 = lane & 31, hi = lane >> 5; const int wid = __builtin_amdgcn_readfirstlane(tid >> 6);
    const size_t rowbase = (size_t)b * SEQ; const int q0 = qb * 256, NT = (q0 + 256) / 64, qw0 = q0 + wid * 32;
    const bf16* Kh = Kg + rowbase * 1536 + h * DQK; const bf16* Vh = Vg + rowbase * 1024 + h * DV;
    LAS float* wsf = (LAS float*)(lds + AT_WS) + wid * 64;
    const int krow_ = lane >> 2, kpiece_ = (lane & 3) ^ (((krow_ >> 2) ^ krow_) & 3);
#define AT_DMA(t, s) do { \
        _Pragma("unroll") for (int i_ = 0; i_ < 3; ++i_) { const int c_ = wid + 8 * i_; \
            glds16(Kh + (size_t)((t) * 64 + 16 * (c_ & 3) + krow_) * 1536 + (c_ >> 2) * 32 + kpiece_ * 8, lds + AT_K + (s) * AT_KSLOT + c_ * 1024); } \
        _Pragma("unroll") for (int i_ = 0; i_ < 2; ++i_) { const int c_ = wid + 8 * i_; \
            glds16(Vh + (size_t)((t) * 64 + 16 * (c_ & 3) + (lane >> 2)) * 1024 + (c_ >> 2) * 32 + (lane & 3) * 8, lds + AT_V + (s) * AT_VSLOT + c_ * 1024); } } while (0)
    AT_DMA(0, 0);
    bf16x8 qr[12];
    { const bf16* qp = Qg + (rowbase + qw0 + r32) * 1536 + h * DQK + hi * 8;
#pragma unroll
      for (int d0 = 0; d0 < 12; ++d0) qr[d0] = *(const GAS bf16x8*)(qp + d0 * 16); }
    float m_run = 0.f, l_run = 0.f; f32x16 o[4];
#pragma unroll
    for (int d = 0; d < 4; ++d)
#pragma unroll
        for (int r = 0; r < 16; ++r) o[d][r] = 0.f;
    const int vlane = tr_att_base(lane);
    const int kfr_ = r32 & 15, kfrag_ = (r32 >> 4) * 1024 + kfr_ * 64 + ((hi ^ (((kfr_ >> 2) ^ kfr_) & 3)) << 4), kfx_ = ((kfrag_ ^ 32) - kfrag_);
    ATP_DECL();
    for (int t = 0; t < NT; ++t) {
        const int s = t & 1;
        ATP(0);
        asm volatile("s_waitcnt vmcnt(0)" ::: "memory"); SBARRIER();
        if (t + 1 < NT) AT_DMA(t + 1, s ^ 1);
        ATP(1);
        const int kbase = t * 64;
        if (kbase <= qw0 + 31) {
            f32x16 p0, p1;
            cldsp kb = lds + AT_K + s * AT_KSLOT + kfrag_;
#pragma unroll
            for (int r = 0; r < 16; ++r) { p0[r] = 0.f; p1[r] = 0.f; }
#define KFA(d) (kb + ((d) >> 1) * 4096 + (((d) & 1) ? kfx_ : 0))
            bf16x8 ka0 = *(const LAS bf16x8*)(KFA(0)), ka1 = *(const LAS bf16x8*)(KFA(0) + 2048), kb0 = *(const LAS bf16x8*)(KFA(1)), kb1 = *(const LAS bf16x8*)(KFA(1) + 2048);
#pragma unroll
            for (int d0 = 0; d0 < 12; ++d0) {
                bf16x8 kc0 = ka0, kc1 = ka1;
                if (d0 + 2 < 12) { kc0 = *(const LAS bf16x8*)(KFA(d0 + 2)); kc1 = *(const LAS bf16x8*)(KFA(d0 + 2) + 2048); }
                __builtin_amdgcn_sched_barrier(0);
                p0 = MFMA32(ka0, qr[d0], p0); p1 = MFMA32(ka1, qr[d0], p1);
                __builtin_amdgcn_sched_barrier(0);
                ka0 = kb0; ka1 = kb1; kb0 = kc0; kb1 = kc1;
            }
#undef KFA
            if (kbase + 63 > qw0) {
                const int qi = qw0 + r32; const float NEG = -__builtin_inff();
#pragma unroll
                for (int r = 0; r < 16; ++r) { const int kv = kbase + crow(r, hi); if (kv > qi) p0[r] = NEG; if (kv + 32 > qi) p1[r] = NEG; }
            }
            asm volatile("s_nop 15\n\ts_nop 7" : "+v"(p0), "+v"(p1));
            float mx;
            { float xa = max3f(p0[0], p0[1], p1[0]), xb = max3f(p0[2], p0[3], p1[1]); xa = max3f(xa, p1[2], p1[3]);
#pragma unroll
              for (int r = 4; r < 16; r += 4) { xa = max3f(xa, p0[r], p0[r + 1]); xb = max3f(xb, p0[r + 2], p0[r + 3]); xa = max3f(xa, p1[r], p1[r + 1]); xb = max3f(xb, p1[r + 2], p1[r + 3]); }
              mx = max2f(xa, xb); }
            { const auto sw_ = __builtin_amdgcn_permlane32_swap(__float_as_uint(mx), __float_as_uint(mx), false, false); mx = max2f(__uint_as_float(sw_[0]), __uint_as_float(sw_[1])); }
            asm volatile("" : "+v"(mx)); ATP(2);
            cldsp vb = lds + AT_V + s * AT_VSLOT + vlane;
            s16x4 vpre[4]; vpre[0] = trrd(vb); vpre[1] = trrd(vb + 512); vpre[2] = trrd(vb + 1024); vpre[3] = trrd(vb + 1024 + 512);
            const bool first = (t == 0);
            if (first || !__all(mx - m_run <= 8.0f)) {
                const float mn = first ? mx : fmaxf(m_run, mx);
                if (!first) { const float alpha = __builtin_amdgcn_exp2f(m_run - mn); l_run *= alpha;
                    if (hi == 0) wsf[r32] = alpha;
                    asm volatile("s_waitcnt lgkmcnt(0)" ::: "memory");
#pragma unroll
                    for (int r = 0; r < 16; ++r) { const float al = wsf[crow(r, hi)];
#pragma unroll
                        for (int d = 0; d < 4; ++d) o[d][r] *= al; } }
                m_run = mn;
            }
            float rs = 0.f;
#pragma unroll
            for (int r = 0; r < 16; ++r) { p0[r] = __builtin_amdgcn_exp2f(p0[r] - m_run); p1[r] = __builtin_amdgcn_exp2f(p1[r] - m_run); rs += p0[r] + p1[r]; }
            l_run += rs;
            bf16x8 pa[4]; pa[0] = pack8f(p0, 0); pa[1] = pack8f(p0, 8); pa[2] = pack8f(p1, 0); pa[3] = pack8f(p1, 8);
            ATP(3);
            { s16x4 c0 = vpre[0], c1 = vpre[1], c2 = vpre[2], c3 = vpre[3];
#pragma unroll
              for (int st = 0; st < 8; ++st) { const int d0 = st >> 1, k2 = (st & 1) * 2;
                s16x4 n0 = c0, n1 = c1, n2 = c2, n3 = c3;
                if (st + 1 < 8) { const int dn = (st + 1) >> 1, kn = ((st + 1) & 1) * 2; cldsp q = vb + (dn * 4 + kn) * 1024; n0 = trrd(q); n1 = trrd(q + 512); n2 = trrd(q + 1024); n3 = trrd(q + 1024 + 512); }
                __builtin_amdgcn_sched_barrier(0);
                o[d0] = MFMA32(pa[k2], MK8(c0, c1), o[d0]); o[d0] = MFMA32(pa[k2 + 1], MK8(c2, c3), o[d0]);
                __builtin_amdgcn_sched_barrier(0);
                c0 = n0; c1 = n1; c2 = n2; c3 = n3; } }
        }
    }
    ATP(0); ATP_END();
    l_run += __shfl_xor(l_run, 32);
    if (hi == 0) wsf[32 + r32] = l_run;
    asm volatile("s_waitcnt lgkmcnt(0)" ::: "memory");
    bf16* Ow = Og + (rowbase + qw0) * DM + h * DV;
#pragma unroll
    for (int r = 0; r < 16; ++r) { const int orow = crow(r, hi); const float rl = 1.0f / wsf[32 + orow];
#pragma unroll
        for (int d0 = 0; d0 < 4; ++d0) { const float v = o[d0][r] * rl; const float vn = __shfl_xor(v, 1);
            if ((r32 & 1) == 0) *(GAS unsigned*)(Ow + (size_t)orow * DM + d0 * 32 + r32) = cvtpk(v, vn); } }
    asm volatile("s_waitcnt lgkmcnt(0)" ::: "memory"); SBARRIER();
#undef AT_DMA
}

constexpr int RT_K = 0, RT_V = 32768, RT_S = 65536, RT_O = 0, RT_OSTRIDE = 132;
static_assert(RT_S + 32768 <= RING_BYTES && RT_O + 128 * RT_OSTRIDE * 4 + 1024 <= RING_BYTES, "retention LDS");
__device__ __forceinline__ void ret_state_unit(const bf16* RK, const bf16* RV, float* U, int bh, int c, float lg2g, ldsp lds, int tid) {
    const int lane = tid & 63, r32 = lane & 31, hi = lane >> 5; const int wid = __builtin_amdgcn_readfirstlane(tid >> 6);
    const int b = bh >> 3, h = bh & 7; const size_t row0 = (size_t)b * SEQ + (size_t)c * RCH;
#pragma unroll
    for (int i = 0; i < 4; ++i) { const int ch = wid * 4 + i, cb = ch >> 3, ks = ch & 7; const size_t tok = row0 + 16 * ks + (lane >> 2); const int col = h * 128 + cb * 32 + (lane & 3) * 8;
        glds16(RK + tok * 1024 + col, lds + RT_K + ch * 1024);
        const v4u w = *(const GAS v4u*)(RV + tok * 1024 + col); const float z = __builtin_amdgcn_exp2f(lg2g * (float)(127 - (16 * ks + (lane >> 2))));
        v4u o; o.x = cvtpk(bf_lo(w.x) * z, bf_hi(w.x) * z); o.y = cvtpk(bf_lo(w.y) * z, bf_hi(w.y) * z); o.z = cvtpk(bf_lo(w.z) * z, bf_hi(w.z) * z); o.w = cvtpk(bf_lo(w.w) * z, bf_hi(w.w) * z);
        *(LAS v4u*)(lds + RT_V + ch * 1024 + lane * 16) = o; }
    asm volatile("s_waitcnt vmcnt(0) lgkmcnt(0)" ::: "memory"); SBARRIER();
    const int dkb = wid >> 1, dvb0 = (wid & 1) * 2; const int nb = tr_nat_base(lane);
    f32x16 acc[2];
#pragma unroll
    for (int r = 0; r < 16; ++r) { acc[0][r] = 0.f; acc[1][r] = 0.f; }
#pragma unroll
    for (int ks = 0; ks < 8; ++ks) { cldsp ka = lds + RT_K + (dkb * 8 + ks) * 1024 + nb; const s16x4 al = trrd(ka), ah = trrd(ka + 256); const bf16x8 A = MK8(al, ah);
#pragma unroll
        for (int j = 0; j < 2; ++j) { cldsp vb = lds + RT_V + ((dvb0 + j) * 8 + ks) * 1024 + nb; const s16x4 bl = trrd(vb), bh2 = trrd(vb + 256); acc[j] = MFMA32(A, MK8(bl, bh2), acc[j]); } }
    float* Uu = U + ((size_t)bh * NCH + c) * 16384;
#pragma unroll
    for (int j = 0; j < 2; ++j)
#pragma unroll
        for (int r = 0; r < 16; ++r) Uu[(dkb * 32 + crow(r, hi)) * 128 + (dvb0 + j) * 32 + r32] = acc[j][r];
    asm volatile("s_waitcnt lgkmcnt(0)" ::: "memory"); SBARRIER();
}
__device__ __forceinline__ void ret_scan(const float* U, bf16* S, cargs_t a, int gtid, int nthr) {
    for (int it = gtid; it < 16 * 8192; it += nthr) { const int bh = it >> 13, e2 = it & 8191; const float g = __builtin_amdgcn_exp2f(128.0f * a->lg2g[bh & 7]);
        const float* up = U + (size_t)bh * NCH * 16384 + e2 * 2; bf16* sp = S + (size_t)bh * NCH * 16384 + e2 * 2; float s0 = 0.f, s1 = 0.f;
#pragma unroll 8
        for (int c = 0; c < NCH; ++c) { *(GAS unsigned*)(sp + (size_t)c * 16384) = cvtpk(s0, s1); const f32x2 u = *(const GAS f32x2*)(up + (size_t)c * 16384); s0 = s0 * g + u.x; s1 = s1 * g + u.y; } }
}
__device__ __forceinline__ void ret_out_unit(const bf16* RQ, const bf16* RK, const bf16* RV, const bf16* RG, const bf16* S, bf16* MIX, int bh, int c, float lg2g, ldsp lds, int tid) {
    const int lane = tid & 63, r32 = lane & 31, hi = lane >> 5; const int wid = __builtin_amdgcn_readfirstlane(tid >> 6);
    const int b = bh >> 3, h = bh & 7; const size_t row0 = (size_t)b * SEQ + (size_t)c * RCH;
    const int rb = wid & 3, dh = wid >> 2;
    const bf16* Ss = S + ((size_t)bh * NCH + c) * 16384;
#pragma unroll
    for (int i = 0; i < 4; ++i) { const int id = wid * 4 + i;
        glds16(RK + (row0 + (id & 1) * 64 + lane) * 1024 + h * 128 + (id >> 1) * 8, lds + RT_K + id * 1024);
        const int cb = id >> 3, ks = id & 7;
        glds16(RV + (row0 + 16 * ks + (lane >> 2)) * 1024 + h * 128 + cb * 32 + (lane & 3) * 8, lds + RT_V + id * 1024);
        glds16(Ss + (16 * ks + (lane >> 2)) * 128 + cb * 32 + (lane & 3) * 8, lds + RT_S + id * 1024); }
    unsigned gate[16];
#pragma unroll
    for (int i = 0; i < 16; ++i) gate[i] = *(const GAS unsigned*)(RG + (row0 + wid * 16 + i) * 1024 + h * 128 + 2 * lane);
    bf16x8 qr[8];
    { const bf16* qp = RQ + (row0 + rb * 32 + r32) * 1024 + h * 128 + hi * 8;
#pragma unroll
      for (int d0 = 0; d0 < 8; ++d0) qr[d0] = *(const GAS bf16x8*)(qp + d0 * 16); }
    asm volatile("s_waitcnt vmcnt(0)" ::: "memory"); SBARRIER();
    f32x16 o[2];
#pragma unroll
    for (int r = 0; r < 16; ++r) { o[0][r] = 0.f; o[1][r] = 0.f; }
    { const int nb = tr_nat_base(lane);
#pragma unroll
      for (int ks = 0; ks < 8; ++ks)
#pragma unroll
          for (int j = 0; j < 2; ++j) { cldsp sb = lds + RT_S + ((dh * 2 + j) * 8 + ks) * 1024 + nb; const s16x4 bl = trrd(sb), bh2 = trrd(sb + 256); o[j] = MFMA32(qr[ks], MK8(bl, bh2), o[j]); }
#pragma unroll
      for (int r = 0; r < 16; ++r) { const float xi = __builtin_amdgcn_exp2f(lg2g * (float)(rb * 32 + crow(r, hi) + 1)); o[0][r] *= xi; o[1][r] *= xi; } }
    const int ab = tr_att_base(lane);
    for (int kb = 0; kb <= rb; ++kb) {
        f32x16 p;
#pragma unroll
        for (int r = 0; r < 16; ++r) p[r] = 0.f;
        cldsp kp = lds + RT_K + hi * 2048 + (kb * 32 + r32) * 16;
#pragma unroll
        for (int d0 = 0; d0 < 8; ++d0) { const bf16x8 ka = *(const LAS bf16x8*)(kp + d0 * 4096); p = MFMA32(ka, qr[d0], p); }
        const int qi = rb * 32 + r32;
#pragma unroll
        for (int r = 0; r < 16; ++r) { const int kj = kb * 32 + crow(r, hi); const float dcy = __builtin_amdgcn_exp2f(lg2g * (float)(qi - kj)); p[r] = (qi >= kj) ? p[r] * dcy : 0.f; }
        const bf16x8 pa0 = pack8f(p, 0), pa1 = pack8f(p, 8);
#pragma unroll
        for (int j = 0; j < 2; ++j) { cldsp vb = lds + RT_V + ((dh * 2 + j) * 8 + kb * 2) * 1024 + ab;
            { const s16x4 lo = trrd(vb), hh = trrd(vb + 512); o[j] = MFMA32(pa0, MK8(lo, hh), o[j]); }
            { const s16x4 lo = trrd(vb + 1024), hh = trrd(vb + 1024 + 512); o[j] = MFMA32(pa1, MK8(lo, hh), o[j]); } }
    }
    asm volatile("s_waitcnt lgkmcnt(0)" ::: "memory"); SBARRIER();
    LAS float* ob = (LAS float*)(lds + RT_O);
#pragma unroll
    for (int j = 0; j < 2; ++j)
#pragma unroll
        for (int r = 0; r < 16; ++r) ob[(rb * 32 + crow(r, hi)) * RT_OSTRIDE + (dh * 2 + j) * 32 + r32] = o[j][r];
    asm volatile("s_waitcnt lgkmcnt(0)" ::: "memory"); SBARRIER();
    { const int srow = tid >> 2, sq = tid & 3; const LAS float* rp = ob + srow * RT_OSTRIDE + 16 * sq; float s1 = 0.f, s2 = 0.f;
#pragma unroll
      for (int j = 0; j < 2; ++j)
#pragma unroll
          for (int i = 0; i < 4; ++i) { const f32x4 v = *(const LAS f32x4*)(rp + 64 * j + 4 * i); s1 += (v.x + v.y) + (v.z + v.w); s2 += (v.x * v.x + v.y * v.y) + (v.z * v.z + v.w * v.w); }
      s1 += __builtin_bit_cast(float, __builtin_amdgcn_mov_dpp(__builtin_bit_cast(int, s1), 0xB1, 0xf, 0xf, true)); s2 += __builtin_bit_cast(float, __builtin_amdgcn_mov_dpp(__builtin_bit_cast(int, s2), 0xB1, 0xf, 0xf, true));
      s1 += __builtin_bit_cast(float, __builtin_amdgcn_mov_dpp(__builtin_bit_cast(int, s1), 0x4E, 0xf, 0xf, true)); s2 += __builtin_bit_cast(float, __builtin_amdgcn_mov_dpp(__builtin_bit_cast(int, s2), 0x4E, 0xf, 0xf, true));
      const float mu = s1 * (1.0f / 128.0f), var = fmaxf(s2 * (1.0f / 128.0f) - mu * mu, 0.f);
      if (sq == 0) *(LAS f32x2*)(ob + 128 * RT_OSTRIDE + 2 * srow) = (f32x2){mu, 1.0f / sqrtf(var + GN_EPS)}; }
    asm volatile("s_waitcnt lgkmcnt(0)" ::: "memory"); SBARRIER();
#pragma unroll
    for (int i = 0; i < 16; ++i) { const int rr = wid * 16 + i; const f32x2 v = *(const LAS f32x2*)(ob + rr * RT_OSTRIDE + 2 * lane); const f32x2 st = *(const LAS f32x2*)(ob + 128 * RT_OSTRIDE + 2 * rr);
        *(GAS unsigned*)(MIX + (row0 + rr) * DM + 1024 + h * 128 + 2 * lane) = cvtpk((v.x - st.x) * st.y * bf_lo(gate[i]), (v.y - st.x) * st.y * bf_hi(gate[i])); }
    asm volatile("s_waitcnt lgkmcnt(0)" ::: "memory"); SBARRIER();
}


#define PHASE_IDS() int tid = tid0; asm volatile("" : "+v"(tid)); int G = G0, bx = bx0; asm volatile("" : "+s"(G), "+s"(bx)); \
    const int lane = tid & 63; const int wave = __builtin_amdgcn_readfirstlane(tid >> 6); const int vcu = (G % 8 == 0) ? (bx % 8) * (G / 8) + bx / 8 : bx; (void)lane; (void)wave; (void)vcu
#define GW (vcu * NWAVES + wave)
#define NGW (G * NWAVES)
#define GTID (vcu * (NWAVES * 64) + tid)
#define NTHR (G * NWAVES * 64)
#ifndef PG_ALIGN
#define PG_ALIGN true
#endif
#define XBAR() xcd_barrier(bar)
#ifdef PROBE_SPAN
#ifndef PROBE_BLOCK
#define PROBE_BLOCK 0
#endif
#ifdef PROBE_CLK
#define PTIME() __builtin_readcyclecounter()
#else
#define PTIME() __builtin_amdgcn_s_memrealtime()
#endif
#ifdef PROBE_PRE
#define STAMP(k) do { if (tid0 == 0 && bx0 == PROBE_BLOCK) { volatile LAS unsigned long long* ts_ = (volatile LAS unsigned long long*)(lds + LDSCTL_OFF + 64); if ((k) == PROBE_SPAN) ts_[0] = PTIME(); } } while (0)
#define STAMP_PRE(k) do { if (tid0 == 0 && bx0 == PROBE_BLOCK) { volatile LAS unsigned long long* ts_ = (volatile LAS unsigned long long*)(lds + LDSCTL_OFF + 64); if ((k) == PROBE_SPAN + 1) ts_[1] += PTIME() - ts_[0]; } } while (0)
#else
#define STAMP(k) do { if (tid0 == 0 && bx0 == PROBE_BLOCK) { volatile LAS unsigned long long* ts_ = (volatile LAS unsigned long long*)(lds + LDSCTL_OFF + 64); const unsigned long long t_ = PTIME(); \
    if ((k) == PROBE_SPAN) ts_[0] = t_; if ((k) == PROBE_SPAN + 1) ts_[1] += t_ - ts_[0]; } } while (0)
#define STAMP_PRE(k) do { } while (0)
#endif
#else
#define STAMP(k) do { } while (0)
#define STAMP_PRE(k) do { } while (0)
#endif
template <int l> __device__ __forceinline__ void layer_body(const int tid0, const int G0, const int bx0, const ldsp lds, const XcdBarrier& bar) {
    STAMP(0);
#ifdef PROBE_IDLE
    { const unsigned long long t0_ = __builtin_amdgcn_s_memrealtime(); while (__builtin_amdgcn_s_memrealtime() - t0_ < (unsigned long long)(PROBE_IDLE) * 100ull) __builtin_amdgcn_s_sleep(32); }
#endif
    { PHASE_IDS(); cargs_t a = get_args(); unsigned char* ws = a->ws; unsigned char* wb = ws + WS_W + (size_t)(l & 1) * W_STRIDE;
      pg8::Gemm g{(bf16*)(ws + WS_XB), (bf16*)(wb + WO_WIN), M, IN_PAD, DM}; pg8::StaticOrder S; S.init(M, IN_PAD, G, bx);
      pg8::Unit u0_; const int pm0_ = S.next(0, u0_) ? u0_.pm : 0; fill_rtab((const float*)(ws + WS_XSS2), pm0_, lds, tid);
      pg8::EpiIn E{(const float*)(ws + WS_XSS2), (bf16*)(ws + WS_CQ), (bf16*)(ws + WS_CKV), (float*)(ws + WS_CQSS), (float*)(ws + WS_CKVSS), (bf16*)(ws + WS_K), (const float*)(ws + WS_C64), (const float*)(ws + WS_S64),
                   (bf16*)(ws + WS_RQ), (bf16*)(ws + WS_RK), (bf16*)(ws + WS_RV), (bf16*)(ws + WS_RG), (const float*)(ws + WS_C128), (const float*)(ws + WS_S128), (const LAS float*)(lds + RTAB_OFF), pm0_};
      pg8::gemm_phase<pg8::EpiIn, pg8::StaticOrder, PG_ALIGN, true>(lds + RING_OFF, g, S, E); }
    STAMP_PRE(1); XBAR(); STAMP(1);
    { PHASE_IDS(); cargs_t a = get_args(); unsigned char* ws = a->ws; unsigned char* wb = ws + WS_W + (size_t)(l & 1) * W_STRIDE;
      pg8::Gemm g{(bf16*)(ws + WS_CQ), (bf16*)(wb + WO_WUQ), M, 1536, QLORA}; pg8::StaticOrder S; S.init(M, 1536, G, bx);
      pg8::EpiQ E{(const float*)(ws + WS_CQSS), (bf16*)(ws + WS_Q), (const float*)(ws + WS_C64), (const float*)(ws + WS_S64), QSCALE};
      pg8::gemm_phase<pg8::EpiQ, pg8::StaticOrder, PG_ALIGN, true>(lds + RING_OFF, g, S, E); }
    __syncthreads();
    { PHASE_IDS(); cargs_t a = get_args(); unsigned char* ws = a->ws; unsigned char* wb = ws + WS_W + (size_t)(l & 1) * W_STRIDE;
      pg8::Gemm g{(bf16*)(ws + WS_CKV), (bf16*)(wb + WO_WUKV), M, 2048, KVLORA}; pg8::StaticOrder S; S.init(M, 2048, G, bx);
      pg8::EpiKV E{(const float*)(ws + WS_CKVSS), (bf16*)(ws + WS_K), (bf16*)(ws + WS_V)};
      pg8::gemm_phase<pg8::EpiKV, pg8::StaticOrder, PG_ALIGN, true>(lds + RING_OFF, g, S, E); }
    __syncthreads();
    { PHASE_IDS(); cargs_t a = get_args(); unsigned char* ws = a->ws;
      for (int u = vcu; u < 16 * NCH; u += G) ret_state_unit((const bf16*)(ws + WS_RK), (const bf16*)(ws + WS_RV), (float*)(ws + WS_U), u >> 6, u & 63, a->lg2g[(u >> 6) & 7], lds + RING_OFF, tid); }
    STAMP_PRE(2); XBAR(); STAMP(2);
    { PHASE_IDS(); cargs_t a = get_args(); unsigned char* ws = a->ws;
      for (int u = vcu; u < 256; u += G) { const int bh = u >> 4, x = u & 15;
        attn_unit((const bf16*)(ws + WS_Q), (const bf16*)(ws + WS_K), (const bf16*)(ws + WS_V), (bf16*)(ws + WS_MIX), bh >> 3, bh & 7, 31 - x, lds + RING_OFF, tid);
        attn_unit((const bf16*)(ws + WS_Q), (const bf16*)(ws + WS_K), (const bf16*)(ws + WS_V), (bf16*)(ws + WS_MIX), bh >> 3, bh & 7, x, lds + RING_OFF, tid); } }
    { PHASE_IDS(); cargs_t a = get_args(); unsigned char* ws = a->ws; ret_scan((const float*)(ws + WS_U), (bf16*)(ws + WS_S), a, GTID, NTHR); }
    if (l + 1 < DEPTH) { PHASE_IDS(); cargs_t a = get_args(); __syncthreads(); convert_weights<true>(a, l + 1, lds, GW, NGW, wave, lane, GTID, NTHR, (unsigned*)((gu32*)(a->ws + WS_CTL) + CW_WQ + l * 64)); }
    STAMP_PRE(3); XBAR(); STAMP(3);
    { PHASE_IDS(); cargs_t a = get_args(); unsigned char* ws = a->ws;
      for (int u = vcu; u < 16 * NCH; u += G) ret_out_unit((const bf16*)(ws + WS_RQ), (const bf16*)(ws + WS_RK), (const bf16*)(ws + WS_RV), (const bf16*)(ws + WS_RG), (const bf16*)(ws + WS_S), (bf16*)(ws + WS_MIX),
                                                          u >> 6, u & 63, a->lg2g[(u >> 6) & 7], lds + RING_OFF, tid); }
    { PHASE_IDS(); cargs_t a = get_args(); bf16* mix = (bf16*)(a->ws + WS_MIX);
      { int m = GW; for (; m + 3 * NGW < M; m += 4 * NGW) attn_norm_rows<4>(mix, m, NGW, lane); for (; m < M; m += NGW) attn_norm_rows<1>(mix, m, NGW, lane); } }
    STAMP_PRE(4); XBAR(); STAMP(4);
    { PHASE_IDS(); cargs_t a = get_args(); unsigned char* ws = a->ws; unsigned char* wb = ws + WS_W + (size_t)(l & 1) * W_STRIDE;
      pg8::Gemm g{(bf16*)(ws + WS_MIX), (bf16*)(wb + WO_WO), M, DM, DM}; pg8::StaticOrder S; S.init(M, DM, G, bx);
      typedef pg8::EpiResT<false, (l == 0)> EpiR; EpiR E{a->x, (bf16*)(ws + WS_XB), (bf16*)(ws + WS_XL), (float*)(ws + WS_XSS), nullptr, nullptr, -1};
      pg8::gemm_phase<EpiR, pg8::StaticOrder, PG_ALIGN, true>(lds + RING_OFF, g, S, E); }
    STAMP_PRE(5); XBAR(); STAMP(5);
    { PHASE_IDS(); cargs_t a = get_args(); unsigned char* ws = a->ws; unsigned char* wb = ws + WS_W + (size_t)(l & 1) * W_STRIDE;
      pg8::Gemm g{(bf16*)(ws + WS_XB), (bf16*)(wb + WO_WUP), M, FF, DM}; pg8::StaticOrder S; S.init(M, FF, G, bx);
      pg8::EpiRelu2 E{(bf16*)(ws + WS_UF), FF};
      pg8::gemm_phase<pg8::EpiRelu2, pg8::StaticOrder, PG_ALIGN, true>(lds + RING_OFF, g, S, E); }
    STAMP_PRE(6); XBAR(); STAMP(6);
    { PHASE_IDS(); cargs_t a = get_args(); unsigned char* ws = a->ws; unsigned char* wb = ws + WS_W + (size_t)(l & 1) * W_STRIDE;
      pg8::Gemm g{(bf16*)(ws + WS_UF), (bf16*)(wb + WO_WDN), M, DM, FF}; pg8::StaticOrder S; S.init(M, DM, G, bx);
      pg8::Unit u0_; const int pm0_ = S.next(0, u0_) ? u0_.pm : 0; fill_rtab((const float*)(ws + WS_XSS), pm0_, lds, tid);
      typedef pg8::EpiResT<true, false> EpiR; EpiR E{nullptr, (bf16*)(ws + WS_XB), (bf16*)(ws + WS_XL), (float*)(ws + WS_XSS2), (const float*)(ws + WS_XSS), (const LAS float*)(lds + RTAB_OFF), pm0_};
      pg8::gemm_phase<EpiR, pg8::StaticOrder, PG_ALIGN, true>(lds + RING_OFF, g, S, E); }
    STAMP_PRE(7); XBAR(); STAMP(7);
}

__global__ void __launch_bounds__(NWAVES * 64, 2) fwd_kernel(Args args_in_kernarg) {
    extern __shared__ __attribute__((aligned(16))) unsigned char lds_raw[];
    const ldsp lds = (ldsp)lds_raw;
    volatile LAS unsigned* MISC = (volatile LAS unsigned*)(lds + MISC_OFF);
    const int tid0 = threadIdx.x; const int G0 = gridDim.x, bx0 = blockIdx.x;
    for (int u = tid0; u < (LDS_BYTES - LDSCTL_OFF) / 4; u += NWAVES * 64) ((LAS unsigned*)(lds + LDSCTL_OFF))[u] = 0u;
    __syncthreads();
    XcdBarrier bar;
    { PHASE_IDS(); cargs_t a = get_args(); bar = xcd_barrier_post((unsigned*)((gu32*)(a->ws + WS_CTL) + CW_BAR), MISC + 8); }
    { PHASE_IDS(); cargs_t a = get_args();
      rope_tables(a, GTID, NTHR);
      convert_weights<false>(a, 0, lds, GW, NGW, wave, lane, GTID, NTHR, nullptr);
      const float* x = a->x; bf16* XB = (bf16*)(a->ws + WS_XB); float* XSS = (float*)(a->ws + WS_XSS2);
      { int m = GW; for (; m + NGW < M; m += 2 * NGW) prep_rows<2>(x, XB, XSS, m, NGW, lane); for (; m < M; m += NGW) prep_rows<1>(x, XB, XSS, m, NGW, lane); } }
    XBAR();

    layer_body<0>(tid0, G0, bx0, lds, bar);
    layer_body<1>(tid0, G0, bx0, lds, bar);
    layer_body<2>(tid0, G0, bx0, lds, bar);
    layer_body<3>(tid0, G0, bx0, lds, bar);
    { PHASE_IDS(); cargs_t a = get_args(); float* xo = a->out; const float* g = a->final_norm; const float* XSS = (const float*)(a->ws + WS_XSS2); const bf16* XB = (const bf16*)(a->ws + WS_XB); const bf16* XL = (const bf16*)(a->ws + WS_XL);
      { int m = GW; for (; m + NGW < M; m += 2 * NGW) rms_rows_final<2>(xo, XB, XL, XSS, g, m, NGW, lane); for (; m < M; m += NGW) rms_rows_final<1>(xo, XB, XL, XSS, g, m, NGW, lane); } }
#if defined(PROBE_ATT) || defined(PROBE_R3)
    if (tid0 == 0 && bx0 == 0) { volatile LAS unsigned long long* q_ = (volatile LAS unsigned long long*)(lds + LDSCTL_OFF + 80); const unsigned long long T_ = q_[0] / 3ull, t0_ = __builtin_amdgcn_s_memrealtime();
        while (__builtin_amdgcn_s_memrealtime() - t0_ < T_) __builtin_amdgcn_s_sleep(8); }
#endif
#ifdef PROBE_SPAN
    if (tid0 == 0 && bx0 == PROBE_BLOCK) { volatile LAS unsigned long long* ts_ = (volatile LAS unsigned long long*)(lds + LDSCTL_OFF + 64);
#ifdef PROBE_CLK
        const unsigned long long T_ = ts_[1] / 3ull,
#else
        const unsigned long long T_ = ts_[1] * 8ull,
#endif
        t0_ = __builtin_amdgcn_s_memrealtime();
        while (__builtin_amdgcn_s_memrealtime() - t0_ < T_) __builtin_amdgcn_s_sleep(8); }
#endif
}

extern "C" void kernel_launch(void* const* d_in, const int* in_sizes, int n_in, void* d_out, int out_size, void* d_ws, size_t ws_size, hipStream_t stream) {
    static int grid = 0;
    if (grid == 0) {
        if (n_in != 15 || in_sizes[0] != M * DM || out_size != M * DM || ws_size < WS_END) { fprintf(stderr, "kernel_launch: unexpected shapes (n_in %d, in0 %d, out %d, ws %zu, need %zu); nothing launched\n", n_in, n_in > 0 ? in_sizes[0] : -1, out_size, ws_size, (size_t)WS_END); grid = -1; return; }
        int dev = 0, cus = 0, per_cu = 0;
        if (hipGetDevice(&dev) != hipSuccess || hipDeviceGetAttribute(&cus, hipDeviceAttributeMultiprocessorCount, dev) != hipSuccess) { fprintf(stderr, "kernel_launch: device query failed\n"); grid = -1; return; }
        if (hipFuncSetAttribute((const void*)fwd_kernel, hipFuncAttributeMaxDynamicSharedMemorySize, LDS_BYTES) != hipSuccess) { fprintf(stderr, "kernel_launch: hipFuncSetAttribute failed\n"); grid = -1; return; }
        if (hipOccupancyMaxActiveBlocksPerMultiprocessor(&per_cu, (const void*)fwd_kernel, NWAVES * 64, LDS_BYTES) != hipSuccess || per_cu < 1)
            fprintf(stderr, "kernel_launch: note: occupancy query reports %d workgroups per CU\n", per_cu);
        (void)hipGetLastError();
        grid = cus;
    }
    if (grid < 0) return;
    if (hipMemsetAsync((char*)d_ws + WS_CTL, 0, CTL_ZERO_BYTES, stream) != hipSuccess) { fprintf(stderr, "kernel_launch: hipMemsetAsync failed\n"); return; }
    Args a{};
    a.x = (const float*)d_in[0]; a.pos = (const int*)d_in[1]; a.attn_norm = (const float*)d_in[2]; a.w_in = (const float*)d_in[3]; a.q_norm = (const float*)d_in[4]; a.kv_norm = (const float*)d_in[5];
    a.w_uq = (const float*)d_in[6]; a.w_ukv = (const float*)d_in[7]; a.beta_attn = (const float*)d_in[8]; a.beta_ret = (const float*)d_in[9]; a.w_o = (const float*)d_in[10]; a.mlp_norm = (const float*)d_in[11];
    a.w_up = (const float*)d_in[12]; a.w_down = (const float*)d_in[13]; a.final_norm = (const float*)d_in[14];
    a.out = (float*)d_out; a.ws = (unsigned char*)d_ws;
    for (int j = 0; j < 32; ++j) a.invf64[j] = pow(10000.0, -(double)(2 * j) / 64.0);
    for (int j = 0; j < 64; ++j) a.invf128[j] = pow(10000.0, -(double)(2 * j) / 128.0);
    for (int h = 0; h < 8; ++h) a.lg2g[h] = (float)(log1p(-exp2(-5.0 - (double)h)) / log(2.0));
    hipLaunchKernelGGL(fwd_kernel, dim3(grid), dim3(NWAVES * 64), LDS_BYTES, stream, a);
    const hipError_t le = hipPeekAtLastError();
    if (le != hipSuccess) fprintf(stderr, "kernel_launch: launch failed: %s\n", hipGetErrorName(le));
}
```

```cpp
#include <hip/hip_runtime.h>
#include <cstdio>
#include <cstdint>
#include <cmath>
namespace pg8 {
#define PG8_LAS __attribute__((address_space(3)))
typedef unsigned short bf16_t;
typedef short bf16x8 __attribute__((ext_vector_type(8)));
typedef float f32x4 __attribute__((ext_vector_type(4)));
typedef unsigned u32x4 __attribute__((ext_vector_type(4)));
constexpr int BM = 256, BK = 64, HALF = 128, HTB = HALF * BK * 2  , STAGE_BYTES = 8 * HTB, NXCD = 8, WGM = 8;

__host__ __device__ __forceinline__ int lds_byte(int r, int c) { const int st = (r >> 4) * 2 + (c >> 5), rr = r & 15, cc = c & 31, ob = rr * 64 + cc * 2; return st * 1024 + (ob ^ (((ob >> 9) & 1) << 5)); }
__host__ __device__ __forceinline__ void stage_rc(int b, int& R, int& C) { const int st = b / 1024, sb = b % 1024, swz = sb ^ (((sb >> 9) & 1) << 5); R = (st >> 1) * 16 + swz / 64; C = (st & 1) * 32 + (swz % 64) / 2; }
__host__ __device__ __forceinline__ int perm32(int rho) { const int n = rho >> 4, i = rho & 15; return 8 * (i >> 2) + 4 * n + (i & 3); }

struct Unit { int pm, pn; };
template <class...> using pg8_void_t = void;
template <class T, class = void> struct has_midk { static constexpr bool value = false; };
template <class T> struct has_midk<T, pg8_void_t<decltype(T::MIDK_T)>> { static constexpr bool value = (T::MIDK_T >= 0); };
struct Gemm { const bf16_t* A; const bf16_t* Bt; int M, N, K; };

struct StaticOrder {
    int nM, nN, nwg, G, c;
    __host__ __device__ void init(int M, int N, int G_, int c_) { nM = M / BM; nN = N / BM; nwg = nM * nN; G = G_; c = c_; }
    __host__ __device__ bool next(int i, Unit& u) const {
        const long L = (long)i * G + c; if (L >= nwg) return false;
        int wgid = (int)L; { const int q = nwg / NXCD, r = nwg % NXCD, xcd = wgid % NXCD, off = wgid / NXCD; wgid = (xcd < r ? xcd * (q + 1) : r * (q + 1) + (xcd - r) * q) + off; }
        const int nig = WGM * nN, gid = wgid / nig, fm = gid * WGM, gsz = (nM - fm) < WGM ? (nM - fm) : WGM;
        u.pm = fm + ((wgid % nig) % gsz); u.pn = (wgid % nig) / gsz; return true;
    }
    __device__ __forceinline__ void a_ready(const Unit&) const {}
    __device__ __forceinline__ void done(const Unit&) const {}
};

__device__ __forceinline__ unsigned cvt_pk_bf16(float lo, float hi) { unsigned r; asm volatile("v_cvt_pk_bf16_f32 %0, %1, %2" : "=v"(r) : "v"(lo), "v"(hi)); return r; }
typedef float f32x2 __attribute__((ext_vector_type(2)));
__device__ __forceinline__ f32x2 gelu_pk(f32x2 v) {
    const f32x2 av = __builtin_elementwise_abs(v), d = av * 0.2316418882f + 1.0f;
    f32x2 t; t.x = __builtin_amdgcn_rcpf(d.x); t.y = __builtin_amdgcn_rcpf(d.y);
    f32x2 q = t * 0.5307027145f + (-0.7265760135f); q = q * t + 0.7107068705f; q = q * t + (-0.142248368f); q = q * t + 0.127414796f; q = q * t;
    const f32x2 s = (v * v) * (-0.72134752044f);
    f32x2 e; e.x = __builtin_amdgcn_exp2f(s.x); e.y = __builtin_amdgcn_exp2f(s.y);
    const f32x2 m = v * (q * e), r = v - m;
    f32x2 o; o.x = v.x < 0.f ? m.x : r.x; o.y = v.y < 0.f ? m.y : r.y; return o;
}

template <int ACT  > struct EpiBf16 {
    static constexpr bool PERM = true, AFTER_DRAIN = false; static_assert(ACT == 0 || ACT == 1, "EpiBf16: ACT is 0 (none) or 1 (gelu_pk)");
    bf16_t* O; int ldc; const float* bias; int split_cols; size_t split_stride; float scale0;
    __device__ __forceinline__ void operator()(const f32x4 (&acc)[2][2][4][2], const Unit& u, int wr, int wc, int fr, int fq) const {
        const int row0 = u.pm * BM + wr * 64 + fr; int colt = u.pn * BM; bf16_t* base = O;
        float sc = 1.f; if (split_cols) { const int t = colt / split_cols; base += (size_t)t * split_stride; colt -= t * split_cols; if (t == 0) sc = scale0; }
        const int col0 = colt + wc * 32 + 8 * fq, bcol0 = u.pn * BM + wc * 32 + 8 * fq;
        f32x4 bv[2][2];
#pragma unroll
        for (int bj = 0; bj < 2; ++bj)
#pragma unroll
            for (int n = 0; n < 2; ++n) bv[bj][n] = bias ? *(const f32x4*)(bias + bcol0 + bj * HALF + 4 * n) : (f32x4){0.f, 0.f, 0.f, 0.f};
#pragma unroll
        for (int ai = 0; ai < 2; ++ai)
#pragma unroll
            for (int m = 0; m < 4; ++m) { bf16_t* rowp = base + (size_t)(row0 + ai * HALF + m * 16) * ldc + col0;
#pragma unroll
                for (int bj = 0; bj < 2; ++bj) { f32x4 v0 = acc[ai][bj][m][0] + bv[bj][0], v1 = acc[ai][bj][m][1] + bv[bj][1];
                    if (ACT == 1) { f32x2 a = gelu_pk((f32x2){v0[0], v0[1]}), b = gelu_pk((f32x2){v0[2], v0[3]}), c = gelu_pk((f32x2){v1[0], v1[1]}), d = gelu_pk((f32x2){v1[2], v1[3]});
                        v0 = (f32x4){a.x, a.y, b.x, b.y}; v1 = (f32x4){c.x, c.y, d.x, d.y}; }
                    v0 = v0 * sc; v1 = v1 * sc; u32x4 w; w.x = cvt_pk_bf16(v0[0], v0[1]); w.y = cvt_pk_bf16(v0[2], v0[3]); w.z = cvt_pk_bf16(v1[0], v1[1]); w.w = cvt_pk_bf16(v1[2], v1[3]);
                    *(u32x4*)(rowp + bj * HALF) = w; } }
    }
};

struct PanelStats {
    unsigned* xbuf;
    unsigned* cnt;
    unsigned* tmo;
    int ntn; float eps;
    unsigned code;
    __device__ __forceinline__ bool run(const f32x4 (&v)[2][2][4][2], const Unit& u, int wr, int wc, int fr, int fq, PG8_LAS unsigned char* lds, int wid, int lane) const {
        typedef float f32x2v __attribute__((ext_vector_type(2)));
        PG8_LAS f32x2v* P = (PG8_LAS f32x2v*)lds;
        PG8_LAS f32x2v* S = (PG8_LAS f32x2v*)(lds + 8192);
        PG8_LAS unsigned* flag = (PG8_LAS unsigned*)(lds + 8192 + 2048);
#pragma unroll
        for (int ai = 0; ai < 2; ++ai)
#pragma unroll
            for (int m = 0; m < 4; ++m) {
                float s = 0.f;
#pragma unroll
                for (int bj = 0; bj < 2; ++bj)
#pragma unroll
                    for (int n = 0; n < 2; ++n) { const f32x4 x = v[ai][bj][m][n]; s += (x[0] + x[1]) + (x[2] + x[3]); }
                s += __shfl_xor(s, 16); s += __shfl_xor(s, 32);
                const float mw = s * (1.0f / 64.0f); float q = 0.f;
#pragma unroll
                for (int bj = 0; bj < 2; ++bj)
#pragma unroll
                    for (int n = 0; n < 2; ++n) { const f32x4 d = v[ai][bj][m][n] - mw; q += (d[0] * d[0] + d[1] * d[1]) + (d[2] * d[2] + d[3] * d[3]); }
                q += __shfl_xor(q, 16); q += __shfl_xor(q, 32);
                if (fq == 0) P[(ai * HALF + wr * 64 + m * 16 + fr) * 4 + wc] = (f32x2v){mw, q};
            }
        asm volatile("s_waitcnt lgkmcnt(0)" ::: "memory"); __builtin_amdgcn_s_barrier(); asm volatile("" ::: "memory");
#if defined(BROKEN_EXCHANGE_NO_WAIT)
#warning BROKEN CONTROL BUILD: the row-statistics exchange does not wait; results are wrong by design
        if (blockIdx.x >= 64) { const long long t0_ = clock64(); while (clock64() - t0_ < 60000) __builtin_amdgcn_s_sleep(8); }
#endif
        const int row = wid * 32 + (lane & 31);
        if (lane < 32) {
            const f32x2v a = P[row * 4 + 0], b = P[row * 4 + 1], c = P[row * 4 + 2], d = P[row * 4 + 3];
            const float mt = (a.x + b.x + c.x + d.x) * 0.25f;
            const float da = a.x - mt, db = b.x - mt, dc = c.x - mt, dd = d.x - mt;
            const float m2 = (a.y + b.y) + (c.y + d.y) + 64.0f * ((da * da + db * db) + (dc * dc + dd * dd));
            unsigned long long* slot = (unsigned long long*)xbuf + ((size_t)(u.pm * BM + row) * 4 + u.pn);
            __hip_atomic_store(slot, ((unsigned long long)__float_as_uint(m2) << 32) | __float_as_uint(mt), __ATOMIC_RELAXED, __HIP_MEMORY_SCOPE_AGENT);
        }
        asm volatile("s_waitcnt vmcnt(0)" ::: "memory");
        if (lane == 0) __hip_atomic_fetch_add(cnt + 64 * u.pm, 1u, __ATOMIC_RELAXED, __HIP_MEMORY_SCOPE_AGENT);
        if (wid == 0) {
            bool dead = false; const unsigned long long t0 = __builtin_amdgcn_s_memrealtime(); const unsigned want = 8u * (unsigned)ntn;
            for (;;) {
#if defined(BROKEN_EXCHANGE_NO_WAIT)
                break;
#endif
                if ((unsigned)__builtin_amdgcn_readfirstlane(__hip_atomic_load(cnt + 64 * u.pm, __ATOMIC_RELAXED, __HIP_MEMORY_SCOPE_AGENT)) >= want) break;
                if (__builtin_amdgcn_s_memrealtime() - t0 > 2000000ull) {
                    if (lane == 0) { unsigned expect = 0u; __hip_atomic_compare_exchange_strong(tmo + 1, &expect, code | (unsigned)(u.pm & 0xff), __ATOMIC_RELAXED, __ATOMIC_RELAXED, __HIP_MEMORY_SCOPE_AGENT);
                                     __hip_atomic_store(tmo, 1u, __ATOMIC_RELAXED, __HIP_MEMORY_SCOPE_AGENT); }
                    dead = true; break; }
                __builtin_amdgcn_s_sleep(2);
            }
            __builtin_amdgcn_fence(__ATOMIC_ACQUIRE, "agent");
            if (lane == 0) flag[0] = dead ? 1u : 0u;
        }
        asm volatile("s_waitcnt vmcnt(0) lgkmcnt(0)" ::: "memory"); __builtin_amdgcn_s_barrier(); asm volatile("" ::: "memory");
        const bool bad = flag[0] != 0u;
        if (lane < 32) {
            const unsigned long long* slot = (const unsigned long long*)xbuf + (size_t)(u.pm * BM + row) * 4; float mt[4], m2[4]; float ms = 0.f;
#pragma unroll
            for (int t = 0; t < 4; ++t) { if (t < ntn) { const unsigned long long w = __hip_atomic_load(slot + t, __ATOMIC_RELAXED, __HIP_MEMORY_SCOPE_AGENT); mt[t] = __uint_as_float((unsigned)w); m2[t] = __uint_as_float((unsigned)(w >> 32)); } else { mt[t] = 0.f; m2[t] = 0.f; } ms += mt[t]; }
            const float mean = ms / (float)ntn; float q = 0.f;
#pragma unroll
            for (int t = 0; t < 4; ++t) if (t < ntn) { const float dm = mt[t] - mean; q += m2[t] + 256.0f * dm * dm; }
            S[row] = (f32x2v){mean, 1.0f / sqrtf(q / (256.0f * (float)ntn) + eps)};
        }
        asm volatile("s_waitcnt lgkmcnt(0)" ::: "memory"); __builtin_amdgcn_s_barrier(); asm volatile("" ::: "memory");
        return bad;
    }
};
struct EpiLnRes {
    static constexpr bool PERM = false, AFTER_DRAIN = true;
    const float* base; float* out; int ldc; const float* bias; PanelStats st; unsigned poison;
    __device__ __forceinline__ void fused(f32x4 (&acc)[2][2][4][2], const Unit& u, int wr, int wc, int fr, int fq, PG8_LAS unsigned char* lds, int wid, int lane) const {
        typedef float f32x2v __attribute__((ext_vector_type(2)));
        const PG8_LAS f32x2v* S = (const PG8_LAS f32x2v*)(lds + 8192);
        const int col0 = u.pn * BM + wc * 32 + 4 * fq;
#pragma unroll
        for (int bj = 0; bj < 2; ++bj)
#pragma unroll
            for (int n = 0; n < 2; ++n) { const f32x4 bv = bias ? *(const f32x4*)(bias + col0 + bj * HALF + n * 16) : (f32x4){0.f, 0.f, 0.f, 0.f};
#pragma unroll
                for (int ai = 0; ai < 2; ++ai)
#pragma unroll
                    for (int m = 0; m < 4; ++m) acc[ai][bj][m][n] += bv; }
        f32x4 pre[4][2][2];
#pragma unroll
        for (int m = 0; m < 4; ++m) { const size_t off = (size_t)(u.pm * BM + wr * 64 + m * 16 + fr) * ldc + col0;
#pragma unroll
            for (int bj = 0; bj < 2; ++bj)
#pragma unroll
                for (int n = 0; n < 2; ++n) pre[m][bj][n] = *(const f32x4*)(base + off + bj * HALF + n * 16); }
        const bool bad = st.run(acc, u, wr, wc, fr, fq, lds, wid, lane) || poison != 0u;
        const float qnan = __builtin_nanf("");
#pragma unroll
        for (int ai = 0; ai < 2; ++ai)
#pragma unroll
            for (int m = 0; m < 4; ++m) { const int r = ai * HALF + wr * 64 + m * 16 + fr; const f32x2v sr = S[r]; const size_t off = (size_t)(u.pm * BM + r) * ldc + col0;
#pragma unroll
                for (int bj = 0; bj < 2; ++bj)
#pragma unroll
                    for (int n = 0; n < 2; ++n) { const f32x4 bs = ai == 0 ? pre[m][bj][n] : *(const f32x4*)(base + off + bj * HALF + n * 16); f32x4 o = bs + (acc[ai][bj][m][n] - sr.x) * sr.y;
                        if (bad) o = (f32x4){qnan, qnan, qnan, qnan}; *(f32x4*)(out + off + bj * HALF + n * 16) = o; }
                if (m & 1) asm volatile("" ::: "memory"); }
    }
};
struct EpiLnResLn {
    static constexpr bool PERM = false, AFTER_DRAIN = true;
    const float* base; float* out; bf16_t* xn; int ldc; const float* bias; PanelStats st1, st2; unsigned poison;
    __device__ __forceinline__ void fused(f32x4 (&acc)[2][2][4][2], const Unit& u, int wr, int wc, int fr, int fq, PG8_LAS unsigned char* lds, int wid, int lane) const {
        typedef float f32x2v __attribute__((ext_vector_type(2))); typedef unsigned u32x2v __attribute__((ext_vector_type(2)));
        const PG8_LAS f32x2v* S = (const PG8_LAS f32x2v*)(lds + 8192);
        const int col0 = u.pn * BM + wc * 32 + 4 * fq;
#pragma unroll
        for (int bj = 0; bj < 2; ++bj)
#pragma unroll
            for (int n = 0; n < 2; ++n) { const f32x4 bv = bias ? *(const f32x4*)(bias + col0 + bj * HALF + n * 16) : (f32x4){0.f, 0.f, 0.f, 0.f};
#pragma unroll
                for (int ai = 0; ai < 2; ++ai)
#pragma unroll
                    for (int m = 0; m < 4; ++m) acc[ai][bj][m][n] += bv; }
        bool bad = st1.run(acc, u, wr, wc, fr, fq, lds, wid, lane) || poison != 0u;
        const float qnan = __builtin_nanf("");
#pragma unroll
        for (int ai = 0; ai < 2; ++ai)
#pragma unroll
            for (int m = 0; m < 4; ++m) { const int r = ai * HALF + wr * 64 + m * 16 + fr; const f32x2v sr = S[r]; const size_t off = (size_t)(u.pm * BM + r) * ldc + col0;
#pragma unroll
                for (int bj = 0; bj < 2; ++bj)
#pragma unroll
                    for (int n = 0; n < 2; ++n) { const f32x4 bs = *(const f32x4*)(base + off + bj * HALF + n * 16); acc[ai][bj][m][n] = bs + (acc[ai][bj][m][n] - sr.x) * sr.y; }
                asm volatile("" : "+v"(acc[ai][0][m][0]), "+v"(acc[ai][0][m][1]), "+v"(acc[ai][1][m][0]), "+v"(acc[ai][1][m][1]));
                if (m & 1) asm volatile("" ::: "memory"); }
        const bool bad1 = bad;
        bad = st2.run(acc, u, wr, wc, fr, fq, lds, wid, lane) || bad;
#pragma unroll
        for (int ai = 0; ai < 2; ++ai)
#pragma unroll
            for (int m = 0; m < 4; ++m) { const int r = ai * HALF + wr * 64 + m * 16 + fr; const f32x2v sr = S[r]; const size_t off = (size_t)(u.pm * BM + r) * ldc + col0;
#pragma unroll
                for (int bj = 0; bj < 2; ++bj)
#pragma unroll
                    for (int n = 0; n < 2; ++n) { const f32x4 x1 = acc[ai][bj][m][n]; *(f32x4*)(out + off + bj * HALF + n * 16) = bad1 ? (f32x4){qnan, qnan, qnan, qnan} : x1;
                        const f32x4 o = (x1 - sr.x) * sr.y; u32x2v w; w.x = cvt_pk_bf16(o[0], o[1]); w.y = cvt_pk_bf16(o[2], o[3]);
                        if (bad) { w.x = 0x7fc07fc0u; w.y = 0x7fc07fc0u; } *(u32x2v*)(xn + off + bj * HALF + n * 16) = w; }
                asm volatile("" ::: "memory"); }
    }
};

template <class Epi, class Sched, bool ALIGN_EPI = false, bool SP2 = false>
__device__ __forceinline__ void gemm_phase(PG8_LAS unsigned char* lds, const Gemm g, const Sched& S, const Epi& E) {
    int tid_l = threadIdx.x; asm volatile("" : "+v"(tid_l));
    const int tid = tid_l, wid = __builtin_amdgcn_readfirstlane(tid >> 6), lane = tid & 63, wr = wid >> 2, wc = wid & 3, fr = lane & 15, fq = lane >> 4;
    const int K = g.K, nt = K / BK;
    unsigned voffA[2], voffB[2];
#pragma unroll
    for (int i = 0; i < 2; ++i) { int R, C; stage_rc(tid * 16 + i * 8192, R, C); const int Rb = Epi::PERM ? ((R & ~31) + perm32(R & 31)) : R;
        voffA[i] = (unsigned)(R * K + C) * 2u; voffB[i] = (unsigned)(Rb * K + C) * 2u; }
    const size_t kstep = (size_t)(BK * 2);
    const size_t hstep = (size_t)HALF * K * 2;
    const size_t tstep = 2 * hstep;
    const unsigned ldsw = (unsigned)wid * 1024u;
    const int aoff = lds_byte(wr * 64 + fr, fq * 8), boff = lds_byte(wc * 32 + fr, fq * 8);
#define PG8_SA(b, h) (((b) * 2 + (h)) * HTB)
#define PG8_SB(b, h) ((4 + (b) * 2 + (h)) * HTB)
#define PG8_STAGE(bufoff, gbase, voff) do { _Pragma("unroll") for (int _i = 0; _i < 2; ++_i) \
        __builtin_amdgcn_global_load_lds((const unsigned*)((const char*)(gbase) + (voff)[_i]), (PG8_LAS unsigned*)(lds + (bufoff) + ldsw + _i * 8192), 16, 0, 0); } while (0)
#define PG8_LDA(dst, b, h) do { _Pragma("unroll") for (int m = 0; m < 4; ++m) _Pragma("unroll") for (int k = 0; k < 2; ++k) dst[m][k] = *(const PG8_LAS bf16x8*)(lds + PG8_SA(b, h) + aoff + m * 2048 + k * 1024); } while (0)
#define PG8_LDB(dst, b, h) do { _Pragma("unroll") for (int n = 0; n < 2; ++n) _Pragma("unroll") for (int k = 0; k < 2; ++k) dst[n][k] = *(const PG8_LAS bf16x8*)(lds + PG8_SB(b, h) + boff + n * 2048 + k * 1024); } while (0)
#define PG8_MMA(ai, bj, At, Bt) do { __builtin_amdgcn_s_setprio(1); _Pragma("unroll") for (int m = 0; m < 4; ++m) _Pragma("unroll") for (int n = 0; n < 2; ++n) _Pragma("unroll") for (int k = 0; k < 2; ++k) \
        acc[ai][bj][m][n] = __builtin_amdgcn_mfma_f32_16x16x32_bf16(Bt[n][k], At[m][k], acc[ai][bj][m][n], 0, 0, 0); __builtin_amdgcn_s_setprio(0); } while (0)
#define PG8_WAIT_V(n) asm volatile("s_waitcnt vmcnt(" #n ")" ::: "memory")
#define PG8_WAIT_L(n) asm volatile("s_waitcnt lgkmcnt(" #n ")" ::: "memory")
#define PG8_BAR __builtin_amdgcn_s_barrier()
#define PG8_SCHED __builtin_amdgcn_sched_barrier(0)
    Unit cur, nxt; int ui = 0;
    if (!S.next(0, cur)) return;
    f32x4 acc[2][2][4][2];
#pragma unroll
    for (int a = 0; a < 2; ++a)
#pragma unroll
        for (int b = 0; b < 2; ++b)
#pragma unroll
            for (int m = 0; m < 4; ++m)
#pragma unroll
                for (int n = 0; n < 2; ++n) acc[a][b][m][n] = (f32x4){0.f, 0.f, 0.f, 0.f};
    bf16x8 At[4][2], B0[2][2], B1[2][2];
    const char* cA = (const char*)g.A + (size_t)cur.pm * tstep; const char* cB = (const char*)g.Bt + (size_t)cur.pn * tstep;
    S.a_ready(cur);
    if constexpr (SP2) {
        PG8_STAGE(PG8_SB(0, 0), cB, voffB); PG8_STAGE(PG8_SB(0, 1), cB + hstep, voffB); PG8_STAGE(PG8_SA(0, 0), cA, voffA); PG8_STAGE(PG8_SA(0, 1), cA + hstep, voffA);
        if (wr == 1) PG8_BAR;
        PG8_WAIT_V(2); PG8_BAR;
        PG8_STAGE(PG8_SB(1, 0), cB + kstep, voffB); PG8_STAGE(PG8_SA(1, 0), cA + kstep, voffA); PG8_STAGE(PG8_SB(1, 1), cB + hstep + kstep, voffB);
        PG8_WAIT_V(6); PG8_BAR;
    } else {
        PG8_STAGE(PG8_SB(0, 0), cB, voffB); PG8_STAGE(PG8_SA(0, 0), cA, voffA); PG8_STAGE(PG8_SB(0, 1), cB + hstep, voffB); PG8_STAGE(PG8_SA(0, 1), cA + hstep, voffA);
        if (wr == 1) PG8_BAR;
        PG8_WAIT_V(4); PG8_BAR;
        PG8_STAGE(PG8_SB(1, 0), cB + kstep, voffB); PG8_STAGE(PG8_SA(1, 0), cA + kstep, voffA); PG8_STAGE(PG8_SB(1, 1), cB + hstep + kstep, voffB);
        PG8_WAIT_V(6); PG8_BAR;
    }
    for (;;) {
        const bool has_next = S.next(ui + 1, nxt);
        const char* nA = has_next ? (const char*)g.A + (size_t)nxt.pm * tstep : cA; const char* nB = has_next ? (const char*)g.Bt + (size_t)nxt.pn * tstep : cB;
        for (int t = 0; t < nt; t += 2) {
            if constexpr (has_midk<Epi>::value) { if (t == Epi::MIDK_T) E.midk(acc, cur, wr, fr); }
            const bool last = (t == nt - 2);
            const char* a1 = cA + (size_t)(t + 1) * kstep;
            const char* a2 = last ? nA : cA + (size_t)(t + 2) * kstep; const char* b2 = last ? nB : cB + (size_t)(t + 2) * kstep;
            const char* a3 = a2 + kstep; const char* b3 = b2 + kstep;
            if (last && has_next) S.a_ready(nxt);
            if constexpr (SP2) {
            PG8_LDB(B0, 0, 0); PG8_LDB(B1, 0, 1); PG8_SCHED; PG8_LDA(At, 0, 0); PG8_STAGE(PG8_SA(1, 1), a1 + hstep, voffA);
            PG8_WAIT_V(8); PG8_WAIT_L(0); PG8_BAR; PG8_MMA(0, 0, At, B0); PG8_MMA(0, 1, At, B1); PG8_BAR; PG8_SCHED;
            PG8_LDA(At, 0, 1); PG8_STAGE(PG8_SB(0, 0), b2, voffB); PG8_STAGE(PG8_SB(0, 1), b2 + hstep, voffB); PG8_STAGE(PG8_SA(0, 0), a2, voffA);
            PG8_WAIT_V(8); PG8_WAIT_L(0); PG8_BAR; PG8_MMA(1, 0, At, B0); PG8_MMA(1, 1, At, B1); PG8_BAR; PG8_SCHED;
            PG8_LDB(B0, 1, 0); PG8_LDB(B1, 1, 1); PG8_SCHED; PG8_LDA(At, 1, 0); PG8_STAGE(PG8_SA(0, 1), a2 + hstep, voffA);
            PG8_WAIT_V(8); PG8_WAIT_L(0); PG8_BAR; PG8_MMA(0, 0, At, B0); PG8_MMA(0, 1, At, B1); PG8_BAR; PG8_SCHED;
            PG8_LDA(At, 1, 1); PG8_STAGE(PG8_SB(1, 0), b3, voffB); PG8_STAGE(PG8_SB(1, 1), b3 + hstep, voffB); PG8_STAGE(PG8_SA(1, 0), a3, voffA);
            PG8_WAIT_V(8); PG8_WAIT_L(0); PG8_BAR; PG8_MMA(1, 0, At, B0); PG8_MMA(1, 1, At, B1); PG8_BAR; PG8_SCHED;
            } else {
            PG8_LDB(B0, 0, 0); PG8_SCHED; PG8_LDA(At, 0, 0); PG8_STAGE(PG8_SA(1, 1), a1 + hstep, voffA);
            PG8_WAIT_L(8); PG8_BAR; PG8_WAIT_L(0); PG8_MMA(0, 0, At, B0); PG8_BAR; PG8_SCHED;
            PG8_LDB(B1, 0, 1); PG8_STAGE(PG8_SB(0, 0), b2, voffB);
            PG8_BAR; PG8_WAIT_L(0); PG8_MMA(0, 1, At, B1); PG8_BAR;
            PG8_LDA(At, 0, 1); PG8_STAGE(PG8_SA(0, 0), a2, voffA);
            PG8_BAR; PG8_WAIT_L(0); PG8_MMA(1, 0, At, B0); PG8_BAR; PG8_SCHED;
            PG8_STAGE(PG8_SB(0, 1), b2 + hstep, voffB);
            PG8_WAIT_V(6); PG8_BAR; PG8_MMA(1, 1, At, B1); PG8_BAR;
            PG8_LDB(B0, 1, 0); PG8_SCHED; PG8_LDA(At, 1, 0); PG8_STAGE(PG8_SA(0, 1), a2 + hstep, voffA);
            PG8_WAIT_L(8); PG8_BAR; PG8_WAIT_L(0); PG8_MMA(0, 0, At, B0); PG8_BAR; PG8_SCHED;
            PG8_LDB(B1, 1, 1); PG8_STAGE(PG8_SB(1, 0), b3, voffB);
            PG8_BAR; PG8_WAIT_L(0); PG8_MMA(0, 1, At, B1); PG8_BAR;
            PG8_LDA(At, 1, 1); PG8_STAGE(PG8_SA(1, 0), a3, voffA);
            PG8_BAR; PG8_WAIT_L(0); PG8_MMA(1, 0, At, B0); PG8_BAR; PG8_SCHED;
            PG8_STAGE(PG8_SB(1, 1), b3 + hstep, voffB);
            PG8_WAIT_V(6); PG8_BAR; PG8_MMA(1, 1, At, B1); PG8_BAR;
            }
        }
        if constexpr (ALIGN_EPI) { if (wr == 0) PG8_BAR; }
        if constexpr (!Epi::AFTER_DRAIN) { E(acc, cur, wr, wc, fr, fq); S.done(cur); }
        if (!has_next) break;
#pragma unroll
        for (int a = 0; a < 2; ++a)
#pragma unroll
            for (int b = 0; b < 2; ++b)
#pragma unroll
                for (int m = 0; m < 4; ++m)
#pragma unroll
                    for (int n = 0; n < 2; ++n) acc[a][b][m][n] = (f32x4){0.f, 0.f, 0.f, 0.f};
        cur = nxt; cA = nA; cB = nB; ++ui;
        if constexpr (ALIGN_EPI) { if (wr == 1) PG8_BAR; }
    }
    PG8_WAIT_V(0);
    if constexpr (!ALIGN_EPI) { if (wr == 0) PG8_BAR; }
    PG8_BAR;
    if constexpr (Epi::AFTER_DRAIN) { E.fused(acc, cur, wr, wc, fr, fq, lds, wid, lane); S.done(cur); }
#undef PG8_SA
#undef PG8_SB
#undef PG8_STAGE
#undef PG8_LDA
#undef PG8_LDB
#undef PG8_MMA
#undef PG8_WAIT_V
#undef PG8_WAIT_L
#undef PG8_BAR
#undef PG8_SCHED
}
}
namespace pg8 {
__device__ __forceinline__ u32x4 pack8bf(const f32x4 a, const f32x4 b) { u32x4 w; w.x = cvt_pk_bf16(a[0], a[1]); w.y = cvt_pk_bf16(a[2], a[3]); w.z = cvt_pk_bf16(b[0], b[1]); w.w = cvt_pk_bf16(b[2], b[3]); return w; }
__device__ __forceinline__ void rope8(f32x4& v0, f32x4& v1, const f32x4 cs, const f32x4 sn) {
    float a, b;
    a = v0[0]; b = v0[1]; v0[0] = a * cs[0] - b * sn[0]; v0[1] = b * cs[0] + a * sn[0];
    a = v0[2]; b = v0[3]; v0[2] = a * cs[1] - b * sn[1]; v0[3] = b * cs[1] + a * sn[1];
    a = v1[0]; b = v1[1]; v1[0] = a * cs[2] - b * sn[2]; v1[1] = b * cs[2] + a * sn[2];
    a = v1[2]; b = v1[3]; v1[2] = a * cs[3] - b * sn[3]; v1[3] = b * cs[3] + a * sn[3];
}
__device__ __forceinline__ float silu_f(float x) { return x * __builtin_amdgcn_rcpf(1.0f + __builtin_amdgcn_exp2f(-1.4426950408889634f * x)); }
__device__ __forceinline__ float sq4(const f32x4 v) { return (v[0] * v[0] + v[1] * v[1]) + (v[2] * v[2] + v[3] * v[3]); }
template <int NP> __device__ __forceinline__ float row_scale(const float* SS, size_t row, float inv_n, float eps, int fq) {
    const float* p = SS + row * NP; float s;
    if constexpr (NP == 32) { const f32x4 a = *(const f32x4*)(p + fq * 8), b = *(const f32x4*)(p + fq * 8 + 4); s = ((a[0] + a[1]) + (a[2] + a[3])) + ((b[0] + b[1]) + (b[2] + b[3])); s += __shfl_xor(s, 16); s += __shfl_xor(s, 32); }
    else if constexpr (NP == 8) { const f32x4 a = *(const f32x4*)p, b = *(const f32x4*)(p + 4); s = ((a[0] + a[1]) + (a[2] + a[3])) + ((b[0] + b[1]) + (b[2] + b[3])); }
    else { const f32x4 a = *(const f32x4*)p; s = (a[0] + a[1]) + (a[2] + a[3]); }
    return 1.0f / sqrtf(s * inv_n + eps);
}

struct EpiIn {
    static constexpr bool PERM = true, AFTER_DRAIN = false;
    const float* XSS; bf16_t* CQ; bf16_t* CKV; float* CQSS; float* CKVSS; bf16_t* Kb; const float* c64; const float* s64;
    bf16_t* RQ; bf16_t* RK; bf16_t* RV; bf16_t* RG; const float* c128; const float* s128;
    const PG8_LAS float* rtab; int rpm;
    __device__ __forceinline__ void operator()(const f32x4 (&acc)[2][2][4][2], const Unit& u, int wr, int wc, int fr, int fq) const {
        const int pn = u.pn, row0 = u.pm * BM + wr * 64 + fr, cw = wc * 32 + 8 * fq;
#pragma unroll
        for (int ai = 0; ai < 2; ++ai) {
            float r4[4];
#pragma unroll
            for (int m = 0; m < 4; ++m) r4[m] = (u.pm == rpm) ? rtab[wr * 64 + fr + ai * HALF + m * 16] : row_scale<32>(XSS, (size_t)(row0 + ai * HALF + m * 16), 1.0f / 2048.0f, 1e-6f, fq);
            asm volatile("" : "+v"(r4[0]), "+v"(r4[1]), "+v"(r4[2]), "+v"(r4[3]));
            if (pn < 3) {
#pragma unroll
                for (int m = 0; m < 4; ++m) { const size_t row = (size_t)(row0 + ai * HALF + m * 16); const float r = r4[m];
                    const f32x4 a0 = acc[ai][0][m][0] * r, a1 = acc[ai][0][m][1] * r, b0 = acc[ai][1][m][0] * r, b1 = acc[ai][1][m][1] * r;
                    float s = (sq4(a0) + sq4(a1)) + (sq4(b0) + sq4(b1)); s += __shfl_xor(s, 16); s += __shfl_xor(s, 32);
                    if (pn < 2) { bf16_t* rp = CQ + row * 512 + pn * 256 + cw; *(u32x4*)rp = pack8bf(a0, a1); *(u32x4*)(rp + HALF) = pack8bf(b0, b1); if (fq == 0) CQSS[row * 8 + pn * 4 + wc] = s; }
                    else { bf16_t* rp = CKV + row * 256 + cw; *(u32x4*)rp = pack8bf(a0, a1); *(u32x4*)(rp + HALF) = pack8bf(b0, b1); if (fq == 0) CKVSS[row * 4 + wc] = s; } }
            } else if (pn == 3) {
                if (wc < 2) { const int j0 = cw >> 1;
#pragma unroll
                    for (int m = 0; m < 4; ++m) { const size_t row = (size_t)(row0 + ai * HALF + m * 16); const float r = r4[m];
                        const f32x4 cs = *(const f32x4*)(c64 + row * 32 + j0), sn = *(const f32x4*)(s64 + row * 32 + j0);
                        f32x4 v0 = acc[ai][0][m][0] * r, v1 = acc[ai][0][m][1] * r; rope8(v0, v1, cs, sn); const u32x4 w = pack8bf(v0, v1);
                        bf16_t* kp = Kb + row * 1536 + 128 + cw;
#pragma unroll
                        for (int h = 0; h < 8; ++h) *(u32x4*)(kp + h * 192) = w; } }
            } else if (pn < 12) {
                bf16_t* T = pn < 8 ? RQ : RK; const float sc = pn < 8 ? 0.08838834764831845f : 1.0f; const int ct = ((pn - 4) & 3) * 256 + cw, j0 = cw >> 1;
#pragma unroll
                for (int m = 0; m < 4; ++m) { const size_t row = (size_t)(row0 + ai * HALF + m * 16); const float r = r4[m] * sc;
                    const f32x4 cs = *(const f32x4*)(c128 + row * 64 + j0), sn = *(const f32x4*)(s128 + row * 64 + j0);
#pragma unroll
                    for (int bj = 0; bj < 2; ++bj) { f32x4 v0 = acc[ai][bj][m][0] * r, v1 = acc[ai][bj][m][1] * r; rope8(v0, v1, cs, sn);
                        *(u32x4*)(T + row * 1024 + ct + bj * HALF) = pack8bf(v0, v1); } }
            } else if (pn < 16) {
                const int ct = (pn - 12) * 256 + cw;
#pragma unroll
                for (int m = 0; m < 4; ++m) { const size_t row = (size_t)(row0 + ai * HALF + m * 16); bf16_t* rp = RV + row * 1024 + ct; const float r = r4[m];
#pragma unroll
                    for (int bj = 0; bj < 2; ++bj) *(u32x4*)(rp + bj * HALF) = pack8bf(acc[ai][bj][m][0] * r, acc[ai][bj][m][1] * r); }
            } else {
                const int ct = (pn - 16) * 256 + cw;
#pragma unroll
                for (int m = 0; m < 4; ++m) { const size_t row = (size_t)(row0 + ai * HALF + m * 16); bf16_t* rp = RG + row * 1024 + ct; const float r = r4[m];
#pragma unroll
                    for (int bj = 0; bj < 2; ++bj) { f32x4 v0 = acc[ai][bj][m][0] * r, v1 = acc[ai][bj][m][1] * r;
#pragma unroll
                        for (int e = 0; e < 4; ++e) { v0[e] = silu_f(v0[e]); v1[e] = silu_f(v1[e]); }
                        *(u32x4*)(rp + bj * HALF) = pack8bf(v0, v1); } }
            }
        }
    }
};
struct EpiQ {
    static constexpr bool PERM = true, AFTER_DRAIN = false;
    const float* CQSS; bf16_t* Q; const float* c64; const float* s64; float sc;
    __device__ __forceinline__ void operator()(const f32x4 (&acc)[2][2][4][2], const Unit& u, int wr, int wc, int fr, int fq) const {
        const int row0 = u.pm * BM + wr * 64 + fr, cw = wc * 32 + 8 * fq;
#pragma unroll
        for (int ai = 0; ai < 2; ++ai)
#pragma unroll
            for (int m = 0; m < 4; ++m) { const size_t row = (size_t)(row0 + ai * HALF + m * 16); const float r = row_scale<8>(CQSS, row, 1.0f / 512.0f, 1e-6f, fq) * sc;
#pragma unroll
                for (int bj = 0; bj < 2; ++bj) { const int c0 = u.pn * 256 + bj * HALF + cw, dd = c0 % 192; const bool rp = dd >= 128; const int j0 = rp ? ((dd - 128) >> 1) : 0;
                    f32x4 v0 = acc[ai][bj][m][0] * r, v1 = acc[ai][bj][m][1] * r;
                    if (rp) { const f32x4 cs = *(const f32x4*)(c64 + row * 32 + j0), sn = *(const f32x4*)(s64 + row * 32 + j0); rope8(v0, v1, cs, sn); }
                    *(u32x4*)(Q + row * 1536 + c0) = pack8bf(v0, v1); } }
    }
};
struct EpiKV {
    static constexpr bool PERM = true, AFTER_DRAIN = false;
    const float* CKVSS; bf16_t* K; bf16_t* V;
    __device__ __forceinline__ void operator()(const f32x4 (&acc)[2][2][4][2], const Unit& u, int wr, int wc, int fr, int fq) const {
        const int row0 = u.pm * BM + wr * 64 + fr, cw = wc * 32 + 8 * fq;
#pragma unroll
        for (int ai = 0; ai < 2; ++ai)
#pragma unroll
            for (int m = 0; m < 4; ++m) { const size_t row = (size_t)(row0 + ai * HALF + m * 16); const float r = row_scale<4>(CKVSS, row, 1.0f / 256.0f, 1e-6f, fq);
                *(u32x4*)(K + row * 1536 + u.pn * 192 + cw) = pack8bf(acc[ai][0][m][0] * r, acc[ai][0][m][1] * r);
                *(u32x4*)(V + row * 1024 + u.pn * 128 + cw) = pack8bf(acc[ai][1][m][0] * r, acc[ai][1][m][1] * r); }
    }
};
__device__ __forceinline__ f32x4 bf_lo4(unsigned a, unsigned b) { return (f32x4){__uint_as_float(a << 16), __uint_as_float(a & 0xffff0000u), __uint_as_float(b << 16), __uint_as_float(b & 0xffff0000u)}; }
template <bool SCALE2  , bool BASE_F32, bool MIDK = false>
struct EpiResT {
    static constexpr bool PERM = true, AFTER_DRAIN = false;
    static constexpr int MIDK_T = MIDK ? 16 : -1;
    const float* base; bf16_t* XB; bf16_t* XL; float* XSS; const float* RS; const PG8_LAS float* rtab; int rpm;
    __device__ __forceinline__ void midk(f32x4 (&acc)[2][2][4][2], const Unit& u, int wr, int fr) const {
#pragma unroll
        for (int ai = 0; ai < 2; ++ai)
#pragma unroll
            for (int m = 0; m < 4; ++m) { float r;
                if (u.pm == rpm) r = rtab[wr * 64 + fr + ai * HALF + m * 16];
                else { const f32x4* p = (const f32x4*)(RS + (size_t)(u.pm * BM + wr * 64 + fr + ai * HALF + m * 16) * 8); const f32x4 a = p[0], b = p[1]; r = 1.0f / sqrtf((((a[0] + a[1]) + (a[2] + a[3])) + ((b[0] + b[1]) + (b[2] + b[3]))) * (1.0f / 1024.0f) + 1e-6f); }
#pragma unroll
                for (int bj = 0; bj < 2; ++bj) { acc[ai][bj][m][0] = acc[ai][bj][m][0] * r; acc[ai][bj][m][1] = acc[ai][bj][m][1] * r; } }
    }
    __device__ __forceinline__ void operator()(const f32x4 (&acc)[2][2][4][2], const Unit& u, int wr, int wc, int fr, int fq) const {
        const int row0 = u.pm * BM + wr * 64 + fr, c0 = u.pn * BM + wc * 32 + 8 * fq;
#pragma unroll
        for (int ai = 0; ai < 2; ++ai) {
            float r2[4];
#pragma unroll
            for (int m = 0; m < 4; ++m) { if constexpr (SCALE2) { const float r = (u.pm == rpm) ? rtab[wr * 64 + fr + ai * HALF + m * 16] : row_scale<32>(RS, (size_t)(row0 + ai * HALF + m * 16), 1.0f / 2048.0f, 1e-6f, fq); r2[m] = r * r; } else r2[m] = 1.0f; }
            if constexpr (SCALE2) asm volatile("" : "+v"(r2[0]), "+v"(r2[1]), "+v"(r2[2]), "+v"(r2[3]));
            f32x4 pre[4][4];
#pragma unroll
            for (int m = 0; m < 4; ++m) { const size_t off = (size_t)(row0 + ai * HALF + m * 16) * 2048 + c0;
                if constexpr (BASE_F32) { pre[m][0] = *(const f32x4*)(base + off); pre[m][1] = *(const f32x4*)(base + off + 4); pre[m][2] = *(const f32x4*)(base + off + HALF); pre[m][3] = *(const f32x4*)(base + off + HALF + 4); }
                else { pre[m][0] = *(const f32x4*)(XB + off); pre[m][1] = *(const f32x4*)(XL + off); pre[m][2] = *(const f32x4*)(XB + off + HALF); pre[m][3] = *(const f32x4*)(XL + off + HALF); } }
#pragma unroll
            for (int m = 0; m < 4; ++m) asm volatile("" : "+v"(pre[m][0]), "+v"(pre[m][1]), "+v"(pre[m][2]), "+v"(pre[m][3]));
#pragma unroll
            for (int m = 0; m < 4; ++m) { const size_t row = (size_t)(row0 + ai * HALF + m * 16); const size_t off = row * 2048 + c0;
                f32x4 x0, x1, y0, y1;
                if constexpr (BASE_F32) { x0 = pre[m][0]; x1 = pre[m][1]; y0 = pre[m][2]; y1 = pre[m][3]; }
                else { const u32x4 h0 = __builtin_bit_cast(u32x4, pre[m][0]), l0 = __builtin_bit_cast(u32x4, pre[m][1]), h1 = __builtin_bit_cast(u32x4, pre[m][2]), l1 = __builtin_bit_cast(u32x4, pre[m][3]);
                    x0 = bf_lo4(h0.x, h0.y) + bf_lo4(l0.x, l0.y); x1 = bf_lo4(h0.z, h0.w) + bf_lo4(l0.z, l0.w); y0 = bf_lo4(h1.x, h1.y) + bf_lo4(l1.x, l1.y); y1 = bf_lo4(h1.z, h1.w) + bf_lo4(l1.z, l1.w); }
                f32x4 a0, a1, b0, b1;
                if constexpr (SCALE2) { a0 = x0 + acc[ai][0][m][0] * r2[m]; a1 = x1 + acc[ai][0][m][1] * r2[m]; b0 = y0 + acc[ai][1][m][0] * r2[m]; b1 = y1 + acc[ai][1][m][1] * r2[m]; }
                else { a0 = x0 + acc[ai][0][m][0]; a1 = x1 + acc[ai][0][m][1]; b0 = y0 + acc[ai][1][m][0]; b1 = y1 + acc[ai][1][m][1]; }
                const u32x4 ha = pack8bf(a0, a1), hb = pack8bf(b0, b1);
                *(u32x4*)(XB + off) = ha; *(u32x4*)(XB + off + HALF) = hb;
                *(u32x4*)(XL + off) = pack8bf(a0 - bf_lo4(ha.x, ha.y), a1 - bf_lo4(ha.z, ha.w)); *(u32x4*)(XL + off + HALF) = pack8bf(b0 - bf_lo4(hb.x, hb.y), b1 - bf_lo4(hb.z, hb.w));
                float s = (sq4(a0) + sq4(a1)) + (sq4(b0) + sq4(b1)); s += __shfl_xor(s, 16); s += __shfl_xor(s, 32);
                if (fq == 0) XSS[row * 32 + u.pn * 4 + wc] = s; }
        }
    }
};
struct EpiRelu2 {
    static constexpr bool PERM = true, AFTER_DRAIN = false;
    bf16_t* O; int ldc;
    __device__ __forceinline__ void operator()(const f32x4 (&acc)[2][2][4][2], const Unit& u, int wr, int wc, int fr, int fq) const {
        const int row0 = u.pm * BM + wr * 64 + fr, c0 = u.pn * BM + wc * 32 + 8 * fq;
#pragma unroll
        for (int ai = 0; ai < 2; ++ai)
#pragma unroll
            for (int m = 0; m < 4; ++m) { bf16_t* rp = O + (size_t)(row0 + ai * HALF + m * 16) * ldc + c0;
#pragma unroll
                for (int bj = 0; bj < 2; ++bj) { f32x4 v0 = acc[ai][bj][m][0], v1 = acc[ai][bj][m][1];
#pragma unroll
                    for (int e = 0; e < 4; ++e) { const float a = fmaxf(v0[e], 0.f), b = fmaxf(v1[e], 0.f); v0[e] = a * a; v1[e] = b * b; }
                    *(u32x4*)(rp + bj * HALF) = pack8bf(v0, v1); } }
    }
};
}
constexpr int NWAVES = 8;
constexpr int BATCH = 2, SEQ = 8192, DM = 2048, DEPTH = 4, M = BATCH * SEQ;
constexpr int NH = 8, QLORA = 512, KVLORA = 256, DQK = 192, DNOPE = 128, DROPE = 64, DV = 128, FF = 8192;
constexpr int IN_SRC = 4928, IN_PAD = 5120;
constexpr int RCH = 128, NCH = SEQ / RCH;
constexpr float NORM_EPS = 1e-6f, GN_EPS = 1e-6f;
constexpr float QSCALE = 0.07216878364870323f * 1.4426950408889634f;

constexpr size_t MiB = 1u << 20;
constexpr size_t WS_CTL = 0, CTL_ZERO_BYTES = 128 * 1024;
constexpr size_t WS_C64 = 2 * MiB, WS_S64 = 4 * MiB, WS_C128 = 6 * MiB, WS_S128 = 10 * MiB;
constexpr size_t WS_XSS = 14 * MiB;
constexpr size_t WS_W = 16 * MiB, W_STRIDE = 96 * MiB;
constexpr size_t WO_WIN = 0, WO_WUQ = 20 * MiB, WO_WUKV = 22 * MiB, WO_WO = 24 * MiB, WO_WUP = 32 * MiB, WO_WDN = 64 * MiB;
constexpr size_t WS_XB = 208 * MiB;
constexpr size_t WS_MIX = 272 * MiB;
constexpr size_t WS_CQSS = 336 * MiB, WS_CKVSS = 337 * MiB;
constexpr size_t WS_RQ = 338 * MiB, WS_RK = 370 * MiB, WS_RV = 402 * MiB, WS_RG = 434 * MiB;
constexpr size_t WS_CQ = 466 * MiB, WS_CKV = 482 * MiB;
constexpr size_t WS_Q = 490 * MiB, WS_K = 538 * MiB, WS_V = 586 * MiB;
constexpr size_t WS_U = 618 * MiB, WS_S = 682 * MiB;
constexpr size_t WS_UF = 338 * MiB;
constexpr size_t WS_XSS2 = 714 * MiB;
constexpr size_t WS_ASS = 337 * MiB + 512 * 1024;
constexpr size_t WS_XL = 716 * MiB;
constexpr size_t WS_END = 780 * MiB;
static_assert(WS_UF + (size_t)M * FF * 2 <= WS_U && WS_S + (size_t)16 * 64 * 16384 * 2 <= WS_END && WS_U + (size_t)16 * 64 * 16384 * 4 <= WS_S, "d_ws map");
static_assert(WO_WIN + (size_t)IN_PAD * DM * 2 <= WO_WUQ && WO_WUQ + (size_t)1536 * 512 * 2 <= WO_WUKV && WO_WUKV + (size_t)2048 * 256 * 2 <= WO_WO && WO_WO + (size_t)DM * DM * 2 <= WO_WUP && WO_WUP + (size_t)FF * DM * 2 <= WO_WDN && WO_WDN + (size_t)FF * DM * 2 <= W_STRIDE && WS_W + 2 * W_STRIDE <= WS_XB, "weights map");
constexpr int CW_TMO = 0, CW_CODE = 1, CW_BAR = 4096;
constexpr int CW_AQ = 12288;
constexpr int CW_SRDY = 12544, CW_RQ = 12800;
constexpr int CW_WQ = 8192;
static_assert(CW_BAR + 3456 <= CW_WQ && (CW_WQ + 64 * DEPTH) <= CW_AQ && (CW_AQ + 64 * DEPTH) <= CW_SRDY && (CW_SRDY + 64 * DEPTH) <= CW_RQ && (CW_RQ + 64 * DEPTH) * 4 <= (int)CTL_ZERO_BYTES, "control words inside the per-call memset");

constexpr int RING_OFF = 0, RING_BYTES = 131072;
constexpr int LDSCTL_OFF = RING_BYTES, MISC_OFF = LDSCTL_OFF + 320;
constexpr int LDS_BYTES = 147456;
static_assert(MISC_OFF + 128 <= LDS_BYTES, "LDS map");

#define GAS __attribute__((address_space(1)))
#define LAS __attribute__((address_space(3)))
typedef unsigned short bf16;
typedef unsigned v4u __attribute__((ext_vector_type(4)));
typedef float f32x4 __attribute__((ext_vector_type(4)));
typedef short bf16x8 __attribute__((ext_vector_type(8)));
typedef GAS unsigned gu32;
typedef GAS unsigned long long gu64;
#define RLX_AGENT __ATOMIC_RELAXED, __HIP_MEMORY_SCOPE_AGENT
#define LDS_WAIT() asm volatile("s_waitcnt lgkmcnt(0)" ::: "memory")
#define VM_WAIT() asm volatile("s_waitcnt vmcnt(0)" ::: "memory")
__device__ __forceinline__ unsigned long long rt() { return __builtin_amdgcn_s_memrealtime(); }
__device__ __forceinline__ unsigned f2bf(float f) { unsigned u = __builtin_bit_cast(unsigned, f); return (u + 0x7fffu + ((u >> 16) & 1u)) >> 16; }
__device__ __forceinline__ unsigned pk2(float lo, float hi) { return f2bf(lo) | (f2bf(hi) << 16); }

#define XB_TMO      128
#define XB_XCNT(j)  (256  + 64 * (j))
#define XB_XSUB(j)  (1280 + 64 * (j))
#define XB_XGEN(j)  (2304 + 64 * (j))
#define XB_TOP      3328
#define XB_TOPGEN   3392
#define XCD_BAR_WORDS 3456
#define XB_SPIN_CAP (1u << 18)

__device__ __forceinline__ unsigned xb_ld(unsigned* p)              { return __hip_atomic_load(p, __ATOMIC_RELAXED, __HIP_MEMORY_SCOPE_AGENT); }
__device__ __forceinline__ unsigned xb_add(unsigned* p, unsigned v) { return __hip_atomic_fetch_add(p, v, __ATOMIC_RELAXED, __HIP_MEMORY_SCOPE_AGENT); }
__device__ __forceinline__ unsigned xb_xcc_id() { return (unsigned)__builtin_amdgcn_s_getreg((3 << 11) | 20) & 0xFu; }
#define XB_SPIN(cond, bar) do { unsigned _sp = 0; while (cond) { __builtin_amdgcn_s_sleep(1); \
    if ((++_sp & 255u) == 0u) { if (xb_ld(&(bar)[XB_TMO])) break; if (_sp > XB_SPIN_CAP) { atomicAdd(&(bar)[XB_TMO], 1u); break; } } } } while (0)

struct XcdBarrier {
    unsigned* bar; unsigned x;
    volatile LAS unsigned* st;
};

__device__ __forceinline__ XcdBarrier xcd_barrier_post(unsigned* bar, volatile LAS unsigned* st) {
    XcdBarrier b; b.bar = bar; b.x = xb_xcc_id(); b.st = st;
    if (threadIdx.x == 0) (void)xb_add(&bar[XB_XCNT(b.x)], 1u);
    return b;
}
__device__ __forceinline__ void xcd_barrier_complete(unsigned* bar, unsigned x, unsigned& nloc, unsigned& nx) {
    const unsigned G = gridDim.x * gridDim.y * gridDim.z;
    unsigned sum, cnt, mine, sp = 0u;
    for (;;) {
        sum = 0u; cnt = 0u; mine = 0u;
#pragma unroll
        for (unsigned j = 0; j < 16; ++j) { const unsigned c = xb_ld(&bar[XB_XCNT(j)]); sum += c; cnt += (c > 0u) ? 1u : 0u; mine = (j == x) ? c : mine; }
        if (sum == G) break;
        __builtin_amdgcn_s_sleep(1);
        if ((++sp & 255u) == 0u) { if (xb_ld(&bar[XB_TMO])) break; if (sp > XB_SPIN_CAP) { atomicAdd(&bar[XB_TMO], 1u); break; } }
    }
    nloc = mine > 0u ? mine : 1u; nx = cnt > 0u ? cnt : 1u;
}

__device__ __forceinline__ void xcd_barrier(const XcdBarrier& b) {
    asm volatile("s_waitcnt vmcnt(0)" ::: "memory");
    __syncthreads();
    if (threadIdx.x == 0) {
        unsigned* bar = b.bar;
        __builtin_amdgcn_s_waitcnt(0);
        unsigned nloc = b.st[0], nx = b.st[1];
        if (nloc == 0u) { xcd_barrier_complete(bar, b.x, nloc, nx); b.st[0] = nloc; b.st[1] = nx; }
        const unsigned old = xb_add(&bar[XB_XSUB(b.x)], 1u);
        const unsigned gen = old / nloc;
        if (old + 1u == (gen + 1u) * nloc) {
            __builtin_amdgcn_fence(__ATOMIC_RELEASE, "agent");
            asm volatile("s_waitcnt vmcnt(0)" ::: "memory");
            const unsigned og = xb_add(&bar[XB_TOP], 1u);
            const unsigned tg = og / nx;
            if (og + 1u == (tg + 1u) * nx) xb_add(&bar[XB_TOPGEN], 1u);
            else XB_SPIN(xb_ld(&bar[XB_TOPGEN]) == tg, bar);
            __builtin_amdgcn_fence(__ATOMIC_ACQUIRE, "agent");
            xb_add(&bar[XB_XGEN(b.x)], 1u);
            asm volatile("s_waitcnt vmcnt(0)" ::: "memory");
        } else {
            XB_SPIN(xb_ld(&bar[XB_XGEN(b.x)]) == gen, bar);
            __builtin_amdgcn_fence(__ATOMIC_ACQUIRE, "agent");
            asm volatile("s_waitcnt vmcnt(0)" ::: "memory");
        }
    }
    __syncthreads();
}

typedef short s16x4 __attribute__((ext_vector_type(4)));
typedef float f32x16 __attribute__((ext_vector_type(16)));
typedef float f32x2 __attribute__((ext_vector_type(2)));
typedef LAS unsigned char* ldsp;
typedef const LAS unsigned char* cldsp;
#define SBARRIER() do { __builtin_amdgcn_s_barrier(); asm volatile("" ::: "memory"); } while (0)
__device__ __forceinline__ float wave_sum(float v) {
#pragma unroll
    for (int o = 1; o < 64; o <<= 1) v += __shfl_xor(v, o);
    return v;
}
__device__ __forceinline__ unsigned cvtpk(float lo, float hi) { unsigned r; asm volatile("v_cvt_pk_bf16_f32 %0, %1, %2" : "=v"(r) : "v"(lo), "v"(hi)); return r; }
__device__ __forceinline__ float bf_lo(unsigned w) { return __builtin_bit_cast(float, w << 16); }
__device__ __forceinline__ float bf_hi(unsigned w) { return __builtin_bit_cast(float, w & 0xffff0000u); }
__device__ __forceinline__ int crow(int r, int hi) { return (r & 3) + 8 * (r >> 2) + 4 * hi; }
__device__ __forceinline__ void glds16(const void* g, ldsp l) { __builtin_amdgcn_global_load_lds((const unsigned*)g, (LAS unsigned*)l, 16, 0, 0); }
typedef short v4i16_t __attribute__((ext_vector_type(4)));
__device__ __forceinline__ s16x4 trrd(cldsp p) { return __builtin_bit_cast(s16x4, __builtin_amdgcn_ds_read_tr16_b64_v4i16((LAS v4i16_t*)p)); }
#define MK8(lo, hi) ((bf16x8){(lo)[0], (lo)[1], (lo)[2], (lo)[3], (hi)[0], (hi)[1], (hi)[2], (hi)[3]})
__device__ __forceinline__ bf16x8 pack8f(const f32x16& p, int b) {
    v4u w; w.x = cvtpk(p[b], p[b + 1]); w.y = cvtpk(p[b + 2], p[b + 3]); w.z = cvtpk(p[b + 4], p[b + 5]); w.w = cvtpk(p[b + 6], p[b + 7]); return __builtin_bit_cast(bf16x8, w);
}
#define MFMA32(a, b, c) __builtin_amdgcn_mfma_f32_32x32x16_bf16((a), (b), (c), 0, 0, 0)
__device__ __forceinline__ int tr_att_base(int lane) { return (4 * (lane >> 5) + ((lane & 15) >> 2)) * 64 + ((lane >> 4) & 1) * 32 + (lane & 3) * 8; }
__device__ __forceinline__ int tr_nat_base(int lane) { return (8 * (lane >> 5) + ((lane & 15) >> 2)) * 64 + ((lane >> 4) & 1) * 32 + (lane & 3) * 8; }

struct Args {
    const float* x; const int* pos; const float* attn_norm; const float* w_in; const float* q_norm; const float* kv_norm; const float* w_uq; const float* w_ukv;
    const float* beta_attn; const float* beta_ret; const float* w_o; const float* mlp_norm; const float* w_up; const float* w_down; const float* final_norm;
    float* out; unsigned char* ws;
    double invf64[32]; double invf128[64];
    float lg2g[8];
};
static_assert(sizeof(Args) == 17 * 8 + 96 * 8 + 32, "Args has no padding");
typedef const __attribute__((address_space(4))) Args* cargs_t;
__device__ __forceinline__ cargs_t get_args() { cargs_t p = (cargs_t)__builtin_amdgcn_kernarg_segment_ptr(); asm volatile("" : "+s"(p)); return p; }

__device__ __forceinline__ void sincos_d(double ang, float& s, float& c) {
    const double k = __builtin_rint(ang * 0.63661977236758134308);
    double y = __builtin_fma(-k, 1.57079632679489655800e+00, ang); y = __builtin_fma(-k, 6.12323399573676603587e-17, y);
    const double z = y * y;
    double sp = 1.0 / 6227020800.0; sp = sp * z - 1.0 / 39916800.0; sp = sp * z + 1.0 / 362880.0; sp = sp * z - 1.0 / 5040.0; sp = sp * z + 1.0 / 120.0; sp = sp * z - 1.0 / 6.0; sp = sp * z + 1.0; sp = sp * y;
    double cp = -1.0 / 87178291200.0; cp = cp * z + 1.0 / 479001600.0; cp = cp * z - 1.0 / 3628800.0; cp = cp * z + 1.0 / 40320.0; cp = cp * z - 1.0 / 720.0; cp = cp * z + 1.0 / 24.0; cp = cp * z - 0.5; cp = cp * z + 1.0;
    const int q = (int)((long long)k & 3);
    const double ss = (q == 0) ? sp : (q == 1) ? cp : (q == 2) ? -sp : -cp;
    const double cc = (q == 0) ? cp : (q == 1) ? -sp : (q == 2) ? -cp : sp;
    s = (float)ss; c = (float)cc;
}
__device__ __forceinline__ void rope_tables(cargs_t a, int gtid, int nthr) {
    unsigned char* ws = a->ws; const int* pos = a->pos;
    float* c64 = (float*)(ws + WS_C64); float* s64 = (float*)(ws + WS_S64); float* c128 = (float*)(ws + WS_C128); float* s128 = (float*)(ws + WS_S128);
    for (int i = gtid; i < M * 96; i += nthr) { const int m = i / 96, j = i - m * 96; const double p = (double)pos[m]; float s, c;
        if (j < 32) { sincos_d(p * a->invf64[j], s, c); c64[m * 32 + j] = c; s64[m * 32 + j] = s; }
        else { sincos_d(p * a->invf128[j - 32], s, c); c128[m * 64 + j - 32] = c; s128[m * 64 + j - 32] = s; } }
}
template <class Map, class Gain>
__device__ __forceinline__ void transpose_item(const float* W, int K, int N, bf16* WT, const Map& map, const Gain& gain, LAS float* scr, int item, int lane) {
    const int nblk = N / 32, kb = item / nblk, nb = item % nblk, k0 = 64 * kb, n0 = 32 * nb;
#pragma unroll 8
    for (int i = 0; i < 32; ++i) { const int kk = 2 * i + (lane >> 5); scr[kk * 33 + (lane & 31)] = W[(size_t)(k0 + kk) * N + n0 + (lane & 31)] * gain(k0 + kk); }
    LDS_WAIT(); asm volatile("" ::: "memory");
    const int c = lane & 7;
#pragma unroll
    for (int j = 0; j < 4; ++j) { const int n = (lane >> 3) + 8 * j; const LAS float* s = scr + (8 * c) * 33 + n;
        v4u o; o.x = pk2(s[0 * 33], s[1 * 33]); o.y = pk2(s[2 * 33], s[3 * 33]); o.z = pk2(s[4 * 33], s[5 * 33]); o.w = pk2(s[6 * 33], s[7 * 33]);
        *(GAS v4u*)(WT + (size_t)map(n0 + n) * K + k0 + 8 * c) = o; }
    LDS_WAIT(); asm volatile("" ::: "memory");
}
struct GainNone { __device__ __forceinline__ float operator()(int) const { return 1.0f; } };
struct GainVec { const float* g; __device__ __forceinline__ float operator()(int k) const { return g[k]; } };
struct GainVec2 { const float* g0; const float* g1; int split; __device__ __forceinline__ float operator()(int k) const { return k < split ? g0[k] : g1[k - split]; } };
struct MapId { __device__ __forceinline__ int operator()(int n) const { return n; } };
struct MapWin {
    __device__ __forceinline__ int operator()(int n) const {
        if (n < 768) return n;
        if (n < 832) { const int d = n - 768; return 768 + (d < 32 ? 2 * d : 2 * (d - 32) + 1); }
        if (n < 2880) { const int e = n - 832, g = e >> 7, d = e & 127; return 1024 + g * 128 + (d < 64 ? 2 * d : 2 * (d - 64) + 1); }
        return n + 192;
    }
};
struct MapWuq {
    __device__ __forceinline__ int operator()(int n) const { const int h = n / 192, d = n - h * 192; if (d < 128) return n; const int e = d - 128; return h * 192 + 128 + (e < 32 ? 2 * e : 2 * (e - 32) + 1); }
};
template <bool DYN>
__device__ __forceinline__ void convert_weights(cargs_t a, int l, ldsp lds, int gw, int ngw, int wave, int lane, int gtid, int nthr, unsigned* qctr) {
    unsigned char* wb = a->ws + WS_W + (size_t)(l & 1) * W_STRIDE;
    LAS float* scr = (LAS float*)(lds + RING_OFF + wave * 16384);
    bf16* Win = (bf16*)(wb + WO_WIN); bf16* Wuq = (bf16*)(wb + WO_WUQ); bf16* Wukv = (bf16*)(wb + WO_WUKV); bf16* Wo = (bf16*)(wb + WO_WO); bf16* Wup = (bf16*)(wb + WO_WUP); bf16* Wdn = (bf16*)(wb + WO_WDN);
    const float* w_in = a->w_in + (size_t)l * DM * IN_SRC; const float* w_uq = a->w_uq + (size_t)l * QLORA * 1536; const float* w_ukv = a->w_ukv + (size_t)l * KVLORA * 2048;
    const float* w_o = a->w_o + (size_t)l * DM * DM; const float* w_up = a->w_up + (size_t)l * DM * FF; const float* w_dn = a->w_down + (size_t)l * FF * DM;
    const GainVec g_in{a->attn_norm + l * DM}, g_uq{a->q_norm + l * QLORA}, g_ukv{a->kv_norm + l * KVLORA}, g_up{a->mlp_norm + l * DM}; const GainVec2 g_o{a->beta_attn + l * 1024, a->beta_ret + l * 1024, 1024};
    constexpr int I_IN = (DM / 64) * (IN_SRC / 32), I_UQ = (QLORA / 64) * (1536 / 32), I_UKV = (KVLORA / 64) * (2048 / 32), I_O = (DM / 64) * (DM / 32), I_UP = (DM / 64) * (FF / 32), I_DN = (FF / 64) * (DM / 32);
    constexpr int NITEMS = I_IN + I_UQ + I_UKV + I_O + I_UP + I_DN, CH = 16;
    GAS v4u* pz = (GAS v4u*)(Win + (size_t)832 * DM);
    for (int i = gtid; i < 192 * DM / 8; i += nthr) pz[i] = (v4u){0u, 0u, 0u, 0u};
    int it = DYN ? 0 : gw, it_end = 0;
    for (;;) {
        if constexpr (DYN) { if (it >= it_end) { unsigned c = 0u; if (lane == 0) c = __hip_atomic_fetch_add(qctr, 1u, __ATOMIC_RELAXED, __HIP_MEMORY_SCOPE_AGENT);
                it = (int)__builtin_amdgcn_readfirstlane(c) * CH; it_end = it + CH; if (it >= NITEMS) break; }
            if (it >= NITEMS) break; }
        else { if (it >= NITEMS) break; }
        int r = it;
        if (r < I_IN) transpose_item(w_in, DM, IN_SRC, Win, MapWin(), g_in, scr, r, lane);
        else if ((r -= I_IN) < I_UQ) transpose_item(w_uq, QLORA, 1536, Wuq, MapWuq(), g_uq, scr, r, lane);
        else if ((r -= I_UQ) < I_UKV) transpose_item(w_ukv, KVLORA, 2048, Wukv, MapId(), g_ukv, scr, r, lane);
        else if ((r -= I_UKV) < I_O) transpose_item(w_o, DM, DM, Wo, MapId(), g_o, scr, r, lane);
        else if ((r -= I_O) < I_UP) transpose_item(w_up, DM, FF, Wup, MapId(), g_up, scr, r, lane);
        else { r -= I_UP; transpose_item(w_dn, FF, DM, Wdn, MapId(), GainNone(), scr, r, lane); }
        it += DYN ? 1 : ngw;
    }
}
constexpr int RTAB_OFF = LDSCTL_OFF + 1024;
static_assert(RTAB_OFF + 1024 <= LDS_BYTES, "row-scale table inside the LDS allocation");
__device__ __forceinline__ void fill_rtab(const float* SS, int pm, ldsp lds, int tid) {
    if (tid < 256) { const GAS f32x4* p = (const GAS f32x4*)(SS + (size_t)(pm * 256 + tid) * 32); float s = 0.f;
#pragma unroll
        for (int j = 0; j < 8; ++j) { const f32x4 v = p[j]; s += (v.x + v.y) + (v.z + v.w); }
        ((LAS float*)(lds + RTAB_OFF))[tid] = 1.0f / sqrtf(s * (1.0f / DM) + NORM_EPS); }
    __syncthreads();
}
__device__ __forceinline__ void fill_atab(const float* ASS, int pm, ldsp lds, int tid) {
    if (tid < 256) { const GAS f32x4* p = (const GAS f32x4*)(ASS + (size_t)(pm * 256 + tid) * 8); const f32x4 a = p[0], b = p[1];
        const float s = ((a.x + a.y) + (a.z + a.w)) + ((b.x + b.y) + (b.z + b.w));
        ((LAS float*)(lds + RTAB_OFF))[tid] = 1.0f / sqrtf(s * (1.0f / 1024.0f) + NORM_EPS); }
    __syncthreads();
}
template <int NR> __device__ __forceinline__ void prep_rows(const float* x, bf16* XB, float* XSS, int row, int stride, int lane) {
    f32x4 v[NR][8]; float s[NR];
#pragma unroll
    for (int q = 0; q < NR; ++q) { const GAS f32x4* xr = (const GAS f32x4*)(x + (size_t)(row + q * stride) * DM) + lane;
#pragma unroll
        for (int j = 0; j < 8; ++j) v[q][j] = xr[64 * j]; }
#pragma unroll
    for (int q = 0; q < NR; ++q) { float t = 0.f;
#pragma unroll
        for (int j = 0; j < 8; ++j) t += (v[q][j].x * v[q][j].x + v[q][j].y * v[q][j].y) + (v[q][j].z * v[q][j].z + v[q][j].w * v[q][j].w);
        s[q] = wave_sum(t); }
#pragma unroll
    for (int q = 0; q < NR; ++q) { GAS unsigned long long* o8 = (GAS unsigned long long*)(XB + (size_t)(row + q * stride) * DM) + lane;
#pragma unroll
        for (int j = 0; j < 8; ++j) o8[64 * j] = (unsigned long long)cvtpk(v[q][j].x, v[q][j].y) | ((unsigned long long)cvtpk(v[q][j].z, v[q][j].w) << 32);
        if (lane < 32) XSS[(size_t)(row + q * stride) * 32 + lane] = (lane == 0) ? s[q] : 0.f; }
}
template <int NR> __device__ __forceinline__ void rms_rows_final(float* xo, const bf16* XB, const bf16* XL, const float* XSS, const float* g, int row, int stride, int lane) {
    v4u vh[NR][4], vl[NR][4]; float r[NR];
#pragma unroll
    for (int q = 0; q < NR; ++q) { const GAS v4u* ph = (const GAS v4u*)(XB + (size_t)(row + q * stride) * DM) + lane; const GAS v4u* pl = (const GAS v4u*)(XL + (size_t)(row + q * stride) * DM) + lane;
#pragma unroll
        for (int j = 0; j < 4; ++j) { vh[q][j] = ph[64 * j]; vl[q][j] = pl[64 * j]; }
        r[q] = (lane < 32) ? XSS[(size_t)(row + q * stride) * 32 + lane] : 0.f; }
#pragma unroll
    for (int q = 0; q < NR; ++q) r[q] = 1.0f / sqrtf(wave_sum(r[q]) * (1.0f / DM) + NORM_EPS);
#pragma unroll
    for (int q = 0; q < NR; ++q) { GAS f32x4* xr = (GAS f32x4*)(xo + (size_t)(row + q * stride) * DM) + 2 * lane;
#pragma unroll
        for (int j = 0; j < 4; ++j) { const f32x4 g0 = ((const GAS f32x4*)g)[128 * j + 2 * lane], g1 = ((const GAS f32x4*)g)[128 * j + 2 * lane + 1]; const float rr = r[q]; const v4u h = vh[q][j], w = vl[q][j];
            xr[128 * j] = (f32x4){(bf_lo(h.x) + bf_lo(w.x)) * rr * g0.x, (bf_hi(h.x) + bf_hi(w.x)) * rr * g0.y, (bf_lo(h.y) + bf_lo(w.y)) * rr * g0.z, (bf_hi(h.y) + bf_hi(w.y)) * rr * g0.w};
            xr[128 * j + 1] = (f32x4){(bf_lo(h.z) + bf_lo(w.z)) * rr * g1.x, (bf_hi(h.z) + bf_hi(w.z)) * rr * g1.y, (bf_lo(h.w) + bf_lo(w.w)) * rr * g1.z, (bf_hi(h.w) + bf_hi(w.w)) * rr * g1.w}; } }
}
template <int NR> __device__ __forceinline__ void attn_norm_rows(bf16* mix, int row, int stride, int lane) {
    v4u w[NR][2]; float r[NR];
#pragma unroll
    for (int q = 0; q < NR; ++q) { const bf16* p = mix + (size_t)(row + q * stride) * DM; w[q][0] = *(const GAS v4u*)(p + lane * 8); w[q][1] = *(const GAS v4u*)(p + 512 + lane * 8); }
#pragma unroll
    for (int q = 0; q < NR; ++q) { float s = 0.f;
#pragma unroll
        for (int j = 0; j < 2; ++j) { const v4u u = w[q][j]; const float f0 = bf_lo(u.x), f1 = bf_hi(u.x), f2 = bf_lo(u.y), f3 = bf_hi(u.y), f4 = bf_lo(u.z), f5 = bf_hi(u.z), f6 = bf_lo(u.w), f7 = bf_hi(u.w);
            s += ((f0 * f0 + f1 * f1) + (f2 * f2 + f3 * f3)) + ((f4 * f4 + f5 * f5) + (f6 * f6 + f7 * f7)); }
        r[q] = 1.0f / sqrtf(wave_sum(s) * (1.0f / 1024.0f) + NORM_EPS); }
#pragma unroll
    for (int q = 0; q < NR; ++q) { bf16* p = mix + (size_t)(row + q * stride) * DM; const float rr = r[q];
#pragma unroll
        for (int j = 0; j < 2; ++j) { const v4u u = w[q][j]; v4u o; o.x = cvtpk(bf_lo(u.x) * rr, bf_hi(u.x) * rr); o.y = cvtpk(bf_lo(u.y) * rr, bf_hi(u.y) * rr); o.z = cvtpk(bf_lo(u.z) * rr, bf_hi(u.z) * rr); o.w = cvtpk(bf_lo(u.w) * rr, bf_hi(u.w) * rr);
            *(GAS v4u*)(p + j * 512 + lane * 8) = o; } }
}

#ifdef PROBE_ATT
#ifndef PROBE_ATT_WAVE
#define PROBE_ATT_WAVE 0
#endif
#define ATP_DECL() unsigned long long atp_t_ = __builtin_readcyclecounter(), atp_acc_ = 0ull; const bool atp_on_ = (blockIdx.x == 0) && (wid == PROBE_ATT_WAVE)
#define ATP(k) do { if (atp_on_) { const unsigned long long n_ = __builtin_readcyclecounter(); if ((k) == ((PROBE_ATT) + 1) % 4) atp_acc_ += n_ - atp_t_; atp_t_ = n_; } } while (0)
#define ATP_END() do { if (atp_on_ && lane == 0) { volatile LAS unsigned long long* q_ = (volatile LAS unsigned long long*)(lds + LDSCTL_OFF + 80); q_[0] += atp_acc_; } } while (0)
#else
#define ATP_DECL() do { } while (0)
#define ATP(k) do { } while (0)
#define ATP_END() do { } while (0)
#endif
__device__ __forceinline__ float max3f(float a, float b, float c) { float r; asm("v_max3_f32 %0, %1, %2, %3" : "=v"(r) : "v"(a), "v"(b), "v"(c)); return r; }
__device__ __forceinline__ float max2f(float a, float b) { float r; asm("v_max_f32_e32 %0, %1, %2" : "=v"(r) : "v"(a), "v"(b)); return r; }
constexpr int AT_KSLOT = 64 * DQK * 2, AT_VSLOT = 64 * DV * 2, AT_K = 0, AT_V = 2 * AT_KSLOT, AT_WS = AT_V + 2 * AT_VSLOT, AT_BYTES = AT_WS + NWAVES * 256;
static_assert(AT_BYTES <= RING_BYTES, "attention LDS");
__device__ __forceinline__ void attn_unit(const bf16* Qg, const bf16* Kg, const bf16* Vg, bf16* Og, float* ASS, int b, int h, int qb, ldsp lds, int tid) {
    const int lane = tid & 63, r32 = lane & 31, hi = lane >> 5; const int wid = __builtin_amdgcn_readfirstlane(tid >> 6);
    const size_t rowbase = (size_t)b * SEQ; const int q0 = qb * 256, NT = (q0 + 256) / 64, qw0 = q0 + wid * 32;
    const bf16* Kh = Kg + rowbase * 1536 + h * DQK; const bf16* Vh = Vg + rowbase * 1024 + h * DV;
    LAS float* wsf = (LAS float*)(lds + AT_WS) + wid * 64;
    const int krow_ = lane >> 2, kpiece_ = (lane & 3) ^ (((krow_ >> 2) ^ krow_) & 3);
#define AT_DMA(t, s) do { \
        _Pragma("unroll") for (int i_ = 0; i_ < 3; ++i_) { const int c_ = wid + 8 * i_; \
            glds16(Kh + (size_t)((t) * 64 + 16 * (c_ & 3) + krow_) * 1536 + (c_ >> 2) * 32 + kpiece_ * 8, lds + AT_K + (s) * AT_KSLOT + c_ * 1024); } \
        _Pragma("unroll") for (int i_ = 0; i_ < 2; ++i_) { const int c_ = wid + 8 * i_; \
            glds16(Vh + (size_t)((t) * 64 + 16 * (c_ & 3) + (lane >> 2)) * 1024 + (c_ >> 2) * 32 + (lane & 3) * 8, lds + AT_V + (s) * AT_VSLOT + c_ * 1024); } } while (0)
    AT_DMA(0, 0);
    bf16x8 qr[12];
    { const bf16* qp = Qg + (rowbase + qw0 + r32) * 1536 + h * DQK + hi * 8;
#pragma unroll
      for (int d0 = 0; d0 < 12; ++d0) qr[d0] = *(const GAS bf16x8*)(qp + d0 * 16); }
    float m_run = 0.f, l_run = 0.f; f32x16 o[4];
#pragma unroll
    for (int d = 0; d < 4; ++d)
#pragma unroll
        for (int r = 0; r < 16; ++r) o[d][r] = 0.f;
    const int vlane = tr_att_base(lane);
    const int kfr_ = r32 & 15, kfrag_ = (r32 >> 4) * 1024 + kfr_ * 64 + ((hi ^ (((kfr_ >> 2) ^ kfr_) & 3)) << 4), kfx_ = ((kfrag_ ^ 32) - kfrag_);
    ATP_DECL();
    for (int t = 0; t < NT; ++t) {
        const int s = t & 1;
        ATP(0);
        asm volatile("s_waitcnt vmcnt(0)" ::: "memory"); SBARRIER();
        if (t + 1 < NT) AT_DMA(t + 1, s ^ 1);
        ATP(1);
        const int kbase = t * 64;
        if (kbase <= qw0 + 31) {
            f32x16 p0, p1;
            cldsp kb = lds + AT_K + s * AT_KSLOT + kfrag_;
#pragma unroll
            for (int r = 0; r < 16; ++r) { p0[r] = 0.f; p1[r] = 0.f; }
#define KFA(d) (kb + ((d) >> 1) * 4096 + (((d) & 1) ? kfx_ : 0))
            bf16x8 ka0 = *(const LAS bf16x8*)(KFA(0)), ka1 = *(const LAS bf16x8*)(KFA(0) + 2048), kb0 = *(const LAS bf16x8*)(KFA(1)), kb1 = *(const LAS bf16x8*)(KFA(1) + 2048);
#pragma unroll
            for (int d0 = 0; d0 < 12; ++d0) {
                bf16x8 kc0 = ka0, kc1 = ka1;
                if (d0 + 2 < 12) { kc0 = *(const LAS bf16x8*)(KFA(d0 + 2)); kc1 = *(const LAS bf16x8*)(KFA(d0 + 2) + 2048); }
                __builtin_amdgcn_sched_barrier(0);
                p0 = MFMA32(ka0, qr[d0], p0); p1 = MFMA32(ka1, qr[d0], p1);
                __builtin_amdgcn_sched_barrier(0);
                ka0 = kb0; ka1 = kb1; kb0 = kc0; kb1 = kc1;
            }
#undef KFA
            if (kbase + 63 > qw0) {
                const int qi = qw0 + r32; const float NEG = -__builtin_inff();
#pragma unroll
                for (int r = 0; r < 16; ++r) { const int kv = kbase + crow(r, hi); if (kv > qi) p0[r] = NEG; if (kv + 32 > qi) p1[r] = NEG; }
            }
            asm volatile("s_nop 15\n\ts_nop 7" : "+v"(p0), "+v"(p1));
            float mx;
            { float xa = max3f(p0[0], p0[1], p1[0]), xb = max3f(p0[2], p0[3], p1[1]); xa = max3f(xa, p1[2], p1[3]);
#pragma unroll
              for (int r = 4; r < 16; r += 4) { xa = max3f(xa, p0[r], p0[r + 1]); xb = max3f(xb, p0[r + 2], p0[r + 3]); xa = max3f(xa, p1[r], p1[r + 1]); xb = max3f(xb, p1[r + 2], p1[r + 3]); }
              mx = max2f(xa, xb); }
            { const auto sw_ = __builtin_amdgcn_permlane32_swap(__float_as_uint(mx), __float_as_uint(mx), false, false); mx = max2f(__uint_as_float(sw_[0]), __uint_as_float(sw_[1])); }
            asm volatile("" : "+v"(mx)); ATP(2);
            cldsp vb = lds + AT_V + s * AT_VSLOT + vlane;
            s16x4 vpre[4]; vpre[0] = trrd(vb); vpre[1] = trrd(vb + 512); vpre[2] = trrd(vb + 1024); vpre[3] = trrd(vb + 1024 + 512);
            const bool first = (t == 0);
            if (first || !__all(mx - m_run <= 8.0f)) {
                const float mn = first ? mx : fmaxf(m_run, mx);
                if (!first) { const float alpha = __builtin_amdgcn_exp2f(m_run - mn); l_run *= alpha;
                    if (hi == 0) wsf[r32] = alpha;
                    asm volatile("s_waitcnt lgkmcnt(0)" ::: "memory");
#pragma unroll
                    for (int r = 0; r < 16; ++r) { const float al = wsf[crow(r, hi)];
#pragma unroll
                        for (int d = 0; d < 4; ++d) o[d][r] *= al; } }
                m_run = mn;
            }
            float rs = 0.f;
#pragma unroll
            for (int r = 0; r < 16; ++r) { p0[r] = __builtin_amdgcn_exp2f(p0[r] - m_run); p1[r] = __builtin_amdgcn_exp2f(p1[r] - m_run); rs += p0[r] + p1[r]; }
            l_run += rs;
            bf16x8 pa[4]; pa[0] = pack8f(p0, 0); pa[1] = pack8f(p0, 8); pa[2] = pack8f(p1, 0); pa[3] = pack8f(p1, 8);
            ATP(3);
            { s16x4 c0 = vpre[0], c1 = vpre[1], c2 = vpre[2], c3 = vpre[3];
#pragma unroll
              for (int st = 0; st < 8; ++st) { const int d0 = st >> 1, k2 = (st & 1) * 2;
                s16x4 n0 = c0, n1 = c1, n2 = c2, n3 = c3;
                if (st + 1 < 8) { const int dn = (st + 1) >> 1, kn = ((st + 1) & 1) * 2; cldsp q = vb + (dn * 4 + kn) * 1024; n0 = trrd(q); n1 = trrd(q + 512); n2 = trrd(q + 1024); n3 = trrd(q + 1024 + 512); }
                __builtin_amdgcn_sched_barrier(0);
                o[d0] = MFMA32(pa[k2], MK8(c0, c1), o[d0]); o[d0] = MFMA32(pa[k2 + 1], MK8(c2, c3), o[d0]);
                __builtin_amdgcn_sched_barrier(0);
                c0 = n0; c1 = n1; c2 = n2; c3 = n3; } }
        }
    }
    ATP(0); ATP_END();
    l_run += __shfl_xor(l_run, 32);
    if (hi == 0) wsf[32 + r32] = l_run;
    asm volatile("s_waitcnt lgkmcnt(0)" ::: "memory");
    bf16* Ow = Og + (rowbase + qw0) * DM + h * DV;
#define DPPF_(x, ctrl) __builtin_bit_cast(float, __builtin_amdgcn_mov_dpp(__builtin_bit_cast(int, x), ctrl, 0xf, 0xf, true))
#pragma unroll
    for (int r = 0; r < 16; ++r) { const int orow = crow(r, hi); const float rl = 1.0f / wsf[32 + orow]; float sq = 0.f;
#pragma unroll
        for (int d0 = 0; d0 < 4; ++d0) { const float v = o[d0][r] * rl; const float vn = __shfl_xor(v, 1); sq += v * v;
            if ((r32 & 1) == 0) *(GAS unsigned*)(Ow + (size_t)orow * DM + d0 * 32 + r32) = cvtpk(v, vn); }
        sq += DPPF_(sq, 0xB1); sq += DPPF_(sq, 0x4E); sq += DPPF_(sq, 0x124); sq += DPPF_(sq, 0x128);
        { const auto sw_ = __builtin_amdgcn_permlane16_swap(__float_as_uint(sq), __float_as_uint(sq), false, false); sq = __uint_as_float(sw_[0]) + __uint_as_float(sw_[1]); }
        if (r32 == 0) wsf[orow] = sq; }
    asm volatile("s_waitcnt lgkmcnt(0)" ::: "memory");
    { int rr_ = r32; asm volatile("" : "+v"(rr_)); if (hi == 0) ASS[(rowbase + qw0 + rr_) * 8 + h] = wsf[rr_]; }
#undef DPPF_
    asm volatile("s_waitcnt lgkmcnt(0)" ::: "memory"); SBARRIER();
#undef AT_DMA
}

constexpr int RT_K = 0, RT_V = 32768, RT_S = 65536, RT_O = 0, RT_OSTRIDE = 132;
static_assert(RT_S + 32768 <= RING_BYTES && RT_O + 128 * RT_OSTRIDE * 4 + 1024 <= RING_BYTES, "retention LDS");
__device__ __forceinline__ void ret_state_unit(const bf16* RK, const bf16* RV, float* U, int bh, int c, float lg2g, ldsp lds, int tid) {
    const int lane = tid & 63, r32 = lane & 31, hi = lane >> 5; const int wid = __builtin_amdgcn_readfirstlane(tid >> 6);
    const int b = bh >> 3, h = bh & 7; const size_t row0 = (size_t)b * SEQ + (size_t)c * RCH;
#pragma unroll
    for (int i = 0; i < 4; ++i) { const int ch = wid * 4 + i, cb = ch >> 3, ks = ch & 7; const size_t tok = row0 + 16 * ks + (lane >> 2); const int col = h * 128 + cb * 32 + (lane & 3) * 8;
        glds16(RK + tok * 1024 + col, lds + RT_K + ch * 1024);
        const v4u w = *(const GAS v4u*)(RV + tok * 1024 + col); const float z = __builtin_amdgcn_exp2f(lg2g * (float)(127 - (16 * ks + (lane >> 2))));
        v4u o; o.x = cvtpk(bf_lo(w.x) * z, bf_hi(w.x) * z); o.y = cvtpk(bf_lo(w.y) * z, bf_hi(w.y) * z); o.z = cvtpk(bf_lo(w.z) * z, bf_hi(w.z) * z); o.w = cvtpk(bf_lo(w.w) * z, bf_hi(w.w) * z);
        *(LAS v4u*)(lds + RT_V + ch * 1024 + lane * 16) = o; }
    asm volatile("s_waitcnt vmcnt(0) lgkmcnt(0)" ::: "memory"); SBARRIER();
    const int dkb = wid >> 1, dvb0 = (wid & 1) * 2; const int nb = tr_nat_base(lane);
    f32x16 acc[2];
#pragma unroll
    for (int r = 0; r < 16; ++r) { acc[0][r] = 0.f; acc[1][r] = 0.f; }
#pragma unroll
    for (int ks = 0; ks < 8; ++ks) { cldsp ka = lds + RT_K + (dkb * 8 + ks) * 1024 + nb; const s16x4 al = trrd(ka), ah = trrd(ka + 256); const bf16x8 A = MK8(al, ah);
#pragma unroll
        for (int j = 0; j < 2; ++j) { cldsp vb = lds + RT_V + ((dvb0 + j) * 8 + ks) * 1024 + nb; const s16x4 bl = trrd(vb), bh2 = trrd(vb + 256); acc[j] = MFMA32(A, MK8(bl, bh2), acc[j]); } }
    float* Uu = U + ((size_t)bh * NCH + c) * 16384;
#pragma unroll
    for (int j = 0; j < 2; ++j)
#pragma unroll
        for (int r = 0; r < 16; ++r) Uu[(dkb * 32 + crow(r, hi)) * 128 + (dvb0 + j) * 32 + r32] = acc[j][r];
    asm volatile("s_waitcnt lgkmcnt(0)" ::: "memory"); SBARRIER();
}
__device__ __forceinline__ void ret_scan(const float* U, bf16* S, cargs_t a, int gtid, int nthr) {
    for (int it = gtid; it < 16 * 8192; it += nthr) { const int bh = it >> 13, e2 = it & 8191; const float g = __builtin_amdgcn_exp2f(128.0f * a->lg2g[bh & 7]);
        const float* up = U + (size_t)bh * NCH * 16384 + e2 * 2; bf16* sp = S + (size_t)bh * NCH * 16384 + e2 * 2; float s0 = 0.f, s1 = 0.f;
#pragma unroll 8
        for (int c = 0; c < NCH; ++c) { *(GAS unsigned*)(sp + (size_t)c * 16384) = cvtpk(s0, s1); const f32x2 u = *(const GAS f32x2*)(up + (size_t)c * 16384); s0 = s0 * g + u.x; s1 = s1 * g + u.y; } }
}
__device__ __forceinline__ void ret_out_unit(const bf16* RQ, const bf16* RK, const bf16* RV, const bf16* RG, const bf16* S, bf16* MIX, int bh, int c, float lg2g, ldsp lds, int tid) {
    const int lane = tid & 63, r32 = lane & 31, hi = lane >> 5; const int wid = __builtin_amdgcn_readfirstlane(tid >> 6);
    const int b = bh >> 3, h = bh & 7; const size_t row0 = (size_t)b * SEQ + (size_t)c * RCH;
    const int rb = wid & 3, dh = wid >> 2;
    const bf16* Ss = S + ((size_t)bh * NCH + c) * 16384;
#pragma unroll
    for (int i = 0; i < 4; ++i) { const int id = wid * 4 + i;
        glds16(RK + (row0 + (id & 1) * 64 + lane) * 1024 + h * 128 + (id >> 1) * 8, lds + RT_K + id * 1024);
        const int cb = id >> 3, ks = id & 7;
        glds16(RV + (row0 + 16 * ks + (lane >> 2)) * 1024 + h * 128 + cb * 32 + (lane & 3) * 8, lds + RT_V + id * 1024);
        glds16(Ss + (16 * ks + (lane >> 2)) * 128 + cb * 32 + (lane & 3) * 8, lds + RT_S + id * 1024); }
    unsigned gate[16];
#pragma unroll
    for (int i = 0; i < 16; ++i) gate[i] = *(const GAS unsigned*)(RG + (row0 + wid * 16 + i) * 1024 + h * 128 + 2 * lane);
    bf16x8 qr[8];
    { const bf16* qp = RQ + (row0 + rb * 32 + r32) * 1024 + h * 128 + hi * 8;
#pragma unroll
      for (int d0 = 0; d0 < 8; ++d0) qr[d0] = *(const GAS bf16x8*)(qp + d0 * 16); }
    asm volatile("s_waitcnt vmcnt(0)" ::: "memory"); SBARRIER();
    f32x16 o[2];
#pragma unroll
    for (int r = 0; r < 16; ++r) { o[0][r] = 0.f; o[1][r] = 0.f; }
    { const int nb = tr_nat_base(lane);
#pragma unroll
      for (int ks = 0; ks < 8; ++ks)
#pragma unroll
          for (int j = 0; j < 2; ++j) { cldsp sb = lds + RT_S + ((dh * 2 + j) * 8 + ks) * 1024 + nb; const s16x4 bl = trrd(sb), bh2 = trrd(sb + 256); o[j] = MFMA32(qr[ks], MK8(bl, bh2), o[j]); }
#pragma unroll
      for (int r = 0; r < 16; ++r) { const float xi = __builtin_amdgcn_exp2f(lg2g * (float)(rb * 32 + crow(r, hi) + 1)); o[0][r] *= xi; o[1][r] *= xi; } }
    const int ab = tr_att_base(lane);
    for (int kb = 0; kb <= rb; ++kb) {
        f32x16 p;
#pragma unroll
        for (int r = 0; r < 16; ++r) p[r] = 0.f;
        cldsp kp = lds + RT_K + hi * 2048 + (kb * 32 + r32) * 16;
#pragma unroll
        for (int d0 = 0; d0 < 8; ++d0) { const bf16x8 ka = *(const LAS bf16x8*)(kp + d0 * 4096); p = MFMA32(ka, qr[d0], p); }
        const int qi = rb * 32 + r32;
#pragma unroll
        for (int r = 0; r < 16; ++r) { const int kj = kb * 32 + crow(r, hi); const float dcy = __builtin_amdgcn_exp2f(lg2g * (float)(qi - kj)); p[r] = (qi >= kj) ? p[r] * dcy : 0.f; }
        const bf16x8 pa0 = pack8f(p, 0), pa1 = pack8f(p, 8);
#pragma unroll
        for (int j = 0; j < 2; ++j) { cldsp vb = lds + RT_V + ((dh * 2 + j) * 8 + kb * 2) * 1024 + ab;
            { const s16x4 lo = trrd(vb), hh = trrd(vb + 512); o[j] = MFMA32(pa0, MK8(lo, hh), o[j]); }
            { const s16x4 lo = trrd(vb + 1024), hh = trrd(vb + 1024 + 512); o[j] = MFMA32(pa1, MK8(lo, hh), o[j]); } }
    }
    asm volatile("s_waitcnt lgkmcnt(0)" ::: "memory"); SBARRIER();
    LAS float* ob = (LAS float*)(lds + RT_O);
#pragma unroll
    for (int j = 0; j < 2; ++j)
#pragma unroll
        for (int r = 0; r < 16; ++r) ob[(rb * 32 + crow(r, hi)) * RT_OSTRIDE + (dh * 2 + j) * 32 + r32] = o[j][r];
    asm volatile("s_waitcnt lgkmcnt(0)" ::: "memory"); SBARRIER();
    { const int srow = tid >> 2, sq = tid & 3; const LAS float* rp = ob + srow * RT_OSTRIDE + 16 * sq; float s1 = 0.f, s2 = 0.f;
#pragma unroll
      for (int j = 0; j < 2; ++j)
#pragma unroll
          for (int i = 0; i < 4; ++i) { const f32x4 v = *(const LAS f32x4*)(rp + 64 * j + 4 * i); s1 += (v.x + v.y) + (v.z + v.w); s2 += (v.x * v.x + v.y * v.y) + (v.z * v.z + v.w * v.w); }
      s1 += __builtin_bit_cast(float, __builtin_amdgcn_mov_dpp(__builtin_bit_cast(int, s1), 0xB1, 0xf, 0xf, true)); s2 += __builtin_bit_cast(float, __builtin_amdgcn_mov_dpp(__builtin_bit_cast(int, s2), 0xB1, 0xf, 0xf, true));
      s1 += __builtin_bit_cast(float, __builtin_amdgcn_mov_dpp(__builtin_bit_cast(int, s1), 0x4E, 0xf, 0xf, true)); s2 += __builtin_bit_cast(float, __builtin_amdgcn_mov_dpp(__builtin_bit_cast(int, s2), 0x4E, 0xf, 0xf, true));
      const float mu = s1 * (1.0f / 128.0f), var = fmaxf(s2 * (1.0f / 128.0f) - mu * mu, 0.f);
      if (sq == 0) *(LAS f32x2*)(ob + 128 * RT_OSTRIDE + 2 * srow) = (f32x2){mu, 1.0f / sqrtf(var + GN_EPS)}; }
    asm volatile("s_waitcnt lgkmcnt(0)" ::: "memory"); SBARRIER();
#pragma unroll
    for (int i = 0; i < 16; ++i) { const int rr = wid * 16 + i; const f32x2 v = *(const LAS f32x2*)(ob + rr * RT_OSTRIDE + 2 * lane); const f32x2 st = *(const LAS f32x2*)(ob + 128 * RT_OSTRIDE + 2 * rr);
        *(GAS unsigned*)(MIX + (row0 + rr) * DM + 1024 + h * 128 + 2 * lane) = cvtpk((v.x - st.x) * st.y * bf_lo(gate[i]), (v.y - st.x) * st.y * bf_hi(gate[i])); }
    asm volatile("s_waitcnt lgkmcnt(0)" ::: "memory"); SBARRIER();
}


#define PHASE_IDS() int tid = tid0; asm volatile("" : "+v"(tid)); int G = G0, bx = bx0; asm volatile("" : "+s"(G), "+s"(bx)); \
    const int lane = tid & 63; const int wave = __builtin_amdgcn_readfirstlane(tid >> 6); const int vcu = (G % 8 == 0) ? (bx % 8) * (G / 8) + bx / 8 : bx; (void)lane; (void)wave; (void)vcu
#define GW (vcu * NWAVES + wave)
#define NGW (G * NWAVES)
#define GTID (vcu * (NWAVES * 64) + tid)
#define NTHR (G * NWAVES * 64)
#ifndef PG_ALIGN
#define PG_ALIGN true
#endif
#define XBAR() xcd_barrier(bar)
#ifdef PROBE_SPAN
#ifndef PROBE_BLOCK
#define PROBE_BLOCK 0
#endif
#ifdef PROBE_CLK
#define PTIME() __builtin_readcyclecounter()
#else
#define PTIME() __builtin_amdgcn_s_memrealtime()
#endif
#ifdef PROBE_PRE
#define STAMP(k) do { if (tid0 == 0 && bx0 == PROBE_BLOCK) { volatile LAS unsigned long long* ts_ = (volatile LAS unsigned long long*)(lds + LDSCTL_OFF + 64); if ((k) == PROBE_SPAN) ts_[0] = PTIME(); } } while (0)
#define STAMP_PRE(k) do { if (tid0 == 0 && bx0 == PROBE_BLOCK) { volatile LAS unsigned long long* ts_ = (volatile LAS unsigned long long*)(lds + LDSCTL_OFF + 64); if ((k) == PROBE_SPAN + 1) ts_[1] += PTIME() - ts_[0]; } } while (0)
#else
#define STAMP(k) do { if (tid0 == 0 && bx0 == PROBE_BLOCK) { volatile LAS unsigned long long* ts_ = (volatile LAS unsigned long long*)(lds + LDSCTL_OFF + 64); const unsigned long long t_ = PTIME(); \
    if ((k) == PROBE_SPAN) ts_[0] = t_; if ((k) == PROBE_SPAN + 1) ts_[1] += t_ - ts_[0]; } } while (0)
#define STAMP_PRE(k) do { } while (0)
#endif
#else
#define STAMP(k) do { } while (0)
#define STAMP_PRE(k) do { } while (0)
#endif
template <int l> __device__ __forceinline__ void layer_body(const int tid0, const int G0, const int bx0, const ldsp lds, const XcdBarrier& bar) {
    STAMP(0);
#ifdef PROBE_IDLE
    { const unsigned long long t0_ = __builtin_amdgcn_s_memrealtime(); while (__builtin_amdgcn_s_memrealtime() - t0_ < (unsigned long long)(PROBE_IDLE) * 100ull) __builtin_amdgcn_s_sleep(32); }
#endif
    { PHASE_IDS(); cargs_t a = get_args(); unsigned char* ws = a->ws; unsigned char* wb = ws + WS_W + (size_t)(l & 1) * W_STRIDE;
      pg8::Gemm g{(bf16*)(ws + WS_XB), (bf16*)(wb + WO_WIN), M, IN_PAD, DM}; pg8::StaticOrder S; S.init(M, IN_PAD, G, bx);
      pg8::Unit u0_; const int pm0_ = S.next(0, u0_) ? u0_.pm : 0; fill_rtab((const float*)(ws + WS_XSS2), pm0_, lds, tid);
      pg8::EpiIn E{(const float*)(ws + WS_XSS2), (bf16*)(ws + WS_CQ), (bf16*)(ws + WS_CKV), (float*)(ws + WS_CQSS), (float*)(ws + WS_CKVSS), (bf16*)(ws + WS_K), (const float*)(ws + WS_C64), (const float*)(ws + WS_S64),
                   (bf16*)(ws + WS_RQ), (bf16*)(ws + WS_RK), (bf16*)(ws + WS_RV), (bf16*)(ws + WS_RG), (const float*)(ws + WS_C128), (const float*)(ws + WS_S128), (const LAS float*)(lds + RTAB_OFF), pm0_};
      pg8::gemm_phase<pg8::EpiIn, pg8::StaticOrder, PG_ALIGN, true>(lds + RING_OFF, g, S, E); }
    STAMP_PRE(1); XBAR(); STAMP(1);
    { PHASE_IDS(); cargs_t a = get_args(); unsigned char* ws = a->ws; unsigned char* wb = ws + WS_W + (size_t)(l & 1) * W_STRIDE;
      pg8::Gemm g{(bf16*)(ws + WS_CQ), (bf16*)(wb + WO_WUQ), M, 1536, QLORA}; pg8::StaticOrder S; S.init(M, 1536, G, bx);
      pg8::EpiQ E{(const float*)(ws + WS_CQSS), (bf16*)(ws + WS_Q), (const float*)(ws + WS_C64), (const float*)(ws + WS_S64), QSCALE};
      pg8::gemm_phase<pg8::EpiQ, pg8::StaticOrder, PG_ALIGN, true>(lds + RING_OFF, g, S, E); }
    __syncthreads();
    { PHASE_IDS(); cargs_t a = get_args(); unsigned char* ws = a->ws; unsigned char* wb = ws + WS_W + (size_t)(l & 1) * W_STRIDE;
      pg8::Gemm g{(bf16*)(ws + WS_CKV), (bf16*)(wb + WO_WUKV), M, 2048, KVLORA}; pg8::StaticOrder S; S.init(M, 2048, G, bx);
      pg8::EpiKV E{(const float*)(ws + WS_CKVSS), (bf16*)(ws + WS_K), (bf16*)(ws + WS_V)};
      pg8::gemm_phase<pg8::EpiKV, pg8::StaticOrder, PG_ALIGN, true>(lds + RING_OFF, g, S, E); }
    __syncthreads();
    { PHASE_IDS(); cargs_t a = get_args(); unsigned char* ws = a->ws;
      for (int u = vcu; u < 16 * NCH; u += G) ret_state_unit((const bf16*)(ws + WS_RK), (const bf16*)(ws + WS_RV), (float*)(ws + WS_U), u >> 6, u & 63, a->lg2g[(u >> 6) & 7], lds + RING_OFF, tid); }
    STAMP_PRE(2); XBAR(); STAMP(2);
    { PHASE_IDS(); cargs_t a = get_args(); unsigned char* ws = a->ws;
      for (int u = vcu; u < 256; u += G) { const int bh = u >> 4, x = u & 15;
        attn_unit((const bf16*)(ws + WS_Q), (const bf16*)(ws + WS_K), (const bf16*)(ws + WS_V), (bf16*)(ws + WS_MIX), (float*)(ws + WS_ASS), bh >> 3, bh & 7, 31 - x, lds + RING_OFF, tid);
        attn_unit((const bf16*)(ws + WS_Q), (const bf16*)(ws + WS_K), (const bf16*)(ws + WS_V), (bf16*)(ws + WS_MIX), (float*)(ws + WS_ASS), bh >> 3, bh & 7, x, lds + RING_OFF, tid); } }
    { PHASE_IDS(); cargs_t a = get_args(); unsigned char* ws = a->ws; ret_scan((const float*)(ws + WS_U), (bf16*)(ws + WS_S), a, GTID, NTHR); }
    if (l + 1 < DEPTH) { PHASE_IDS(); cargs_t a = get_args(); __syncthreads(); convert_weights<true>(a, l + 1, lds, GW, NGW, wave, lane, GTID, NTHR, (unsigned*)((gu32*)(a->ws + WS_CTL) + CW_WQ + l * 64)); }
    STAMP_PRE(3); XBAR(); STAMP(3);
    { PHASE_IDS(); cargs_t a = get_args(); unsigned char* ws = a->ws;
      for (int u = vcu; u < 16 * NCH; u += G) ret_out_unit((const bf16*)(ws + WS_RQ), (const bf16*)(ws + WS_RK), (const bf16*)(ws + WS_RV), (const bf16*)(ws + WS_RG), (const bf16*)(ws + WS_S), (bf16*)(ws + WS_MIX),
                                                          u >> 6, u & 63, a->lg2g[(u >> 6) & 7], lds + RING_OFF, tid); }
    STAMP_PRE(4); XBAR(); STAMP(4);
    { PHASE_IDS(); cargs_t a = get_args(); unsigned char* ws = a->ws; unsigned char* wb = ws + WS_W + (size_t)(l & 1) * W_STRIDE;
      pg8::Gemm g{(bf16*)(ws + WS_MIX), (bf16*)(wb + WO_WO), M, DM, DM}; pg8::StaticOrder S; S.init(M, DM, G, bx);
      pg8::Unit u0_; const int pm0_ = S.next(0, u0_) ? u0_.pm : 0; fill_atab((const float*)(ws + WS_ASS), pm0_, lds, tid);
      typedef pg8::EpiResT<false, (l == 0), true> EpiR; EpiR E{a->x, (bf16*)(ws + WS_XB), (bf16*)(ws + WS_XL), (float*)(ws + WS_XSS), (const float*)(ws + WS_ASS), (const LAS float*)(lds + RTAB_OFF), pm0_};
      pg8::gemm_phase<EpiR, pg8::StaticOrder, PG_ALIGN, true>(lds + RING_OFF, g, S, E); }
    STAMP_PRE(5); XBAR(); STAMP(5);
    { PHASE_IDS(); cargs_t a = get_args(); unsigned char* ws = a->ws; unsigned char* wb = ws + WS_W + (size_t)(l & 1) * W_STRIDE;
      pg8::Gemm g{(bf16*)(ws + WS_XB), (bf16*)(wb + WO_WUP), M, FF, DM}; pg8::StaticOrder S; S.init(M, FF, G, bx);
      pg8::EpiRelu2 E{(bf16*)(ws + WS_UF), FF};
      pg8::gemm_phase<pg8::EpiRelu2, pg8::StaticOrder, PG_ALIGN, true>(lds + RING_OFF, g, S, E); }
    STAMP_PRE(6); XBAR(); STAMP(6);
    { PHASE_IDS(); cargs_t a = get_args(); unsigned char* ws = a->ws; unsigned char* wb = ws + WS_W + (size_t)(l & 1) * W_STRIDE;
      pg8::Gemm g{(bf16*)(ws + WS_UF), (bf16*)(wb + WO_WDN), M, DM, FF}; pg8::StaticOrder S; S.init(M, DM, G, bx);
      pg8::Unit u0_; const int pm0_ = S.next(0, u0_) ? u0_.pm : 0; fill_rtab((const float*)(ws + WS_XSS), pm0_, lds, tid);
      typedef pg8::EpiResT<true, false> EpiR; EpiR E{nullptr, (bf16*)(ws + WS_XB), (bf16*)(ws + WS_XL), (float*)(ws + WS_XSS2), (const float*)(ws + WS_XSS), (const LAS float*)(lds + RTAB_OFF), pm0_};
      pg8::gemm_phase<EpiR, pg8::StaticOrder, PG_ALIGN, true>(lds + RING_OFF, g, S, E); }
    STAMP_PRE(7); XBAR(); STAMP(7);
}

__global__ void __launch_bounds__(NWAVES * 64, 2) fwd_kernel(Args args_in_kernarg) {
    extern __shared__ __attribute__((aligned(16))) unsigned char lds_raw[];
    const ldsp lds = (ldsp)lds_raw;
    volatile LAS unsigned* MISC = (volatile LAS unsigned*)(lds + MISC_OFF);
    const int tid0 = threadIdx.x; const int G0 = gridDim.x, bx0 = blockIdx.x;
    for (int u = tid0; u < (LDS_BYTES - LDSCTL_OFF) / 4; u += NWAVES * 64) ((LAS unsigned*)(lds + LDSCTL_OFF))[u] = 0u;
    __syncthreads();
    XcdBarrier bar;
    { PHASE_IDS(); cargs_t a = get_args(); bar = xcd_barrier_post((unsigned*)((gu32*)(a->ws + WS_CTL) + CW_BAR), MISC + 8); }
    { PHASE_IDS(); cargs_t a = get_args();
      rope_tables(a, GTID, NTHR);
      convert_weights<false>(a, 0, lds, GW, NGW, wave, lane, GTID, NTHR, nullptr);
      const float* x = a->x; bf16* XB = (bf16*)(a->ws + WS_XB); float* XSS = (float*)(a->ws + WS_XSS2);
      { int m = GW; for (; m + NGW < M; m += 2 * NGW) prep_rows<2>(x, XB, XSS, m, NGW, lane); for (; m < M; m += NGW) prep_rows<1>(x, XB, XSS, m, NGW, lane); } }
    XBAR();

    layer_body<0>(tid0, G0, bx0, lds, bar);
    layer_body<1>(tid0, G0, bx0, lds, bar);
    layer_body<2>(tid0, G0, bx0, lds, bar);
    layer_body<3>(tid0, G0, bx0, lds, bar);
    { PHASE_IDS(); cargs_t a = get_args(); float* xo = a->out; const float* g = a->final_norm; const float* XSS = (const float*)(a->ws + WS_XSS2); const bf16* XB = (const bf16*)(a->ws + WS_XB); const bf16* XL = (const bf16*)(a->ws + WS_XL);
      { int m = GW; for (; m + NGW < M; m += 2 * NGW) rms_rows_final<2>(xo, XB, XL, XSS, g, m, NGW, lane); for (; m < M; m += NGW) rms_rows_final<1>(xo, XB, XL, XSS, g, m, NGW, lane); } }
#if defined(PROBE_ATT) || defined(PROBE_R3)
    if (tid0 == 0 && bx0 == 0) { volatile LAS unsigned long long* q_ = (volatile LAS unsigned long long*)(lds + LDSCTL_OFF + 80); const unsigned long long T_ = q_[0] / 3ull, t0_ = __builtin_amdgcn_s_memrealtime();
        while (__builtin_amdgcn_s_memrealtime() - t0_ < T_) __builtin_amdgcn_s_sleep(8); }
#endif
#ifdef PROBE_SPAN
    if (tid0 == 0 && bx0 == PROBE_BLOCK) { volatile LAS unsigned long long* ts_ = (volatile LAS unsigned long long*)(lds + LDSCTL_OFF + 64);
#ifdef PROBE_CLK
        const unsigned long long T_ = ts_[1] / 3ull,
#else
        const unsigned long long T_ = ts_[1] * 8ull,
#endif
        t0_ = __builtin_amdgcn_s_memrealtime();
        while (__builtin_amdgcn_s_memrealtime() - t0_ < T_) __builtin_amdgcn_s_sleep(8); }
#endif
}

extern "C" void kernel_launch(void* const* d_in, const int* in_sizes, int n_in, void* d_out, int out_size, void* d_ws, size_t ws_size, hipStream_t stream) {
    static int grid = 0;
    if (grid == 0) {
        if (n_in != 15 || in_sizes[0] != M * DM || out_size != M * DM || ws_size < WS_END) { fprintf(stderr, "kernel_launch: unexpected shapes (n_in %d, in0 %d, out %d, ws %zu, need %zu); nothing launched\n", n_in, n_in > 0 ? in_sizes[0] : -1, out_size, ws_size, (size_t)WS_END); grid = -1; return; }
        int dev = 0, cus = 0, per_cu = 0;
        if (hipGetDevice(&dev) != hipSuccess || hipDeviceGetAttribute(&cus, hipDeviceAttributeMultiprocessorCount, dev) != hipSuccess) { fprintf(stderr, "kernel_launch: device query failed\n"); grid = -1; return; }
        if (hipFuncSetAttribute((const void*)fwd_kernel, hipFuncAttributeMaxDynamicSharedMemorySize, LDS_BYTES) != hipSuccess) { fprintf(stderr, "kernel_launch: hipFuncSetAttribute failed\n"); grid = -1; return; }
        if (hipOccupancyMaxActiveBlocksPerMultiprocessor(&per_cu, (const void*)fwd_kernel, NWAVES * 64, LDS_BYTES) != hipSuccess || per_cu < 1)
            fprintf(stderr, "kernel_launch: note: occupancy query reports %d workgroups per CU\n", per_cu);
        (void)hipGetLastError();
        grid = cus;
    }
    if (grid < 0) return;
    if (hipMemsetAsync((char*)d_ws + WS_CTL, 0, CTL_ZERO_BYTES, stream) != hipSuccess) { fprintf(stderr, "kernel_launch: hipMemsetAsync failed\n"); return; }
    Args a{};
    a.x = (const float*)d_in[0]; a.pos = (const int*)d_in[1]; a.attn_norm = (const float*)d_in[2]; a.w_in = (const float*)d_in[3]; a.q_norm = (const float*)d_in[4]; a.kv_norm = (const float*)d_in[5];
    a.w_uq = (const float*)d_in[6]; a.w_ukv = (const float*)d_in[7]; a.beta_attn = (const float*)d_in[8]; a.beta_ret = (const float*)d_in[9]; a.w_o = (const float*)d_in[10]; a.mlp_norm = (const float*)d_in[11];
    a.w_up = (const float*)d_in[12]; a.w_down = (const float*)d_in[13]; a.final_norm = (const float*)d_in[14];
    a.out = (float*)d_out; a.ws = (unsigned char*)d_ws;
    for (int j = 0; j < 32; ++j) a.invf64[j] = pow(10000.0, -(double)(2 * j) / 64.0);
    for (int j = 0; j < 64; ++j) a.invf128[j] = pow(10000.0, -(double)(2 * j) / 128.0);
    for (int h = 0; h < 8; ++h) a.lg2g[h] = (float)(log1p(-exp2(-5.0 - (double)h)) / log(2.0));
    hipLaunchKernelGGL(fwd_kernel, dim3(grid), dim3(NWAVES * 64), LDS_BYTES, stream, a);
    const hipError_t le = hipPeekAtLastError();
    if (le != hipSuccess) fprintf(stderr, "kernel_launch: launch failed: %s\n", hipGetErrorName(le));
}
```
